# Optimizing an MI355X kernel written in HIP

```python
import jax, jax.numpy as jnp
from jax import lax
import numpy as np

D_MODEL = 1024
BATCH = 8
SEQ = 4096
DEPTH = 2

HEAD_DIM = 64
MIX_HEADS = D_MODEL // HEAD_DIM
A_HEADS = MIX_HEADS // 2
B_HEADS = MIX_HEADS - A_HEADS
C_HEADS = MIX_HEADS
C_KV_HEADS = max(1, C_HEADS // 8)
A_WIDTH = A_HEADS * HEAD_DIM
B_WIDTH = B_HEADS * HEAD_DIM
C_WIDTH = C_HEADS * HEAD_DIM
C_KV_WIDTH = C_KV_HEADS * HEAD_DIM
EVEN_IN = 4 * A_WIDTH + 4 * B_WIDTH
ODD_IN = 2 * C_WIDTH + 2 * C_KV_WIDTH
DILATED_PAIRS = ((128, 1), (512, 4), (2048, 16))
MOBA_BLOCK = 256
MOBA_TOPK = 3
MOBA_QCHUNK = 32
C_WINDOW = 128
BAND_BLOCK = 128
ROPE_THETA = 10000.0
NORM_EPS = 1e-6
NEG_INF = -1e30
N_EVEN = (DEPTH + 1) // 2
N_ODD = DEPTH // 2

kernel_name = "hybrid_dilated_moba_swa_sink_trunk"


def rms_norm(x, g):
    xf = x.astype(jnp.float32)
    xf = xf * lax.rsqrt(jnp.mean(xf * xf, axis=-1, keepdims=True) + NORM_EPS)
    return xf.astype(x.dtype) * g


def rope_tables(seq):
    pos = jnp.arange(seq, dtype=jnp.float32)
    inv_freq = ROPE_THETA ** (-jnp.arange(0, HEAD_DIM, 2, dtype=jnp.float32) / HEAD_DIM)
    ang = pos[:, None] * inv_freq[None, :]
    ang = jnp.concatenate([ang, ang], axis=-1)
    return jnp.cos(ang), jnp.sin(ang)


def apply_rope(t, cos, sin):
    tf = t.astype(jnp.float32)
    t1, t2 = jnp.split(tf, 2, axis=-1)
    rot = jnp.concatenate([-t2, t1], axis=-1)
    return (tf * cos + rot * sin).astype(t.dtype)


def qk_prep(t, g, cos, sin):
    return apply_rope(rms_norm(t, g), cos, sin)


def to_heads(t, n_heads):
    b, s, _ = t.shape
    return t.reshape(b, s, n_heads, HEAD_DIM).transpose(0, 2, 1, 3)


def from_heads(t):
    b, h, s, d = t.shape
    return t.transpose(0, 2, 1, 3).reshape(b, s, h * d)


def split_cols(t, widths):
    parts, start = [], 0
    for w in widths:
        parts.append(t[..., start:start + w])
        start += w
    return parts


def banded_attention(q, k, v, max_dist, sinks=None):
    n, hk, g, seq, d = q.shape
    nq = -(-seq // BAND_BLOCK)
    lp = nq * BAND_BLOCK
    qb = jnp.pad(q, ((0, 0), (0, 0), (0, 0), (0, lp - seq), (0, 0))).reshape(n, hk, g, nq, BAND_BLOCK, d)
    kv_pad = ((0, 0), (0, 0), (BAND_BLOCK, lp - seq), (0, 0))

    def windows(t):
        tb = jnp.pad(t, kv_pad).reshape(n, hk, nq + 1, BAND_BLOCK, d)
        return jnp.concatenate([tb[:, :, :-1], tb[:, :, 1:]], axis=3)

    kw, vw = windows(k), windows(v)
    s = jnp.einsum('nhgcqd,nhckd->nhgcqk', qb, kw, preferred_element_type=jnp.float32) * (d ** -0.5)
    blk = jnp.arange(nq)[:, None, None]
    qi = jnp.arange(BAND_BLOCK)[None, :, None]
    kj = jnp.arange(2 * BAND_BLOCK)[None, None, :]
    dist = BAND_BLOCK + qi - kj
    kpos = (blk - 1) * BAND_BLOCK + kj
    mask = (dist >= 0) & (dist <= max_dist) & (kpos >= 0)
    s = jnp.where(mask, s, NEG_INF)
    m = jnp.max(s, axis=-1)
    if sinks is not None:
        sk = sinks.astype(jnp.float32)[None, :, :, None, None]
        m = jnp.maximum(m, sk)
    p = jnp.exp(s - m[..., None])
    l = jnp.sum(p, axis=-1)
    if sinks is not None:
        l = l + jnp.exp(sk - m)
    o = jnp.einsum('nhgcqk,nhckd->nhgcqd', p, vw.astype(jnp.float32)) / l[..., None]
    lse = m + jnp.log(l)
    o = o.reshape(n, hk, g, lp, d)[:, :, :, :seq]
    lse = lse.reshape(n, hk, g, lp)[:, :, :, :seq]
    return o, lse


def dilated_mixture_attention(q, k, v):
    b, h, seq, d = q.shape
    outs, lses = [], []
    for window, dil in DILATED_PAIRS:
        sub = seq // dil

        def to_sub(t):
            return t.reshape(b, h, sub, dil, d).transpose(0, 3, 1, 2, 4).reshape(b * dil, h, sub, d)

        o, lse = banded_attention(to_sub(q)[:, :, None], to_sub(k), to_sub(v), window // dil)
        outs.append(o[:, :, 0].reshape(b, dil, h, sub, d).transpose(0, 2, 3, 1, 4).reshape(b, h, seq, d))
        lses.append(lse[:, :, 0].reshape(b, dil, h, sub).transpose(0, 2, 3, 1).reshape(b, h, seq))
    w = jax.nn.softmax(jnp.stack(lses, axis=0), axis=0)
    return jnp.sum(w[..., None] * jnp.stack(outs, axis=0), axis=0)


def moba_attention(q, k, v):
    b, h, seq, d = q.shape
    nb = -(-seq // MOBA_BLOCK)
    sp = nb * MOBA_BLOCK
    pad = ((0, 0), (0, 0), (0, sp - seq), (0, 0))
    qp, kp, vp = jnp.pad(q, pad), jnp.pad(k, pad), jnp.pad(v, pad)
    kb = kp.reshape(b, h, nb, MOBA_BLOCK, d)
    vb = vp.reshape(b, h, nb, MOBA_BLOCK, d)
    scale = d ** -0.5
    own_blk = jnp.arange(sp) // MOBA_BLOCK
    n_sel = min(MOBA_TOPK, nb - 1)
    nc = sp // MOBA_QCHUNK

    def to_chunks(t):
        return jnp.moveaxis(t.reshape(b, h, nc, MOBA_QCHUNK, t.shape[-1]), 2, 0)

    xs = [jnp.arange(nc), to_chunks(qp)]
    if n_sel > 0:
        kmean = jnp.mean(kb.astype(jnp.float32), axis=3)
        gate = jnp.einsum('bhsd,bhnd->bhsn', qp.astype(jnp.float32), kmean)
        past = jnp.arange(nb)[None, :] < own_blk[:, None]
        gate = jnp.where(past, gate, NEG_INF)
        _, sel = lax.top_k(gate, n_sel)
        sel_valid = sel < own_blk[:, None]
        xs += [to_chunks(sel), to_chunks(sel_valid)]
    bi = jnp.arange(b)[:, None, None]
    hi = jnp.arange(h)[None, :, None]
    offs = jnp.arange(MOBA_BLOCK)

    def one_chunk(args):
        c, qc = args[0], args[1]
        qpos = c * MOBA_QCHUNK + jnp.arange(MOBA_QCHUNK)
        blk = (c * MOBA_QCHUNK) // MOBA_BLOCK
        k_own = lax.dynamic_slice_in_dim(kp, blk * MOBA_BLOCK, MOBA_BLOCK, axis=2)
        v_own = lax.dynamic_slice_in_dim(vp, blk * MOBA_BLOCK, MOBA_BLOCK, axis=2)
        s_own = jnp.einsum('bhqd,bhkd->bhqk', qc, k_own, preferred_element_type=jnp.float32) * scale
        causal = (blk * MOBA_BLOCK + offs)[None, :] <= qpos[:, None]
        s_own = jnp.where(causal, s_own, NEG_INF)
        if n_sel == 0:
            p = jax.nn.softmax(s_own, axis=-1)
            return jnp.einsum('bhqk,bhkd->bhqd', p, v_own.astype(jnp.float32))
        selc, validc = args[2], args[3]
        flat = selc.reshape(b, h, MOBA_QCHUNK * n_sel)
        k_sel = kb[bi, hi, flat].reshape(b, h, MOBA_QCHUNK, n_sel * MOBA_BLOCK, d)
        v_sel = vb[bi, hi, flat].reshape(b, h, MOBA_QCHUNK, n_sel * MOBA_BLOCK, d)
        s_sel = jnp.einsum('bhqd,bhqkd->bhqk', qc, k_sel, preferred_element_type=jnp.float32) * scale
        s_sel = jnp.where(jnp.repeat(validc, MOBA_BLOCK, axis=-1), s_sel, NEG_INF)
        p = jax.nn.softmax(jnp.concatenate([s_sel, s_own], axis=-1), axis=-1)
        nsk = n_sel * MOBA_BLOCK
        return (jnp.einsum('bhqk,bhqkd->bhqd', p[..., :nsk], v_sel.astype(jnp.float32))
                + jnp.einsum('bhqk,bhkd->bhqd', p[..., nsk:], v_own.astype(jnp.float32)))

    out = lax.map(one_chunk, tuple(xs))
    return jnp.moveaxis(out, 0, 2).reshape(b, h, sp, d)[:, :, :seq]


def sliding_window_sink_attention(q, k, v, sinks):
    b, hq, seq, d = q.shape
    g = hq // C_KV_HEADS
    o, _ = banded_attention(q.reshape(b, C_KV_HEADS, g, seq, d), k, v, C_WINDOW - 1,
                            sinks.reshape(C_KV_HEADS, g))
    return o.reshape(b, hq, seq, d)


def even_layer(x, g_norm, w_in, w_out, qn_a, kn_a, qn_b, kn_b, cos, sin):
    h = rms_norm(x, g_norm)
    proj = h @ w_in
    qa, ka, va, za, qb, kb, vb, zb = split_cols(proj, [A_WIDTH] * 4 + [B_WIDTH] * 4)
    qa = qk_prep(to_heads(qa, A_HEADS), qn_a, cos, sin)
    ka = qk_prep(to_heads(ka, A_HEADS), kn_a, cos, sin)
    qb = qk_prep(to_heads(qb, B_HEADS), qn_b, cos, sin)
    kb = qk_prep(to_heads(kb, B_HEADS), kn_b, cos, sin)
    oa = dilated_mixture_attention(qa, ka, to_heads(va, A_HEADS))
    ob = moba_attention(qb, kb, to_heads(vb, B_HEADS))
    y = from_heads(jnp.concatenate([oa, ob], axis=1)).astype(x.dtype)
    z = jnp.concatenate([za, zb], axis=-1)
    return x + (y * jax.nn.silu(z)) @ w_out


def odd_layer(x, g_norm, w_in, w_out, qn_c, kn_c, sinks, cos, sin):
    h = rms_norm(x, g_norm)
    proj = h @ w_in
    qc, kc, vc, zc = split_cols(proj, [C_WIDTH, C_KV_WIDTH, C_KV_WIDTH, C_WIDTH])
    qc = qk_prep(to_heads(qc, C_HEADS), qn_c, cos, sin)
    kc = qk_prep(to_heads(kc, C_KV_HEADS), kn_c, cos, sin)
    oc = sliding_window_sink_attention(qc, kc, to_heads(vc, C_KV_HEADS), sinks)
    y = from_heads(oc).astype(x.dtype)
    return x + (y * jax.nn.silu(zc)) @ w_out


def setup_inputs(seed: int = 0) -> dict:
    key = jax.random.key(seed)
    ks = jax.random.split(key, 16)

    def normal(k, shape, scale):
        return jax.random.normal(k, shape, jnp.float32) * scale

    def gain(k, shape):
        return 1.0 + 0.05 * jax.random.normal(k, shape, jnp.float32)

    return {
        'x': normal(ks[0], (BATCH, SEQ, D_MODEL), 1.0),
        'norm_even': gain(ks[1], (N_EVEN, D_MODEL)),
        'w_in_even': normal(ks[2], (N_EVEN, D_MODEL, EVEN_IN), D_MODEL ** -0.5),
        'w_out_even': normal(ks[3], (N_EVEN, A_WIDTH + B_WIDTH, D_MODEL), (A_WIDTH + B_WIDTH) ** -0.5),
        'qnorm_a': gain(ks[4], (N_EVEN, HEAD_DIM)),
        'knorm_a': gain(ks[5], (N_EVEN, HEAD_DIM)),
        'qnorm_b': gain(ks[6], (N_EVEN, HEAD_DIM)),
        'knorm_b': gain(ks[7], (N_EVEN, HEAD_DIM)),
        'norm_odd': gain(ks[8], (N_ODD, D_MODEL)),
        'w_in_odd': normal(ks[9], (N_ODD, D_MODEL, ODD_IN), D_MODEL ** -0.5),
        'w_out_odd': normal(ks[10], (N_ODD, C_WIDTH, D_MODEL), C_WIDTH ** -0.5),
        'qnorm_c': gain(ks[11], (N_ODD, HEAD_DIM)),
        'knorm_c': gain(ks[12], (N_ODD, HEAD_DIM)),
        'sinks_c': normal(ks[13], (N_ODD, C_HEADS), 1.0),
    }


def reference(x, norm_even, w_in_even, w_out_even, qnorm_a, knorm_a, qnorm_b, knorm_b,
              norm_odd, w_in_odd, w_out_odd, qnorm_c, knorm_c, sinks_c):
    cos, sin = rope_tables(x.shape[1])
    for layer in range(DEPTH):
        i = layer // 2
        if layer % 2 == 0:
            x = even_layer(x, norm_even[i], w_in_even[i], w_out_even[i],
                           qnorm_a[i], knorm_a[i], qnorm_b[i], knorm_b[i], cos, sin)
        else:
            x = odd_layer(x, norm_odd[i], w_in_odd[i], w_out_odd[i],
                          qnorm_c[i], knorm_c[i], sinks_c[i], cos, sin)
    return x
```

```cpp
#include <hip/hip_runtime.h>
#include <hip/hip_cooperative_groups.h>
#include <cstdio>
#include <cstdint>
namespace cg = cooperative_groups;
namespace pg8 {
#define PG8_LAS __attribute__((address_space(3)))
typedef unsigned short bf16_t;
typedef short bf16x8 __attribute__((ext_vector_type(8)));
typedef float f32x4 __attribute__((ext_vector_type(4)));
typedef unsigned u32x4 __attribute__((ext_vector_type(4)));
constexpr int BM = 256, BK = 64, HALF = 128, HTB = HALF * BK * 2  , STAGE_BYTES = 8 * HTB, NXCD = 8, WGM = 8;

__host__ __device__ __forceinline__ int lds_byte(int r, int c) { const int st = (r >> 4) * 2 + (c >> 5), rr = r & 15, cc = c & 31, ob = rr * 64 + cc * 2; return st * 1024 + (ob ^ (((ob >> 9) & 1) << 5)); }
__host__ __device__ __forceinline__ void stage_rc(int b, int& R, int& C) { const int st = b / 1024, sb = b % 1024, swz = sb ^ (((sb >> 9) & 1) << 5); R = (st >> 1) * 16 + swz / 64; C = (st & 1) * 32 + (swz % 64) / 2; }
__host__ __device__ __forceinline__ int perm32(int rho) { const int n = rho >> 4, i = rho & 15; return 8 * (i >> 2) + 4 * n + (i & 3); }

struct Unit { int pm, pn; };
struct Gemm { const bf16_t* A; const bf16_t* Bt; int M, N, K; };

struct StaticOrder {
    int nM, nN, nwg, G, c;
    __host__ __device__ void init(int M, int N, int G_, int c_) { nM = M / BM; nN = N / BM; nwg = nM * nN; G = G_; c = c_; }
    __host__ __device__ bool next(int i, Unit& u) const {
        const long L = (long)i * G + c; if (L >= nwg) return false;
        int wgid = (int)L; { const int q = nwg / NXCD, r = nwg % NXCD, xcd = wgid % NXCD, off = wgid / NXCD; wgid = (xcd < r ? xcd * (q + 1) : r * (q + 1) + (xcd - r) * q) + off; }
        const int nig = WGM * nN, gid = wgid / nig, fm = gid * WGM, gsz = (nM - fm) < WGM ? (nM - fm) : WGM;
        u.pm = fm + ((wgid % nig) % gsz); u.pn = (wgid % nig) / gsz; return true;
    }
    __device__ __forceinline__ void a_ready(const Unit&) const {}
    __device__ __forceinline__ void done(const Unit&) const {}
};

template <class Epi, class Sched, bool ALIGN_EPI = false, bool SP2 = false>
__device__ __forceinline__ void gemm_phase(PG8_LAS unsigned char* lds, const Gemm g, const Sched& S, const Epi& E) {
    int tid_l = threadIdx.x; asm volatile("" : "+v"(tid_l));
    const int tid = tid_l, wid = __builtin_amdgcn_readfirstlane(tid >> 6), lane = tid & 63, wr = wid >> 2, wc = wid & 3, fr = lane & 15, fq = lane >> 4;
    const int K = g.K, nt = K / BK;
    unsigned voffA[2], voffB[2];
#pragma unroll
    for (int i = 0; i < 2; ++i) { int R, C; stage_rc(tid * 16 + i * 8192, R, C); const int Rb = Epi::PERM ? ((R & ~31) + perm32(R & 31)) : R;
        voffA[i] = (unsigned)(R * K + C) * 2u; voffB[i] = (unsigned)(Rb * K + C) * 2u; }
    const size_t kstep = (size_t)(BK * 2);
    const size_t hstep = (size_t)HALF * K * 2;
    const size_t tstep = 2 * hstep;
    const unsigned ldsw = (unsigned)wid * 1024u;
    const int aoff = lds_byte(wr * 64 + fr, fq * 8), boff = lds_byte(wc * 32 + fr, fq * 8);
#define PG8_SA(b, h) (((b) * 2 + (h)) * HTB)
#define PG8_SB(b, h) ((4 + (b) * 2 + (h)) * HTB)
#define PG8_STAGE(bufoff, gbase, voff) do { _Pragma("unroll") for (int _i = 0; _i < 2; ++_i) \
        __builtin_amdgcn_global_load_lds((const unsigned*)((const char*)(gbase) + (voff)[_i]), (PG8_LAS unsigned*)(lds + (bufoff) + ldsw + _i * 8192), 16, 0, 0); } while (0)
#define PG8_LDA(dst, b, h) do { _Pragma("unroll") for (int m = 0; m < 4; ++m) _Pragma("unroll") for (int k = 0; k < 2; ++k) dst[m][k] = *(const PG8_LAS bf16x8*)(lds + PG8_SA(b, h) + aoff + m * 2048 + k * 1024); } while (0)
#define PG8_LDB(dst, b, h) do { _Pragma("unroll") for (int n = 0; n < 2; ++n) _Pragma("unroll") for (int k = 0; k < 2; ++k) dst[n][k] = *(const PG8_LAS bf16x8*)(lds + PG8_SB(b, h) + boff + n * 2048 + k * 1024); } while (0)
#define PG8_MMA(ai, bj, At, Bt) do { __builtin_amdgcn_s_setprio(1); _Pragma("unroll") for (int m = 0; m < 4; ++m) _Pragma("unroll") for (int n = 0; n < 2; ++n) _Pragma("unroll") for (int k = 0; k < 2; ++k) \
        acc[ai][bj][m][n] = __builtin_amdgcn_mfma_f32_16x16x32_bf16(Bt[n][k], At[m][k], acc[ai][bj][m][n], 0, 0, 0); __builtin_amdgcn_s_setprio(0); } while (0)
#define PG8_WAIT_V(n) asm volatile("s_waitcnt vmcnt(" #n ")" ::: "memory")
#define PG8_WAIT_L(n) asm volatile("s_waitcnt lgkmcnt(" #n ")" ::: "memory")
#define PG8_BAR __builtin_amdgcn_s_barrier()
#define PG8_SCHED __builtin_amdgcn_sched_barrier(0)
    Unit cur, nxt; int ui = 0;
    if (!S.next(0, cur)) return;
    f32x4 acc[2][2][4][2];
#pragma unroll
    for (int a = 0; a < 2; ++a)
#pragma unroll
        for (int b = 0; b < 2; ++b)
#pragma unroll
            for (int m = 0; m < 4; ++m)
#pragma unroll
                for (int n = 0; n < 2; ++n) acc[a][b][m][n] = (f32x4){0.f, 0.f, 0.f, 0.f};
    bf16x8 At[4][2], B0[2][2], B1[2][2];
    const char* cA = (const char*)g.A + (size_t)cur.pm * tstep; const char* cB = (const char*)g.Bt + (size_t)cur.pn * tstep;
    S.a_ready(cur);
    if constexpr (SP2) {
        PG8_STAGE(PG8_SB(0, 0), cB, voffB); PG8_STAGE(PG8_SB(0, 1), cB + hstep, voffB); PG8_STAGE(PG8_SA(0, 0), cA, voffA); PG8_STAGE(PG8_SA(0, 1), cA + hstep, voffA);
        if (wr == 1) PG8_BAR;
        PG8_WAIT_V(2); PG8_BAR;
        PG8_STAGE(PG8_SB(1, 0), cB + kstep, voffB); PG8_STAGE(PG8_SA(1, 0), cA + kstep, voffA); PG8_STAGE(PG8_SB(1, 1), cB + hstep + kstep, voffB);
        PG8_WAIT_V(6); PG8_BAR;
    } else {
        PG8_STAGE(PG8_SB(0, 0), cB, voffB); PG8_STAGE(PG8_SA(0, 0), cA, voffA); PG8_STAGE(PG8_SB(0, 1), cB + hstep, voffB); PG8_STAGE(PG8_SA(0, 1), cA + hstep, voffA);
        if (wr == 1) PG8_BAR;
        PG8_WAIT_V(4); PG8_BAR;
        PG8_STAGE(PG8_SB(1, 0), cB + kstep, voffB); PG8_STAGE(PG8_SA(1, 0), cA + kstep, voffA); PG8_STAGE(PG8_SB(1, 1), cB + hstep + kstep, voffB);
        PG8_WAIT_V(6); PG8_BAR;
    }
    for (;;) {
        const bool has_next = S.next(ui + 1, nxt);
        const char* nA = has_next ? (const char*)g.A + (size_t)nxt.pm * tstep : cA; const char* nB = has_next ? (const char*)g.Bt + (size_t)nxt.pn * tstep : cB;
        for (int t = 0; t < nt; t += 2) {
            const bool last = (t == nt - 2);
            const char* a1 = cA + (size_t)(t + 1) * kstep;
            const char* a2 = last ? nA : cA + (size_t)(t + 2) * kstep; const char* b2 = last ? nB : cB + (size_t)(t + 2) * kstep;
            const char* a3 = a2 + kstep; const char* b3 = b2 + kstep;
            if (last && has_next) S.a_ready(nxt);
            if constexpr (SP2) {
            PG8_LDB(B0, 0, 0); PG8_LDB(B1, 0, 1); PG8_SCHED; PG8_LDA(At, 0, 0); PG8_STAGE(PG8_SA(1, 1), a1 + hstep, voffA);
            PG8_WAIT_V(8); PG8_WAIT_L(0); PG8_BAR; PG8_MMA(0, 0, At, B0); PG8_MMA(0, 1, At, B1); PG8_BAR; PG8_SCHED;
            PG8_LDA(At, 0, 1); PG8_STAGE(PG8_SB(0, 0), b2, voffB); PG8_STAGE(PG8_SB(0, 1), b2 + hstep, voffB); PG8_STAGE(PG8_SA(0, 0), a2, voffA);
            PG8_WAIT_V(8); PG8_WAIT_L(0); PG8_BAR; PG8_MMA(1, 0, At, B0); PG8_MMA(1, 1, At, B1); PG8_BAR; PG8_SCHED;
            PG8_LDB(B0, 1, 0); PG8_LDB(B1, 1, 1); PG8_SCHED; PG8_LDA(At, 1, 0); PG8_STAGE(PG8_SA(0, 1), a2 + hstep, voffA);
            PG8_WAIT_V(8); PG8_WAIT_L(0); PG8_BAR; PG8_MMA(0, 0, At, B0); PG8_MMA(0, 1, At, B1); PG8_BAR; PG8_SCHED;
            PG8_LDA(At, 1, 1); PG8_STAGE(PG8_SB(1, 0), b3, voffB); PG8_STAGE(PG8_SB(1, 1), b3 + hstep, voffB); PG8_STAGE(PG8_SA(1, 0), a3, voffA);
            PG8_WAIT_V(8); PG8_WAIT_L(0); PG8_BAR; PG8_MMA(1, 0, At, B0); PG8_MMA(1, 1, At, B1); PG8_BAR; PG8_SCHED;
            } else {
            PG8_LDB(B0, 0, 0); PG8_SCHED; PG8_LDA(At, 0, 0); PG8_STAGE(PG8_SA(1, 1), a1 + hstep, voffA);
            PG8_WAIT_L(8); PG8_BAR; PG8_WAIT_L(0); PG8_MMA(0, 0, At, B0); PG8_BAR; PG8_SCHED;
            PG8_LDB(B1, 0, 1); PG8_STAGE(PG8_SB(0, 0), b2, voffB);
            PG8_BAR; PG8_WAIT_L(0); PG8_MMA(0, 1, At, B1); PG8_BAR;
            PG8_LDA(At, 0, 1); PG8_STAGE(PG8_SA(0, 0), a2, voffA);
            PG8_BAR; PG8_WAIT_L(0); PG8_MMA(1, 0, At, B0); PG8_BAR; PG8_SCHED;
            PG8_STAGE(PG8_SB(0, 1), b2 + hstep, voffB);
            PG8_WAIT_V(6); PG8_BAR; PG8_MMA(1, 1, At, B1); PG8_BAR;
            PG8_LDB(B0, 1, 0); PG8_SCHED; PG8_LDA(At, 1, 0); PG8_STAGE(PG8_SA(0, 1), a2 + hstep, voffA);
            PG8_WAIT_L(8); PG8_BAR; PG8_WAIT_L(0); PG8_MMA(0, 0, At, B0); PG8_BAR; PG8_SCHED;
            PG8_LDB(B1, 1, 1); PG8_STAGE(PG8_SB(1, 0), b3, voffB);
            PG8_BAR; PG8_WAIT_L(0); PG8_MMA(0, 1, At, B1); PG8_BAR;
            PG8_LDA(At, 1, 1); PG8_STAGE(PG8_SA(1, 0), a3, voffA);
            PG8_BAR; PG8_WAIT_L(0); PG8_MMA(1, 0, At, B0); PG8_BAR; PG8_SCHED;
            PG8_STAGE(PG8_SB(1, 1), b3 + hstep, voffB);
            PG8_WAIT_V(6); PG8_BAR; PG8_MMA(1, 1, At, B1); PG8_BAR;
            }
        }
        if constexpr (ALIGN_EPI) { if (wr == 0) PG8_BAR; }
        if constexpr (!Epi::AFTER_DRAIN) { E(acc, cur, wr, wc, fr, fq); S.done(cur); }
        if (!has_next) break;
#pragma unroll
        for (int a = 0; a < 2; ++a)
#pragma unroll
            for (int b = 0; b < 2; ++b)
#pragma unroll
                for (int m = 0; m < 4; ++m)
#pragma unroll
                    for (int n = 0; n < 2; ++n) acc[a][b][m][n] = (f32x4){0.f, 0.f, 0.f, 0.f};
        cur = nxt; cA = nA; cB = nB; ++ui;
        if constexpr (ALIGN_EPI) { if (wr == 1) PG8_BAR; }
    }
    PG8_WAIT_V(0);
    if constexpr (!ALIGN_EPI) { if (wr == 0) PG8_BAR; }
    PG8_BAR;
    if constexpr (Epi::AFTER_DRAIN) { E.fused(acc, cur, wr, wc, fr, fq, lds, wid, lane); S.done(cur); }
#undef PG8_SA
#undef PG8_SB
#undef PG8_STAGE
#undef PG8_LDA
#undef PG8_LDB
#undef PG8_MMA
#undef PG8_WAIT_V
#undef PG8_WAIT_L
#undef PG8_BAR
#undef PG8_SCHED
}
}

using pg8::bf16_t; using pg8::bf16x8; using pg8::f32x4; using pg8::u32x4; using pg8::Unit;
typedef float f32x16 __attribute__((ext_vector_type(16)));
typedef short s16x4 __attribute__((ext_vector_type(4)));
typedef unsigned u32x2 __attribute__((ext_vector_type(2)));
typedef float f32x2 __attribute__((ext_vector_type(2)));
#define DI __device__ __forceinline__
#define LAS __attribute__((address_space(3)))

constexpr int BATCH = 8, SEQ = 4096, DM = 1024, NTOK = BATCH * SEQ;
constexpr int N_IN0 = 4096, N_IN1 = 2304;
constexpr float NORM_EPS = 1e-6f;
constexpr float SC_LOG2 = 0.125f * 1.44269504088896341f;
constexpr float NEGBIG = -1e30f;
constexpr int NTHREADS = 512;
#ifndef PH_MASK
#define PH_MASK 0x7f
#endif
constexpr int LDS_BYTES = 131072 + 8192;

constexpr size_t MiB = 1u << 20;
constexpr size_t WS_BT0 = 0 * MiB, WS_BT1 = 8 * MiB, WS_BT2 = 10 * MiB, WS_BT3 = 15 * MiB;
constexpr size_t WS_GAINS = 17 * MiB;
constexpr size_t WS_RSTD0 = 18 * MiB, WS_CS = 19 * MiB, WS_KMP = 20 * MiB, WS_SSQ = 21 * MiB;
constexpr size_t WS_XB = 32 * MiB;
constexpr size_t WS_Y = 32 * MiB;
constexpr size_t WS_QA = 96 * MiB, WS_KA = 128 * MiB, WS_VTA = 160 * MiB, WS_QB = 192 * MiB, WS_KB = 224 * MiB, WS_VTB = 256 * MiB;
constexpr size_t WS_ZS = 288 * MiB;
constexpr size_t WS_X1 = 352 * MiB;
constexpr size_t WS_X1B = 96 * MiB;
constexpr size_t WS_QC = 160 * MiB, WS_KC = 224 * MiB, WS_VTC = 232 * MiB, WS_ZS1 = 240 * MiB;
constexpr size_t WS_END = 480 * MiB;

struct Params {
    const float* x; const float* norm_even; const float* w_in_even; const float* w_out_even;
    const float* qn_a; const float* kn_a; const float* qn_b; const float* kn_b;
    const float* norm_odd; const float* w_in_odd; const float* w_out_odd; const float* qn_c; const float* kn_c; const float* sinks;
    float* out; unsigned char* ws;
};

typedef __bf16 bf16v2 __attribute__((ext_vector_type(2)));
DI unsigned cvt_pk(float lo, float hi) { const f32x2 v = {lo, hi}; return __builtin_bit_cast(unsigned, __builtin_convertvector(v, bf16v2)); }
DI float bf_lo(unsigned u) { return __uint_as_float(u << 16); }
DI float bf_hi(unsigned u) { return __uint_as_float(u & 0xffff0000u); }

DI void p0_weight_tile(LAS float* tile, const float* W, bf16_t* Bt, int N, const float* g, bool permute, int t) {
    const int tid = threadIdx.x;
    const int ntn = N / 64, k0 = (t / ntn) * 64, n0 = (t % ntn) * 64;
    {
        const int n = tid & 63, kr = tid >> 6;
#pragma unroll
        for (int i = 0; i < 8; ++i) { const int k = kr + 8 * i; tile[k * 65 + n] = W[(size_t)(k0 + k) * N + n0 + n] * (g ? g[k0 + k] : 1.0f); }
    }
    __syncthreads();
    {
        const int nn = tid >> 3, ks = tid & 7;
        const int nlog = n0 + nn;
        const int c = permute ? ((nlog & ~255) | (((nlog >> 5) & 1) << 7) | (((nlog >> 6) & 3) << 5) | (nlog & 31)) : nlog;
        float v[8];
#pragma unroll
        for (int i = 0; i < 8; ++i) v[i] = tile[(ks * 8 + i) * 65 + nn];
        u32x4 w; w.x = cvt_pk(v[0], v[1]); w.y = cvt_pk(v[2], v[3]); w.z = cvt_pk(v[4], v[5]); w.w = cvt_pk(v[6], v[7]);
        *(u32x4*)(Bt + (size_t)c * 1024 + k0 + ks * 8) = w;
    }
    __syncthreads();
}

DI void sincos_d(double x, double& s, double& c) {
    const double kq = __builtin_rint(x * 0.63661977236758134308);
    double r = __builtin_fma(-kq, 1.57079632679489655800e+00, x); r = __builtin_fma(-kq, 6.12323399573676603587e-17, r);
    const int q = ((int)kq) & 3;
    const double r2 = r * r;
    const double sp = r * (1.0 + r2 * (-1.0 / 6 + r2 * (1.0 / 120 + r2 * (-1.0 / 5040 + r2 * (1.0 / 362880 + r2 * (-1.0 / 39916800 + r2 * (1.0 / 6227020800.0)))))));
    const double cp = 1.0 + r2 * (-0.5 + r2 * (1.0 / 24 + r2 * (-1.0 / 720 + r2 * (1.0 / 40320 + r2 * (-1.0 / 3628800 + r2 * (1.0 / 479001600.0 + r2 * (-1.0 / 87178291200.0)))))));
    s = (q == 0) ? sp : (q == 1) ? cp : (q == 2) ? -sp : -cp;
    c = (q == 0) ? cp : (q == 1) ? -sp : (q == 2) ? -cp : sp;
}

DI void p0_prologue(const Params& P, LAS unsigned char* lds) {
    unsigned char* ws = P.ws;
    const int tid = threadIdx.x, lane = tid & 63, wid = tid >> 6;
    const int G = gridDim.x, bid = blockIdx.x;
    {
        bf16_t* xb = (bf16_t*)(ws + WS_XB); float* rstd = (float*)(ws + WS_RSTD0);
        for (int row = bid * 8 + wid; row < NTOK; row += G * 8) {
            const f32x4* xr = (const f32x4*)(P.x + (size_t)row * DM);
            float ss = 0.f;
#pragma unroll
            for (int i = 0; i < 4; ++i) {
                const f32x4 v = xr[lane + 64 * i];
                ss += v[0] * v[0] + v[1] * v[1] + v[2] * v[2] + v[3] * v[3];
                u32x2 w; w.x = cvt_pk(v[0], v[1]); w.y = cvt_pk(v[2], v[3]);
                *(u32x2*)(xb + (size_t)row * DM + 4 * (lane + 64 * i)) = w;
            }
#pragma unroll
            for (int o = 32; o >= 1; o >>= 1) ss += __shfl_xor(ss, o);
            if (lane == 0) rstd[row] = rsqrtf(ss * (1.0f / DM) + NORM_EPS);
        }
    }
    if (bid == 0 && tid < 64) {
        float* gw = (float*)(ws + WS_GAINS);
        gw[tid] = P.qn_a[tid]; gw[64 + tid] = P.kn_a[tid]; gw[128 + tid] = P.qn_b[tid]; gw[192 + tid] = P.kn_b[tid]; gw[256 + tid] = P.qn_c[tid]; gw[320 + tid] = P.kn_c[tid];
        if (tid < 16) gw[384 + tid] = P.sinks[tid];
    }
    {
        f32x2* cs = (f32x2*)(ws + WS_CS);
        for (int e = bid * NTHREADS + tid; e < SEQ * 32; e += G * NTHREADS) {
            const int pos = e >> 5, i = e & 31;
            double f = 1.0;
            for (int k = 0; k < i; ++k) f *= 0.7498942093324558;
            const float invf = (float)f;
            const float ang = (float)pos * invf;
            double s, c; sincos_d((double)ang, s, c);
            cs[e] = (f32x2){(float)c, (float)s};
        }
    }
    {
        LAS float* tile = (LAS float*)lds;
        const int T0 = 16 * (N_IN0 / 64), T1 = 16 * (DM / 64), T2 = 16 * (N_IN1 / 64), T3 = 16 * (DM / 64);
        for (int t = bid; t < T0 + T1 + T2 + T3; t += G) {
            if (t < T0) p0_weight_tile(tile, P.w_in_even, (bf16_t*)(ws + WS_BT0), N_IN0, P.norm_even, true, t);
            else if (t < T0 + T1) p0_weight_tile(tile, P.w_out_even, (bf16_t*)(ws + WS_BT1), DM, nullptr, false, t - T0);
            else if (t < T0 + T1 + T2) p0_weight_tile(tile, P.w_in_odd, (bf16_t*)(ws + WS_BT2), N_IN1, P.norm_odd, true, t - T0 - T1);
            else p0_weight_tile(tile, P.w_out_odd, (bf16_t*)(ws + WS_BT3), DM, nullptr, false, t - T0 - T1 - T2);
        }
    }
}

DI float row_rstd1(const float* ssq, int row, int fq) {
    const f32x4 a = *(const f32x4*)(ssq + (size_t)row * 16 + 4 * fq);
    float t = (a[0] + a[1]) + (a[2] + a[3]);
    t += __shfl_xor(t, 16); t += __shfl_xor(t, 32);
    return rsqrtf(t * (1.0f / DM) + NORM_EPS);
}
struct EpiIn {
    static constexpr bool PERM = true, AFTER_DRAIN = false;
    int layer; unsigned char* ws;
    __device__ __forceinline__ void operator()(const f32x4 (&acc)[2][2][4][2], const Unit& u, int wr, int wc, int fr, int fq) const {
        const float* rstd0 = (const float*)(ws + WS_RSTD0); const float* ssq = (const float*)(ws + WS_SSQ); const f32x2* cs = (const f32x2*)(ws + WS_CS);
        const float* gains = (const float*)(ws + WS_GAINS); bf16_t* zs = (bf16_t*)(ws + (layer == 0 ? WS_ZS : WS_ZS1)); float* kmp = (float*)(ws + WS_KMP);
        int mode, head, hpb = 8, zcol = 0; bf16_t* dst = nullptr; const float* gain = gains; bool do_km = false;
        if (layer == 0) {
            const int seg = u.pn >> 1; head = (u.pn & 1) * 4 + wc;
            if (seg == 0) { mode = 0; dst = (bf16_t*)(ws + WS_QA); gain = gains; }
            else if (seg == 1) { mode = 0; dst = (bf16_t*)(ws + WS_KA); gain = gains + 64; }
            else if (seg == 2) { mode = 1; dst = (bf16_t*)(ws + WS_VTA); }
            else if (seg == 3) { mode = 2; zcol = head * 64; }
            else if (seg == 4) { mode = 0; dst = (bf16_t*)(ws + WS_QB); gain = gains + 128; }
            else if (seg == 5) { mode = 0; dst = (bf16_t*)(ws + WS_KB); gain = gains + 192; do_km = true; }
            else if (seg == 6) { mode = 1; dst = (bf16_t*)(ws + WS_VTB); }
            else { mode = 2; zcol = 512 + head * 64; }
        } else {
            if (u.pn < 4) { mode = 0; dst = (bf16_t*)(ws + WS_QC); gain = gains + 256; head = u.pn * 4 + wc; hpb = 16; }
            else if (u.pn == 4) { hpb = 2; if (wc < 2) { mode = 0; dst = (bf16_t*)(ws + WS_KC); gain = gains + 320; head = wc; } else { mode = 1; dst = (bf16_t*)(ws + WS_VTC); head = wc - 2; } }
            else { mode = 2; head = (u.pn - 5) * 4 + wc; zcol = head * 64; }
        }
        const int b = u.pm >> 4, sbase = (u.pm & 15) * 256 + wr * 64 + fr, rowbase = u.pm * 256 + wr * 64 + fr;
        const size_t bh = (size_t)b * hpb + head;
#define ROW_RS(row) ((layer == 0) ? rstd0[(row)] : row_rstd1(ssq, (row), fq))
        if (mode == 0) {
            float g0[8], g1[8], cs0[8], cs1[8];
#pragma unroll
            for (int i = 0; i < 8; ++i) { g0[i] = gain[8 * fq + i]; g1[i] = gain[32 + 8 * fq + i]; cs0[i] = 0.f; cs1[i] = 0.f; }
#pragma unroll
            for (int ai = 0; ai < 2; ++ai)
#pragma unroll
                for (int m = 0; m < 4; ++m) {
                    const int s = sbase + ai * 128 + m * 16; const float r = ROW_RS(rowbase + ai * 128 + m * 16);
                    float t0[8], t1[8]; float ss = 0.f;
#pragma unroll
                    for (int n = 0; n < 2; ++n)
#pragma unroll
                        for (int j = 0; j < 4; ++j) { t0[4 * n + j] = acc[ai][0][m][n][j] * r; t1[4 * n + j] = acc[ai][1][m][n][j] * r; }
#pragma unroll
                    for (int i = 0; i < 8; ++i) ss += t0[i] * t0[i] + t1[i] * t1[i];
                    ss += __shfl_xor(ss, 16); ss += __shfl_xor(ss, 32);
                    const float hr = rsqrtf(ss * (1.0f / 64.0f) + NORM_EPS);
                    const f32x4* cp = (const f32x4*)(cs + (size_t)s * 32 + 8 * fq);
                    float o0[8], o1[8];
#pragma unroll
                    for (int q = 0; q < 4; ++q) { const f32x4 c4 = cp[q];
                        { const int i = 2 * q; const float a = t0[i] * hr * g0[i], bb = t1[i] * hr * g1[i]; o0[i] = a * c4[0] - bb * c4[1]; o1[i] = bb * c4[0] + a * c4[1]; }
                        { const int i = 2 * q + 1; const float a = t0[i] * hr * g0[i], bb = t1[i] * hr * g1[i]; o0[i] = a * c4[2] - bb * c4[3]; o1[i] = bb * c4[2] + a * c4[3]; } }
                    u32x4 w0, w1;
                    w0.x = cvt_pk(o0[0], o0[1]); w0.y = cvt_pk(o0[2], o0[3]); w0.z = cvt_pk(o0[4], o0[5]); w0.w = cvt_pk(o0[6], o0[7]);
                    w1.x = cvt_pk(o1[0], o1[1]); w1.y = cvt_pk(o1[2], o1[3]); w1.z = cvt_pk(o1[4], o1[5]); w1.w = cvt_pk(o1[6], o1[7]);
                    bf16_t* rp = dst + ((bh * SEQ + s) * 64 + 8 * fq);
                    *(u32x4*)rp = w0; *(u32x4*)(rp + 32) = w1;
                    if (do_km) {
#pragma unroll
                        for (int i = 0; i < 8; ++i) { cs0[i] += o0[i]; cs1[i] += o1[i]; }
                    }
                }
            if (do_km) {
#pragma unroll
                for (int i = 0; i < 8; ++i) {
#pragma unroll
                    for (int o = 1; o <= 8; o <<= 1) { cs0[i] += __shfl_xor(cs0[i], o); cs1[i] += __shfl_xor(cs1[i], o); }
                }
                if (fr == 0) {
                    float* kp = kmp + (((size_t)wr * 64 + bh) * 16 + (u.pm & 15)) * 64 + 8 * fq;
                    *(f32x4*)kp = (f32x4){cs0[0], cs0[1], cs0[2], cs0[3]}; *(f32x4*)(kp + 4) = (f32x4){cs0[4], cs0[5], cs0[6], cs0[7]};
                    *(f32x4*)(kp + 32) = (f32x4){cs1[0], cs1[1], cs1[2], cs1[3]}; *(f32x4*)(kp + 36) = (f32x4){cs1[4], cs1[5], cs1[6], cs1[7]};
                }
            }
        } else if (mode == 1) {
            bf16_t* vb = dst + bh * 64 * SEQ;
#pragma unroll
            for (int ai = 0; ai < 2; ++ai)
#pragma unroll
                for (int m = 0; m < 4; ++m) {
                    const int s = sbase + ai * 128 + m * 16; const float r = ROW_RS(rowbase + ai * 128 + m * 16);
#pragma unroll
                    for (int bj = 0; bj < 2; ++bj)
#pragma unroll
                        for (int n = 0; n < 2; ++n) {
                            const f32x4 v = acc[ai][bj][m][n] * r;
                            const unsigned p0 = cvt_pk(v[0], v[1]), p1 = cvt_pk(v[2], v[3]);
                            bf16_t* q = vb + (size_t)(32 * bj + 8 * fq + 4 * n) * SEQ + s;
                            q[0] = (bf16_t)(p0 & 0xffffu); q[SEQ] = (bf16_t)(p0 >> 16); q[2 * SEQ] = (bf16_t)(p1 & 0xffffu); q[3 * SEQ] = (bf16_t)(p1 >> 16);
                        }
                }
        } else {
#pragma unroll
            for (int ai = 0; ai < 2; ++ai)
#pragma unroll
                for (int m = 0; m < 4; ++m) {
                    const int row = rowbase + ai * 128 + m * 16; const float r = ROW_RS(row);
#pragma unroll
                    for (int bj = 0; bj < 2; ++bj) {
                        float sv[8];
#pragma unroll
                        for (int n = 0; n < 2; ++n)
#pragma unroll
                            for (int j = 0; j < 4; ++j) { const float z = acc[ai][bj][m][n][j] * r; sv[4 * n + j] = z / (1.0f + __expf(-z)); }
                        u32x4 w; w.x = cvt_pk(sv[0], sv[1]); w.y = cvt_pk(sv[2], sv[3]); w.z = cvt_pk(sv[4], sv[5]); w.w = cvt_pk(sv[6], sv[7]);
                        *(u32x4*)(zs + (size_t)row * DM + zcol + 32 * bj + 8 * fq) = w;
                    }
                }
        }
    }
};

struct EpiOut {
    static constexpr bool PERM = true, AFTER_DRAIN = false;
    const float* resid; float* out; bf16_t* xb; float* ssq;
    __device__ __forceinline__ void operator()(const f32x4 (&acc)[2][2][4][2], const Unit& u, int wr, int wc, int fr, int fq) const {
        const int col0 = u.pn * 256 + wc * 32 + 8 * fq, rowbase = u.pm * 256 + wr * 64 + fr;
#pragma unroll
        for (int ai = 0; ai < 2; ++ai)
#pragma unroll
            for (int m = 0; m < 4; ++m) {
                const int row = rowbase + ai * 128 + m * 16; const size_t off = (size_t)row * DM + col0;
                float q = 0.f;
#pragma unroll
                for (int bj = 0; bj < 2; ++bj) {
                    const f32x4 r0 = *(const f32x4*)(resid + off + bj * 128), r1 = *(const f32x4*)(resid + off + bj * 128 + 4);
                    const f32x4 o0 = r0 + acc[ai][bj][m][0], o1 = r1 + acc[ai][bj][m][1];
                    *(f32x4*)(out + off + bj * 128) = o0; *(f32x4*)(out + off + bj * 128 + 4) = o1;
                    if (xb) {
                        u32x4 w; w.x = cvt_pk(o0[0], o0[1]); w.y = cvt_pk(o0[2], o0[3]); w.z = cvt_pk(o1[0], o1[1]); w.w = cvt_pk(o1[2], o1[3]);
                        *(u32x4*)(xb + off + bj * 128) = w;
                        q += (o0[0] * o0[0] + o0[1] * o0[1]) + (o0[2] * o0[2] + o0[3] * o0[3]) + (o1[0] * o1[0] + o1[1] * o1[1]) + (o1[2] * o1[2] + o1[3] * o1[3]);
                    }
                }
                if (xb) { q += __shfl_xor(q, 16); q += __shfl_xor(q, 32); if (fq == 0) ssq[(size_t)row * 16 + u.pn * 4 + wc] = q; }
            }
    }
};

#define MFMA32(a, b, c) __builtin_amdgcn_mfma_f32_32x32x16_bf16((a), (b), (c), 0, 0, 0)
struct KVFrag { bf16x8 k[4]; bf16x8 v[2][2]; };
struct ASt { f32x16 o0, o1; float m, l; };

DI void ast_init(ASt& st) {
#pragma unroll
    for (int i = 0; i < 16; ++i) { st.o0[i] = 0.f; st.o1[i] = 0.f; }
    st.m = NEGBIG; st.l = 0.f;
}

DI void load_kv(KVFrag& f, const bf16_t* K, const bf16_t* Vt, int kbase, int kstride, int r, int h) {
    const bf16x8* kp = (const bf16x8*)(K + (size_t)(kbase + kstride * r) * 64);
#pragma unroll
    for (int ks = 0; ks < 4; ++ks) f.k[ks] = kp[2 * ks + h];
    if (kstride == 1) {
#pragma unroll
        for (int dt = 0; dt < 2; ++dt) {
            const s16x4* vp = (const s16x4*)(Vt + (size_t)(r + 32 * dt) * SEQ + kbase + 4 * h);
#pragma unroll
            for (int s2 = 0; s2 < 2; ++s2) { const s16x4 lo = vp[4 * s2], hi = vp[4 * s2 + 2]; f.v[dt][s2] = __builtin_shufflevector(lo, hi, 0, 1, 2, 3, 4, 5, 6, 7); }
        }
    } else {
#pragma unroll
        for (int dt = 0; dt < 2; ++dt) {
            const bf16_t* vp = Vt + (size_t)(r + 32 * dt) * SEQ + kbase + kstride * 4 * h;
#pragma unroll
            for (int s2 = 0; s2 < 2; ++s2) {
                bf16x8 t;
#pragma unroll
                for (int j = 0; j < 8; ++j) t[j] = (short)vp[kstride * (16 * s2 + 8 * (j >> 2) + (j & 3))];
                f.v[dt][s2] = t;
            }
        }
    }
}

DI void attn_tile(ASt& st, const bf16x8 (&qf)[4], const KVFrag& f, int dist0, int kstride, int hi) {
    f32x16 s;
#pragma unroll
    for (int i = 0; i < 16; ++i) s[i] = 0.f;
#pragma unroll
    for (int ks = 0; ks < 4; ++ks) s = MFMA32(f.k[ks], qf[ks], s);
    float tmax = NEGBIG;
#pragma unroll
    for (int i = 0; i < 16; ++i) {
        const int dist = dist0 - kstride * ((i & 3) + 8 * (i >> 2));
        const bool ok = (dist >= 0) && (dist <= hi);
        s[i] = ok ? s[i] * SC_LOG2 : NEGBIG;
        tmax = fmaxf(tmax, s[i]);
    }
    tmax = fmaxf(tmax, __shfl_xor(tmax, 32));
    const float mnew = fmaxf(st.m, tmax);
    const float alpha = __builtin_amdgcn_exp2f(st.m - mnew);
    const float msub = (mnew < -1e29f) ? 0.f : mnew;
    st.m = mnew;
    float ps = 0.f;
#pragma unroll
    for (int i = 0; i < 16; ++i) { s[i] = __builtin_amdgcn_exp2f(s[i] - msub); ps += s[i]; }
    st.l = st.l * alpha + ps;
#pragma unroll
    for (int i = 0; i < 16; ++i) { st.o0[i] *= alpha; st.o1[i] *= alpha; }
#pragma unroll
    for (int s2 = 0; s2 < 2; ++s2) {
        u32x4 p;
        p.x = cvt_pk(s[8 * s2 + 0], s[8 * s2 + 1]); p.y = cvt_pk(s[8 * s2 + 2], s[8 * s2 + 3]);
        p.z = cvt_pk(s[8 * s2 + 4], s[8 * s2 + 5]); p.w = cvt_pk(s[8 * s2 + 6], s[8 * s2 + 7]);
        const bf16x8 pb = __builtin_bit_cast(bf16x8, p);
        st.o0 = MFMA32(f.v[0][s2], pb, st.o0);
        st.o1 = MFMA32(f.v[1][s2], pb, st.o1);
    }
}

DI void load_q(bf16x8 (&qf)[4], const bf16_t* qrow, int h) {
    const bf16x8* qp = (const bf16x8*)qrow;
#pragma unroll
    for (int ks = 0; ks < 4; ++ks) qf[ks] = qp[2 * ks + h];
}

DI void attn_finish(ASt& st, float sink_l2, const bf16_t* zs, bf16_t* y, size_t rowoff  , int h) {
    float l = st.l + __shfl_xor(st.l, 32);
    const float mf = fmaxf(st.m, sink_l2);
    const float a = __builtin_amdgcn_exp2f(st.m - mf);
    l = l * a + ((sink_l2 > -1e29f) ? __builtin_amdgcn_exp2f(sink_l2 - mf) : 0.f);
    const float inv = a / l;
#pragma unroll
    for (int dt = 0; dt < 2; ++dt)
#pragma unroll
        for (int g = 0; g < 4; ++g) {
            const size_t off = rowoff + 32 * dt + 8 * g + 4 * h;
            const u32x2 z = *(const u32x2*)(zs + off);
            const float v0 = (dt ? st.o1[4 * g + 0] : st.o0[4 * g + 0]) * inv * bf_lo(z.x);
            const float v1 = (dt ? st.o1[4 * g + 1] : st.o0[4 * g + 1]) * inv * bf_hi(z.x);
            const float v2 = (dt ? st.o1[4 * g + 2] : st.o0[4 * g + 2]) * inv * bf_lo(z.y);
            const float v3 = (dt ? st.o1[4 * g + 3] : st.o0[4 * g + 3]) * inv * bf_hi(z.y);
            u32x2 w; w.x = cvt_pk(v0, v1); w.y = cvt_pk(v2, v3);
            *(u32x2*)(y + off) = w;
        }
}

DI bool a_tile_desc(int tau, int r16, int i0, int& kbase, int& kstride, int& hi) {
    if (tau < 5) { const int jb = i0 - 128 + 32 * tau; kbase = r16 + 16 * jb; kstride = 16; hi = 2048; return jb >= 0; }
    if (tau < 13) { const int ub = 4 * i0 - 128 + 32 * (tau - 5); kbase = (r16 & 3) + 4 * ub; kstride = 4; hi = 512; return ub >= 0; }
    { const int kb = 16 * i0 - 128 + 32 * (tau - 13); kbase = kb; kstride = 1; hi = 128; return kb >= 0; }
}
DI void attn_a_item(unsigned char* ws, int bh, int r16, int wid, int lane) {
    const int r = lane & 31, h = lane >> 5, i0 = wid * 32;
    const bf16_t* Q = (const bf16_t*)(ws + WS_QA) + (size_t)bh * SEQ * 64;
    const bf16_t* K = (const bf16_t*)(ws + WS_KA) + (size_t)bh * SEQ * 64;
    const bf16_t* Vt = (const bf16_t*)(ws + WS_VTA) + (size_t)bh * 64 * SEQ;
    const int qpos = r16 + 16 * (i0 + r);
    bf16x8 qf[4]; load_q(qf, Q + (size_t)qpos * 64, h);
    ASt st; ast_init(st);
    KVFrag cur, nxt;
    int tau = 0, kb, kst, hi;
    while (!a_tile_desc(tau, r16, i0, kb, kst, hi)) ++tau;
    load_kv(cur, K, Vt, kb, kst, r, h);
    for (;;) {
        int tn = tau + 1, kb2 = 0, kst2 = 1, hi2 = 0; bool have = false;
        while (tn < 33) { if (a_tile_desc(tn, r16, i0, kb2, kst2, hi2)) { have = true; break; } ++tn; }
        if (have) load_kv(nxt, K, Vt, kb2, kst2, r, h);
        attn_tile(st, qf, cur, qpos - kb - kst * 4 * h, kst, hi);
        if (!have) break;
        cur = nxt; tau = tn; kb = kb2; kst = kst2; hi = hi2;
    }
    const int b = bh >> 3, head = bh & 7;
    const size_t rowoff = ((size_t)b * SEQ + qpos) * DM + head * 64;
    attn_finish(st, NEGBIG, (const bf16_t*)(ws + WS_ZS), (bf16_t*)(ws + WS_Y), rowoff, h);
}

DI void attn_b_item(unsigned char* ws, LAS float* km  , int bh, int qblk, int wid, int lane) {
    const int r = lane & 31, h = lane >> 5;
    const bf16_t* Q = (const bf16_t*)(ws + WS_QB) + (size_t)bh * SEQ * 64;
    const bf16_t* K = (const bf16_t*)(ws + WS_KB) + (size_t)bh * SEQ * 64;
    const bf16_t* Vt = (const bf16_t*)(ws + WS_VTB) + (size_t)bh * 64 * SEQ;
    const int qpos = qblk * 256 + wid * 32 + r;
    bf16x8 qf[4]; load_q(qf, Q + (size_t)qpos * 64, h);
    float v1 = -3e38f, v2 = -3e38f, v3 = -3e38f; int i1 = 31, i2 = 31, i3 = 31;
    for (int n = 0; n < qblk; ++n) {
        float g = 0.f;
#pragma unroll
        for (int ks = 0; ks < 4; ++ks) {
            const LAS f32x4* kp = (const LAS f32x4*)(km + n * 64 + 16 * ks + 8 * h);
            const f32x4 a = kp[0], bq = kp[1];
            const u32x4 qu = __builtin_bit_cast(u32x4, qf[ks]);
            g += bf_lo(qu.x) * a[0] + bf_hi(qu.x) * a[1] + bf_lo(qu.y) * a[2] + bf_hi(qu.y) * a[3]
               + bf_lo(qu.z) * bq[0] + bf_hi(qu.z) * bq[1] + bf_lo(qu.w) * bq[2] + bf_hi(qu.w) * bq[3];
        }
        g += __shfl_xor(g, 32);
        if (g > v1) { v3 = v2; i3 = i2; v2 = v1; i2 = i1; v1 = g; i1 = n; }
        else if (g > v2) { v3 = v2; i3 = i2; v2 = g; i2 = n; }
        else if (g > v3) { v3 = g; i3 = n; }
    }
    unsigned sel = 0u;
    if (i1 < 16) sel |= 1u << i1;
    if (i2 < 16) sel |= 1u << i2;
    if (i3 < 16) sel |= 1u << i3;
    unsigned uni = 0u;
    for (int n = 0; n < qblk; ++n) { if (__builtin_amdgcn_ballot_w64((sel >> n) & 1u) != 0ull) uni |= 1u << n; }
    uni |= 1u << qblk;
    const int own_tiles = wid + 1;
    ASt st; ast_init(st);
    KVFrag cur, nxt;
    int n = __builtin_ctz(uni), T = 0;
    load_kv(cur, K, Vt, n * 256, 1, r, h);
    for (;;) {
        const int cnt = (n == qblk) ? own_tiles : 8;
        int n2 = n, T2 = T + 1; bool have = true;
        if (T2 >= cnt) { const unsigned rest = uni & ~((2u << n) - 1u); if (rest) { n2 = __builtin_ctz(rest); T2 = 0; } else have = false; }
        if (have) load_kv(nxt, K, Vt, n2 * 256 + 32 * T2, 1, r, h);
        const int kb = n * 256 + 32 * T;
        const int hi = (n == qblk || ((sel >> n) & 1u)) ? 0x7fffffff : -1;
        attn_tile(st, qf, cur, qpos - kb - 4 * h, 1, hi);
        if (!have) break;
        cur = nxt; n = n2; T = T2;
    }
    const int b = bh >> 3, head = 8 + (bh & 7);
    const size_t rowoff = ((size_t)b * SEQ + qpos) * DM + head * 64;
    attn_finish(st, NEGBIG, (const bf16_t*)(ws + WS_ZS), (bf16_t*)(ws + WS_Y), rowoff, h);
}

DI void attn_c_item(unsigned char* ws, int b, int hq, int chunk, int wid, int lane) {
    const int r = lane & 31, h = lane >> 5, kvh = hq >> 3;
    const bf16_t* Q = (const bf16_t*)(ws + WS_QC) + ((size_t)b * 16 + hq) * SEQ * 64;
    const bf16_t* K = (const bf16_t*)(ws + WS_KC) + ((size_t)b * 2 + kvh) * SEQ * 64;
    const bf16_t* Vt = (const bf16_t*)(ws + WS_VTC) + ((size_t)b * 2 + kvh) * 64 * SEQ;
    const int t0 = chunk * 256 + wid * 32, qpos = t0 + r;
    bf16x8 qf[4]; load_q(qf, Q + (size_t)qpos * 64, h);
    ASt st; ast_init(st);
    KVFrag cur, nxt;
    int T = (t0 >= 128) ? 0 : (128 - t0) / 32;
    load_kv(cur, K, Vt, t0 - 128 + 32 * T, 1, r, h);
    for (;;) {
        const bool have = (T + 1) < 5;
        if (have) load_kv(nxt, K, Vt, t0 - 128 + 32 * (T + 1), 1, r, h);
        attn_tile(st, qf, cur, qpos - (t0 - 128 + 32 * T) - 4 * h, 1, 127);
        if (!have) break;
        cur = nxt; ++T;
    }
    const size_t rowoff = ((size_t)b * SEQ + qpos) * DM + hq * 64;
    attn_finish(st, ((const float*)(ws + WS_GAINS))[384 + hq] * 1.44269504088896341f, (const bf16_t*)(ws + WS_ZS1), (bf16_t*)(ws + WS_Y), rowoff, h);
}

__global__ void __launch_bounds__(NTHREADS) fwd_megakernel(Params P) {
    extern __shared__ __attribute__((aligned(16))) unsigned char lds_raw[];
    cg::grid_group grid = cg::this_grid();
    LAS unsigned char* lds = (LAS unsigned char*)lds_raw;
    unsigned char* ws = P.ws;
    const int G = gridDim.x, bid = blockIdx.x;
#define PHASE_IDS() int tid_l = threadIdx.x; asm volatile("" : "+v"(tid_l)); const int tid = tid_l, lane = tid & 63, wid = __builtin_amdgcn_readfirstlane(tid >> 6); (void)lane; (void)wid

    if constexpr (PH_MASK & 1) p0_prologue(P, lds);
    grid.sync();

    if constexpr ((PH_MASK & 2) != 0) {
        pg8::Gemm g{(const bf16_t*)(ws + WS_XB), (const bf16_t*)(ws + WS_BT0), NTOK, N_IN0, DM};
        pg8::StaticOrder S; S.init(NTOK, N_IN0, G, bid);
        EpiIn E{0, ws};
        pg8::gemm_phase<EpiIn, pg8::StaticOrder, true, true>(lds, g, S, E);
    }
    grid.sync();

    if constexpr ((PH_MASK & 4) != 0) {
        PHASE_IDS();
        LAS float* km = (LAS float*)lds;
        const float* kmp = (const float*)(ws + WS_KMP);
        for (int it = bid; it < 2048; it += G) {
            const int itt = it & 1023, j = itt >> 8, c = itt & 255, xcd = c & 7, slot = c >> 3, idx = j * 32 + slot;
            const int bh = xcd * 8 + (idx >> 4), q16 = idx & 15;
            if (it < 1024) {
                const int qblk = (j & 1) ? 15 - q16 : q16;
                __syncthreads();
                for (int e = tid; e < 1024; e += NTHREADS) km[e] = kmp[(size_t)bh * 1024 + e] + kmp[(size_t)(64 + bh) * 1024 + e];
                __syncthreads();
                attn_b_item(ws, km, bh, qblk, wid, lane);
            } else {
                attn_a_item(ws, bh, q16, wid, lane);
            }
        }
    }
    grid.sync();

    if constexpr ((PH_MASK & 8) != 0) {
        pg8::Gemm g{(const bf16_t*)(ws + WS_Y), (const bf16_t*)(ws + WS_BT1), NTOK, DM, DM};
        pg8::StaticOrder S; S.init(NTOK, DM, G, bid);
        EpiOut E{P.x, (float*)(ws + WS_X1), (bf16_t*)(ws + WS_X1B), (float*)(ws + WS_SSQ)};
        pg8::gemm_phase<EpiOut, pg8::StaticOrder, true, true>(lds, g, S, E);
    }
    grid.sync();

    if constexpr ((PH_MASK & 16) != 0) {
        pg8::Gemm g{(const bf16_t*)(ws + WS_X1B), (const bf16_t*)(ws + WS_BT2), NTOK, N_IN1, DM};
        pg8::StaticOrder S; S.init(NTOK, N_IN1, G, bid);
        EpiIn E{1, ws};
        pg8::gemm_phase<EpiIn, pg8::StaticOrder, true, true>(lds, g, S, E);
    }
    grid.sync();

    if constexpr ((PH_MASK & 32) != 0) {
        PHASE_IDS();
        for (int it = bid; it < 2048; it += G) {
            const int j = it >> 8, c = it & 255, xcd = c & 7, slot = c >> 3, idx = j * 32 + slot;
            const int bkv = xcd * 2 + (idx >> 7), rem = idx & 127, hq = (bkv & 1) * 8 + (rem >> 4), chunk = rem & 15;
            attn_c_item(ws, bkv >> 1, hq, chunk, wid, lane);
        }
    }
    grid.sync();

    if constexpr ((PH_MASK & 64) != 0) {
        pg8::Gemm g{(const bf16_t*)(ws + WS_Y), (const bf16_t*)(ws + WS_BT3), NTOK, DM, DM};
        pg8::StaticOrder S; S.init(NTOK, DM, G, bid);
        EpiOut E{(const float*)(ws + WS_X1), P.out, nullptr, nullptr};
        pg8::gemm_phase<EpiOut, pg8::StaticOrder, true, true>(lds, g, S, E);
    }
}

extern "C" void kernel_launch(void* const* d_in, const int* in_sizes, int n_in, void* d_out, int out_size, void* d_ws, size_t ws_size, hipStream_t stream) {
    static int grid_blocks = 0;
    if (grid_blocks == 0) {
        if (n_in != 14 || in_sizes[0] != NTOK * DM || out_size != NTOK * DM || ws_size < WS_END) {
            fprintf(stderr, "kernel_launch: unexpected shapes (n_in %d in0 %d out %d ws %zu)\n", n_in, n_in > 0 ? in_sizes[0] : -1, out_size, ws_size); grid_blocks = -1; return; }
        int dev = 0, cus = 0, per_cu = 0;
        hipGetDevice(&dev);
        hipDeviceGetAttribute(&cus, hipDeviceAttributeMultiprocessorCount, dev);
        if (hipFuncSetAttribute((const void*)fwd_megakernel, hipFuncAttributeMaxDynamicSharedMemorySize, LDS_BYTES) != hipSuccess) {
            fprintf(stderr, "kernel_launch: hipFuncSetAttribute failed\n"); grid_blocks = -1; return; }
        if (hipOccupancyMaxActiveBlocksPerMultiprocessor(&per_cu, (const void*)fwd_megakernel, NTHREADS, LDS_BYTES) != hipSuccess || per_cu < 1) {
            fprintf(stderr, "kernel_launch: occupancy query gave %d\n", per_cu); per_cu = 1; (void)hipGetLastError(); }
        grid_blocks = cus * 1;
        if (per_cu < 1) grid_blocks = -1;
    }
    if (grid_blocks < 0) return;
    Params p{};
    p.x = (const float*)d_in[0]; p.norm_even = (const float*)d_in[1]; p.w_in_even = (const float*)d_in[2]; p.w_out_even = (const float*)d_in[3];
    p.qn_a = (const float*)d_in[4]; p.kn_a = (const float*)d_in[5]; p.qn_b = (const float*)d_in[6]; p.kn_b = (const float*)d_in[7];
    p.norm_odd = (const float*)d_in[8]; p.w_in_odd = (const float*)d_in[9]; p.w_out_odd = (const float*)d_in[10];
    p.qn_c = (const float*)d_in[11]; p.kn_c = (const float*)d_in[12]; p.sinks = (const float*)d_in[13];
    p.out = (float*)d_out; p.ws = (unsigned char*)d_ws;
    void* args[] = {&p};
    hipError_t e = hipLaunchCooperativeKernel((const void*)fwd_megakernel, dim3(grid_blocks), dim3(NTHREADS), args, LDS_BYTES, stream);
    if (e != hipSuccess) fprintf(stderr, "cooperative launch failed: %s (grid %d)\n", hipGetErrorString(e), grid_blocks);
}
```

```cpp
#include <hip/hip_runtime.h>
#include <hip/hip_cooperative_groups.h>
#include <cstdio>
#include <cstdint>
namespace cg = cooperative_groups;
namespace pg8 {
#define PG8_LAS __attribute__((address_space(3)))
typedef unsigned short bf16_t;
typedef short bf16x8 __attribute__((ext_vector_type(8)));
typedef float f32x4 __attribute__((ext_vector_type(4)));
typedef unsigned u32x4 __attribute__((ext_vector_type(4)));
constexpr int BM = 256, BK = 64, HALF = 128, HTB = HALF * BK * 2  , STAGE_BYTES = 8 * HTB, NXCD = 8, WGM = 8;

__host__ __device__ __forceinline__ int lds_byte(int r, int c) { const int st = (r >> 4) * 2 + (c >> 5), rr = r & 15, cc = c & 31, ob = rr * 64 + cc * 2; return st * 1024 + (ob ^ (((ob >> 9) & 1) << 5)); }
__host__ __device__ __forceinline__ void stage_rc(int b, int& R, int& C) { const int st = b / 1024, sb = b % 1024, swz = sb ^ (((sb >> 9) & 1) << 5); R = (st >> 1) * 16 + swz / 64; C = (st & 1) * 32 + (swz % 64) / 2; }
__host__ __device__ __forceinline__ int perm32(int rho) { const int n = rho >> 4, i = rho & 15; return 8 * (i >> 2) + 4 * n + (i & 3); }

struct Unit { int pm, pn; };
struct Gemm { const bf16_t* A; const bf16_t* Bt; int M, N, K; };

struct StaticOrder {
    int nM, nN, nwg, G, c;
    __host__ __device__ void init(int M, int N, int G_, int c_) { nM = M / BM; nN = N / BM; nwg = nM * nN; G = G_; c = c_; }
    __host__ __device__ bool next(int i, Unit& u) const {
        const long L = (long)i * G + c; if (L >= nwg) return false;
        int wgid = (int)L; { const int q = nwg / NXCD, r = nwg % NXCD, xcd = wgid % NXCD, off = wgid / NXCD; wgid = (xcd < r ? xcd * (q + 1) : r * (q + 1) + (xcd - r) * q) + off; }
        const int nig = WGM * nN, gid = wgid / nig, fm = gid * WGM, gsz = (nM - fm) < WGM ? (nM - fm) : WGM;
        u.pm = fm + ((wgid % nig) % gsz); u.pn = (wgid % nig) / gsz; return true;
    }
    __device__ __forceinline__ void a_ready(const Unit&) const {}
    __device__ __forceinline__ void done(const Unit&) const {}
};

template <class Epi, class Sched, bool ALIGN_EPI = false, bool SP2 = false>
__device__ __forceinline__ void gemm_phase(PG8_LAS unsigned char* lds, const Gemm g, const Sched& S, const Epi& E) {
    int tid_l = threadIdx.x; asm volatile("" : "+v"(tid_l));
    const int tid = tid_l, wid = __builtin_amdgcn_readfirstlane(tid >> 6), lane = tid & 63, wr = wid >> 2, wc = wid & 3, fr = lane & 15, fq = lane >> 4;
    const int K = g.K, nt = K / BK;
    unsigned voffA[2], voffB[2];
#pragma unroll
    for (int i = 0; i < 2; ++i) { int R, C; stage_rc(tid * 16 + i * 8192, R, C); const int Rb = Epi::PERM ? ((R & ~31) + perm32(R & 31)) : R;
        voffA[i] = (unsigned)(R * K + C) * 2u; voffB[i] = (unsigned)(Rb * K + C) * 2u; }
    const size_t kstep = (size_t)(BK * 2);
    const size_t hstep = (size_t)HALF * K * 2;
    const size_t tstep = 2 * hstep;
    const unsigned ldsw = (unsigned)wid * 1024u;
    const int aoff = lds_byte(wr * 64 + fr, fq * 8), boff = lds_byte(wc * 32 + fr, fq * 8);
#define PG8_SA(b, h) (((b) * 2 + (h)) * HTB)
#define PG8_SB(b, h) ((4 + (b) * 2 + (h)) * HTB)
#define PG8_STAGE(bufoff, gbase, voff) do { _Pragma("unroll") for (int _i = 0; _i < 2; ++_i) \
        __builtin_amdgcn_global_load_lds((const unsigned*)((const char*)(gbase) + (voff)[_i]), (PG8_LAS unsigned*)(lds + (bufoff) + ldsw + _i * 8192), 16, 0, 0); } while (0)
#define PG8_LDA(dst, b, h) do { _Pragma("unroll") for (int m = 0; m < 4; ++m) _Pragma("unroll") for (int k = 0; k < 2; ++k) dst[m][k] = *(const PG8_LAS bf16x8*)(lds + PG8_SA(b, h) + aoff + m * 2048 + k * 1024); } while (0)
#define PG8_LDB(dst, b, h) do { _Pragma("unroll") for (int n = 0; n < 2; ++n) _Pragma("unroll") for (int k = 0; k < 2; ++k) dst[n][k] = *(const PG8_LAS bf16x8*)(lds + PG8_SB(b, h) + boff + n * 2048 + k * 1024); } while (0)
#define PG8_MMA(ai, bj, At, Bt) do { __builtin_amdgcn_s_setprio(1); _Pragma("unroll") for (int m = 0; m < 4; ++m) _Pragma("unroll") for (int n = 0; n < 2; ++n) _Pragma("unroll") for (int k = 0; k < 2; ++k) \
        acc[ai][bj][m][n] = __builtin_amdgcn_mfma_f32_16x16x32_bf16(Bt[n][k], At[m][k], acc[ai][bj][m][n], 0, 0, 0); __builtin_amdgcn_s_setprio(0); } while (0)
#define PG8_WAIT_V(n) asm volatile("s_waitcnt vmcnt(" #n ")" ::: "memory")
#define PG8_WAIT_L(n) asm volatile("s_waitcnt lgkmcnt(" #n ")" ::: "memory")
#define PG8_BAR __builtin_amdgcn_s_barrier()
#define PG8_SCHED __builtin_amdgcn_sched_barrier(0)
    Unit cur, nxt; int ui = 0;
    if (!S.next(0, cur)) return;
    f32x4 acc[2][2][4][2];
#pragma unroll
    for (int a = 0; a < 2; ++a)
#pragma unroll
        for (int b = 0; b < 2; ++b)
#pragma unroll
            for (int m = 0; m < 4; ++m)
#pragma unroll
                for (int n = 0; n < 2; ++n) acc[a][b][m][n] = (f32x4){0.f, 0.f, 0.f, 0.f};
    bf16x8 At[4][2], B0[2][2], B1[2][2];
    const char* cA = (const char*)g.A + (size_t)cur.pm * tstep; const char* cB = (const char*)g.Bt + (size_t)cur.pn * tstep;
    S.a_ready(cur);
    if constexpr (SP2) {
        PG8_STAGE(PG8_SB(0, 0), cB, voffB); PG8_STAGE(PG8_SB(0, 1), cB + hstep, voffB); PG8_STAGE(PG8_SA(0, 0), cA, voffA); PG8_STAGE(PG8_SA(0, 1), cA + hstep, voffA);
        if (wr == 1) PG8_BAR;
        PG8_WAIT_V(2); PG8_BAR;
        PG8_STAGE(PG8_SB(1, 0), cB + kstep, voffB); PG8_STAGE(PG8_SA(1, 0), cA + kstep, voffA); PG8_STAGE(PG8_SB(1, 1), cB + hstep + kstep, voffB);
        PG8_WAIT_V(6); PG8_BAR;
    } else {
        PG8_STAGE(PG8_SB(0, 0), cB, voffB); PG8_STAGE(PG8_SA(0, 0), cA, voffA); PG8_STAGE(PG8_SB(0, 1), cB + hstep, voffB); PG8_STAGE(PG8_SA(0, 1), cA + hstep, voffA);
        if (wr == 1) PG8_BAR;
        PG8_WAIT_V(4); PG8_BAR;
        PG8_STAGE(PG8_SB(1, 0), cB + kstep, voffB); PG8_STAGE(PG8_SA(1, 0), cA + kstep, voffA); PG8_STAGE(PG8_SB(1, 1), cB + hstep + kstep, voffB);
        PG8_WAIT_V(6); PG8_BAR;
    }
    for (;;) {
        const bool has_next = S.next(ui + 1, nxt);
        const char* nA = has_next ? (const char*)g.A + (size_t)nxt.pm * tstep : cA; const char* nB = has_next ? (const char*)g.Bt + (size_t)nxt.pn * tstep : cB;
        for (int t = 0; t < nt; t += 2) {
            const bool last = (t == nt - 2);
            const char* a1 = cA + (size_t)(t + 1) * kstep;
            const char* a2 = last ? nA : cA + (size_t)(t + 2) * kstep; const char* b2 = last ? nB : cB + (size_t)(t + 2) * kstep;
            const char* a3 = a2 + kstep; const char* b3 = b2 + kstep;
            if (last && has_next) S.a_ready(nxt);
            if constexpr (SP2) {
            PG8_LDB(B0, 0, 0); PG8_LDB(B1, 0, 1); PG8_SCHED; PG8_LDA(At, 0, 0); PG8_STAGE(PG8_SA(1, 1), a1 + hstep, voffA);
            PG8_WAIT_V(8); PG8_WAIT_L(0); PG8_BAR; PG8_MMA(0, 0, At, B0); PG8_MMA(0, 1, At, B1); PG8_BAR; PG8_SCHED;
            PG8_LDA(At, 0, 1); PG8_STAGE(PG8_SB(0, 0), b2, voffB); PG8_STAGE(PG8_SB(0, 1), b2 + hstep, voffB); PG8_STAGE(PG8_SA(0, 0), a2, voffA);
            PG8_WAIT_V(8); PG8_WAIT_L(0); PG8_BAR; PG8_MMA(1, 0, At, B0); PG8_MMA(1, 1, At, B1); PG8_BAR; PG8_SCHED;
            PG8_LDB(B0, 1, 0); PG8_LDB(B1, 1, 1); PG8_SCHED; PG8_LDA(At, 1, 0); PG8_STAGE(PG8_SA(0, 1), a2 + hstep, voffA);
            PG8_WAIT_V(8); PG8_WAIT_L(0); PG8_BAR; PG8_MMA(0, 0, At, B0); PG8_MMA(0, 1, At, B1); PG8_BAR; PG8_SCHED;
            PG8_LDA(At, 1, 1); PG8_STAGE(PG8_SB(1, 0), b3, voffB); PG8_STAGE(PG8_SB(1, 1), b3 + hstep, voffB); PG8_STAGE(PG8_SA(1, 0), a3, voffA);
            PG8_WAIT_V(8); PG8_WAIT_L(0); PG8_BAR; PG8_MMA(1, 0, At, B0); PG8_MMA(1, 1, At, B1); PG8_BAR; PG8_SCHED;
            } else {
            PG8_LDB(B0, 0, 0); PG8_SCHED; PG8_LDA(At, 0, 0); PG8_STAGE(PG8_SA(1, 1), a1 + hstep, voffA);
            PG8_WAIT_L(8); PG8_BAR; PG8_WAIT_L(0); PG8_MMA(0, 0, At, B0); PG8_BAR; PG8_SCHED;
            PG8_LDB(B1, 0, 1); PG8_STAGE(PG8_SB(0, 0), b2, voffB);
            PG8_BAR; PG8_WAIT_L(0); PG8_MMA(0, 1, At, B1); PG8_BAR;
            PG8_LDA(At, 0, 1); PG8_STAGE(PG8_SA(0, 0), a2, voffA);
            PG8_BAR; PG8_WAIT_L(0); PG8_MMA(1, 0, At, B0); PG8_BAR; PG8_SCHED;
            PG8_STAGE(PG8_SB(0, 1), b2 + hstep, voffB);
            PG8_WAIT_V(6); PG8_BAR; PG8_MMA(1, 1, At, B1); PG8_BAR;
            PG8_LDB(B0, 1, 0); PG8_SCHED; PG8_LDA(At, 1, 0); PG8_STAGE(PG8_SA(0, 1), a2 + hstep, voffA);
            PG8_WAIT_L(8); PG8_BAR; PG8_WAIT_L(0); PG8_MMA(0, 0, At, B0); PG8_BAR; PG8_SCHED;
            PG8_LDB(B1, 1, 1); PG8_STAGE(PG8_SB(1, 0), b3, voffB);
            PG8_BAR; PG8_WAIT_L(0); PG8_MMA(0, 1, At, B1); PG8_BAR;
            PG8_LDA(At, 1, 1); PG8_STAGE(PG8_SA(1, 0), a3, voffA);
            PG8_BAR; PG8_WAIT_L(0); PG8_MMA(1, 0, At, B0); PG8_BAR; PG8_SCHED;
            PG8_STAGE(PG8_SB(1, 1), b3 + hstep, voffB);
            PG8_WAIT_V(6); PG8_BAR; PG8_MMA(1, 1, At, B1); PG8_BAR;
            }
        }
        if constexpr (ALIGN_EPI) { if (wr == 0) PG8_BAR; }
        if constexpr (!Epi::AFTER_DRAIN) { E(acc, cur, wr, wc, fr, fq); S.done(cur); }
        if (!has_next) break;
#pragma unroll
        for (int a = 0; a < 2; ++a)
#pragma unroll
            for (int b = 0; b < 2; ++b)
#pragma unroll
                for (int m = 0; m < 4; ++m)
#pragma unroll
                    for (int n = 0; n < 2; ++n) acc[a][b][m][n] = (f32x4){0.f, 0.f, 0.f, 0.f};
        cur = nxt; cA = nA; cB = nB; ++ui;
        if constexpr (ALIGN_EPI) { if (wr == 1) PG8_BAR; }
    }
    PG8_WAIT_V(0);
    if constexpr (!ALIGN_EPI) { if (wr == 0) PG8_BAR; }
    PG8_BAR;
    if constexpr (Epi::AFTER_DRAIN) { E.fused(acc, cur, wr, wc, fr, fq, lds, wid, lane); S.done(cur); }
#undef PG8_SA
#undef PG8_SB
#undef PG8_STAGE
#undef PG8_LDA
#undef PG8_LDB
#undef PG8_MMA
#undef PG8_WAIT_V
#undef PG8_WAIT_L
#undef PG8_BAR
#undef PG8_SCHED
}
}

using pg8::bf16_t; using pg8::bf16x8; using pg8::f32x4; using pg8::u32x4; using pg8::Unit;
typedef float f32x16 __attribute__((ext_vector_type(16)));
typedef short s16x4 __attribute__((ext_vector_type(4)));
typedef unsigned u32x2 __attribute__((ext_vector_type(2)));
typedef float f32x2 __attribute__((ext_vector_type(2)));
#define DI __device__ __forceinline__
#define LAS __attribute__((address_space(3)))

constexpr int BATCH = 8, SEQ = 4096, DM = 1024, NTOK = BATCH * SEQ;
constexpr int N_IN0 = 4096, N_IN1 = 2304;
constexpr float NORM_EPS = 1e-6f;
constexpr float SC_LOG2 = 0.125f * 1.44269504088896341f;
constexpr float NEGBIG = -1e30f;
constexpr int NTHREADS = 512;
#ifndef PH_MASK
#define PH_MASK 0x7f
#endif
#ifndef PROBE_REP
#define PROBE_REP 0
#endif
#define NREP(k) (((PROBE_REP >> (k)) & 1) ? 2 : 1)
constexpr int LDS_BYTES = 131072 + 8192;

constexpr size_t MiB = 1u << 20;
constexpr size_t WS_BT0 = 0 * MiB, WS_BT1 = 8 * MiB, WS_BT2 = 10 * MiB, WS_BT3 = 15 * MiB;
constexpr size_t WS_GAINS = 17 * MiB;
constexpr size_t WS_RSTD0 = 18 * MiB, WS_CS = 19 * MiB, WS_KMP = 20 * MiB, WS_SSQ = 21 * MiB;
constexpr size_t WS_XB = 32 * MiB;
constexpr size_t WS_Y = 32 * MiB;
constexpr size_t WS_QA = 96 * MiB, WS_KA = 128 * MiB, WS_VTA = 160 * MiB, WS_QB = 192 * MiB, WS_KB = 224 * MiB, WS_VTB = 256 * MiB;
constexpr size_t WS_ZS = 288 * MiB;
constexpr size_t WS_X1 = 352 * MiB;
constexpr size_t WS_X1B = 96 * MiB;
constexpr size_t WS_QC = 160 * MiB, WS_KC = 224 * MiB, WS_VTC = 232 * MiB, WS_ZS1 = 240 * MiB;
constexpr size_t WS_END = 480 * MiB;

struct Params {
    const float* x; const float* norm_even; const float* w_in_even; const float* w_out_even;
    const float* qn_a; const float* kn_a; const float* qn_b; const float* kn_b;
    const float* norm_odd; const float* w_in_odd; const float* w_out_odd; const float* qn_c; const float* kn_c; const float* sinks;
    float* out; unsigned char* ws;
};

typedef __bf16 bf16v2 __attribute__((ext_vector_type(2)));
DI unsigned cvt_pk(float lo, float hi) { const f32x2 v = {lo, hi}; return __builtin_bit_cast(unsigned, __builtin_convertvector(v, bf16v2)); }
DI float bf_lo(unsigned u) { return __uint_as_float(u << 16); }
DI float bf_hi(unsigned u) { return __uint_as_float(u & 0xffff0000u); }

DI void p0_weight_tile(LAS float* tile, const float* W, bf16_t* Bt, int N, const float* g, bool permute, int t) {
    const int tid = threadIdx.x;
    const int ntn = N / 64, k0 = (t / ntn) * 64, n0 = (t % ntn) * 64;
    {
        const int n = tid & 63, kr = tid >> 6;
#pragma unroll
        for (int i = 0; i < 8; ++i) { const int k = kr + 8 * i; tile[k * 65 + n] = W[(size_t)(k0 + k) * N + n0 + n] * (g ? g[k0 + k] : 1.0f); }
    }
    __syncthreads();
    {
        const int nn = tid >> 3, ks = tid & 7;
        const int nlog = n0 + nn;
        const int c = permute ? ((nlog & ~255) | (((nlog >> 5) & 1) << 7) | (((nlog >> 6) & 3) << 5) | (nlog & 31)) : nlog;
        float v[8];
#pragma unroll
        for (int i = 0; i < 8; ++i) v[i] = tile[(ks * 8 + i) * 65 + nn];
        u32x4 w; w.x = cvt_pk(v[0], v[1]); w.y = cvt_pk(v[2], v[3]); w.z = cvt_pk(v[4], v[5]); w.w = cvt_pk(v[6], v[7]);
        *(u32x4*)(Bt + (size_t)c * 1024 + k0 + ks * 8) = w;
    }
    __syncthreads();
}

DI void sincos_d(double x, double& s, double& c) {
    const double kq = __builtin_rint(x * 0.63661977236758134308);
    double r = __builtin_fma(-kq, 1.57079632679489655800e+00, x); r = __builtin_fma(-kq, 6.12323399573676603587e-17, r);
    const int q = ((int)kq) & 3;
    const double r2 = r * r;
    const double sp = r * (1.0 + r2 * (-1.0 / 6 + r2 * (1.0 / 120 + r2 * (-1.0 / 5040 + r2 * (1.0 / 362880 + r2 * (-1.0 / 39916800 + r2 * (1.0 / 6227020800.0)))))));
    const double cp = 1.0 + r2 * (-0.5 + r2 * (1.0 / 24 + r2 * (-1.0 / 720 + r2 * (1.0 / 40320 + r2 * (-1.0 / 3628800 + r2 * (1.0 / 479001600.0 + r2 * (-1.0 / 87178291200.0)))))));
    s = (q == 0) ? sp : (q == 1) ? cp : (q == 2) ? -sp : -cp;
    c = (q == 0) ? cp : (q == 1) ? -sp : (q == 2) ? -cp : sp;
}

DI void p0_prologue(const Params& P, LAS unsigned char* lds) {
    unsigned char* ws = P.ws;
    const int tid = threadIdx.x, lane = tid & 63, wid = tid >> 6;
    const int G = gridDim.x, bid = blockIdx.x;
    {
        bf16_t* xb = (bf16_t*)(ws + WS_XB); float* rstd = (float*)(ws + WS_RSTD0);
        for (int row = bid * 8 + wid; row < NTOK; row += G * 8) {
            const f32x4* xr = (const f32x4*)(P.x + (size_t)row * DM);
            float ss = 0.f;
#pragma unroll
            for (int i = 0; i < 4; ++i) {
                const f32x4 v = xr[lane + 64 * i];
                ss += v[0] * v[0] + v[1] * v[1] + v[2] * v[2] + v[3] * v[3];
                u32x2 w; w.x = cvt_pk(v[0], v[1]); w.y = cvt_pk(v[2], v[3]);
                *(u32x2*)(xb + (size_t)row * DM + 4 * (lane + 64 * i)) = w;
            }
#pragma unroll
            for (int o = 32; o >= 1; o >>= 1) ss += __shfl_xor(ss, o);
            if (lane == 0) rstd[row] = rsqrtf(ss * (1.0f / DM) + NORM_EPS);
        }
    }
    if (bid == 0 && tid < 64) {
        float* gw = (float*)(ws + WS_GAINS);
        gw[tid] = P.qn_a[tid]; gw[64 + tid] = P.kn_a[tid]; gw[128 + tid] = P.qn_b[tid]; gw[192 + tid] = P.kn_b[tid]; gw[256 + tid] = P.qn_c[tid]; gw[320 + tid] = P.kn_c[tid];
        if (tid < 16) gw[384 + tid] = P.sinks[tid];
    }
    {
        f32x2* cs = (f32x2*)(ws + WS_CS);
        for (int e = bid * NTHREADS + tid; e < SEQ * 32; e += G * NTHREADS) {
            const int pos = e >> 5, i = e & 31;
            double f = 1.0;
            for (int k = 0; k < i; ++k) f *= 0.7498942093324558;
            const float invf = (float)f;
            const float ang = (float)pos * invf;
            double s, c; sincos_d((double)ang, s, c);
            cs[e] = (f32x2){(float)c, (float)s};
        }
    }
    {
        LAS float* tile = (LAS float*)lds;
        const int T0 = 16 * (N_IN0 / 64), T1 = 16 * (DM / 64), T2 = 16 * (N_IN1 / 64), T3 = 16 * (DM / 64);
        for (int t = bid; t < T0 + T1 + T2 + T3; t += G) {
            if (t < T0) p0_weight_tile(tile, P.w_in_even, (bf16_t*)(ws + WS_BT0), N_IN0, P.norm_even, true, t);
            else if (t < T0 + T1) p0_weight_tile(tile, P.w_out_even, (bf16_t*)(ws + WS_BT1), DM, nullptr, false, t - T0);
            else if (t < T0 + T1 + T2) p0_weight_tile(tile, P.w_in_odd, (bf16_t*)(ws + WS_BT2), N_IN1, P.norm_odd, true, t - T0 - T1);
            else p0_weight_tile(tile, P.w_out_odd, (bf16_t*)(ws + WS_BT3), DM, nullptr, false, t - T0 - T1 - T2);
        }
    }
}

DI float row_rstd1(const float* ssq, int row, int fq) {
    const f32x4 a = *(const f32x4*)(ssq + (size_t)row * 16 + 4 * fq);
    float t = (a[0] + a[1]) + (a[2] + a[3]);
    t += __shfl_xor(t, 16); t += __shfl_xor(t, 32);
    return rsqrtf(t * (1.0f / DM) + NORM_EPS);
}
struct EpiIn {
    static constexpr bool PERM = true, AFTER_DRAIN = false;
    int layer; unsigned char* ws;
    __device__ __forceinline__ void operator()(const f32x4 (&acc)[2][2][4][2], const Unit& u, int wr, int wc, int fr, int fq) const {
        const float* rstd0 = (const float*)(ws + WS_RSTD0); const float* ssq = (const float*)(ws + WS_SSQ); const f32x2* cs = (const f32x2*)(ws + WS_CS);
        const float* gains = (const float*)(ws + WS_GAINS); bf16_t* zs = (bf16_t*)(ws + (layer == 0 ? WS_ZS : WS_ZS1)); float* kmp = (float*)(ws + WS_KMP);
        int mode, head, hpb = 8, zcol = 0; bf16_t* dst = nullptr; const float* gain = gains; bool do_km = false;
        if (layer == 0) {
            const int seg = u.pn >> 1; head = (u.pn & 1) * 4 + wc;
            if (seg == 0) { mode = 0; dst = (bf16_t*)(ws + WS_QA); gain = gains; }
            else if (seg == 1) { mode = 0; dst = (bf16_t*)(ws + WS_KA); gain = gains + 64; }
            else if (seg == 2) { mode = 1; dst = (bf16_t*)(ws + WS_VTA); }
            else if (seg == 3) { mode = 2; zcol = head * 64; }
            else if (seg == 4) { mode = 0; dst = (bf16_t*)(ws + WS_QB); gain = gains + 128; }
            else if (seg == 5) { mode = 0; dst = (bf16_t*)(ws + WS_KB); gain = gains + 192; do_km = true; }
            else if (seg == 6) { mode = 1; dst = (bf16_t*)(ws + WS_VTB); }
            else { mode = 2; zcol = 512 + head * 64; }
        } else {
            if (u.pn < 4) { mode = 0; dst = (bf16_t*)(ws + WS_QC); gain = gains + 256; head = u.pn * 4 + wc; hpb = 16; }
            else if (u.pn == 4) { hpb = 2; if (wc < 2) { mode = 0; dst = (bf16_t*)(ws + WS_KC); gain = gains + 320; head = wc; } else { mode = 1; dst = (bf16_t*)(ws + WS_VTC); head = wc - 2; } }
            else { mode = 2; head = (u.pn - 5) * 4 + wc; zcol = head * 64; }
        }
        const int b = u.pm >> 4, sbase = (u.pm & 15) * 256 + wr * 64 + fr, rowbase = u.pm * 256 + wr * 64 + fr;
        const size_t bh = (size_t)b * hpb + head;
#define ROW_RS(row) ((layer == 0) ? rstd0[(row)] : row_rstd1(ssq, (row), fq))
        if (mode == 0) {
            float g0[8], g1[8], cs0[8], cs1[8];
#pragma unroll
            for (int i = 0; i < 8; ++i) { g0[i] = gain[8 * fq + i]; g1[i] = gain[32 + 8 * fq + i]; cs0[i] = 0.f; cs1[i] = 0.f; }
#pragma unroll
            for (int ai = 0; ai < 2; ++ai)
#pragma unroll
                for (int m = 0; m < 4; ++m) {
                    const int s = sbase + ai * 128 + m * 16; const float r = ROW_RS(rowbase + ai * 128 + m * 16);
                    float t0[8], t1[8]; float ss = 0.f;
#pragma unroll
                    for (int n = 0; n < 2; ++n)
#pragma unroll
                        for (int j = 0; j < 4; ++j) { t0[4 * n + j] = acc[ai][0][m][n][j] * r; t1[4 * n + j] = acc[ai][1][m][n][j] * r; }
#pragma unroll
                    for (int i = 0; i < 8; ++i) ss += t0[i] * t0[i] + t1[i] * t1[i];
                    ss += __shfl_xor(ss, 16); ss += __shfl_xor(ss, 32);
                    const float hr = rsqrtf(ss * (1.0f / 64.0f) + NORM_EPS);
                    const f32x4* cp = (const f32x4*)(cs + (size_t)s * 32 + 8 * fq);
                    float o0[8], o1[8];
#pragma unroll
                    for (int q = 0; q < 4; ++q) { const f32x4 c4 = cp[q];
                        { const int i = 2 * q; const float a = t0[i] * hr * g0[i], bb = t1[i] * hr * g1[i]; o0[i] = a * c4[0] - bb * c4[1]; o1[i] = bb * c4[0] + a * c4[1]; }
                        { const int i = 2 * q + 1; const float a = t0[i] * hr * g0[i], bb = t1[i] * hr * g1[i]; o0[i] = a * c4[2] - bb * c4[3]; o1[i] = bb * c4[2] + a * c4[3]; } }
                    u32x4 w0, w1;
                    w0.x = cvt_pk(o0[0], o0[1]); w0.y = cvt_pk(o0[2], o0[3]); w0.z = cvt_pk(o0[4], o0[5]); w0.w = cvt_pk(o0[6], o0[7]);
                    w1.x = cvt_pk(o1[0], o1[1]); w1.y = cvt_pk(o1[2], o1[3]); w1.z = cvt_pk(o1[4], o1[5]); w1.w = cvt_pk(o1[6], o1[7]);
                    bf16_t* rp = dst + ((bh * SEQ + s) * 64 + 8 * fq);
                    *(u32x4*)rp = w0; *(u32x4*)(rp + 32) = w1;
                    if (do_km) {
#pragma unroll
                        for (int i = 0; i < 8; ++i) { cs0[i] += o0[i]; cs1[i] += o1[i]; }
                    }
                }
            if (do_km) {
#pragma unroll
                for (int i = 0; i < 8; ++i) {
#pragma unroll
                    for (int o = 1; o <= 8; o <<= 1) { cs0[i] += __shfl_xor(cs0[i], o); cs1[i] += __shfl_xor(cs1[i], o); }
                }
                if (fr == 0) {
                    float* kp = kmp + (((size_t)wr * 64 + bh) * 16 + (u.pm & 15)) * 64 + 8 * fq;
                    *(f32x4*)kp = (f32x4){cs0[0], cs0[1], cs0[2], cs0[3]}; *(f32x4*)(kp + 4) = (f32x4){cs0[4], cs0[5], cs0[6], cs0[7]};
                    *(f32x4*)(kp + 32) = (f32x4){cs1[0], cs1[1], cs1[2], cs1[3]}; *(f32x4*)(kp + 36) = (f32x4){cs1[4], cs1[5], cs1[6], cs1[7]};
                }
            }
        } else if (mode == 1) {
#pragma unroll
            for (int ai = 0; ai < 2; ++ai)
#pragma unroll
                for (int m = 0; m < 4; ++m) {
                    const int s = sbase + ai * 128 + m * 16; const float r = ROW_RS(rowbase + ai * 128 + m * 16);
                    bf16_t* rp = dst + ((bh * SEQ + s) * 64 + 8 * fq);
#pragma unroll
                    for (int bj = 0; bj < 2; ++bj) {
                        const f32x4 v0 = acc[ai][bj][m][0] * r, v1 = acc[ai][bj][m][1] * r;
                        u32x4 w; w.x = cvt_pk(v0[0], v0[1]); w.y = cvt_pk(v0[2], v0[3]); w.z = cvt_pk(v1[0], v1[1]); w.w = cvt_pk(v1[2], v1[3]);
                        *(u32x4*)(rp + 32 * bj) = w;
                    }
                }
        } else {
#pragma unroll
            for (int ai = 0; ai < 2; ++ai)
#pragma unroll
                for (int m = 0; m < 4; ++m) {
                    const int row = rowbase + ai * 128 + m * 16; const float r = ROW_RS(row);
#pragma unroll
                    for (int bj = 0; bj < 2; ++bj) {
                        float sv[8];
#pragma unroll
                        for (int n = 0; n < 2; ++n)
#pragma unroll
                            for (int j = 0; j < 4; ++j) { const float z = acc[ai][bj][m][n][j] * r; sv[4 * n + j] = z / (1.0f + __expf(-z)); }
                        u32x4 w; w.x = cvt_pk(sv[0], sv[1]); w.y = cvt_pk(sv[2], sv[3]); w.z = cvt_pk(sv[4], sv[5]); w.w = cvt_pk(sv[6], sv[7]);
                        *(u32x4*)(zs + (size_t)row * DM + zcol + 32 * bj + 8 * fq) = w;
                    }
                }
        }
    }
};

struct EpiOut {
    static constexpr bool PERM = true, AFTER_DRAIN = false;
    const float* resid; float* out; bf16_t* xb; float* ssq;
    __device__ __forceinline__ void operator()(const f32x4 (&acc)[2][2][4][2], const Unit& u, int wr, int wc, int fr, int fq) const {
        const int col0 = u.pn * 256 + wc * 32 + 8 * fq, rowbase = u.pm * 256 + wr * 64 + fr;
#pragma unroll
        for (int ai = 0; ai < 2; ++ai)
#pragma unroll
            for (int m = 0; m < 4; ++m) {
                const int row = rowbase + ai * 128 + m * 16; const size_t off = (size_t)row * DM + col0;
                float q = 0.f;
#pragma unroll
                for (int bj = 0; bj < 2; ++bj) {
                    const f32x4 r0 = *(const f32x4*)(resid + off + bj * 128), r1 = *(const f32x4*)(resid + off + bj * 128 + 4);
                    const f32x4 o0 = r0 + acc[ai][bj][m][0], o1 = r1 + acc[ai][bj][m][1];
                    *(f32x4*)(out + off + bj * 128) = o0; *(f32x4*)(out + off + bj * 128 + 4) = o1;
                    if (xb) {
                        u32x4 w; w.x = cvt_pk(o0[0], o0[1]); w.y = cvt_pk(o0[2], o0[3]); w.z = cvt_pk(o1[0], o1[1]); w.w = cvt_pk(o1[2], o1[3]);
                        *(u32x4*)(xb + off + bj * 128) = w;
                        q += (o0[0] * o0[0] + o0[1] * o0[1]) + (o0[2] * o0[2] + o0[3] * o0[3]) + (o1[0] * o1[0] + o1[1] * o1[1]) + (o1[2] * o1[2] + o1[3] * o1[3]);
                    }
                }
                if (xb) { q += __shfl_xor(q, 16); q += __shfl_xor(q, 32); if (fq == 0) ssq[(size_t)row * 16 + u.pn * 4 + wc] = q; }
            }
    }
};

#define MFMA32(a, b, c) __builtin_amdgcn_mfma_f32_32x32x16_bf16((a), (b), (c), 0, 0, 0)
constexpr int TROW = 144;
constexpr int TBUF = 2 * 32 * TROW;
struct TileRegs { u32x4 k[4]; u32x4 v[4]; };
struct ASt { f32x16 o0, o1; float m, l; };

DI void ast_init(ASt& st) {
#pragma unroll
    for (int i = 0; i < 16; ++i) { st.o0[i] = 0.f; st.o1[i] = 0.f; }
    st.m = NEGBIG; st.l = 0.f;
}

DI void tile_gload(TileRegs& t, const bf16_t* K, const bf16_t* V, int kbase, int kstride, int lane) {
    const int row0 = lane >> 3, ch = lane & 7;
#pragma unroll
    for (int i = 0; i < 4; ++i) {
        const size_t off = (size_t)(kbase + kstride * (row0 + 8 * i)) * 64 + ch * 8;
        t.k[i] = *(const u32x4*)(K + off); t.v[i] = *(const u32x4*)(V + off);
    }
}
DI void tile_lds_write(LAS unsigned char* buf, const TileRegs& t, int lane) {
    const int row0 = lane >> 3, ch = lane & 7;
#pragma unroll
    for (int i = 0; i < 4; ++i) {
        const int off = (row0 + 8 * i) * TROW + ch * 16;
        *(LAS u32x4*)(buf + off) = t.k[i]; *(LAS u32x4*)(buf + 32 * TROW + off) = t.v[i];
    }
}

DI void attn_tile(ASt& st, const bf16x8 (&qf)[4], LAS unsigned char* buf, int dist0, int kstride, int hi, int lane) {
    const int r = lane & 31, h = lane >> 5;
    f32x16 s;
#pragma unroll
    for (int i = 0; i < 16; ++i) s[i] = 0.f;
#pragma unroll
    for (int ks = 0; ks < 4; ++ks) { const bf16x8 kf = *(const LAS bf16x8*)(buf + r * TROW + (2 * ks + h) * 16); s = MFMA32(kf, qf[ks], s); }
    bf16x8 vf[2][2];
    {
        const int q = (lane & 15) >> 2, p = lane & 3, blk = (lane >> 4) & 1;
        LAS unsigned char* vb = buf + 32 * TROW + (4 * h + q) * TROW + 32 * blk + 8 * p;
#pragma unroll
        for (int dt = 0; dt < 2; ++dt)
#pragma unroll
            for (int s2 = 0; s2 < 2; ++s2) {
                const s16x4 lo = __builtin_amdgcn_ds_read_tr16_b64_v4i16((LAS s16x4*)(vb + (16 * s2) * TROW + 64 * dt));
                const s16x4 hi4 = __builtin_amdgcn_ds_read_tr16_b64_v4i16((LAS s16x4*)(vb + (16 * s2 + 8) * TROW + 64 * dt));
                vf[dt][s2] = __builtin_shufflevector(lo, hi4, 0, 1, 2, 3, 4, 5, 6, 7);
            }
    }
    float tmax = NEGBIG;
#pragma unroll
    for (int i = 0; i < 16; ++i) {
        const int dist = dist0 - kstride * ((i & 3) + 8 * (i >> 2));
        const bool ok = (dist >= 0) && (dist <= hi);
        s[i] = ok ? s[i] * SC_LOG2 : NEGBIG;
        tmax = fmaxf(tmax, s[i]);
    }
    tmax = fmaxf(tmax, __shfl_xor(tmax, 32));
    const float mnew = fmaxf(st.m, tmax);
    const float alpha = __builtin_amdgcn_exp2f(st.m - mnew);
    const float msub = (mnew < -1e29f) ? 0.f : mnew;
    st.m = mnew;
    float ps = 0.f;
#pragma unroll
    for (int i = 0; i < 16; ++i) { s[i] = __builtin_amdgcn_exp2f(s[i] - msub); ps += s[i]; }
    st.l = st.l * alpha + ps;
#pragma unroll
    for (int i = 0; i < 16; ++i) { st.o0[i] *= alpha; st.o1[i] *= alpha; }
#pragma unroll
    for (int s2 = 0; s2 < 2; ++s2) {
        u32x4 p;
        p.x = cvt_pk(s[8 * s2 + 0], s[8 * s2 + 1]); p.y = cvt_pk(s[8 * s2 + 2], s[8 * s2 + 3]);
        p.z = cvt_pk(s[8 * s2 + 4], s[8 * s2 + 5]); p.w = cvt_pk(s[8 * s2 + 6], s[8 * s2 + 7]);
        const bf16x8 pb = __builtin_bit_cast(bf16x8, p);
        st.o0 = MFMA32(vf[0][s2], pb, st.o0);
        st.o1 = MFMA32(vf[1][s2], pb, st.o1);
    }
}

DI void load_q(bf16x8 (&qf)[4], const bf16_t* qrow, int h) {
    const bf16x8* qp = (const bf16x8*)qrow;
#pragma unroll
    for (int ks = 0; ks < 4; ++ks) qf[ks] = qp[2 * ks + h];
}

DI void attn_finish(ASt& st, float sink_l2, const bf16_t* zs, bf16_t* y, size_t rowoff  , int h) {
    float l = st.l + __shfl_xor(st.l, 32);
    const float mf = fmaxf(st.m, sink_l2);
    const float a = __builtin_amdgcn_exp2f(st.m - mf);
    l = l * a + ((sink_l2 > -1e29f) ? __builtin_amdgcn_exp2f(sink_l2 - mf) : 0.f);
    const float inv = a / l;
#pragma unroll
    for (int dt = 0; dt < 2; ++dt)
#pragma unroll
        for (int g = 0; g < 4; ++g) {
            const size_t off = rowoff + 32 * dt + 8 * g + 4 * h;
            const u32x2 z = *(const u32x2*)(zs + off);
            const float v0 = (dt ? st.o1[4 * g + 0] : st.o0[4 * g + 0]) * inv * bf_lo(z.x);
            const float v1 = (dt ? st.o1[4 * g + 1] : st.o0[4 * g + 1]) * inv * bf_hi(z.x);
            const float v2 = (dt ? st.o1[4 * g + 2] : st.o0[4 * g + 2]) * inv * bf_lo(z.y);
            const float v3 = (dt ? st.o1[4 * g + 3] : st.o0[4 * g + 3]) * inv * bf_hi(z.y);
            u32x2 w; w.x = cvt_pk(v0, v1); w.y = cvt_pk(v2, v3);
            *(u32x2*)(y + off) = w;
        }
}

DI bool a_tile_desc(int tau, int r16, int i0, int& kbase, int& kstride, int& hi) {
    if (tau < 5) { const int jb = i0 - 128 + 32 * tau; kbase = r16 + 16 * jb; kstride = 16; hi = 2048; return jb >= 0; }
    if (tau < 13) { const int ub = 4 * i0 - 128 + 32 * (tau - 5); kbase = (r16 & 3) + 4 * ub; kstride = 4; hi = 512; return ub >= 0; }
    { const int kb = 16 * i0 - 128 + 32 * (tau - 13); kbase = kb; kstride = 1; hi = 128; return kb >= 0; }
}
DI void attn_a_item(unsigned char* ws, LAS unsigned char* buf, int bh, int r16, int i0, int lane) {
    const int r = lane & 31, h = lane >> 5;
    const bf16_t* Q = (const bf16_t*)(ws + WS_QA) + (size_t)bh * SEQ * 64;
    const bf16_t* K = (const bf16_t*)(ws + WS_KA) + (size_t)bh * SEQ * 64;
    const bf16_t* V = (const bf16_t*)(ws + WS_VTA) + (size_t)bh * SEQ * 64;
    const int qpos = r16 + 16 * (i0 + r);
    bf16x8 qf[4]; load_q(qf, Q + (size_t)qpos * 64, h);
    ASt st; ast_init(st);
    TileRegs tr;
    int tau = 0, kb, kst, hi;
    while (!a_tile_desc(tau, r16, i0, kb, kst, hi)) ++tau;
    tile_gload(tr, K, V, kb, kst, lane);
    tile_lds_write(buf, tr, lane);
    for (;;) {
        int tn = tau + 1, kb2 = 0, kst2 = 1, hi2 = 0; bool have = false;
        while (tn < 33) { if (a_tile_desc(tn, r16, i0, kb2, kst2, hi2)) { have = true; break; } ++tn; }
        if (have) tile_gload(tr, K, V, kb2, kst2, lane);
        attn_tile(st, qf, buf, qpos - kb - kst * 4 * h, kst, hi, lane);
        if (!have) break;
        tile_lds_write(buf, tr, lane);
        tau = tn; kb = kb2; kst = kst2; hi = hi2;
    }
    const int b = bh >> 3, head = bh & 7;
    const size_t rowoff = ((size_t)b * SEQ + qpos) * DM + head * 64;
    attn_finish(st, NEGBIG, (const bf16_t*)(ws + WS_ZS), (bf16_t*)(ws + WS_Y), rowoff, h);
}

DI void attn_b_item(unsigned char* ws, LAS unsigned char* buf, LAS float* km  , int bh, int qblk, int wid, int lane) {
    const int r = lane & 31, h = lane >> 5;
    const bf16_t* Q = (const bf16_t*)(ws + WS_QB) + (size_t)bh * SEQ * 64;
    const bf16_t* K = (const bf16_t*)(ws + WS_KB) + (size_t)bh * SEQ * 64;
    const bf16_t* V = (const bf16_t*)(ws + WS_VTB) + (size_t)bh * SEQ * 64;
    const int qpos = qblk * 256 + wid * 32 + r;
    bf16x8 qf[4]; load_q(qf, Q + (size_t)qpos * 64, h);
    float v1 = -3e38f, v2 = -3e38f, v3 = -3e38f; int i1 = 31, i2 = 31, i3 = 31;
    for (int n = 0; n < qblk; ++n) {
        float g = 0.f;
#pragma unroll
        for (int ks = 0; ks < 4; ++ks) {
            const LAS f32x4* kp = (const LAS f32x4*)(km + n * 64 + 16 * ks + 8 * h);
            const f32x4 a = kp[0], bq = kp[1];
            const u32x4 qu = __builtin_bit_cast(u32x4, qf[ks]);
            g += bf_lo(qu.x) * a[0] + bf_hi(qu.x) * a[1] + bf_lo(qu.y) * a[2] + bf_hi(qu.y) * a[3]
               + bf_lo(qu.z) * bq[0] + bf_hi(qu.z) * bq[1] + bf_lo(qu.w) * bq[2] + bf_hi(qu.w) * bq[3];
        }
        g += __shfl_xor(g, 32);
        if (g > v1) { v3 = v2; i3 = i2; v2 = v1; i2 = i1; v1 = g; i1 = n; }
        else if (g > v2) { v3 = v2; i3 = i2; v2 = g; i2 = n; }
        else if (g > v3) { v3 = g; i3 = n; }
    }
    unsigned sel = 0u;
    if (i1 < 16) sel |= 1u << i1;
    if (i2 < 16) sel |= 1u << i2;
    if (i3 < 16) sel |= 1u << i3;
    unsigned uni = 0u;
    for (int n = 0; n < qblk; ++n) { if (__builtin_amdgcn_ballot_w64((sel >> n) & 1u) != 0ull) uni |= 1u << n; }
    uni |= 1u << qblk;
    const int own_tiles = wid + 1;
    ASt st; ast_init(st);
    TileRegs tr;
    int n = __builtin_ctz(uni), T = 0;
    tile_gload(tr, K, V, n * 256, 1, lane);
    tile_lds_write(buf, tr, lane);
    for (;;) {
        const int cnt = (n == qblk) ? own_tiles : 8;
        int n2 = n, T2 = T + 1; bool have = true;
        if (T2 >= cnt) { const unsigned rest = uni & ~((2u << n) - 1u); if (rest) { n2 = __builtin_ctz(rest); T2 = 0; } else have = false; }
        if (have) tile_gload(tr, K, V, n2 * 256 + 32 * T2, 1, lane);
        const int kb = n * 256 + 32 * T;
        const int hi = (n == qblk || ((sel >> n) & 1u)) ? 0x7fffffff : -1;
        attn_tile(st, qf, buf, qpos - kb - 4 * h, 1, hi, lane);
        if (!have) break;
        tile_lds_write(buf, tr, lane);
        n = n2; T = T2;
    }
    const int b = bh >> 3, head = 8 + (bh & 7);
    const size_t rowoff = ((size_t)b * SEQ + qpos) * DM + head * 64;
    attn_finish(st, NEGBIG, (const bf16_t*)(ws + WS_ZS), (bf16_t*)(ws + WS_Y), rowoff, h);
}

DI void attn_c_item(unsigned char* ws, LAS unsigned char* buf, int b, int hq, int chunk, int wid, int lane) {
    const int r = lane & 31, h = lane >> 5, kvh = hq >> 3;
    const bf16_t* Q = (const bf16_t*)(ws + WS_QC) + ((size_t)b * 16 + hq) * SEQ * 64;
    const bf16_t* K = (const bf16_t*)(ws + WS_KC) + ((size_t)b * 2 + kvh) * SEQ * 64;
    const bf16_t* V = (const bf16_t*)(ws + WS_VTC) + ((size_t)b * 2 + kvh) * SEQ * 64;
    const int t0 = chunk * 256 + wid * 32, qpos = t0 + r;
    bf16x8 qf[4]; load_q(qf, Q + (size_t)qpos * 64, h);
    ASt st; ast_init(st);
    TileRegs tr;
    int T = (t0 >= 128) ? 0 : (128 - t0) / 32;
    tile_gload(tr, K, V, t0 - 128 + 32 * T, 1, lane);
    tile_lds_write(buf, tr, lane);
    for (;;) {
        const bool have = (T + 1) < 5;
        if (have) tile_gload(tr, K, V, t0 - 128 + 32 * (T + 1), 1, lane);
        attn_tile(st, qf, buf, qpos - (t0 - 128 + 32 * T) - 4 * h, 1, 127, lane);
        if (!have) break;
        tile_lds_write(buf, tr, lane);
        ++T;
    }
    const size_t rowoff = ((size_t)b * SEQ + qpos) * DM + hq * 64;
    attn_finish(st, ((const float*)(ws + WS_GAINS))[384 + hq] * 1.44269504088896341f, (const bf16_t*)(ws + WS_ZS1), (bf16_t*)(ws + WS_Y), rowoff, h);
}

__global__ void __launch_bounds__(NTHREADS) fwd_megakernel(Params P) {
    extern __shared__ __attribute__((aligned(16))) unsigned char lds_raw[];
    cg::grid_group grid = cg::this_grid();
    LAS unsigned char* lds = (LAS unsigned char*)lds_raw;
    unsigned char* ws = P.ws;
    const int G = gridDim.x, bid = blockIdx.x;
#define PHASE_IDS() int tid_l = threadIdx.x; asm volatile("" : "+v"(tid_l)); const int tid = tid_l, lane = tid & 63, wid = __builtin_amdgcn_readfirstlane(tid >> 6); (void)lane; (void)wid

    if constexpr (PH_MASK & 1) { for (int rep = 0; rep < NREP(0); ++rep) p0_prologue(P, lds); }
    grid.sync();

    if constexpr ((PH_MASK & 2) != 0) {
        pg8::Gemm g{(const bf16_t*)(ws + WS_XB), (const bf16_t*)(ws + WS_BT0), NTOK, N_IN0, DM};
        pg8::StaticOrder S; S.init(NTOK, N_IN0, G, bid);
        EpiIn E{0, ws};
        for (int rep = 0; rep < NREP(1); ++rep) pg8::gemm_phase<EpiIn, pg8::StaticOrder, true, true>(lds, g, S, E);
    }
    grid.sync();

    if constexpr ((PH_MASK & 4) != 0) {
        PHASE_IDS();
        LAS float* km = (LAS float*)(lds + 8 * TBUF);
        LAS unsigned char* buf = lds + wid * TBUF;
        const float* kmp = (const float*)(ws + WS_KMP);
        for (int rep = 0; rep < 2; ++rep)
        for (int it = bid; it < 2048; it += G) {
            if (rep == 1 && !((it < 1024) ? (NREP(2) == 2) : (NREP(7) == 2))) continue;
            const int itt = it & 1023, j = itt >> 8, c = itt & 255, xcd = c & 7, slot = c >> 3, idx = j * 32 + slot;
            const int bh = xcd * 8 + (idx >> 4), q16 = idx & 15;
            if (it < 1024) {
                const int qblk = (j & 1) ? 15 - q16 : q16;
                __syncthreads();
                for (int e = tid; e < 1024; e += NTHREADS) km[e] = kmp[(size_t)bh * 1024 + e] + kmp[(size_t)(64 + bh) * 1024 + e];
                __syncthreads();
                attn_b_item(ws, buf, km, bh, qblk, wid, lane);
            } else {
                attn_a_item(ws, buf, bh, (q16 & 1) * 8 + wid, (q16 >> 1) * 32, lane);
            }
        }
    }
    grid.sync();

    if constexpr ((PH_MASK & 8) != 0) {
        pg8::Gemm g{(const bf16_t*)(ws + WS_Y), (const bf16_t*)(ws + WS_BT1), NTOK, DM, DM};
        pg8::StaticOrder S; S.init(NTOK, DM, G, bid);
        EpiOut E{P.x, (float*)(ws + WS_X1), (bf16_t*)(ws + WS_X1B), (float*)(ws + WS_SSQ)};
        for (int rep = 0; rep < NREP(3); ++rep) pg8::gemm_phase<EpiOut, pg8::StaticOrder, true, true>(lds, g, S, E);
    }
    grid.sync();

    if constexpr ((PH_MASK & 16) != 0) {
        pg8::Gemm g{(const bf16_t*)(ws + WS_X1B), (const bf16_t*)(ws + WS_BT2), NTOK, N_IN1, DM};
        pg8::StaticOrder S; S.init(NTOK, N_IN1, G, bid);
        EpiIn E{1, ws};
        for (int rep = 0; rep < NREP(4); ++rep) pg8::gemm_phase<EpiIn, pg8::StaticOrder, true, true>(lds, g, S, E);
    }
    grid.sync();

    if constexpr ((PH_MASK & 32) != 0) {
        PHASE_IDS();
        for (int rep = 0; rep < NREP(5); ++rep)
        for (int it = bid; it < 2048; it += G) {
            const int j = it >> 8, c = it & 255, xcd = c & 7, slot = c >> 3, idx = j * 32 + slot;
            const int bkv = xcd * 2 + (idx >> 7), rem = idx & 127, hq = (bkv & 1) * 8 + (rem >> 4), chunk = rem & 15;
            attn_c_item(ws, lds + wid * TBUF, bkv >> 1, hq, chunk, wid, lane);
        }
    }
    grid.sync();

    if constexpr ((PH_MASK & 64) != 0) {
        pg8::Gemm g{(const bf16_t*)(ws + WS_Y), (const bf16_t*)(ws + WS_BT3), NTOK, DM, DM};
        pg8::StaticOrder S; S.init(NTOK, DM, G, bid);
        EpiOut E{(const float*)(ws + WS_X1), P.out, nullptr, nullptr};
        for (int rep = 0; rep < NREP(6); ++rep) pg8::gemm_phase<EpiOut, pg8::StaticOrder, true, true>(lds, g, S, E);
    }
}

extern "C" void kernel_launch(void* const* d_in, const int* in_sizes, int n_in, void* d_out, int out_size, void* d_ws, size_t ws_size, hipStream_t stream) {
    static int grid_blocks = 0;
    if (grid_blocks == 0) {
        if (n_in != 14 || in_sizes[0] != NTOK * DM || out_size != NTOK * DM || ws_size < WS_END) {
            fprintf(stderr, "kernel_launch: unexpected shapes (n_in %d in0 %d out %d ws %zu)\n", n_in, n_in > 0 ? in_sizes[0] : -1, out_size, ws_size); grid_blocks = -1; return; }
        int dev = 0, cus = 0, per_cu = 0;
        hipGetDevice(&dev);
        hipDeviceGetAttribute(&cus, hipDeviceAttributeMultiprocessorCount, dev);
        if (hipFuncSetAttribute((const void*)fwd_megakernel, hipFuncAttributeMaxDynamicSharedMemorySize, LDS_BYTES) != hipSuccess) {
            fprintf(stderr, "kernel_launch: hipFuncSetAttribute failed\n"); grid_blocks = -1; return; }
        if (hipOccupancyMaxActiveBlocksPerMultiprocessor(&per_cu, (const void*)fwd_megakernel, NTHREADS, LDS_BYTES) != hipSuccess || per_cu < 1) {
            fprintf(stderr, "kernel_launch: occupancy query gave %d\n", per_cu); per_cu = 1; (void)hipGetLastError(); }
        grid_blocks = cus * 1;
        if (per_cu < 1) grid_blocks = -1;
    }
    if (grid_blocks < 0) return;
    Params p{};
    p.x = (const float*)d_in[0]; p.norm_even = (const float*)d_in[1]; p.w_in_even = (const float*)d_in[2]; p.w_out_even = (const float*)d_in[3];
    p.qn_a = (const float*)d_in[4]; p.kn_a = (const float*)d_in[5]; p.qn_b = (const float*)d_in[6]; p.kn_b = (const float*)d_in[7];
    p.norm_odd = (const float*)d_in[8]; p.w_in_odd = (const float*)d_in[9]; p.w_out_odd = (const float*)d_in[10];
    p.qn_c = (const float*)d_in[11]; p.kn_c = (const float*)d_in[12]; p.sinks = (const float*)d_in[13];
    p.out = (float*)d_out; p.ws = (unsigned char*)d_ws;
    void* args[] = {&p};
    hipError_t e = hipLaunchCooperativeKernel((const void*)fwd_megakernel, dim3(grid_blocks), dim3(NTHREADS), args, LDS_BYTES, stream);
    if (e != hipSuccess) fprintf(stderr, "cooperative launch failed: %s (grid %d)\n", hipGetErrorString(e), grid_blocks);
}
```

```cpp
#include <hip/hip_runtime.h>
#include <hip/hip_cooperative_groups.h>
#include <cstdio>
#include <cstdint>
namespace cg = cooperative_groups;
namespace pg8 {
#define PG8_LAS __attribute__((address_space(3)))
typedef unsigned short bf16_t;
typedef short bf16x8 __attribute__((ext_vector_type(8)));
typedef float f32x4 __attribute__((ext_vector_type(4)));
typedef unsigned u32x4 __attribute__((ext_vector_type(4)));
constexpr int BM = 256, BK = 64, HALF = 128, HTB = HALF * BK * 2  , STAGE_BYTES = 8 * HTB, NXCD = 8, WGM = 8;

__host__ __device__ __forceinline__ int lds_byte(int r, int c) { const int st = (r >> 4) * 2 + (c >> 5), rr = r & 15, cc = c & 31, ob = rr * 64 + cc * 2; return st * 1024 + (ob ^ (((ob >> 9) & 1) << 5)); }
__host__ __device__ __forceinline__ void stage_rc(int b, int& R, int& C) { const int st = b / 1024, sb = b % 1024, swz = sb ^ (((sb >> 9) & 1) << 5); R = (st >> 1) * 16 + swz / 64; C = (st & 1) * 32 + (swz % 64) / 2; }
__host__ __device__ __forceinline__ int perm32(int rho) { const int n = rho >> 4, i = rho & 15; return 8 * (i >> 2) + 4 * n + (i & 3); }

struct Unit { int pm, pn; };
struct Gemm { const bf16_t* A; const bf16_t* Bt; int M, N, K; };

struct StaticOrder {
    int nM, nN, nwg, G, c;
    __host__ __device__ void init(int M, int N, int G_, int c_) { nM = M / BM; nN = N / BM; nwg = nM * nN; G = G_; c = c_; }
    __host__ __device__ bool next(int i, Unit& u) const {
        const long L = (long)i * G + c; if (L >= nwg) return false;
        int wgid = (int)L; { const int q = nwg / NXCD, r = nwg % NXCD, xcd = wgid % NXCD, off = wgid / NXCD; wgid = (xcd < r ? xcd * (q + 1) : r * (q + 1) + (xcd - r) * q) + off; }
        const int nig = WGM * nN, gid = wgid / nig, fm = gid * WGM, gsz = (nM - fm) < WGM ? (nM - fm) : WGM;
        u.pm = fm + ((wgid % nig) % gsz); u.pn = (wgid % nig) / gsz; return true;
    }
    __device__ __forceinline__ void a_ready(const Unit&) const {}
    __device__ __forceinline__ void done(const Unit&) const {}
};

template <class Epi, class Sched, bool ALIGN_EPI = false, bool SP2 = false>
__device__ __forceinline__ void gemm_phase(PG8_LAS unsigned char* lds, const Gemm g, const Sched& S, const Epi& E) {
    int tid_l = threadIdx.x; asm volatile("" : "+v"(tid_l));
    const int tid = tid_l, wid = __builtin_amdgcn_readfirstlane(tid >> 6), lane = tid & 63, wr = wid >> 2, wc = wid & 3, fr = lane & 15, fq = lane >> 4;
    const int K = g.K, nt = K / BK;
    unsigned voffA[2], voffB[2];
#pragma unroll
    for (int i = 0; i < 2; ++i) { int R, C; stage_rc(tid * 16 + i * 8192, R, C); const int Rb = Epi::PERM ? ((R & ~31) + perm32(R & 31)) : R;
        voffA[i] = (unsigned)(R * K + C) * 2u; voffB[i] = (unsigned)(Rb * K + C) * 2u; }
    const size_t kstep = (size_t)(BK * 2);
    const size_t hstep = (size_t)HALF * K * 2;
    const size_t tstep = 2 * hstep;
    const unsigned ldsw = (unsigned)wid * 1024u;
    const int aoff = lds_byte(wr * 64 + fr, fq * 8), boff = lds_byte(wc * 32 + fr, fq * 8);
#define PG8_SA(b, h) (((b) * 2 + (h)) * HTB)
#define PG8_SB(b, h) ((4 + (b) * 2 + (h)) * HTB)
#define PG8_STAGE(bufoff, gbase, voff) do { _Pragma("unroll") for (int _i = 0; _i < 2; ++_i) \
        __builtin_amdgcn_global_load_lds((const unsigned*)((const char*)(gbase) + (voff)[_i]), (PG8_LAS unsigned*)(lds + (bufoff) + ldsw + _i * 8192), 16, 0, 0); } while (0)
#define PG8_LDA(dst, b, h) do { _Pragma("unroll") for (int m = 0; m < 4; ++m) _Pragma("unroll") for (int k = 0; k < 2; ++k) dst[m][k] = *(const PG8_LAS bf16x8*)(lds + PG8_SA(b, h) + aoff + m * 2048 + k * 1024); } while (0)
#define PG8_LDB(dst, b, h) do { _Pragma("unroll") for (int n = 0; n < 2; ++n) _Pragma("unroll") for (int k = 0; k < 2; ++k) dst[n][k] = *(const PG8_LAS bf16x8*)(lds + PG8_SB(b, h) + boff + n * 2048 + k * 1024); } while (0)
#define PG8_MMA(ai, bj, At, Bt) do { __builtin_amdgcn_s_setprio(1); _Pragma("unroll") for (int m = 0; m < 4; ++m) _Pragma("unroll") for (int n = 0; n < 2; ++n) _Pragma("unroll") for (int k = 0; k < 2; ++k) \
        acc[ai][bj][m][n] = __builtin_amdgcn_mfma_f32_16x16x32_bf16(Bt[n][k], At[m][k], acc[ai][bj][m][n], 0, 0, 0); __builtin_amdgcn_s_setprio(0); } while (0)
#define PG8_WAIT_V(n) asm volatile("s_waitcnt vmcnt(" #n ")" ::: "memory")
#define PG8_WAIT_L(n) asm volatile("s_waitcnt lgkmcnt(" #n ")" ::: "memory")
#define PG8_BAR __builtin_amdgcn_s_barrier()
#define PG8_SCHED __builtin_amdgcn_sched_barrier(0)
    Unit cur, nxt; int ui = 0;
    if (!S.next(0, cur)) return;
    f32x4 acc[2][2][4][2];
#pragma unroll
    for (int a = 0; a < 2; ++a)
#pragma unroll
        for (int b = 0; b < 2; ++b)
#pragma unroll
            for (int m = 0; m < 4; ++m)
#pragma unroll
                for (int n = 0; n < 2; ++n) acc[a][b][m][n] = (f32x4){0.f, 0.f, 0.f, 0.f};
    bf16x8 At[4][2], B0[2][2], B1[2][2];
    const char* cA = (const char*)g.A + (size_t)cur.pm * tstep; const char* cB = (const char*)g.Bt + (size_t)cur.pn * tstep;
    S.a_ready(cur);
    if constexpr (SP2) {
        PG8_STAGE(PG8_SB(0, 0), cB, voffB); PG8_STAGE(PG8_SB(0, 1), cB + hstep, voffB); PG8_STAGE(PG8_SA(0, 0), cA, voffA); PG8_STAGE(PG8_SA(0, 1), cA + hstep, voffA);
        if (wr == 1) PG8_BAR;
        PG8_WAIT_V(2); PG8_BAR;
        PG8_STAGE(PG8_SB(1, 0), cB + kstep, voffB); PG8_STAGE(PG8_SA(1, 0), cA + kstep, voffA); PG8_STAGE(PG8_SB(1, 1), cB + hstep + kstep, voffB);
        PG8_WAIT_V(6); PG8_BAR;
    } else {
        PG8_STAGE(PG8_SB(0, 0), cB, voffB); PG8_STAGE(PG8_SA(0, 0), cA, voffA); PG8_STAGE(PG8_SB(0, 1), cB + hstep, voffB); PG8_STAGE(PG8_SA(0, 1), cA + hstep, voffA);
        if (wr == 1) PG8_BAR;
        PG8_WAIT_V(4); PG8_BAR;
        PG8_STAGE(PG8_SB(1, 0), cB + kstep, voffB); PG8_STAGE(PG8_SA(1, 0), cA + kstep, voffA); PG8_STAGE(PG8_SB(1, 1), cB + hstep + kstep, voffB);
        PG8_WAIT_V(6); PG8_BAR;
    }
    for (;;) {
        const bool has_next = S.next(ui + 1, nxt);
        const char* nA = has_next ? (const char*)g.A + (size_t)nxt.pm * tstep : cA; const char* nB = has_next ? (const char*)g.Bt + (size_t)nxt.pn * tstep : cB;
        for (int t = 0; t < nt; t += 2) {
            const bool last = (t == nt - 2);
            const char* a1 = cA + (size_t)(t + 1) * kstep;
            const char* a2 = last ? nA : cA + (size_t)(t + 2) * kstep; const char* b2 = last ? nB : cB + (size_t)(t + 2) * kstep;
            const char* a3 = a2 + kstep; const char* b3 = b2 + kstep;
            if (last && has_next) S.a_ready(nxt);
            if constexpr (SP2) {
            PG8_LDB(B0, 0, 0); PG8_LDB(B1, 0, 1); PG8_SCHED; PG8_LDA(At, 0, 0); PG8_STAGE(PG8_SA(1, 1), a1 + hstep, voffA);
            PG8_WAIT_V(8); PG8_WAIT_L(0); PG8_BAR; PG8_MMA(0, 0, At, B0); PG8_MMA(0, 1, At, B1); PG8_BAR; PG8_SCHED;
            PG8_LDA(At, 0, 1); PG8_STAGE(PG8_SB(0, 0), b2, voffB); PG8_STAGE(PG8_SB(0, 1), b2 + hstep, voffB); PG8_STAGE(PG8_SA(0, 0), a2, voffA);
            PG8_WAIT_V(8); PG8_WAIT_L(0); PG8_BAR; PG8_MMA(1, 0, At, B0); PG8_MMA(1, 1, At, B1); PG8_BAR; PG8_SCHED;
            PG8_LDB(B0, 1, 0); PG8_LDB(B1, 1, 1); PG8_SCHED; PG8_LDA(At, 1, 0); PG8_STAGE(PG8_SA(0, 1), a2 + hstep, voffA);
            PG8_WAIT_V(8); PG8_WAIT_L(0); PG8_BAR; PG8_MMA(0, 0, At, B0); PG8_MMA(0, 1, At, B1); PG8_BAR; PG8_SCHED;
            PG8_LDA(At, 1, 1); PG8_STAGE(PG8_SB(1, 0), b3, voffB); PG8_STAGE(PG8_SB(1, 1), b3 + hstep, voffB); PG8_STAGE(PG8_SA(1, 0), a3, voffA);
            PG8_WAIT_V(8); PG8_WAIT_L(0); PG8_BAR; PG8_MMA(1, 0, At, B0); PG8_MMA(1, 1, At, B1); PG8_BAR; PG8_SCHED;
            } else {
            PG8_LDB(B0, 0, 0); PG8_SCHED; PG8_LDA(At, 0, 0); PG8_STAGE(PG8_SA(1, 1), a1 + hstep, voffA);
            PG8_WAIT_L(8); PG8_BAR; PG8_WAIT_L(0); PG8_MMA(0, 0, At, B0); PG8_BAR; PG8_SCHED;
            PG8_LDB(B1, 0, 1); PG8_STAGE(PG8_SB(0, 0), b2, voffB);
            PG8_BAR; PG8_WAIT_L(0); PG8_MMA(0, 1, At, B1); PG8_BAR;
            PG8_LDA(At, 0, 1); PG8_STAGE(PG8_SA(0, 0), a2, voffA);
            PG8_BAR; PG8_WAIT_L(0); PG8_MMA(1, 0, At, B0); PG8_BAR; PG8_SCHED;
            PG8_STAGE(PG8_SB(0, 1), b2 + hstep, voffB);
            PG8_WAIT_V(6); PG8_BAR; PG8_MMA(1, 1, At, B1); PG8_BAR;
            PG8_LDB(B0, 1, 0); PG8_SCHED; PG8_LDA(At, 1, 0); PG8_STAGE(PG8_SA(0, 1), a2 + hstep, voffA);
            PG8_WAIT_L(8); PG8_BAR; PG8_WAIT_L(0); PG8_MMA(0, 0, At, B0); PG8_BAR; PG8_SCHED;
            PG8_LDB(B1, 1, 1); PG8_STAGE(PG8_SB(1, 0), b3, voffB);
            PG8_BAR; PG8_WAIT_L(0); PG8_MMA(0, 1, At, B1); PG8_BAR;
            PG8_LDA(At, 1, 1); PG8_STAGE(PG8_SA(1, 0), a3, voffA);
            PG8_BAR; PG8_WAIT_L(0); PG8_MMA(1, 0, At, B0); PG8_BAR; PG8_SCHED;
            PG8_STAGE(PG8_SB(1, 1), b3 + hstep, voffB);
            PG8_WAIT_V(6); PG8_BAR; PG8_MMA(1, 1, At, B1); PG8_BAR;
            }
        }
        if constexpr (ALIGN_EPI) { if (wr == 0) PG8_BAR; }
        if constexpr (!Epi::AFTER_DRAIN) { E(acc, cur, wr, wc, fr, fq); S.done(cur); }
        if (!has_next) break;
#pragma unroll
        for (int a = 0; a < 2; ++a)
#pragma unroll
            for (int b = 0; b < 2; ++b)
#pragma unroll
                for (int m = 0; m < 4; ++m)
#pragma unroll
                    for (int n = 0; n < 2; ++n) acc[a][b][m][n] = (f32x4){0.f, 0.f, 0.f, 0.f};
        cur = nxt; cA = nA; cB = nB; ++ui;
        if constexpr (ALIGN_EPI) { if (wr == 1) PG8_BAR; }
    }
    PG8_WAIT_V(0);
    if constexpr (!ALIGN_EPI) { if (wr == 0) PG8_BAR; }
    PG8_BAR;
    if constexpr (Epi::AFTER_DRAIN) { E.fused(acc, cur, wr, wc, fr, fq, lds, wid, lane); S.done(cur); }
#undef PG8_SA
#undef PG8_SB
#undef PG8_STAGE
#undef PG8_LDA
#undef PG8_LDB
#undef PG8_MMA
#undef PG8_WAIT_V
#undef PG8_WAIT_L
#undef PG8_BAR
#undef PG8_SCHED
}
}

using pg8::bf16_t; using pg8::bf16x8; using pg8::f32x4; using pg8::u32x4; using pg8::Unit;
typedef float f32x16 __attribute__((ext_vector_type(16)));
typedef short s16x4 __attribute__((ext_vector_type(4)));
typedef unsigned u32x2 __attribute__((ext_vector_type(2)));
typedef float f32x2 __attribute__((ext_vector_type(2)));
#define DI __device__ __forceinline__
#define LAS __attribute__((address_space(3)))

constexpr int BATCH = 8, SEQ = 4096, DM = 1024, NTOK = BATCH * SEQ;
constexpr int N_IN0 = 4096, N_IN1 = 2304;
constexpr float NORM_EPS = 1e-6f;
constexpr float SC_LOG2 = 0.125f * 1.44269504088896341f;
constexpr float NEGBIG = -1e30f;
constexpr int NTHREADS = 512;
#ifndef PH_MASK
#define PH_MASK 0x7f
#endif
#ifndef PROBE_REP
#define PROBE_REP 0
#endif
#define NREP(k) (((PROBE_REP >> (k)) & 1) ? 2 : 1)
constexpr int LDS_BYTES = 131072 + 8192;

constexpr size_t MiB = 1u << 20;
constexpr size_t WS_BT0 = 0 * MiB, WS_BT1 = 8 * MiB, WS_BT2 = 10 * MiB, WS_BT3 = 15 * MiB;
constexpr size_t WS_BAR = 17 * MiB + 512 * 1024;
constexpr size_t WS_GAINS = 17 * MiB;
constexpr size_t WS_RSTD0 = 18 * MiB, WS_CS = 19 * MiB, WS_KMP = 20 * MiB, WS_SSQ = 21 * MiB;
constexpr size_t WS_XB = 32 * MiB;
constexpr size_t WS_Y = 32 * MiB;
constexpr size_t WS_QA = 96 * MiB, WS_KA = 128 * MiB, WS_VTA = 160 * MiB, WS_QB = 192 * MiB, WS_KB = 224 * MiB, WS_VTB = 256 * MiB;
constexpr size_t WS_ZS = 288 * MiB;
constexpr size_t WS_X1 = 352 * MiB;
constexpr size_t WS_X1B = 96 * MiB;
constexpr size_t WS_QC = 160 * MiB, WS_KC = 224 * MiB, WS_VTC = 232 * MiB, WS_ZS1 = 240 * MiB;
constexpr size_t WS_END = 480 * MiB;

struct Params {
    const float* x; const float* norm_even; const float* w_in_even; const float* w_out_even;
    const float* qn_a; const float* kn_a; const float* qn_b; const float* kn_b;
    const float* norm_odd; const float* w_in_odd; const float* w_out_odd; const float* qn_c; const float* kn_c; const float* sinks;
    float* out; unsigned char* ws;
};

typedef __bf16 bf16v2 __attribute__((ext_vector_type(2)));
DI unsigned cvt_pk(float lo, float hi) { const f32x2 v = {lo, hi}; return __builtin_bit_cast(unsigned, __builtin_convertvector(v, bf16v2)); }
DI float bf_lo(unsigned u) { return __uint_as_float(u << 16); }
DI float bf_hi(unsigned u) { return __uint_as_float(u & 0xffff0000u); }

DI void p0_weight_tile(LAS float* tile, const float* W, bf16_t* Bt, int N, const float* g, bool permute, int t) {
    const int tid = threadIdx.x;
    const int ntn = N / 64, k0 = (t / ntn) * 64, n0 = (t % ntn) * 64;
    {
        const int n = tid & 63, kr = tid >> 6;
#pragma unroll
        for (int i = 0; i < 8; ++i) { const int k = kr + 8 * i; tile[k * 65 + n] = W[(size_t)(k0 + k) * N + n0 + n] * (g ? g[k0 + k] : 1.0f); }
    }
    __syncthreads();
    {
        const int nn = tid >> 3, ks = tid & 7;
        const int nlog = n0 + nn;
        const int c = permute ? ((nlog & ~255) | (((nlog >> 5) & 1) << 7) | (((nlog >> 6) & 3) << 5) | (nlog & 31)) : nlog;
        float v[8];
#pragma unroll
        for (int i = 0; i < 8; ++i) v[i] = tile[(ks * 8 + i) * 65 + nn];
        u32x4 w; w.x = cvt_pk(v[0], v[1]); w.y = cvt_pk(v[2], v[3]); w.z = cvt_pk(v[4], v[5]); w.w = cvt_pk(v[6], v[7]);
        *(u32x4*)(Bt + (size_t)c * 1024 + k0 + ks * 8) = w;
    }
    __syncthreads();
}

DI void sincos_d(double x, double& s, double& c) {
    const double kq = __builtin_rint(x * 0.63661977236758134308);
    double r = __builtin_fma(-kq, 1.57079632679489655800e+00, x); r = __builtin_fma(-kq, 6.12323399573676603587e-17, r);
    const int q = ((int)kq) & 3;
    const double r2 = r * r;
    const double sp = r * (1.0 + r2 * (-1.0 / 6 + r2 * (1.0 / 120 + r2 * (-1.0 / 5040 + r2 * (1.0 / 362880 + r2 * (-1.0 / 39916800 + r2 * (1.0 / 6227020800.0)))))));
    const double cp = 1.0 + r2 * (-0.5 + r2 * (1.0 / 24 + r2 * (-1.0 / 720 + r2 * (1.0 / 40320 + r2 * (-1.0 / 3628800 + r2 * (1.0 / 479001600.0 + r2 * (-1.0 / 87178291200.0)))))));
    s = (q == 0) ? sp : (q == 1) ? cp : (q == 2) ? -sp : -cp;
    c = (q == 0) ? cp : (q == 1) ? -sp : (q == 2) ? -cp : sp;
}

DI void p0_prologue(const Params& P, LAS unsigned char* lds) {
    unsigned char* ws = P.ws;
    const int tid = threadIdx.x, lane = tid & 63, wid = tid >> 6;
    const int G = gridDim.x, bid = blockIdx.x;
    {
        bf16_t* xb = (bf16_t*)(ws + WS_XB); float* rstd = (float*)(ws + WS_RSTD0);
        for (int row = bid * 8 + wid; row < NTOK; row += G * 8) {
            const f32x4* xr = (const f32x4*)(P.x + (size_t)row * DM);
            float ss = 0.f;
#pragma unroll
            for (int i = 0; i < 4; ++i) {
                const f32x4 v = xr[lane + 64 * i];
                ss += v[0] * v[0] + v[1] * v[1] + v[2] * v[2] + v[3] * v[3];
                u32x2 w; w.x = cvt_pk(v[0], v[1]); w.y = cvt_pk(v[2], v[3]);
                *(u32x2*)(xb + (size_t)row * DM + 4 * (lane + 64 * i)) = w;
            }
#pragma unroll
            for (int o = 32; o >= 1; o >>= 1) ss += __shfl_xor(ss, o);
            if (lane == 0) rstd[row] = rsqrtf(ss * (1.0f / DM) + NORM_EPS);
        }
    }
    if (bid == 0 && tid < 64) {
        float* gw = (float*)(ws + WS_GAINS);
        gw[tid] = P.qn_a[tid]; gw[64 + tid] = P.kn_a[tid]; gw[128 + tid] = P.qn_b[tid]; gw[192 + tid] = P.kn_b[tid]; gw[256 + tid] = P.qn_c[tid]; gw[320 + tid] = P.kn_c[tid];
        if (tid < 16) gw[384 + tid] = P.sinks[tid];
    }
    {
        f32x2* cs = (f32x2*)(ws + WS_CS);
        for (int e = bid * NTHREADS + tid; e < SEQ * 32; e += G * NTHREADS) {
            const int pos = e >> 5, i = e & 31;
            double f = 1.0;
            for (int k = 0; k < i; ++k) f *= 0.7498942093324558;
            const float invf = (float)f;
            const float ang = (float)pos * invf;
            double s, c; sincos_d((double)ang, s, c);
            cs[e] = (f32x2){(float)c, (float)s};
        }
    }
    {
        LAS float* tile = (LAS float*)lds;
        const int T0 = 16 * (N_IN0 / 64), T1 = 16 * (DM / 64), T2 = 16 * (N_IN1 / 64), T3 = 16 * (DM / 64);
        for (int t = bid; t < T0 + T1 + T2 + T3; t += G) {
            if (t < T0) p0_weight_tile(tile, P.w_in_even, (bf16_t*)(ws + WS_BT0), N_IN0, P.norm_even, true, t);
            else if (t < T0 + T1) p0_weight_tile(tile, P.w_out_even, (bf16_t*)(ws + WS_BT1), DM, nullptr, false, t - T0);
            else if (t < T0 + T1 + T2) p0_weight_tile(tile, P.w_in_odd, (bf16_t*)(ws + WS_BT2), N_IN1, P.norm_odd, true, t - T0 - T1);
            else p0_weight_tile(tile, P.w_out_odd, (bf16_t*)(ws + WS_BT3), DM, nullptr, false, t - T0 - T1 - T2);
        }
    }
}

DI float row_rstd1(const float* ssq, int row, int fq) {
    const f32x4 a = *(const f32x4*)(ssq + (size_t)row * 16 + 4 * fq);
    float t = (a[0] + a[1]) + (a[2] + a[3]);
    t += __shfl_xor(t, 16); t += __shfl_xor(t, 32);
    return rsqrtf(t * (1.0f / DM) + NORM_EPS);
}
struct EpiIn {
    static constexpr bool PERM = true, AFTER_DRAIN = false;
    int layer; unsigned char* ws;
    __device__ __forceinline__ void operator()(const f32x4 (&acc)[2][2][4][2], const Unit& u, int wr, int wc, int fr, int fq) const {
        const float* rstd0 = (const float*)(ws + WS_RSTD0); const float* ssq = (const float*)(ws + WS_SSQ); const f32x2* cs = (const f32x2*)(ws + WS_CS);
        const float* gains = (const float*)(ws + WS_GAINS); bf16_t* zs = (bf16_t*)(ws + (layer == 0 ? WS_ZS : WS_ZS1)); float* kmp = (float*)(ws + WS_KMP);
        int mode, head, hpb = 8, zcol = 0; bf16_t* dst = nullptr; const float* gain = gains; bool do_km = false;
        if (layer == 0) {
            const int seg = u.pn >> 1; head = (u.pn & 1) * 4 + wc;
            if (seg == 0) { mode = 0; dst = (bf16_t*)(ws + WS_QA); gain = gains; }
            else if (seg == 1) { mode = 0; dst = (bf16_t*)(ws + WS_KA); gain = gains + 64; }
            else if (seg == 2) { mode = 1; dst = (bf16_t*)(ws + WS_VTA); }
            else if (seg == 3) { mode = 2; zcol = head * 64; }
            else if (seg == 4) { mode = 0; dst = (bf16_t*)(ws + WS_QB); gain = gains + 128; }
            else if (seg == 5) { mode = 0; dst = (bf16_t*)(ws + WS_KB); gain = gains + 192; do_km = true; }
            else if (seg == 6) { mode = 1; dst = (bf16_t*)(ws + WS_VTB); }
            else { mode = 2; zcol = 512 + head * 64; }
        } else {
            if (u.pn < 4) { mode = 0; dst = (bf16_t*)(ws + WS_QC); gain = gains + 256; head = u.pn * 4 + wc; hpb = 16; }
            else if (u.pn == 4) { hpb = 2; if (wc < 2) { mode = 0; dst = (bf16_t*)(ws + WS_KC); gain = gains + 320; head = wc; } else { mode = 1; dst = (bf16_t*)(ws + WS_VTC); head = wc - 2; } }
            else { mode = 2; head = (u.pn - 5) * 4 + wc; zcol = head * 64; }
        }
        const int b = u.pm >> 4, sbase = (u.pm & 15) * 256 + wr * 64 + fr, rowbase = u.pm * 256 + wr * 64 + fr;
        const size_t bh = (size_t)b * hpb + head;
#define ROW_RS(row) ((layer == 0) ? rstd0[(row)] : row_rstd1(ssq, (row), fq))
        if (mode == 0) {
            float g0[8], g1[8], cs0[8], cs1[8];
#pragma unroll
            for (int i = 0; i < 8; ++i) { g0[i] = gain[8 * fq + i]; g1[i] = gain[32 + 8 * fq + i]; cs0[i] = 0.f; cs1[i] = 0.f; }
#pragma unroll
            for (int ai = 0; ai < 2; ++ai)
#pragma unroll
                for (int m = 0; m < 4; ++m) {
                    const int s = sbase + ai * 128 + m * 16; const float r = ROW_RS(rowbase + ai * 128 + m * 16);
                    float t0[8], t1[8]; float ss = 0.f;
#pragma unroll
                    for (int n = 0; n < 2; ++n)
#pragma unroll
                        for (int j = 0; j < 4; ++j) { t0[4 * n + j] = acc[ai][0][m][n][j] * r; t1[4 * n + j] = acc[ai][1][m][n][j] * r; }
#pragma unroll
                    for (int i = 0; i < 8; ++i) ss += t0[i] * t0[i] + t1[i] * t1[i];
                    ss += __shfl_xor(ss, 16); ss += __shfl_xor(ss, 32);
                    const float hr = rsqrtf(ss * (1.0f / 64.0f) + NORM_EPS);
                    const f32x4* cp = (const f32x4*)(cs + (size_t)s * 32 + 8 * fq);
                    float o0[8], o1[8];
#pragma unroll
                    for (int q = 0; q < 4; ++q) { const f32x4 c4 = cp[q];
                        { const int i = 2 * q; const float a = t0[i] * hr * g0[i], bb = t1[i] * hr * g1[i]; o0[i] = a * c4[0] - bb * c4[1]; o1[i] = bb * c4[0] + a * c4[1]; }
                        { const int i = 2 * q + 1; const float a = t0[i] * hr * g0[i], bb = t1[i] * hr * g1[i]; o0[i] = a * c4[2] - bb * c4[3]; o1[i] = bb * c4[2] + a * c4[3]; } }
                    u32x4 w0, w1;
                    w0.x = cvt_pk(o0[0], o0[1]); w0.y = cvt_pk(o0[2], o0[3]); w0.z = cvt_pk(o0[4], o0[5]); w0.w = cvt_pk(o0[6], o0[7]);
                    w1.x = cvt_pk(o1[0], o1[1]); w1.y = cvt_pk(o1[2], o1[3]); w1.z = cvt_pk(o1[4], o1[5]); w1.w = cvt_pk(o1[6], o1[7]);
                    bf16_t* rp = dst + ((bh * SEQ + s) * 64 + 8 * fq);
                    *(u32x4*)rp = w0; *(u32x4*)(rp + 32) = w1;
                    if (do_km) {
#pragma unroll
                        for (int i = 0; i < 8; ++i) { cs0[i] += o0[i]; cs1[i] += o1[i]; }
                    }
                }
            if (do_km) {
#pragma unroll
                for (int i = 0; i < 8; ++i) {
#pragma unroll
                    for (int o = 1; o <= 8; o <<= 1) { cs0[i] += __shfl_xor(cs0[i], o); cs1[i] += __shfl_xor(cs1[i], o); }
                }
                if (fr == 0) {
                    float* kp = kmp + (((size_t)wr * 64 + bh) * 16 + (u.pm & 15)) * 64 + 8 * fq;
                    *(f32x4*)kp = (f32x4){cs0[0], cs0[1], cs0[2], cs0[3]}; *(f32x4*)(kp + 4) = (f32x4){cs0[4], cs0[5], cs0[6], cs0[7]};
                    *(f32x4*)(kp + 32) = (f32x4){cs1[0], cs1[1], cs1[2], cs1[3]}; *(f32x4*)(kp + 36) = (f32x4){cs1[4], cs1[5], cs1[6], cs1[7]};
                }
            }
        } else if (mode == 1) {
#pragma unroll
            for (int ai = 0; ai < 2; ++ai)
#pragma unroll
                for (int m = 0; m < 4; ++m) {
                    const int s = sbase + ai * 128 + m * 16; const float r = ROW_RS(rowbase + ai * 128 + m * 16);
                    bf16_t* rp = dst + ((bh * SEQ + s) * 64 + 8 * fq);
#pragma unroll
                    for (int bj = 0; bj < 2; ++bj) {
                        const f32x4 v0 = acc[ai][bj][m][0] * r, v1 = acc[ai][bj][m][1] * r;
                        u32x4 w; w.x = cvt_pk(v0[0], v0[1]); w.y = cvt_pk(v0[2], v0[3]); w.z = cvt_pk(v1[0], v1[1]); w.w = cvt_pk(v1[2], v1[3]);
                        *(u32x4*)(rp + 32 * bj) = w;
                    }
                }
        } else {
#pragma unroll
            for (int ai = 0; ai < 2; ++ai)
#pragma unroll
                for (int m = 0; m < 4; ++m) {
                    const int row = rowbase + ai * 128 + m * 16; const float r = ROW_RS(row);
#pragma unroll
                    for (int bj = 0; bj < 2; ++bj) {
                        float sv[8];
#pragma unroll
                        for (int n = 0; n < 2; ++n)
#pragma unroll
                            for (int j = 0; j < 4; ++j) { const float z = acc[ai][bj][m][n][j] * r; sv[4 * n + j] = z / (1.0f + __expf(-z)); }
                        u32x4 w; w.x = cvt_pk(sv[0], sv[1]); w.y = cvt_pk(sv[2], sv[3]); w.z = cvt_pk(sv[4], sv[5]); w.w = cvt_pk(sv[6], sv[7]);
                        *(u32x4*)(zs + (size_t)row * DM + zcol + 32 * bj + 8 * fq) = w;
                    }
                }
        }
    }
};

struct EpiOut {
    static constexpr bool PERM = true, AFTER_DRAIN = false;
    const float* resid; float* out; bf16_t* xb; float* ssq;
    __device__ __forceinline__ void operator()(const f32x4 (&acc)[2][2][4][2], const Unit& u, int wr, int wc, int fr, int fq) const {
        const int col0 = u.pn * 256 + wc * 32 + 8 * fq, rowbase = u.pm * 256 + wr * 64 + fr;
#pragma unroll
        for (int ai = 0; ai < 2; ++ai)
#pragma unroll
            for (int m = 0; m < 4; ++m) {
                const int row = rowbase + ai * 128 + m * 16; const size_t off = (size_t)row * DM + col0;
                float q = 0.f;
#pragma unroll
                for (int bj = 0; bj < 2; ++bj) {
                    const f32x4 r0 = *(const f32x4*)(resid + off + bj * 128), r1 = *(const f32x4*)(resid + off + bj * 128 + 4);
                    const f32x4 o0 = r0 + acc[ai][bj][m][0], o1 = r1 + acc[ai][bj][m][1];
                    *(f32x4*)(out + off + bj * 128) = o0; *(f32x4*)(out + off + bj * 128 + 4) = o1;
                    if (xb) {
                        u32x4 w; w.x = cvt_pk(o0[0], o0[1]); w.y = cvt_pk(o0[2], o0[3]); w.z = cvt_pk(o1[0], o1[1]); w.w = cvt_pk(o1[2], o1[3]);
                        *(u32x4*)(xb + off + bj * 128) = w;
                        q += (o0[0] * o0[0] + o0[1] * o0[1]) + (o0[2] * o0[2] + o0[3] * o0[3]) + (o1[0] * o1[0] + o1[1] * o1[1]) + (o1[2] * o1[2] + o1[3] * o1[3]);
                    }
                }
                if (xb) { q += __shfl_xor(q, 16); q += __shfl_xor(q, 32); if (fq == 0) ssq[(size_t)row * 16 + u.pn * 4 + wc] = q; }
            }
    }
};

#define MFMA32(a, b, c) __builtin_amdgcn_mfma_f32_32x32x16_bf16((a), (b), (c), 0, 0, 0)
constexpr int TROW = 144;
constexpr int TBUF = 2 * 32 * TROW;
struct TileRegs { u32x4 k[4]; u32x4 v[4]; };
struct ASt { f32x16 o0, o1; float m, l; };

DI void ast_init(ASt& st) {
#pragma unroll
    for (int i = 0; i < 16; ++i) { st.o0[i] = 0.f; st.o1[i] = 0.f; }
    st.m = NEGBIG; st.l = 0.f;
}

DI void tile_gload(TileRegs& t, const bf16_t* K, const bf16_t* V, int kbase, int kstride, int lane) {
    const int row0 = lane >> 3, ch = lane & 7;
#pragma unroll
    for (int i = 0; i < 4; ++i) {
        const size_t off = (size_t)(kbase + kstride * (row0 + 8 * i)) * 64 + ch * 8;
        t.k[i] = *(const u32x4*)(K + off); t.v[i] = *(const u32x4*)(V + off);
    }
}
DI void tile_lds_write(LAS unsigned char* buf, const TileRegs& t, int lane) {
    const int row0 = lane >> 3, ch = lane & 7;
#pragma unroll
    for (int i = 0; i < 4; ++i) {
        const int off = (row0 + 8 * i) * TROW + ch * 16;
        *(LAS u32x4*)(buf + off) = t.k[i]; *(LAS u32x4*)(buf + 32 * TROW + off) = t.v[i];
    }
}

DI void attn_tile(ASt& st, const bf16x8 (&qf)[4], LAS unsigned char* buf, int dist0, int kstride, int hi, int lane) {
    const int r = lane & 31, h = lane >> 5;
    f32x16 s;
#pragma unroll
    for (int i = 0; i < 16; ++i) s[i] = 0.f;
#pragma unroll
    for (int ks = 0; ks < 4; ++ks) { const bf16x8 kf = *(const LAS bf16x8*)(buf + r * TROW + (2 * ks + h) * 16); s = MFMA32(kf, qf[ks], s); }
    bf16x8 vf[2][2];
    {
        const int q = (lane & 15) >> 2, p = lane & 3, blk = (lane >> 4) & 1;
        LAS unsigned char* vb = buf + 32 * TROW + (4 * h + q) * TROW + 32 * blk + 8 * p;
#pragma unroll
        for (int dt = 0; dt < 2; ++dt)
#pragma unroll
            for (int s2 = 0; s2 < 2; ++s2) {
                const s16x4 lo = __builtin_amdgcn_ds_read_tr16_b64_v4i16((LAS s16x4*)(vb + (16 * s2) * TROW + 64 * dt));
                const s16x4 hi4 = __builtin_amdgcn_ds_read_tr16_b64_v4i16((LAS s16x4*)(vb + (16 * s2 + 8) * TROW + 64 * dt));
                vf[dt][s2] = __builtin_shufflevector(lo, hi4, 0, 1, 2, 3, 4, 5, 6, 7);
            }
    }
    float tmax = NEGBIG;
#pragma unroll
    for (int i = 0; i < 16; ++i) {
        const int dist = dist0 - kstride * ((i & 3) + 8 * (i >> 2));
        const bool ok = (dist >= 0) && (dist <= hi);
        s[i] = ok ? s[i] * SC_LOG2 : NEGBIG;
        tmax = fmaxf(tmax, s[i]);
    }
    tmax = fmaxf(tmax, __shfl_xor(tmax, 32));
    const float mnew = fmaxf(st.m, tmax);
    const float alpha = __builtin_amdgcn_exp2f(st.m - mnew);
    const float msub = (mnew < -1e29f) ? 0.f : mnew;
    st.m = mnew;
    float ps = 0.f;
#pragma unroll
    for (int i = 0; i < 16; ++i) { s[i] = __builtin_amdgcn_exp2f(s[i] - msub); ps += s[i]; }
    st.l = st.l * alpha + ps;
#pragma unroll
    for (int i = 0; i < 16; ++i) { st.o0[i] *= alpha; st.o1[i] *= alpha; }
#pragma unroll
    for (int s2 = 0; s2 < 2; ++s2) {
        u32x4 p;
        p.x = cvt_pk(s[8 * s2 + 0], s[8 * s2 + 1]); p.y = cvt_pk(s[8 * s2 + 2], s[8 * s2 + 3]);
        p.z = cvt_pk(s[8 * s2 + 4], s[8 * s2 + 5]); p.w = cvt_pk(s[8 * s2 + 6], s[8 * s2 + 7]);
        const bf16x8 pb = __builtin_bit_cast(bf16x8, p);
        st.o0 = MFMA32(vf[0][s2], pb, st.o0);
        st.o1 = MFMA32(vf[1][s2], pb, st.o1);
    }
}

DI void load_q(bf16x8 (&qf)[4], const bf16_t* qrow, int h) {
    const bf16x8* qp = (const bf16x8*)qrow;
#pragma unroll
    for (int ks = 0; ks < 4; ++ks) qf[ks] = qp[2 * ks + h];
}

DI void attn_finish(ASt& st, float sink_l2, const bf16_t* zs, bf16_t* y, size_t rowoff  , int h) {
    float l = st.l + __shfl_xor(st.l, 32);
    const float mf = fmaxf(st.m, sink_l2);
    const float a = __builtin_amdgcn_exp2f(st.m - mf);
    l = l * a + ((sink_l2 > -1e29f) ? __builtin_amdgcn_exp2f(sink_l2 - mf) : 0.f);
    const float inv = a / l;
#pragma unroll
    for (int dt = 0; dt < 2; ++dt)
#pragma unroll
        for (int g = 0; g < 4; ++g) {
            const size_t off = rowoff + 32 * dt + 8 * g + 4 * h;
            const u32x2 z = *(const u32x2*)(zs + off);
            const float v0 = (dt ? st.o1[4 * g + 0] : st.o0[4 * g + 0]) * inv * bf_lo(z.x);
            const float v1 = (dt ? st.o1[4 * g + 1] : st.o0[4 * g + 1]) * inv * bf_hi(z.x);
            const float v2 = (dt ? st.o1[4 * g + 2] : st.o0[4 * g + 2]) * inv * bf_lo(z.y);
            const float v3 = (dt ? st.o1[4 * g + 3] : st.o0[4 * g + 3]) * inv * bf_hi(z.y);
            u32x2 w; w.x = cvt_pk(v0, v1); w.y = cvt_pk(v2, v3);
            *(u32x2*)(y + off) = w;
        }
}

DI bool a_tile_desc(int tau, int r16, int i0, int& kbase, int& kstride, int& hi) {
    if (tau < 5) { const int jb = i0 - 128 + 32 * tau; kbase = r16 + 16 * jb; kstride = 16; hi = 2048; return jb >= 0; }
    if (tau < 13) { const int ub = 4 * i0 - 128 + 32 * (tau - 5); kbase = (r16 & 3) + 4 * ub; kstride = 4; hi = 512; return ub >= 0; }
    { const int kb = 16 * i0 - 128 + 32 * (tau - 13); kbase = kb; kstride = 1; hi = 128; return kb >= 0; }
}
DI void attn_a_item(unsigned char* ws, LAS unsigned char* buf, int bh, int r16, int i0, int lane) {
    const int r = lane & 31, h = lane >> 5;
    const bf16_t* Q = (const bf16_t*)(ws + WS_QA) + (size_t)bh * SEQ * 64;
    const bf16_t* K = (const bf16_t*)(ws + WS_KA) + (size_t)bh * SEQ * 64;
    const bf16_t* V = (const bf16_t*)(ws + WS_VTA) + (size_t)bh * SEQ * 64;
    const int qpos = r16 + 16 * (i0 + r);
    bf16x8 qf[4]; load_q(qf, Q + (size_t)qpos * 64, h);
    ASt st; ast_init(st);
    TileRegs tr;
    int tau = 0, kb, kst, hi;
    while (!a_tile_desc(tau, r16, i0, kb, kst, hi)) ++tau;
    tile_gload(tr, K, V, kb, kst, lane);
    tile_lds_write(buf, tr, lane);
    for (;;) {
        int tn = tau + 1, kb2 = 0, kst2 = 1, hi2 = 0; bool have = false;
        while (tn < 33) { if (a_tile_desc(tn, r16, i0, kb2, kst2, hi2)) { have = true; break; } ++tn; }
        if (have) tile_gload(tr, K, V, kb2, kst2, lane);
        attn_tile(st, qf, buf, qpos - kb - kst * 4 * h, kst, hi, lane);
        if (!have) break;
        tile_lds_write(buf, tr, lane);
        tau = tn; kb = kb2; kst = kst2; hi = hi2;
    }
    const int b = bh >> 3, head = bh & 7;
    const size_t rowoff = ((size_t)b * SEQ + qpos) * DM + head * 64;
    attn_finish(st, NEGBIG, (const bf16_t*)(ws + WS_ZS), (bf16_t*)(ws + WS_Y), rowoff, h);
}

DI void attn_b_item(unsigned char* ws, LAS unsigned char* buf, LAS float* km  , int bh, int qblk, int wid, int lane) {
    const int r = lane & 31, h = lane >> 5;
    const bf16_t* Q = (const bf16_t*)(ws + WS_QB) + (size_t)bh * SEQ * 64;
    const bf16_t* K = (const bf16_t*)(ws + WS_KB) + (size_t)bh * SEQ * 64;
    const bf16_t* V = (const bf16_t*)(ws + WS_VTB) + (size_t)bh * SEQ * 64;
    const int qpos = qblk * 256 + wid * 32 + r;
    bf16x8 qf[4]; load_q(qf, Q + (size_t)qpos * 64, h);
    float v1 = -3e38f, v2 = -3e38f, v3 = -3e38f; int i1 = 31, i2 = 31, i3 = 31;
    for (int n = 0; n < qblk; ++n) {
        float g = 0.f;
#pragma unroll
        for (int ks = 0; ks < 4; ++ks) {
            const LAS f32x4* kp = (const LAS f32x4*)(km + n * 64 + 16 * ks + 8 * h);
            const f32x4 a = kp[0], bq = kp[1];
            const u32x4 qu = __builtin_bit_cast(u32x4, qf[ks]);
            g += bf_lo(qu.x) * a[0] + bf_hi(qu.x) * a[1] + bf_lo(qu.y) * a[2] + bf_hi(qu.y) * a[3]
               + bf_lo(qu.z) * bq[0] + bf_hi(qu.z) * bq[1] + bf_lo(qu.w) * bq[2] + bf_hi(qu.w) * bq[3];
        }
        g += __shfl_xor(g, 32);
        if (g > v1) { v3 = v2; i3 = i2; v2 = v1; i2 = i1; v1 = g; i1 = n; }
        else if (g > v2) { v3 = v2; i3 = i2; v2 = g; i2 = n; }
        else if (g > v3) { v3 = g; i3 = n; }
    }
    unsigned sel = 0u;
    if (i1 < 16) sel |= 1u << i1;
    if (i2 < 16) sel |= 1u << i2;
    if (i3 < 16) sel |= 1u << i3;
    unsigned uni = 0u;
    for (int n = 0; n < qblk; ++n) { if (__builtin_amdgcn_ballot_w64((sel >> n) & 1u) != 0ull) uni |= 1u << n; }
    uni |= 1u << qblk;
    const int own_tiles = wid + 1;
    ASt st; ast_init(st);
    TileRegs tr;
    int n = __builtin_ctz(uni), T = 0;
    tile_gload(tr, K, V, n * 256, 1, lane);
    tile_lds_write(buf, tr, lane);
    for (;;) {
        const int cnt = (n == qblk) ? own_tiles : 8;
        int n2 = n, T2 = T + 1; bool have = true;
        if (T2 >= cnt) { const unsigned rest = uni & ~((2u << n) - 1u); if (rest) { n2 = __builtin_ctz(rest); T2 = 0; } else have = false; }
        if (have) tile_gload(tr, K, V, n2 * 256 + 32 * T2, 1, lane);
        const int kb = n * 256 + 32 * T;
        const int hi = (n == qblk || ((sel >> n) & 1u)) ? 0x7fffffff : -1;
        attn_tile(st, qf, buf, qpos - kb - 4 * h, 1, hi, lane);
        if (!have) break;
        tile_lds_write(buf, tr, lane);
        n = n2; T = T2;
    }
    const int b = bh >> 3, head = 8 + (bh & 7);
    const size_t rowoff = ((size_t)b * SEQ + qpos) * DM + head * 64;
    attn_finish(st, NEGBIG, (const bf16_t*)(ws + WS_ZS), (bf16_t*)(ws + WS_Y), rowoff, h);
}

DI void attn_c_item(unsigned char* ws, LAS unsigned char* buf, int b, int hq, int chunk, int wid, int lane) {
    const int r = lane & 31, h = lane >> 5, kvh = hq >> 3;
    const bf16_t* Q = (const bf16_t*)(ws + WS_QC) + ((size_t)b * 16 + hq) * SEQ * 64;
    const bf16_t* K = (const bf16_t*)(ws + WS_KC) + ((size_t)b * 2 + kvh) * SEQ * 64;
    const bf16_t* V = (const bf16_t*)(ws + WS_VTC) + ((size_t)b * 2 + kvh) * SEQ * 64;
    const int t0 = chunk * 256 + wid * 32, qpos = t0 + r;
    bf16x8 qf[4]; load_q(qf, Q + (size_t)qpos * 64, h);
    ASt st; ast_init(st);
    TileRegs tr;
    int T = (t0 >= 128) ? 0 : (128 - t0) / 32;
    tile_gload(tr, K, V, t0 - 128 + 32 * T, 1, lane);
    tile_lds_write(buf, tr, lane);
    for (;;) {
        const bool have = (T + 1) < 5;
        if (have) tile_gload(tr, K, V, t0 - 128 + 32 * (T + 1), 1, lane);
        attn_tile(st, qf, buf, qpos - (t0 - 128 + 32 * T) - 4 * h, 1, 127, lane);
        if (!have) break;
        tile_lds_write(buf, tr, lane);
        ++T;
    }
    const size_t rowoff = ((size_t)b * SEQ + qpos) * DM + hq * 64;
    attn_finish(st, ((const float*)(ws + WS_GAINS))[384 + hq] * 1.44269504088896341f, (const bf16_t*)(ws + WS_ZS1), (bf16_t*)(ws + WS_Y), rowoff, h);
}

#define XB_TMO      128
#define XB_XCNT(j)  (256  + 64 * (j))
#define XB_XSUB(j)  (1280 + 64 * (j))
#define XB_XGEN(j)  (2304 + 64 * (j))
#define XB_TOP      3328
#define XB_TOPGEN   3392
#define XCD_BAR_WORDS 3456
#define XB_SPIN_CAP (1u << 18)

__device__ __forceinline__ unsigned xb_ld(unsigned* p)              { return __hip_atomic_load(p, __ATOMIC_RELAXED, __HIP_MEMORY_SCOPE_AGENT); }
__device__ __forceinline__ unsigned xb_add(unsigned* p, unsigned v) { return __hip_atomic_fetch_add(p, v, __ATOMIC_RELAXED, __HIP_MEMORY_SCOPE_AGENT); }
__device__ __forceinline__ unsigned xb_xcc_id() { return (unsigned)__builtin_amdgcn_s_getreg((3 << 11) | 20) & 0xFu; }
#define XB_SPIN(cond, bar) do { unsigned _sp = 0; while (cond) { __builtin_amdgcn_s_sleep(1); \
    if ((++_sp & 255u) == 0u) { if (xb_ld(&(bar)[XB_TMO])) break; if (_sp > XB_SPIN_CAP) { atomicAdd(&(bar)[XB_TMO], 1u); break; } } } } while (0)

struct XcdBarrier {
    unsigned* bar; unsigned x;
    volatile LAS unsigned* st;
};

__device__ __forceinline__ XcdBarrier xcd_barrier_post(unsigned* bar, volatile LAS unsigned* st) {
    XcdBarrier b; b.bar = bar; b.x = xb_xcc_id(); b.st = st;
    if (threadIdx.x == 0) (void)xb_add(&bar[XB_XCNT(b.x)], 1u);
    return b;
}
__device__ __forceinline__ void xcd_barrier_complete(unsigned* bar, unsigned x, unsigned& nloc, unsigned& nx) {
    const unsigned G = gridDim.x * gridDim.y * gridDim.z;
    unsigned sum, cnt, mine, sp = 0u;
    for (;;) {
        sum = 0u; cnt = 0u; mine = 0u;
#pragma unroll
        for (unsigned j = 0; j < 16; ++j) { const unsigned c = xb_ld(&bar[XB_XCNT(j)]); sum += c; cnt += (c > 0u) ? 1u : 0u; mine = (j == x) ? c : mine; }
        if (sum == G) break;
        __builtin_amdgcn_s_sleep(1);
        if ((++sp & 255u) == 0u) { if (xb_ld(&bar[XB_TMO])) break; if (sp > XB_SPIN_CAP) { atomicAdd(&bar[XB_TMO], 1u); break; } }
    }
    nloc = mine > 0u ? mine : 1u; nx = cnt > 0u ? cnt : 1u;
}

__device__ __forceinline__ void xcd_barrier(const XcdBarrier& b) {
    asm volatile("s_waitcnt vmcnt(0)" ::: "memory");
    __syncthreads();
    if (threadIdx.x == 0) {
        unsigned* bar = b.bar;
        __builtin_amdgcn_s_waitcnt(0);
        unsigned nloc = b.st[0], nx = b.st[1];
        if (nloc == 0u) { xcd_barrier_complete(bar, b.x, nloc, nx); b.st[0] = nloc; b.st[1] = nx; }
        const unsigned old = xb_add(&bar[XB_XSUB(b.x)], 1u);
        const unsigned gen = old / nloc;
        if (old + 1u == (gen + 1u) * nloc) {
            __builtin_amdgcn_fence(__ATOMIC_RELEASE, "agent");
            asm volatile("s_waitcnt vmcnt(0)" ::: "memory");
            const unsigned og = xb_add(&bar[XB_TOP], 1u);
            const unsigned tg = og / nx;
            if (og + 1u == (tg + 1u) * nx) xb_add(&bar[XB_TOPGEN], 1u);
            else XB_SPIN(xb_ld(&bar[XB_TOPGEN]) == tg, bar);
            __builtin_amdgcn_fence(__ATOMIC_ACQUIRE, "agent");
            xb_add(&bar[XB_XGEN(b.x)], 1u);
            asm volatile("s_waitcnt vmcnt(0)" ::: "memory");
        } else {
            XB_SPIN(xb_ld(&bar[XB_XGEN(b.x)]) == gen, bar);
            __builtin_amdgcn_fence(__ATOMIC_ACQUIRE, "agent");
            asm volatile("s_waitcnt vmcnt(0)" ::: "memory");
        }
    }
    __syncthreads();
}


__global__ void __launch_bounds__(NTHREADS) fwd_megakernel(Params P) {
    extern __shared__ __attribute__((aligned(16))) unsigned char lds_raw[];
    cg::grid_group grid = cg::this_grid();
    LAS unsigned char* lds = (LAS unsigned char*)lds_raw;
    unsigned char* ws = P.ws;
    const int G = gridDim.x, bid = blockIdx.x;
    volatile LAS unsigned* xb_st = (volatile LAS unsigned*)(lds + LDS_BYTES - 16);
    if (threadIdx.x == 0) { xb_st[0] = 0u; xb_st[1] = 0u; }
    __syncthreads();
    const XcdBarrier xbar = xcd_barrier_post((unsigned*)(ws + WS_BAR), xb_st);
#define PHASE_IDS() int tid_l = threadIdx.x; asm volatile("" : "+v"(tid_l)); const int tid = tid_l, lane = tid & 63, wid = __builtin_amdgcn_readfirstlane(tid >> 6); (void)lane; (void)wid

    if constexpr (PH_MASK & 1) { for (int rep = 0; rep < NREP(0); ++rep) p0_prologue(P, lds); }
    grid.sync();

    if constexpr ((PH_MASK & 2) != 0) {
        pg8::Gemm g{(const bf16_t*)(ws + WS_XB), (const bf16_t*)(ws + WS_BT0), NTOK, N_IN0, DM};
        pg8::StaticOrder S; S.init(NTOK, N_IN0, G, bid);
        EpiIn E{0, ws};
        for (int rep = 0; rep < NREP(1); ++rep) pg8::gemm_phase<EpiIn, pg8::StaticOrder, true, true>(lds, g, S, E);
    }
    xcd_barrier(xbar);

    if constexpr ((PH_MASK & 4) != 0) {
        PHASE_IDS();
        LAS float* km = (LAS float*)(lds + 8 * TBUF);
        LAS unsigned char* buf = lds + wid * TBUF;
        const float* kmp = (const float*)(ws + WS_KMP);
        for (int rep = 0; rep < 2; ++rep)
        for (int it = bid; it < 2048; it += G) {
            if (rep == 1 && !((it < 1024) ? (NREP(2) == 2) : (NREP(7) == 2))) continue;
            const int itt = it & 1023, j = itt >> 8, c = itt & 255, xcd = c & 7, slot = c >> 3, idx = j * 32 + slot;
            const int bh = xcd * 8 + (idx >> 4), q16 = idx & 15;
            if (it < 1024) {
                const int qblk = (j & 1) ? 15 - q16 : q16;
                __syncthreads();
                for (int e = tid; e < 1024; e += NTHREADS) km[e] = kmp[(size_t)bh * 1024 + e] + kmp[(size_t)(64 + bh) * 1024 + e];
                __syncthreads();
                attn_b_item(ws, buf, km, bh, qblk, wid, lane);
            } else {
                attn_a_item(ws, buf, bh, (q16 & 1) * 8 + wid, (q16 >> 1) * 32, lane);
            }
        }
    }
    xcd_barrier(xbar);

    if constexpr ((PH_MASK & 8) != 0) {
        pg8::Gemm g{(const bf16_t*)(ws + WS_Y), (const bf16_t*)(ws + WS_BT1), NTOK, DM, DM};
        pg8::StaticOrder S; S.init(NTOK, DM, G, bid);
        EpiOut E{P.x, (float*)(ws + WS_X1), (bf16_t*)(ws + WS_X1B), (float*)(ws + WS_SSQ)};
        for (int rep = 0; rep < NREP(3); ++rep) pg8::gemm_phase<EpiOut, pg8::StaticOrder, true, true>(lds, g, S, E);
    }
    xcd_barrier(xbar);

    if constexpr ((PH_MASK & 16) != 0) {
        pg8::Gemm g{(const bf16_t*)(ws + WS_X1B), (const bf16_t*)(ws + WS_BT2), NTOK, N_IN1, DM};
        pg8::StaticOrder S; S.init(NTOK, N_IN1, G, bid);
        EpiIn E{1, ws};
        for (int rep = 0; rep < NREP(4); ++rep) pg8::gemm_phase<EpiIn, pg8::StaticOrder, true, true>(lds, g, S, E);
    }
    xcd_barrier(xbar);

    if constexpr ((PH_MASK & 32) != 0) {
        PHASE_IDS();
        for (int rep = 0; rep < NREP(5); ++rep)
        for (int it = bid; it < 2048; it += G) {
            const int j = it >> 8, c = it & 255, xcd = c & 7, slot = c >> 3, idx = j * 32 + slot;
            const int bkv = xcd * 2 + (idx >> 7), rem = idx & 127, hq = (bkv & 1) * 8 + (rem >> 4), chunk = rem & 15;
            attn_c_item(ws, lds + wid * TBUF, bkv >> 1, hq, chunk, wid, lane);
        }
    }
    xcd_barrier(xbar);

    if constexpr ((PH_MASK & 64) != 0) {
        pg8::Gemm g{(const bf16_t*)(ws + WS_Y), (const bf16_t*)(ws + WS_BT3), NTOK, DM, DM};
        pg8::StaticOrder S; S.init(NTOK, DM, G, bid);
        EpiOut E{(const float*)(ws + WS_X1), P.out, nullptr, nullptr};
        for (int rep = 0; rep < NREP(6); ++rep) pg8::gemm_phase<EpiOut, pg8::StaticOrder, true, true>(lds, g, S, E);
    }
}

extern "C" void kernel_launch(void* const* d_in, const int* in_sizes, int n_in, void* d_out, int out_size, void* d_ws, size_t ws_size, hipStream_t stream) {
    static int grid_blocks = 0;
    if (grid_blocks == 0) {
        if (n_in != 14 || in_sizes[0] != NTOK * DM || out_size != NTOK * DM || ws_size < WS_END) {
            fprintf(stderr, "kernel_launch: unexpected shapes (n_in %d in0 %d out %d ws %zu)\n", n_in, n_in > 0 ? in_sizes[0] : -1, out_size, ws_size); grid_blocks = -1; return; }
        int dev = 0, cus = 0, per_cu = 0;
        hipGetDevice(&dev);
        hipDeviceGetAttribute(&cus, hipDeviceAttributeMultiprocessorCount, dev);
        if (hipFuncSetAttribute((const void*)fwd_megakernel, hipFuncAttributeMaxDynamicSharedMemorySize, LDS_BYTES) != hipSuccess) {
            fprintf(stderr, "kernel_launch: hipFuncSetAttribute failed\n"); grid_blocks = -1; return; }
        if (hipOccupancyMaxActiveBlocksPerMultiprocessor(&per_cu, (const void*)fwd_megakernel, NTHREADS, LDS_BYTES) != hipSuccess || per_cu < 1) {
            fprintf(stderr, "kernel_launch: occupancy query gave %d\n", per_cu); per_cu = 1; (void)hipGetLastError(); }
        grid_blocks = cus * 1;
        if (per_cu < 1) grid_blocks = -1;
    }
    if (grid_blocks < 0) return;
    Params p{};
    p.x = (const float*)d_in[0]; p.norm_even = (const float*)d_in[1]; p.w_in_even = (const float*)d_in[2]; p.w_out_even = (const float*)d_in[3];
    p.qn_a = (const float*)d_in[4]; p.kn_a = (const float*)d_in[5]; p.qn_b = (const float*)d_in[6]; p.kn_b = (const float*)d_in[7];
    p.norm_odd = (const float*)d_in[8]; p.w_in_odd = (const float*)d_in[9]; p.w_out_odd = (const float*)d_in[10];
    p.qn_c = (const float*)d_in[11]; p.kn_c = (const float*)d_in[12]; p.sinks = (const float*)d_in[13];
    p.out = (float*)d_out; p.ws = (unsigned char*)d_ws;
    if (hipMemsetAsync((unsigned char*)d_ws + WS_BAR, 0, XCD_BAR_WORDS * 4, stream) != hipSuccess) { fprintf(stderr, "kernel_launch: memset failed\n"); return; }
    void* args[] = {&p};
    hipError_t e = hipLaunchCooperativeKernel((const void*)fwd_megakernel, dim3(grid_blocks), dim3(NTHREADS), args, LDS_BYTES, stream);
    if (e != hipSuccess) fprintf(stderr, "cooperative launch failed: %s (grid %d)\n", hipGetErrorString(e), grid_blocks);
}
```

```cpp
#include <hip/hip_runtime.h>
#include <hip/hip_cooperative_groups.h>
#include <cstdio>
#include <cstdint>
namespace cg = cooperative_groups;
namespace pg8 {
#define PG8_LAS __attribute__((address_space(3)))
typedef unsigned short bf16_t;
typedef short bf16x8 __attribute__((ext_vector_type(8)));
typedef float f32x4 __attribute__((ext_vector_type(4)));
typedef unsigned u32x4 __attribute__((ext_vector_type(4)));
constexpr int BM = 256, BK = 64, HALF = 128, HTB = HALF * BK * 2  , STAGE_BYTES = 8 * HTB, NXCD = 8, WGM = 8;

__host__ __device__ __forceinline__ int lds_byte(int r, int c) { const int st = (r >> 4) * 2 + (c >> 5), rr = r & 15, cc = c & 31, ob = rr * 64 + cc * 2; return st * 1024 + (ob ^ (((ob >> 9) & 1) << 5)); }
__host__ __device__ __forceinline__ void stage_rc(int b, int& R, int& C) { const int st = b / 1024, sb = b % 1024, swz = sb ^ (((sb >> 9) & 1) << 5); R = (st >> 1) * 16 + swz / 64; C = (st & 1) * 32 + (swz % 64) / 2; }
__host__ __device__ __forceinline__ int perm32(int rho) { const int n = rho >> 4, i = rho & 15; return 8 * (i >> 2) + 4 * n + (i & 3); }

struct Unit { int pm, pn; };
struct Gemm { const bf16_t* A; const bf16_t* Bt; int M, N, K; };

struct StaticOrder {
    int nM, nN, nwg, G, c;
    __host__ __device__ void init(int M, int N, int G_, int c_) { nM = M / BM; nN = N / BM; nwg = nM * nN; G = G_; c = c_; }
    __host__ __device__ bool next(int i, Unit& u) const {
        const long L = (long)i * G + c; if (L >= nwg) return false;
        int wgid = (int)L; { const int q = nwg / NXCD, r = nwg % NXCD, xcd = wgid % NXCD, off = wgid / NXCD; wgid = (xcd < r ? xcd * (q + 1) : r * (q + 1) + (xcd - r) * q) + off; }
        const int nig = WGM * nN, gid = wgid / nig, fm = gid * WGM, gsz = (nM - fm) < WGM ? (nM - fm) : WGM;
        u.pm = fm + ((wgid % nig) % gsz); u.pn = (wgid % nig) / gsz; return true;
    }
    __device__ __forceinline__ void a_ready(const Unit&) const {}
    __device__ __forceinline__ void done(const Unit&) const {}
};

template <class Epi, class Sched, bool ALIGN_EPI = false, bool SP2 = false>
__device__ __forceinline__ void gemm_phase(PG8_LAS unsigned char* lds, const Gemm g, const Sched& S, const Epi& E) {
    int tid_l = threadIdx.x; asm volatile("" : "+v"(tid_l));
    const int tid = tid_l, wid = __builtin_amdgcn_readfirstlane(tid >> 6), lane = tid & 63, wr = wid >> 2, wc = wid & 3, fr = lane & 15, fq = lane >> 4;
    const int K = g.K, nt = K / BK;
    unsigned voffA[2], voffB[2];
#pragma unroll
    for (int i = 0; i < 2; ++i) { int R, C; stage_rc(tid * 16 + i * 8192, R, C); const int Rb = Epi::PERM ? ((R & ~31) + perm32(R & 31)) : R;
        voffA[i] = (unsigned)(R * K + C) * 2u; voffB[i] = (unsigned)(Rb * K + C) * 2u; }
    const size_t kstep = (size_t)(BK * 2);
    const size_t hstep = (size_t)HALF * K * 2;
    const size_t tstep = 2 * hstep;
    const unsigned ldsw = (unsigned)wid * 1024u;
    const int aoff = lds_byte(wr * 64 + fr, fq * 8), boff = lds_byte(wc * 32 + fr, fq * 8);
#define PG8_SA(b, h) (((b) * 2 + (h)) * HTB)
#define PG8_SB(b, h) ((4 + (b) * 2 + (h)) * HTB)
#define PG8_STAGE(bufoff, gbase, voff) do { _Pragma("unroll") for (int _i = 0; _i < 2; ++_i) \
        __builtin_amdgcn_global_load_lds((const unsigned*)((const char*)(gbase) + (voff)[_i]), (PG8_LAS unsigned*)(lds + (bufoff) + ldsw + _i * 8192), 16, 0, 0); } while (0)
#define PG8_LDA(dst, b, h) do { _Pragma("unroll") for (int m = 0; m < 4; ++m) _Pragma("unroll") for (int k = 0; k < 2; ++k) dst[m][k] = *(const PG8_LAS bf16x8*)(lds + PG8_SA(b, h) + aoff + m * 2048 + k * 1024); } while (0)
#define PG8_LDB(dst, b, h) do { _Pragma("unroll") for (int n = 0; n < 2; ++n) _Pragma("unroll") for (int k = 0; k < 2; ++k) dst[n][k] = *(const PG8_LAS bf16x8*)(lds + PG8_SB(b, h) + boff + n * 2048 + k * 1024); } while (0)
#define PG8_MMA(ai, bj, At, Bt) do { __builtin_amdgcn_s_setprio(1); _Pragma("unroll") for (int m = 0; m < 4; ++m) _Pragma("unroll") for (int n = 0; n < 2; ++n) _Pragma("unroll") for (int k = 0; k < 2; ++k) \
        acc[ai][bj][m][n] = __builtin_amdgcn_mfma_f32_16x16x32_bf16(Bt[n][k], At[m][k], acc[ai][bj][m][n], 0, 0, 0); __builtin_amdgcn_s_setprio(0); } while (0)
#define PG8_WAIT_V(n) asm volatile("s_waitcnt vmcnt(" #n ")" ::: "memory")
#define PG8_WAIT_L(n) asm volatile("s_waitcnt lgkmcnt(" #n ")" ::: "memory")
#define PG8_BAR __builtin_amdgcn_s_barrier()
#define PG8_SCHED __builtin_amdgcn_sched_barrier(0)
    Unit cur, nxt; int ui = 0;
    if (!S.next(0, cur)) return;
    f32x4 acc[2][2][4][2];
#pragma unroll
    for (int a = 0; a < 2; ++a)
#pragma unroll
        for (int b = 0; b < 2; ++b)
#pragma unroll
            for (int m = 0; m < 4; ++m)
#pragma unroll
                for (int n = 0; n < 2; ++n) acc[a][b][m][n] = (f32x4){0.f, 0.f, 0.f, 0.f};
    bf16x8 At[4][2], B0[2][2], B1[2][2];
    const char* cA = (const char*)g.A + (size_t)cur.pm * tstep; const char* cB = (const char*)g.Bt + (size_t)cur.pn * tstep;
    S.a_ready(cur);
    if constexpr (SP2) {
        PG8_STAGE(PG8_SB(0, 0), cB, voffB); PG8_STAGE(PG8_SB(0, 1), cB + hstep, voffB); PG8_STAGE(PG8_SA(0, 0), cA, voffA); PG8_STAGE(PG8_SA(0, 1), cA + hstep, voffA);
        if (wr == 1) PG8_BAR;
        PG8_WAIT_V(2); PG8_BAR;
        PG8_STAGE(PG8_SB(1, 0), cB + kstep, voffB); PG8_STAGE(PG8_SA(1, 0), cA + kstep, voffA); PG8_STAGE(PG8_SB(1, 1), cB + hstep + kstep, voffB);
        PG8_WAIT_V(6); PG8_BAR;
    } else {
        PG8_STAGE(PG8_SB(0, 0), cB, voffB); PG8_STAGE(PG8_SA(0, 0), cA, voffA); PG8_STAGE(PG8_SB(0, 1), cB + hstep, voffB); PG8_STAGE(PG8_SA(0, 1), cA + hstep, voffA);
        if (wr == 1) PG8_BAR;
        PG8_WAIT_V(4); PG8_BAR;
        PG8_STAGE(PG8_SB(1, 0), cB + kstep, voffB); PG8_STAGE(PG8_SA(1, 0), cA + kstep, voffA); PG8_STAGE(PG8_SB(1, 1), cB + hstep + kstep, voffB);
        PG8_WAIT_V(6); PG8_BAR;
    }
    for (;;) {
        const bool has_next = S.next(ui + 1, nxt);
        const char* nA = has_next ? (const char*)g.A + (size_t)nxt.pm * tstep : cA; const char* nB = has_next ? (const char*)g.Bt + (size_t)nxt.pn * tstep : cB;
        for (int t = 0; t < nt; t += 2) {
            const bool last = (t == nt - 2);
            const char* a1 = cA + (size_t)(t + 1) * kstep;
            const char* a2 = last ? nA : cA + (size_t)(t + 2) * kstep; const char* b2 = last ? nB : cB + (size_t)(t + 2) * kstep;
            const char* a3 = a2 + kstep; const char* b3 = b2 + kstep;
            if (last && has_next) S.a_ready(nxt);
            if constexpr (SP2) {
            PG8_LDB(B0, 0, 0); PG8_LDB(B1, 0, 1); PG8_SCHED; PG8_LDA(At, 0, 0); PG8_STAGE(PG8_SA(1, 1), a1 + hstep, voffA);
            PG8_WAIT_V(8); PG8_WAIT_L(0); PG8_BAR; PG8_MMA(0, 0, At, B0); PG8_MMA(0, 1, At, B1); PG8_BAR; PG8_SCHED;
            PG8_LDA(At, 0, 1); PG8_STAGE(PG8_SB(0, 0), b2, voffB); PG8_STAGE(PG8_SB(0, 1), b2 + hstep, voffB); PG8_STAGE(PG8_SA(0, 0), a2, voffA);
            PG8_WAIT_V(8); PG8_WAIT_L(0); PG8_BAR; PG8_MMA(1, 0, At, B0); PG8_MMA(1, 1, At, B1); PG8_BAR; PG8_SCHED;
            PG8_LDB(B0, 1, 0); PG8_LDB(B1, 1, 1); PG8_SCHED; PG8_LDA(At, 1, 0); PG8_STAGE(PG8_SA(0, 1), a2 + hstep, voffA);
            PG8_WAIT_V(8); PG8_WAIT_L(0); PG8_BAR; PG8_MMA(0, 0, At, B0); PG8_MMA(0, 1, At, B1); PG8_BAR; PG8_SCHED;
            PG8_LDA(At, 1, 1); PG8_STAGE(PG8_SB(1, 0), b3, voffB); PG8_STAGE(PG8_SB(1, 1), b3 + hstep, voffB); PG8_STAGE(PG8_SA(1, 0), a3, voffA);
            PG8_WAIT_V(8); PG8_WAIT_L(0); PG8_BAR; PG8_MMA(1, 0, At, B0); PG8_MMA(1, 1, At, B1); PG8_BAR; PG8_SCHED;
            } else {
            PG8_LDB(B0, 0, 0); PG8_SCHED; PG8_LDA(At, 0, 0); PG8_STAGE(PG8_SA(1, 1), a1 + hstep, voffA);
            PG8_WAIT_L(8); PG8_BAR; PG8_WAIT_L(0); PG8_MMA(0, 0, At, B0); PG8_BAR; PG8_SCHED;
            PG8_LDB(B1, 0, 1); PG8_STAGE(PG8_SB(0, 0), b2, voffB);
            PG8_BAR; PG8_WAIT_L(0); PG8_MMA(0, 1, At, B1); PG8_BAR;
            PG8_LDA(At, 0, 1); PG8_STAGE(PG8_SA(0, 0), a2, voffA);
            PG8_BAR; PG8_WAIT_L(0); PG8_MMA(1, 0, At, B0); PG8_BAR; PG8_SCHED;
            PG8_STAGE(PG8_SB(0, 1), b2 + hstep, voffB);
            PG8_WAIT_V(6); PG8_BAR; PG8_MMA(1, 1, At, B1); PG8_BAR;
            PG8_LDB(B0, 1, 0); PG8_SCHED; PG8_LDA(At, 1, 0); PG8_STAGE(PG8_SA(0, 1), a2 + hstep, voffA);
            PG8_WAIT_L(8); PG8_BAR; PG8_WAIT_L(0); PG8_MMA(0, 0, At, B0); PG8_BAR; PG8_SCHED;
            PG8_LDB(B1, 1, 1); PG8_STAGE(PG8_SB(1, 0), b3, voffB);
            PG8_BAR; PG8_WAIT_L(0); PG8_MMA(0, 1, At, B1); PG8_BAR;
            PG8_LDA(At, 1, 1); PG8_STAGE(PG8_SA(1, 0), a3, voffA);
            PG8_BAR; PG8_WAIT_L(0); PG8_MMA(1, 0, At, B0); PG8_BAR; PG8_SCHED;
            PG8_STAGE(PG8_SB(1, 1), b3 + hstep, voffB);
            PG8_WAIT_V(6); PG8_BAR; PG8_MMA(1, 1, At, B1); PG8_BAR;
            }
        }
        if constexpr (ALIGN_EPI) { if (wr == 0) PG8_BAR; }
        if constexpr (!Epi::AFTER_DRAIN) { E(acc, cur, wr, wc, fr, fq); S.done(cur); }
        if (!has_next) break;
#pragma unroll
        for (int a = 0; a < 2; ++a)
#pragma unroll
            for (int b = 0; b < 2; ++b)
#pragma unroll
                for (int m = 0; m < 4; ++m)
#pragma unroll
                    for (int n = 0; n < 2; ++n) acc[a][b][m][n] = (f32x4){0.f, 0.f, 0.f, 0.f};
        cur = nxt; cA = nA; cB = nB; ++ui;
        if constexpr (ALIGN_EPI) { if (wr == 1) PG8_BAR; }
    }
    PG8_WAIT_V(0);
    if constexpr (!ALIGN_EPI) { if (wr == 0) PG8_BAR; }
    PG8_BAR;
    if constexpr (Epi::AFTER_DRAIN) { E.fused(acc, cur, wr, wc, fr, fq, lds, wid, lane); S.done(cur); }
#undef PG8_SA
#undef PG8_SB
#undef PG8_STAGE
#undef PG8_LDA
#undef PG8_LDB
#undef PG8_MMA
#undef PG8_WAIT_V
#undef PG8_WAIT_L
#undef PG8_BAR
#undef PG8_SCHED
}
}

using pg8::bf16_t; using pg8::bf16x8; using pg8::f32x4; using pg8::u32x4; using pg8::Unit;
typedef float f32x16 __attribute__((ext_vector_type(16)));
typedef short s16x4 __attribute__((ext_vector_type(4)));
typedef unsigned u32x2 __attribute__((ext_vector_type(2)));
typedef float f32x2 __attribute__((ext_vector_type(2)));
#define DI __device__ __forceinline__
#define LAS __attribute__((address_space(3)))

constexpr int BATCH = 8, SEQ = 4096, DM = 1024, NTOK = BATCH * SEQ;
constexpr int N_IN0 = 4096, N_IN1 = 2304;
constexpr float NORM_EPS = 1e-6f;
constexpr float SC_LOG2 = 0.125f * 1.44269504088896341f;
constexpr float NEGBIG = -1e30f;
constexpr int NTHREADS = 512;
#ifndef PH_MASK
#define PH_MASK 0x7f
#endif
#ifndef PROBE_REP
#define PROBE_REP 0
#endif
#define NREP(k) (((PROBE_REP >> (k)) & 1) ? 2 : 1)
constexpr int LDS_BYTES = 131072 + 8192;

constexpr size_t MiB = 1u << 20;
constexpr size_t WS_BT0 = 0 * MiB, WS_BT1 = 8 * MiB, WS_BT2 = 10 * MiB, WS_BT3 = 15 * MiB;
constexpr size_t WS_BAR = 17 * MiB + 512 * 1024;
constexpr size_t WS_GAINS = 17 * MiB;
constexpr size_t WS_RSTD0 = 18 * MiB, WS_CS = 19 * MiB, WS_KMP = 20 * MiB, WS_SSQ = 21 * MiB;
constexpr size_t WS_XB = 32 * MiB;
constexpr size_t WS_Y = 32 * MiB;
constexpr size_t WS_QA = 96 * MiB, WS_KA = 128 * MiB, WS_VTA = 160 * MiB, WS_QB = 192 * MiB, WS_KB = 224 * MiB, WS_VTB = 256 * MiB;
constexpr size_t WS_ZS = 288 * MiB;
constexpr size_t WS_X1 = 352 * MiB;
constexpr size_t WS_X1B = 96 * MiB;
constexpr size_t WS_QC = 160 * MiB, WS_KC = 224 * MiB, WS_VTC = 232 * MiB, WS_ZS1 = 240 * MiB;
constexpr size_t WS_END = 480 * MiB;

struct Params {
    const float* x; const float* norm_even; const float* w_in_even; const float* w_out_even;
    const float* qn_a; const float* kn_a; const float* qn_b; const float* kn_b;
    const float* norm_odd; const float* w_in_odd; const float* w_out_odd; const float* qn_c; const float* kn_c; const float* sinks;
    float* out; unsigned char* ws;
};

typedef __bf16 bf16v2 __attribute__((ext_vector_type(2)));
DI unsigned cvt_pk(float lo, float hi) { const f32x2 v = {lo, hi}; return __builtin_bit_cast(unsigned, __builtin_convertvector(v, bf16v2)); }
DI float bf_lo(unsigned u) { return __uint_as_float(u << 16); }
DI float bf_hi(unsigned u) { return __uint_as_float(u & 0xffff0000u); }

DI void p0_weight_tile(LAS float* tile, const float* W, bf16_t* Bt, int N, const float* g, bool permute, int t) {
    const int tid = threadIdx.x;
    const int ntn = N / 64, k0 = (t / ntn) * 64, n0 = (t % ntn) * 64;
    {
        const int n = tid & 63, kr = tid >> 6;
#pragma unroll
        for (int i = 0; i < 8; ++i) { const int k = kr + 8 * i; tile[k * 65 + n] = W[(size_t)(k0 + k) * N + n0 + n] * (g ? g[k0 + k] : 1.0f); }
    }
    __syncthreads();
    {
        const int nn = tid >> 3, ks = tid & 7;
        const int nlog = n0 + nn;
        const int c = permute ? ((nlog & ~255) | (((nlog >> 5) & 1) << 7) | (((nlog >> 6) & 3) << 5) | (nlog & 31)) : nlog;
        float v[8];
#pragma unroll
        for (int i = 0; i < 8; ++i) v[i] = tile[(ks * 8 + i) * 65 + nn];
        u32x4 w; w.x = cvt_pk(v[0], v[1]); w.y = cvt_pk(v[2], v[3]); w.z = cvt_pk(v[4], v[5]); w.w = cvt_pk(v[6], v[7]);
        *(u32x4*)(Bt + (size_t)c * 1024 + k0 + ks * 8) = w;
    }
    __syncthreads();
}

DI void sincos_d(double x, double& s, double& c) {
    const double kq = __builtin_rint(x * 0.63661977236758134308);
    double r = __builtin_fma(-kq, 1.57079632679489655800e+00, x); r = __builtin_fma(-kq, 6.12323399573676603587e-17, r);
    const int q = ((int)kq) & 3;
    const double r2 = r * r;
    const double sp = r * (1.0 + r2 * (-1.0 / 6 + r2 * (1.0 / 120 + r2 * (-1.0 / 5040 + r2 * (1.0 / 362880 + r2 * (-1.0 / 39916800 + r2 * (1.0 / 6227020800.0)))))));
    const double cp = 1.0 + r2 * (-0.5 + r2 * (1.0 / 24 + r2 * (-1.0 / 720 + r2 * (1.0 / 40320 + r2 * (-1.0 / 3628800 + r2 * (1.0 / 479001600.0 + r2 * (-1.0 / 87178291200.0)))))));
    s = (q == 0) ? sp : (q == 1) ? cp : (q == 2) ? -sp : -cp;
    c = (q == 0) ? cp : (q == 1) ? -sp : (q == 2) ? -cp : sp;
}

DI void p0_prologue(const Params& P, LAS unsigned char* lds) {
    unsigned char* ws = P.ws;
    const int tid = threadIdx.x, lane = tid & 63, wid = tid >> 6;
    const int G = gridDim.x, bid = blockIdx.x;
    {
        bf16_t* xb = (bf16_t*)(ws + WS_XB); float* rstd = (float*)(ws + WS_RSTD0);
        for (int row = bid * 8 + wid; row < NTOK; row += G * 8) {
            const f32x4* xr = (const f32x4*)(P.x + (size_t)row * DM);
            float ss = 0.f;
#pragma unroll
            for (int i = 0; i < 4; ++i) {
                const f32x4 v = xr[lane + 64 * i];
                ss += v[0] * v[0] + v[1] * v[1] + v[2] * v[2] + v[3] * v[3];
                u32x2 w; w.x = cvt_pk(v[0], v[1]); w.y = cvt_pk(v[2], v[3]);
                *(u32x2*)(xb + (size_t)row * DM + 4 * (lane + 64 * i)) = w;
            }
#pragma unroll
            for (int o = 32; o >= 1; o >>= 1) ss += __shfl_xor(ss, o);
            if (lane == 0) rstd[row] = rsqrtf(ss * (1.0f / DM) + NORM_EPS);
        }
    }
    if (bid == 0 && tid < 64) {
        float* gw = (float*)(ws + WS_GAINS);
        gw[tid] = P.qn_a[tid]; gw[64 + tid] = P.kn_a[tid]; gw[128 + tid] = P.qn_b[tid]; gw[192 + tid] = P.kn_b[tid]; gw[256 + tid] = P.qn_c[tid]; gw[320 + tid] = P.kn_c[tid];
        if (tid < 16) gw[384 + tid] = P.sinks[tid];
    }
    {
        f32x2* cs = (f32x2*)(ws + WS_CS);
        for (int e = bid * NTHREADS + tid; e < SEQ * 32; e += G * NTHREADS) {
            const int pos = e >> 5, i = e & 31;
            double f = 1.0;
            for (int k = 0; k < i; ++k) f *= 0.7498942093324558;
            const float invf = (float)f;
            const float ang = (float)pos * invf;
            double s, c; sincos_d((double)ang, s, c);
            cs[e] = (f32x2){(float)c, (float)s};
        }
    }
    {
        LAS float* tile = (LAS float*)lds;
        const int T0 = 16 * (N_IN0 / 64), T1 = 16 * (DM / 64), T2 = 16 * (N_IN1 / 64), T3 = 16 * (DM / 64);
        for (int t = bid; t < T0 + T1 + T2 + T3; t += G) {
            if (t < T0) p0_weight_tile(tile, P.w_in_even, (bf16_t*)(ws + WS_BT0), N_IN0, P.norm_even, true, t);
            else if (t < T0 + T1) p0_weight_tile(tile, P.w_out_even, (bf16_t*)(ws + WS_BT1), DM, nullptr, false, t - T0);
            else if (t < T0 + T1 + T2) p0_weight_tile(tile, P.w_in_odd, (bf16_t*)(ws + WS_BT2), N_IN1, P.norm_odd, true, t - T0 - T1);
            else p0_weight_tile(tile, P.w_out_odd, (bf16_t*)(ws + WS_BT3), DM, nullptr, false, t - T0 - T1 - T2);
        }
    }
}

DI float row_rstd1(const float* ssq, int row, int fq) {
    const f32x4 a = *(const f32x4*)(ssq + (size_t)row * 16 + 4 * fq);
    float t = (a[0] + a[1]) + (a[2] + a[3]);
    t += __shfl_xor(t, 16); t += __shfl_xor(t, 32);
    return rsqrtf(t * (1.0f / DM) + NORM_EPS);
}
struct EpiIn {
    static constexpr bool PERM = true, AFTER_DRAIN = false;
    int layer; unsigned char* ws;
    __device__ __forceinline__ void operator()(const f32x4 (&acc)[2][2][4][2], const Unit& u, int wr, int wc, int fr, int fq) const {
        const float* rstd0 = (const float*)(ws + WS_RSTD0); const float* ssq = (const float*)(ws + WS_SSQ); const f32x2* cs = (const f32x2*)(ws + WS_CS);
        const float* gains = (const float*)(ws + WS_GAINS); bf16_t* zs = (bf16_t*)(ws + (layer == 0 ? WS_ZS : WS_ZS1)); float* kmp = (float*)(ws + WS_KMP);
        int mode, head, hpb = 8, zcol = 0; bf16_t* dst = nullptr; const float* gain = gains; bool do_km = false;
        if (layer == 0) {
            const int seg = u.pn >> 1; head = (u.pn & 1) * 4 + wc;
            if (seg == 0) { mode = 0; dst = (bf16_t*)(ws + WS_QA); gain = gains; }
            else if (seg == 1) { mode = 0; dst = (bf16_t*)(ws + WS_KA); gain = gains + 64; }
            else if (seg == 2) { mode = 1; dst = (bf16_t*)(ws + WS_VTA); }
            else if (seg == 3) { mode = 2; zcol = head * 64; }
            else if (seg == 4) { mode = 0; dst = (bf16_t*)(ws + WS_QB); gain = gains + 128; }
            else if (seg == 5) { mode = 0; dst = (bf16_t*)(ws + WS_KB); gain = gains + 192; do_km = true; }
            else if (seg == 6) { mode = 1; dst = (bf16_t*)(ws + WS_VTB); }
            else { mode = 2; zcol = 512 + head * 64; }
        } else {
            if (u.pn < 4) { mode = 0; dst = (bf16_t*)(ws + WS_QC); gain = gains + 256; head = u.pn * 4 + wc; hpb = 16; }
            else if (u.pn == 4) { hpb = 2; if (wc < 2) { mode = 0; dst = (bf16_t*)(ws + WS_KC); gain = gains + 320; head = wc; } else { mode = 1; dst = (bf16_t*)(ws + WS_VTC); head = wc - 2; } }
            else { mode = 2; head = (u.pn - 5) * 4 + wc; zcol = head * 64; }
        }
        const int b = u.pm >> 4, sbase = (u.pm & 15) * 256 + wr * 64 + fr, rowbase = u.pm * 256 + wr * 64 + fr;
        const size_t bh = (size_t)b * hpb + head;
#define ROW_RS(row) ((layer == 0) ? rstd0[(row)] : row_rstd1(ssq, (row), fq))
        if (mode == 0) {
            float g0[8], g1[8], cs0[8], cs1[8];
#pragma unroll
            for (int i = 0; i < 8; ++i) { g0[i] = gain[8 * fq + i]; g1[i] = gain[32 + 8 * fq + i]; cs0[i] = 0.f; cs1[i] = 0.f; }
#pragma unroll
            for (int ai = 0; ai < 2; ++ai)
#pragma unroll
                for (int m = 0; m < 4; ++m) {
                    const int s = sbase + ai * 128 + m * 16; const float r = ROW_RS(rowbase + ai * 128 + m * 16);
                    float t0[8], t1[8]; float ss = 0.f;
#pragma unroll
                    for (int n = 0; n < 2; ++n)
#pragma unroll
                        for (int j = 0; j < 4; ++j) { t0[4 * n + j] = acc[ai][0][m][n][j] * r; t1[4 * n + j] = acc[ai][1][m][n][j] * r; }
#pragma unroll
                    for (int i = 0; i < 8; ++i) ss += t0[i] * t0[i] + t1[i] * t1[i];
                    ss += __shfl_xor(ss, 16); ss += __shfl_xor(ss, 32);
                    const float hr = rsqrtf(ss * (1.0f / 64.0f) + NORM_EPS);
                    const f32x4* cp = (const f32x4*)(cs + (size_t)s * 32 + 8 * fq);
                    float o0[8], o1[8];
#pragma unroll
                    for (int q = 0; q < 4; ++q) { const f32x4 c4 = cp[q];
                        { const int i = 2 * q; const float a = t0[i] * hr * g0[i], bb = t1[i] * hr * g1[i]; o0[i] = a * c4[0] - bb * c4[1]; o1[i] = bb * c4[0] + a * c4[1]; }
                        { const int i = 2 * q + 1; const float a = t0[i] * hr * g0[i], bb = t1[i] * hr * g1[i]; o0[i] = a * c4[2] - bb * c4[3]; o1[i] = bb * c4[2] + a * c4[3]; } }
                    u32x4 w0, w1;
                    w0.x = cvt_pk(o0[0], o0[1]); w0.y = cvt_pk(o0[2], o0[3]); w0.z = cvt_pk(o0[4], o0[5]); w0.w = cvt_pk(o0[6], o0[7]);
                    w1.x = cvt_pk(o1[0], o1[1]); w1.y = cvt_pk(o1[2], o1[3]); w1.z = cvt_pk(o1[4], o1[5]); w1.w = cvt_pk(o1[6], o1[7]);
                    bf16_t* rp = dst + ((bh * SEQ + s) * 64 + 8 * fq);
                    *(u32x4*)rp = w0; *(u32x4*)(rp + 32) = w1;
                    if (do_km) {
#pragma unroll
                        for (int i = 0; i < 8; ++i) { cs0[i] += o0[i]; cs1[i] += o1[i]; }
                    }
                }
            if (do_km) {
#pragma unroll
                for (int i = 0; i < 8; ++i) {
#pragma unroll
                    for (int o = 1; o <= 8; o <<= 1) { cs0[i] += __shfl_xor(cs0[i], o); cs1[i] += __shfl_xor(cs1[i], o); }
                }
                if (fr == 0) {
                    float* kp = kmp + (((size_t)wr * 64 + bh) * 16 + (u.pm & 15)) * 64 + 8 * fq;
                    *(f32x4*)kp = (f32x4){cs0[0], cs0[1], cs0[2], cs0[3]}; *(f32x4*)(kp + 4) = (f32x4){cs0[4], cs0[5], cs0[6], cs0[7]};
                    *(f32x4*)(kp + 32) = (f32x4){cs1[0], cs1[1], cs1[2], cs1[3]}; *(f32x4*)(kp + 36) = (f32x4){cs1[4], cs1[5], cs1[6], cs1[7]};
                }
            }
        } else if (mode == 1) {
#pragma unroll
            for (int ai = 0; ai < 2; ++ai)
#pragma unroll
                for (int m = 0; m < 4; ++m) {
                    const int s = sbase + ai * 128 + m * 16; const float r = ROW_RS(rowbase + ai * 128 + m * 16);
                    bf16_t* rp = dst + ((bh * SEQ + s) * 64 + 8 * fq);
#pragma unroll
                    for (int bj = 0; bj < 2; ++bj) {
                        const f32x4 v0 = acc[ai][bj][m][0] * r, v1 = acc[ai][bj][m][1] * r;
                        u32x4 w; w.x = cvt_pk(v0[0], v0[1]); w.y = cvt_pk(v0[2], v0[3]); w.z = cvt_pk(v1[0], v1[1]); w.w = cvt_pk(v1[2], v1[3]);
                        *(u32x4*)(rp + 32 * bj) = w;
                    }
                }
        } else {
#pragma unroll
            for (int ai = 0; ai < 2; ++ai)
#pragma unroll
                for (int m = 0; m < 4; ++m) {
                    const int row = rowbase + ai * 128 + m * 16; const float r = ROW_RS(row);
#pragma unroll
                    for (int bj = 0; bj < 2; ++bj) {
                        float sv[8];
#pragma unroll
                        for (int n = 0; n < 2; ++n)
#pragma unroll
                            for (int j = 0; j < 4; ++j) { const float z = acc[ai][bj][m][n][j] * r; sv[4 * n + j] = z / (1.0f + __expf(-z)); }
                        u32x4 w; w.x = cvt_pk(sv[0], sv[1]); w.y = cvt_pk(sv[2], sv[3]); w.z = cvt_pk(sv[4], sv[5]); w.w = cvt_pk(sv[6], sv[7]);
                        *(u32x4*)(zs + (size_t)row * DM + zcol + 32 * bj + 8 * fq) = w;
                    }
                }
        }
    }
};

struct EpiOut {
    static constexpr bool PERM = true, AFTER_DRAIN = false;
    const float* resid; float* out; bf16_t* xb; float* ssq;
    __device__ __forceinline__ void operator()(const f32x4 (&acc)[2][2][4][2], const Unit& u, int wr, int wc, int fr, int fq) const {
        const int col0 = u.pn * 256 + wc * 32 + 8 * fq, rowbase = u.pm * 256 + wr * 64 + fr;
#pragma unroll
        for (int ai = 0; ai < 2; ++ai)
#pragma unroll
            for (int m = 0; m < 4; ++m) {
                const int row = rowbase + ai * 128 + m * 16; const size_t off = (size_t)row * DM + col0;
                float q = 0.f;
#pragma unroll
                for (int bj = 0; bj < 2; ++bj) {
                    const f32x4 r0 = *(const f32x4*)(resid + off + bj * 128), r1 = *(const f32x4*)(resid + off + bj * 128 + 4);
                    const f32x4 o0 = r0 + acc[ai][bj][m][0], o1 = r1 + acc[ai][bj][m][1];
                    *(f32x4*)(out + off + bj * 128) = o0; *(f32x4*)(out + off + bj * 128 + 4) = o1;
                    if (xb) {
                        u32x4 w; w.x = cvt_pk(o0[0], o0[1]); w.y = cvt_pk(o0[2], o0[3]); w.z = cvt_pk(o1[0], o1[1]); w.w = cvt_pk(o1[2], o1[3]);
                        *(u32x4*)(xb + off + bj * 128) = w;
                        q += (o0[0] * o0[0] + o0[1] * o0[1]) + (o0[2] * o0[2] + o0[3] * o0[3]) + (o1[0] * o1[0] + o1[1] * o1[1]) + (o1[2] * o1[2] + o1[3] * o1[3]);
                    }
                }
                if (xb) { q += __shfl_xor(q, 16); q += __shfl_xor(q, 32); if (fq == 0) ssq[(size_t)row * 16 + u.pn * 4 + wc] = q; }
            }
    }
};

#define MFMA32(a, b, c) __builtin_amdgcn_mfma_f32_32x32x16_bf16((a), (b), (c), 0, 0, 0)
constexpr int TROW = 144;
constexpr int TBUF = 2 * 32 * TROW;
struct TileRegs { u32x4 k[4]; u32x4 v[4]; };
struct ASt { f32x16 o0, o1; float m, l; };

DI void ast_init(ASt& st) {
#pragma unroll
    for (int i = 0; i < 16; ++i) { st.o0[i] = 0.f; st.o1[i] = 0.f; }
    st.m = NEGBIG; st.l = 0.f;
}

DI void tile_gload(TileRegs& t, const bf16_t* K, const bf16_t* V, int kbase, int kstride, int lane) {
    const int row0 = lane >> 3, ch = lane & 7;
#pragma unroll
    for (int i = 0; i < 4; ++i) {
        const size_t off = (size_t)(kbase + kstride * (row0 + 8 * i)) * 64 + ch * 8;
        t.k[i] = *(const u32x4*)(K + off); t.v[i] = *(const u32x4*)(V + off);
    }
}
DI void tile_lds_write(LAS unsigned char* buf, const TileRegs& t, int lane) {
    const int row0 = lane >> 3, ch = lane & 7;
#pragma unroll
    for (int i = 0; i < 4; ++i) {
        const int off = (row0 + 8 * i) * TROW + ch * 16;
        *(LAS u32x4*)(buf + off) = t.k[i]; *(LAS u32x4*)(buf + 32 * TROW + off) = t.v[i];
    }
}

template <bool ELEM_MASK>
DI void attn_tile_core(ASt& st, const bf16x8 (&qf)[4], LAS unsigned char* buf, int dist0, int kstride, int hi, bool lane_ok, int lane) {
    const int r = lane & 31, h = lane >> 5;
    f32x16 s;
#pragma unroll
    for (int i = 0; i < 16; ++i) s[i] = 0.f;
#pragma unroll
    for (int ks = 0; ks < 4; ++ks) { const bf16x8 kf = *(const LAS bf16x8*)(buf + r * TROW + (2 * ks + h) * 16); s = MFMA32(kf, qf[ks], s); }
    bf16x8 vf[2][2];
    {
        const int q = (lane & 15) >> 2, p = lane & 3, blk = (lane >> 4) & 1;
        LAS unsigned char* vb = buf + 32 * TROW + (4 * h + q) * TROW + 32 * blk + 8 * p;
#pragma unroll
        for (int dt = 0; dt < 2; ++dt)
#pragma unroll
            for (int s2 = 0; s2 < 2; ++s2) {
                const s16x4 lo = __builtin_amdgcn_ds_read_tr16_b64_v4i16((LAS s16x4*)(vb + (16 * s2) * TROW + 64 * dt));
                const s16x4 hi4 = __builtin_amdgcn_ds_read_tr16_b64_v4i16((LAS s16x4*)(vb + (16 * s2 + 8) * TROW + 64 * dt));
                vf[dt][s2] = __builtin_shufflevector(lo, hi4, 0, 1, 2, 3, 4, 5, 6, 7);
            }
    }
    if (ELEM_MASK) {
#pragma unroll
        for (int i = 0; i < 16; ++i) {
            const unsigned dist = (unsigned)(dist0 - kstride * ((i & 3) + 8 * (i >> 2)));
            s[i] = (dist <= (unsigned)hi) ? s[i] : NEGBIG;
        }
    }
    float tmax = fmaxf(fmaxf(fmaxf(s[0], s[1]), fmaxf(s[2], s[3])), fmaxf(fmaxf(s[4], s[5]), fmaxf(s[6], s[7])));
    tmax = fmaxf(tmax, fmaxf(fmaxf(fmaxf(s[8], s[9]), fmaxf(s[10], s[11])), fmaxf(fmaxf(s[12], s[13]), fmaxf(s[14], s[15]))));
    tmax = lane_ok ? tmax : NEGBIG;
    tmax = fmaxf(tmax, __shfl_xor(tmax, 32));
    const float mnew = fmaxf(st.m, tmax * SC_LOG2);
    if (__builtin_amdgcn_ballot_w64(mnew > st.m) != 0ull) {
        const float alpha = __builtin_amdgcn_exp2f(st.m - mnew);
        st.l *= alpha;
#pragma unroll
        for (int i = 0; i < 16; ++i) { st.o0[i] *= alpha; st.o1[i] *= alpha; }
    }
    st.m = mnew;
    const float msub = lane_ok ? ((mnew < -1e29f) ? 0.f : mnew) : 1e30f;
    float ps0 = 0.f, ps1 = 0.f;
#pragma unroll
    for (int i = 0; i < 16; i += 2) {
        s[i] = __builtin_amdgcn_exp2f(__builtin_fmaf(s[i], SC_LOG2, -msub)); s[i + 1] = __builtin_amdgcn_exp2f(__builtin_fmaf(s[i + 1], SC_LOG2, -msub));
        ps0 += s[i]; ps1 += s[i + 1];
    }
    st.l += ps0 + ps1;
#pragma unroll
    for (int s2 = 0; s2 < 2; ++s2) {
        u32x4 p;
        p.x = cvt_pk(s[8 * s2 + 0], s[8 * s2 + 1]); p.y = cvt_pk(s[8 * s2 + 2], s[8 * s2 + 3]);
        p.z = cvt_pk(s[8 * s2 + 4], s[8 * s2 + 5]); p.w = cvt_pk(s[8 * s2 + 6], s[8 * s2 + 7]);
        const bf16x8 pb = __builtin_bit_cast(bf16x8, p);
        st.o0 = MFMA32(vf[0][s2], pb, st.o0);
        st.o1 = MFMA32(vf[1][s2], pb, st.o1);
    }
}
DI void attn_tile(ASt& st, const bf16x8 (&qf)[4], LAS unsigned char* buf, int dist0, int kstride, int hi, int lane) {
    const int h = lane >> 5;
    const int d_first = dist0 + kstride * 4 * h, d_last = d_first - 31 * kstride;
    const bool all_ok = (d_last >= 0) && (d_first <= hi);
    if (__builtin_amdgcn_ballot_w64(!all_ok) == 0ull) attn_tile_core<false>(st, qf, buf, dist0, kstride, hi, true, lane);
    else attn_tile_core<true>(st, qf, buf, dist0, kstride, hi, true, lane);
}

DI void load_q(bf16x8 (&qf)[4], const bf16_t* qrow, int h) {
    const bf16x8* qp = (const bf16x8*)qrow;
#pragma unroll
    for (int ks = 0; ks < 4; ++ks) qf[ks] = qp[2 * ks + h];
}

DI void attn_finish(ASt& st, float sink_l2, const bf16_t* zs, bf16_t* y, size_t rowoff  , int h) {
    float l = st.l + __shfl_xor(st.l, 32);
    const float mf = fmaxf(st.m, sink_l2);
    const float a = __builtin_amdgcn_exp2f(st.m - mf);
    l = l * a + ((sink_l2 > -1e29f) ? __builtin_amdgcn_exp2f(sink_l2 - mf) : 0.f);
    const float inv = a / l;
#pragma unroll
    for (int dt = 0; dt < 2; ++dt)
#pragma unroll
        for (int g = 0; g < 4; ++g) {
            const size_t off = rowoff + 32 * dt + 8 * g + 4 * h;
            const u32x2 z = *(const u32x2*)(zs + off);
            const float v0 = (dt ? st.o1[4 * g + 0] : st.o0[4 * g + 0]) * inv * bf_lo(z.x);
            const float v1 = (dt ? st.o1[4 * g + 1] : st.o0[4 * g + 1]) * inv * bf_hi(z.x);
            const float v2 = (dt ? st.o1[4 * g + 2] : st.o0[4 * g + 2]) * inv * bf_lo(z.y);
            const float v3 = (dt ? st.o1[4 * g + 3] : st.o0[4 * g + 3]) * inv * bf_hi(z.y);
            u32x2 w; w.x = cvt_pk(v0, v1); w.y = cvt_pk(v2, v3);
            *(u32x2*)(y + off) = w;
        }
}

DI bool a_tile_desc(int tau, int r16, int i0, int& kbase, int& kstride, int& hi) {
    if (tau < 5) { const int jb = i0 - 128 + 32 * tau; kbase = r16 + 16 * jb; kstride = 16; hi = 2048; return jb >= 0; }
    if (tau < 13) { const int ub = 4 * i0 - 128 + 32 * (tau - 5); kbase = (r16 & 3) + 4 * ub; kstride = 4; hi = 512; return ub >= 0; }
    { const int kb = 16 * i0 - 128 + 32 * (tau - 13); kbase = kb; kstride = 1; hi = 128; return kb >= 0; }
}
DI int a_next(int tau, int r16, int i0) { int t = tau + 1, kb, ks, hi; while (t < 33 && !a_tile_desc(t, r16, i0, kb, ks, hi)) ++t; return t; }
DI void attn_a_item(unsigned char* ws, LAS unsigned char* buf, int bh, int r16, int i0, int lane) {
    const int r = lane & 31, h = lane >> 5;
    const bf16_t* Q = (const bf16_t*)(ws + WS_QA) + (size_t)bh * SEQ * 64;
    const bf16_t* K = (const bf16_t*)(ws + WS_KA) + (size_t)bh * SEQ * 64;
    const bf16_t* V = (const bf16_t*)(ws + WS_VTA) + (size_t)bh * SEQ * 64;
    const int qpos = r16 + 16 * (i0 + r);
    bf16x8 qf[4]; load_q(qf, Q + (size_t)qpos * 64, h);
    ASt st; ast_init(st);
    TileRegs ta, tb;
#define A_GLOAD(R, tau) do { int kb_, ks_, hi_; (void)a_tile_desc((tau), r16, i0, kb_, ks_, hi_); tile_gload(R, K, V, kb_, ks_, lane); } while (0)
#define A_COMP(tau) do { int kb_, ks_, hi_; (void)a_tile_desc((tau), r16, i0, kb_, ks_, hi_); attn_tile(st, qf, buf, qpos - kb_ - ks_ * 4 * h, ks_, hi_, lane); } while (0)
    int tl = a_next(-1, r16, i0), tc = tl;
    A_GLOAD(ta, tl); tl = a_next(tl, r16, i0);
    if (tl < 33) { A_GLOAD(tb, tl); tl = a_next(tl, r16, i0); }
    for (;;) {
        tile_lds_write(buf, ta, lane);
        if (tl < 33) { A_GLOAD(ta, tl); tl = a_next(tl, r16, i0); }
        A_COMP(tc); tc = a_next(tc, r16, i0); if (tc >= 33) break;
        tile_lds_write(buf, tb, lane);
        if (tl < 33) { A_GLOAD(tb, tl); tl = a_next(tl, r16, i0); }
        A_COMP(tc); tc = a_next(tc, r16, i0); if (tc >= 33) break;
    }
#undef A_GLOAD
#undef A_COMP
    const int b = bh >> 3, head = bh & 7;
    const size_t rowoff = ((size_t)b * SEQ + qpos) * DM + head * 64;
    attn_finish(st, NEGBIG, (const bf16_t*)(ws + WS_ZS), (bf16_t*)(ws + WS_Y), rowoff, h);
}

DI void attn_b_item(unsigned char* ws, LAS unsigned char* buf, LAS float* km  , int bh, int qblk, int wid, int lane) {
    const int r = lane & 31, h = lane >> 5;
    const bf16_t* Q = (const bf16_t*)(ws + WS_QB) + (size_t)bh * SEQ * 64;
    const bf16_t* K = (const bf16_t*)(ws + WS_KB) + (size_t)bh * SEQ * 64;
    const bf16_t* V = (const bf16_t*)(ws + WS_VTB) + (size_t)bh * SEQ * 64;
    const int qpos = qblk * 256 + wid * 32 + r;
    bf16x8 qf[4]; load_q(qf, Q + (size_t)qpos * 64, h);
    float v1 = -3e38f, v2 = -3e38f, v3 = -3e38f; int i1 = 31, i2 = 31, i3 = 31;
    for (int n = 0; n < qblk; ++n) {
        float g = 0.f;
#pragma unroll
        for (int ks = 0; ks < 4; ++ks) {
            const LAS f32x4* kp = (const LAS f32x4*)(km + n * 64 + 16 * ks + 8 * h);
            const f32x4 a = kp[0], bq = kp[1];
            const u32x4 qu = __builtin_bit_cast(u32x4, qf[ks]);
            g += bf_lo(qu.x) * a[0] + bf_hi(qu.x) * a[1] + bf_lo(qu.y) * a[2] + bf_hi(qu.y) * a[3]
               + bf_lo(qu.z) * bq[0] + bf_hi(qu.z) * bq[1] + bf_lo(qu.w) * bq[2] + bf_hi(qu.w) * bq[3];
        }
        g += __shfl_xor(g, 32);
        if (g > v1) { v3 = v2; i3 = i2; v2 = v1; i2 = i1; v1 = g; i1 = n; }
        else if (g > v2) { v3 = v2; i3 = i2; v2 = g; i2 = n; }
        else if (g > v3) { v3 = g; i3 = n; }
    }
    unsigned sel = 0u;
    if (i1 < 16) sel |= 1u << i1;
    if (i2 < 16) sel |= 1u << i2;
    if (i3 < 16) sel |= 1u << i3;
    unsigned uni = 0u;
    for (int n = 0; n < qblk; ++n) { if (__builtin_amdgcn_ballot_w64((sel >> n) & 1u) != 0ull) uni |= 1u << n; }
    uni |= 1u << qblk;
    const int own_tiles = wid + 1;
    ASt st; ast_init(st);
    TileRegs ta, tb;
#define B_ADV(n_, T_, ok_) do { const int cnt_ = ((n_) == qblk) ? own_tiles : 8; if (++(T_) >= cnt_) { const unsigned rest_ = uni & ~((2u << (n_)) - 1u); if (rest_) { (n_) = __builtin_ctz(rest_); (T_) = 0; } else (ok_) = false; } } while (0)
#define B_COMP() do { const int kb_ = nc * 256 + 32 * Tc; \
        if (nc == qblk) { if (Tc == wid) attn_tile_core<true>(st, qf, buf, qpos - kb_ - 4 * h, 1, 0x7fffffff, true, lane); else attn_tile_core<false>(st, qf, buf, 0, 1, 0, true, lane); } \
        else attn_tile_core<false>(st, qf, buf, 0, 1, 0, ((sel >> nc) & 1u) != 0u, lane); } while (0)
    int nl = __builtin_ctz(uni), Tl = 0; bool okl = true;
    int nc = nl, Tc = 0; bool okc = true;
    tile_gload(ta, K, V, nl * 256 + 32 * Tl, 1, lane); B_ADV(nl, Tl, okl);
    if (okl) { tile_gload(tb, K, V, nl * 256 + 32 * Tl, 1, lane); B_ADV(nl, Tl, okl); }
    for (;;) {
        tile_lds_write(buf, ta, lane);
        if (okl) { tile_gload(ta, K, V, nl * 256 + 32 * Tl, 1, lane); B_ADV(nl, Tl, okl); }
        B_COMP(); B_ADV(nc, Tc, okc); if (!okc) break;
        tile_lds_write(buf, tb, lane);
        if (okl) { tile_gload(tb, K, V, nl * 256 + 32 * Tl, 1, lane); B_ADV(nl, Tl, okl); }
        B_COMP(); B_ADV(nc, Tc, okc); if (!okc) break;
    }
#undef B_ADV
#undef B_COMP
    const int b = bh >> 3, head = 8 + (bh & 7);
    const size_t rowoff = ((size_t)b * SEQ + qpos) * DM + head * 64;
    attn_finish(st, NEGBIG, (const bf16_t*)(ws + WS_ZS), (bf16_t*)(ws + WS_Y), rowoff, h);
}

DI void attn_c_item(unsigned char* ws, LAS unsigned char* buf, int b, int hq, int chunk, int wid, int lane) {
    const int r = lane & 31, h = lane >> 5, kvh = hq >> 3;
    const bf16_t* Q = (const bf16_t*)(ws + WS_QC) + ((size_t)b * 16 + hq) * SEQ * 64;
    const bf16_t* K = (const bf16_t*)(ws + WS_KC) + ((size_t)b * 2 + kvh) * SEQ * 64;
    const bf16_t* V = (const bf16_t*)(ws + WS_VTC) + ((size_t)b * 2 + kvh) * SEQ * 64;
    const int t0 = chunk * 256 + wid * 32, qpos = t0 + r;
    bf16x8 qf[4]; load_q(qf, Q + (size_t)qpos * 64, h);
    ASt st; ast_init(st);
    TileRegs ta, tb;
    int Tl = (t0 >= 128) ? 0 : (128 - t0) / 32, Tc = Tl;
#define C_COMP() attn_tile(st, qf, buf, qpos - (t0 - 128 + 32 * Tc) - 4 * h, 1, 127, lane)
    tile_gload(ta, K, V, t0 - 128 + 32 * Tl, 1, lane); ++Tl;
    if (Tl < 5) { tile_gload(tb, K, V, t0 - 128 + 32 * Tl, 1, lane); ++Tl; }
    for (;;) {
        tile_lds_write(buf, ta, lane);
        if (Tl < 5) { tile_gload(ta, K, V, t0 - 128 + 32 * Tl, 1, lane); ++Tl; }
        C_COMP(); if (++Tc >= 5) break;
        tile_lds_write(buf, tb, lane);
        if (Tl < 5) { tile_gload(tb, K, V, t0 - 128 + 32 * Tl, 1, lane); ++Tl; }
        C_COMP(); if (++Tc >= 5) break;
    }
#undef C_COMP
    const size_t rowoff = ((size_t)b * SEQ + qpos) * DM + hq * 64;
    attn_finish(st, ((const float*)(ws + WS_GAINS))[384 + hq] * 1.44269504088896341f, (const bf16_t*)(ws + WS_ZS1), (bf16_t*)(ws + WS_Y), rowoff, h);
}

#define XB_TMO      128
#define XB_XCNT(j)  (256  + 64 * (j))
#define XB_XSUB(j)  (1280 + 64 * (j))
#define XB_XGEN(j)  (2304 + 64 * (j))
#define XB_TOP      3328
#define XB_TOPGEN   3392
#define XCD_BAR_WORDS 3456
#define XB_SPIN_CAP (1u << 18)

__device__ __forceinline__ unsigned xb_ld(unsigned* p)              { return __hip_atomic_load(p, __ATOMIC_RELAXED, __HIP_MEMORY_SCOPE_AGENT); }
__device__ __forceinline__ unsigned xb_add(unsigned* p, unsigned v) { return __hip_atomic_fetch_add(p, v, __ATOMIC_RELAXED, __HIP_MEMORY_SCOPE_AGENT); }
__device__ __forceinline__ unsigned xb_xcc_id() { return (unsigned)__builtin_amdgcn_s_getreg((3 << 11) | 20) & 0xFu; }
#define XB_SPIN(cond, bar) do { unsigned _sp = 0; while (cond) { __builtin_amdgcn_s_sleep(1); \
    if ((++_sp & 255u) == 0u) { if (xb_ld(&(bar)[XB_TMO])) break; if (_sp > XB_SPIN_CAP) { atomicAdd(&(bar)[XB_TMO], 1u); break; } } } } while (0)

struct XcdBarrier {
    unsigned* bar; unsigned x;
    volatile LAS unsigned* st;
};

__device__ __forceinline__ XcdBarrier xcd_barrier_post(unsigned* bar, volatile LAS unsigned* st) {
    XcdBarrier b; b.bar = bar; b.x = xb_xcc_id(); b.st = st;
    if (threadIdx.x == 0) (void)xb_add(&bar[XB_XCNT(b.x)], 1u);
    return b;
}
__device__ __forceinline__ void xcd_barrier_complete(unsigned* bar, unsigned x, unsigned& nloc, unsigned& nx) {
    const unsigned G = gridDim.x * gridDim.y * gridDim.z;
    unsigned sum, cnt, mine, sp = 0u;
    for (;;) {
        sum = 0u; cnt = 0u; mine = 0u;
#pragma unroll
        for (unsigned j = 0; j < 16; ++j) { const unsigned c = xb_ld(&bar[XB_XCNT(j)]); sum += c; cnt += (c > 0u) ? 1u : 0u; mine = (j == x) ? c : mine; }
        if (sum == G) break;
        __builtin_amdgcn_s_sleep(1);
        if ((++sp & 255u) == 0u) { if (xb_ld(&bar[XB_TMO])) break; if (sp > XB_SPIN_CAP) { atomicAdd(&bar[XB_TMO], 1u); break; } }
    }
    nloc = mine > 0u ? mine : 1u; nx = cnt > 0u ? cnt : 1u;
}

__device__ __forceinline__ void xcd_barrier(const XcdBarrier& b) {
    asm volatile("s_waitcnt vmcnt(0)" ::: "memory");
    __syncthreads();
    if (threadIdx.x == 0) {
        unsigned* bar = b.bar;
        __builtin_amdgcn_s_waitcnt(0);
        unsigned nloc = b.st[0], nx = b.st[1];
        if (nloc == 0u) { xcd_barrier_complete(bar, b.x, nloc, nx); b.st[0] = nloc; b.st[1] = nx; }
        const unsigned old = xb_add(&bar[XB_XSUB(b.x)], 1u);
        const unsigned gen = old / nloc;
        if (old + 1u == (gen + 1u) * nloc) {
            __builtin_amdgcn_fence(__ATOMIC_RELEASE, "agent");
            asm volatile("s_waitcnt vmcnt(0)" ::: "memory");
            const unsigned og = xb_add(&bar[XB_TOP], 1u);
            const unsigned tg = og / nx;
            if (og + 1u == (tg + 1u) * nx) xb_add(&bar[XB_TOPGEN], 1u);
            else XB_SPIN(xb_ld(&bar[XB_TOPGEN]) == tg, bar);
            __builtin_amdgcn_fence(__ATOMIC_ACQUIRE, "agent");
            xb_add(&bar[XB_XGEN(b.x)], 1u);
            asm volatile("s_waitcnt vmcnt(0)" ::: "memory");
        } else {
            XB_SPIN(xb_ld(&bar[XB_XGEN(b.x)]) == gen, bar);
            __builtin_amdgcn_fence(__ATOMIC_ACQUIRE, "agent");
            asm volatile("s_waitcnt vmcnt(0)" ::: "memory");
        }
    }
    __syncthreads();
}


__global__ void __launch_bounds__(NTHREADS) fwd_megakernel(Params P) {
    extern __shared__ __attribute__((aligned(16))) unsigned char lds_raw[];
    cg::grid_group grid = cg::this_grid();
    LAS unsigned char* lds = (LAS unsigned char*)lds_raw;
    unsigned char* ws = P.ws;
    const int G = gridDim.x, bid = blockIdx.x;
    volatile LAS unsigned* xb_st = (volatile LAS unsigned*)(lds + LDS_BYTES - 16);
    if (threadIdx.x == 0) { xb_st[0] = 0u; xb_st[1] = 0u; }
    __syncthreads();
    const XcdBarrier xbar = xcd_barrier_post((unsigned*)(ws + WS_BAR), xb_st);
#define PHASE_IDS() int tid_l = threadIdx.x; asm volatile("" : "+v"(tid_l)); const int tid = tid_l, lane = tid & 63, wid = __builtin_amdgcn_readfirstlane(tid >> 6); (void)lane; (void)wid

    if constexpr (PH_MASK & 1) { for (int rep = 0; rep < NREP(0); ++rep) p0_prologue(P, lds); }
    grid.sync();

    if constexpr ((PH_MASK & 2) != 0) {
        pg8::Gemm g{(const bf16_t*)(ws + WS_XB), (const bf16_t*)(ws + WS_BT0), NTOK, N_IN0, DM};
        pg8::StaticOrder S; S.init(NTOK, N_IN0, G, bid);
        EpiIn E{0, ws};
        for (int rep = 0; rep < NREP(1); ++rep) pg8::gemm_phase<EpiIn, pg8::StaticOrder, true, true>(lds, g, S, E);
    }
    xcd_barrier(xbar);

    if constexpr ((PH_MASK & 4) != 0) {
        PHASE_IDS();
        LAS float* km = (LAS float*)(lds + 8 * TBUF);
        LAS unsigned char* buf = lds + wid * TBUF;
        const float* kmp = (const float*)(ws + WS_KMP);
        for (int rep = 0; rep < 2; ++rep)
        for (int it = bid; it < 2048; it += G) {
            if (rep == 1 && !((it < 1024) ? (NREP(2) == 2) : (NREP(7) == 2))) continue;
            const int itt = it & 1023, j = itt >> 8, c = itt & 255, xcd = c & 7, slot = c >> 3, idx = j * 32 + slot;
            const int bh = xcd * 8 + (idx >> 4), q16 = idx & 15;
            if (it < 1024) {
                const int qblk = (j & 1) ? 15 - q16 : q16;
                __syncthreads();
                for (int e = tid; e < 1024; e += NTHREADS) km[e] = kmp[(size_t)bh * 1024 + e] + kmp[(size_t)(64 + bh) * 1024 + e];
                __syncthreads();
                attn_b_item(ws, buf, km, bh, qblk, wid, lane);
            } else {
                attn_a_item(ws, buf, bh, (q16 & 1) * 8 + wid, (q16 >> 1) * 32, lane);
            }
        }
    }
    xcd_barrier(xbar);

    if constexpr ((PH_MASK & 8) != 0) {
        pg8::Gemm g{(const bf16_t*)(ws + WS_Y), (const bf16_t*)(ws + WS_BT1), NTOK, DM, DM};
        pg8::StaticOrder S; S.init(NTOK, DM, G, bid);
        EpiOut E{P.x, (float*)(ws + WS_X1), (bf16_t*)(ws + WS_X1B), (float*)(ws + WS_SSQ)};
        for (int rep = 0; rep < NREP(3); ++rep) pg8::gemm_phase<EpiOut, pg8::StaticOrder, true, true>(lds, g, S, E);
    }
    xcd_barrier(xbar);

    if constexpr ((PH_MASK & 16) != 0) {
        pg8::Gemm g{(const bf16_t*)(ws + WS_X1B), (const bf16_t*)(ws + WS_BT2), NTOK, N_IN1, DM};
        pg8::StaticOrder S; S.init(NTOK, N_IN1, G, bid);
        EpiIn E{1, ws};
        for (int rep = 0; rep < NREP(4); ++rep) pg8::gemm_phase<EpiIn, pg8::StaticOrder, true, true>(lds, g, S, E);
    }
    xcd_barrier(xbar);

    if constexpr ((PH_MASK & 32) != 0) {
        PHASE_IDS();
        for (int rep = 0; rep < NREP(5); ++rep)
        for (int it = bid; it < 2048; it += G) {
            const int j = it >> 8, c = it & 255, xcd = c & 7, slot = c >> 3, idx = j * 32 + slot;
            const int bkv = xcd * 2 + (idx >> 7), rem = idx & 127, hq = (bkv & 1) * 8 + (rem >> 4), chunk = rem & 15;
            attn_c_item(ws, lds + wid * TBUF, bkv >> 1, hq, chunk, wid, lane);
        }
    }
    xcd_barrier(xbar);

    if constexpr ((PH_MASK & 64) != 0) {
        pg8::Gemm g{(const bf16_t*)(ws + WS_Y), (const bf16_t*)(ws + WS_BT3), NTOK, DM, DM};
        pg8::StaticOrder S; S.init(NTOK, DM, G, bid);
        EpiOut E{(const float*)(ws + WS_X1), P.out, nullptr, nullptr};
        for (int rep = 0; rep < NREP(6); ++rep) pg8::gemm_phase<EpiOut, pg8::StaticOrder, true, true>(lds, g, S, E);
    }
}

extern "C" void kernel_launch(void* const* d_in, const int* in_sizes, int n_in, void* d_out, int out_size, void* d_ws, size_t ws_size, hipStream_t stream) {
    static int grid_blocks = 0;
    if (grid_blocks == 0) {
        if (n_in != 14 || in_sizes[0] != NTOK * DM || out_size != NTOK * DM || ws_size < WS_END) {
            fprintf(stderr, "kernel_launch: unexpected shapes (n_in %d in0 %d out %d ws %zu)\n", n_in, n_in > 0 ? in_sizes[0] : -1, out_size, ws_size); grid_blocks = -1; return; }
        int dev = 0, cus = 0, per_cu = 0;
        hipGetDevice(&dev);
        hipDeviceGetAttribute(&cus, hipDeviceAttributeMultiprocessorCount, dev);
        if (hipFuncSetAttribute((const void*)fwd_megakernel, hipFuncAttributeMaxDynamicSharedMemorySize, LDS_BYTES) != hipSuccess) {
            fprintf(stderr, "kernel_launch: hipFuncSetAttribute failed\n"); grid_blocks = -1; return; }
        if (hipOccupancyMaxActiveBlocksPerMultiprocessor(&per_cu, (const void*)fwd_megakernel, NTHREADS, LDS_BYTES) != hipSuccess || per_cu < 1) {
            fprintf(stderr, "kernel_launch: occupancy query gave %d\n", per_cu); per_cu = 1; (void)hipGetLastError(); }
        grid_blocks = cus * 1;
        if (per_cu < 1) grid_blocks = -1;
    }
    if (grid_blocks < 0) return;
    Params p{};
    p.x = (const float*)d_in[0]; p.norm_even = (const float*)d_in[1]; p.w_in_even = (const float*)d_in[2]; p.w_out_even = (const float*)d_in[3];
    p.qn_a = (const float*)d_in[4]; p.kn_a = (const float*)d_in[5]; p.qn_b = (const float*)d_in[6]; p.kn_b = (const float*)d_in[7];
    p.norm_odd = (const float*)d_in[8]; p.w_in_odd = (const float*)d_in[9]; p.w_out_odd = (const float*)d_in[10];
    p.qn_c = (const float*)d_in[11]; p.kn_c = (const float*)d_in[12]; p.sinks = (const float*)d_in[13];
    p.out = (float*)d_out; p.ws = (unsigned char*)d_ws;
    if (hipMemsetAsync((unsigned char*)d_ws + WS_BAR, 0, XCD_BAR_WORDS * 4, stream) != hipSuccess) { fprintf(stderr, "kernel_launch: memset failed\n"); return; }
    void* args[] = {&p};
    hipError_t e = hipLaunchCooperativeKernel((const void*)fwd_megakernel, dim3(grid_blocks), dim3(NTHREADS), args, LDS_BYTES, stream);
    if (e != hipSuccess) fprintf(stderr, "cooperative launch failed: %s (grid %d)\n", hipGetErrorString(e), grid_blocks);
}
```

```cpp
#include <hip/hip_runtime.h>
#include <hip/hip_cooperative_groups.h>
#include <cstdio>
#include <cstdint>
namespace cg = cooperative_groups;
namespace pg8 {
#define PG8_LAS __attribute__((address_space(3)))
typedef unsigned short bf16_t;
typedef short bf16x8 __attribute__((ext_vector_type(8)));
typedef float f32x4 __attribute__((ext_vector_type(4)));
typedef unsigned u32x4 __attribute__((ext_vector_type(4)));
constexpr int BM = 256, BK = 64, HALF = 128, HTB = HALF * BK * 2  , STAGE_BYTES = 8 * HTB, NXCD = 8, WGM = 8;

__host__ __device__ __forceinline__ int lds_byte(int r, int c) { const int st = (r >> 4) * 2 + (c >> 5), rr = r & 15, cc = c & 31, ob = rr * 64 + cc * 2; return st * 1024 + (ob ^ (((ob >> 9) & 1) << 5)); }
__host__ __device__ __forceinline__ void stage_rc(int b, int& R, int& C) { const int st = b / 1024, sb = b % 1024, swz = sb ^ (((sb >> 9) & 1) << 5); R = (st >> 1) * 16 + swz / 64; C = (st & 1) * 32 + (swz % 64) / 2; }
__host__ __device__ __forceinline__ int perm32(int rho) { const int n = rho >> 4, i = rho & 15; return 8 * (i >> 2) + 4 * n + (i & 3); }

struct Unit { int pm, pn; };
struct Gemm { const bf16_t* A; const bf16_t* Bt; int M, N, K; };

struct StaticOrder {
    int nM, nN, nwg, G, c;
    __host__ __device__ void init(int M, int N, int G_, int c_) { nM = M / BM; nN = N / BM; nwg = nM * nN; G = G_; c = c_; }
    __host__ __device__ bool next(int i, Unit& u) const {
        const long L = (long)i * G + c; if (L >= nwg) return false;
        int wgid = (int)L; { const int q = nwg / NXCD, r = nwg % NXCD, xcd = wgid % NXCD, off = wgid / NXCD; wgid = (xcd < r ? xcd * (q + 1) : r * (q + 1) + (xcd - r) * q) + off; }
        const int nig = WGM * nN, gid = wgid / nig, fm = gid * WGM, gsz = (nM - fm) < WGM ? (nM - fm) : WGM;
        u.pm = fm + ((wgid % nig) % gsz); u.pn = (wgid % nig) / gsz; return true;
    }
    __device__ __forceinline__ void a_ready(const Unit&) const {}
    __device__ __forceinline__ void done(const Unit&) const {}
};

template <class Epi, class Sched, bool ALIGN_EPI = false, bool SP2 = false>
__device__ __forceinline__ void gemm_phase(PG8_LAS unsigned char* lds, const Gemm g, const Sched& S, const Epi& E) {
    int tid_l = threadIdx.x; asm volatile("" : "+v"(tid_l));
    const int tid = tid_l, wid = __builtin_amdgcn_readfirstlane(tid >> 6), lane = tid & 63, wr = wid >> 2, wc = wid & 3, fr = lane & 15, fq = lane >> 4;
    const int K = g.K, nt = K / BK;
    unsigned voffA[2], voffB[2];
#pragma unroll
    for (int i = 0; i < 2; ++i) { int R, C; stage_rc(tid * 16 + i * 8192, R, C); const int Rb = Epi::PERM ? ((R & ~31) + perm32(R & 31)) : R;
        voffA[i] = (unsigned)(R * K + C) * 2u; voffB[i] = (unsigned)(Rb * K + C) * 2u; }
    const size_t kstep = (size_t)(BK * 2);
    const size_t hstep = (size_t)HALF * K * 2;
    const size_t tstep = 2 * hstep;
    const unsigned ldsw = (unsigned)wid * 1024u;
    const int aoff = lds_byte(wr * 64 + fr, fq * 8), boff = lds_byte(wc * 32 + fr, fq * 8);
#define PG8_SA(b, h) (((b) * 2 + (h)) * HTB)
#define PG8_SB(b, h) ((4 + (b) * 2 + (h)) * HTB)
#define PG8_STAGE(bufoff, gbase, voff) do { _Pragma("unroll") for (int _i = 0; _i < 2; ++_i) \
        __builtin_amdgcn_global_load_lds((const unsigned*)((const char*)(gbase) + (voff)[_i]), (PG8_LAS unsigned*)(lds + (bufoff) + ldsw + _i * 8192), 16, 0, 0); } while (0)
#define PG8_LDA(dst, b, h) do { _Pragma("unroll") for (int m = 0; m < 4; ++m) _Pragma("unroll") for (int k = 0; k < 2; ++k) dst[m][k] = *(const PG8_LAS bf16x8*)(lds + PG8_SA(b, h) + aoff + m * 2048 + k * 1024); } while (0)
#define PG8_LDB(dst, b, h) do { _Pragma("unroll") for (int n = 0; n < 2; ++n) _Pragma("unroll") for (int k = 0; k < 2; ++k) dst[n][k] = *(const PG8_LAS bf16x8*)(lds + PG8_SB(b, h) + boff + n * 2048 + k * 1024); } while (0)
#define PG8_MMA(ai, bj, At, Bt) do { __builtin_amdgcn_s_setprio(1); _Pragma("unroll") for (int m = 0; m < 4; ++m) _Pragma("unroll") for (int n = 0; n < 2; ++n) _Pragma("unroll") for (int k = 0; k < 2; ++k) \
        acc[ai][bj][m][n] = __builtin_amdgcn_mfma_f32_16x16x32_bf16(Bt[n][k], At[m][k], acc[ai][bj][m][n], 0, 0, 0); __builtin_amdgcn_s_setprio(0); } while (0)
#define PG8_WAIT_V(n) asm volatile("s_waitcnt vmcnt(" #n ")" ::: "memory")
#define PG8_WAIT_L(n) asm volatile("s_waitcnt lgkmcnt(" #n ")" ::: "memory")
#define PG8_BAR __builtin_amdgcn_s_barrier()
#define PG8_SCHED __builtin_amdgcn_sched_barrier(0)
    Unit cur, nxt; int ui = 0;
    if (!S.next(0, cur)) return;
    f32x4 acc[2][2][4][2];
#pragma unroll
    for (int a = 0; a < 2; ++a)
#pragma unroll
        for (int b = 0; b < 2; ++b)
#pragma unroll
            for (int m = 0; m < 4; ++m)
#pragma unroll
                for (int n = 0; n < 2; ++n) acc[a][b][m][n] = (f32x4){0.f, 0.f, 0.f, 0.f};
    bf16x8 At[4][2], B0[2][2], B1[2][2];
    const char* cA = (const char*)g.A + (size_t)cur.pm * tstep; const char* cB = (const char*)g.Bt + (size_t)cur.pn * tstep;
    S.a_ready(cur);
    if constexpr (SP2) {
        PG8_STAGE(PG8_SB(0, 0), cB, voffB); PG8_STAGE(PG8_SB(0, 1), cB + hstep, voffB); PG8_STAGE(PG8_SA(0, 0), cA, voffA); PG8_STAGE(PG8_SA(0, 1), cA + hstep, voffA);
        if (wr == 1) PG8_BAR;
        PG8_WAIT_V(2); PG8_BAR;
        PG8_STAGE(PG8_SB(1, 0), cB + kstep, voffB); PG8_STAGE(PG8_SA(1, 0), cA + kstep, voffA); PG8_STAGE(PG8_SB(1, 1), cB + hstep + kstep, voffB);
        PG8_WAIT_V(6); PG8_BAR;
    } else {
        PG8_STAGE(PG8_SB(0, 0), cB, voffB); PG8_STAGE(PG8_SA(0, 0), cA, voffA); PG8_STAGE(PG8_SB(0, 1), cB + hstep, voffB); PG8_STAGE(PG8_SA(0, 1), cA + hstep, voffA);
        if (wr == 1) PG8_BAR;
        PG8_WAIT_V(4); PG8_BAR;
        PG8_STAGE(PG8_SB(1, 0), cB + kstep, voffB); PG8_STAGE(PG8_SA(1, 0), cA + kstep, voffA); PG8_STAGE(PG8_SB(1, 1), cB + hstep + kstep, voffB);
        PG8_WAIT_V(6); PG8_BAR;
    }
    for (;;) {
        const bool has_next = S.next(ui + 1, nxt);
        const char* nA = has_next ? (const char*)g.A + (size_t)nxt.pm * tstep : cA; const char* nB = has_next ? (const char*)g.Bt + (size_t)nxt.pn * tstep : cB;
        for (int t = 0; t < nt; t += 2) {
            const bool last = (t == nt - 2);
            const char* a1 = cA + (size_t)(t + 1) * kstep;
            const char* a2 = last ? nA : cA + (size_t)(t + 2) * kstep; const char* b2 = last ? nB : cB + (size_t)(t + 2) * kstep;
            const char* a3 = a2 + kstep; const char* b3 = b2 + kstep;
            if (last && has_next) S.a_ready(nxt);
            if constexpr (SP2) {
            PG8_LDB(B0, 0, 0); PG8_LDB(B1, 0, 1); PG8_SCHED; PG8_LDA(At, 0, 0); PG8_STAGE(PG8_SA(1, 1), a1 + hstep, voffA);
            PG8_WAIT_V(8); PG8_WAIT_L(0); PG8_BAR; PG8_MMA(0, 0, At, B0); PG8_MMA(0, 1, At, B1); PG8_BAR; PG8_SCHED;
            PG8_LDA(At, 0, 1); PG8_STAGE(PG8_SB(0, 0), b2, voffB); PG8_STAGE(PG8_SB(0, 1), b2 + hstep, voffB); PG8_STAGE(PG8_SA(0, 0), a2, voffA);
            PG8_WAIT_V(8); PG8_WAIT_L(0); PG8_BAR; PG8_MMA(1, 0, At, B0); PG8_MMA(1, 1, At, B1); PG8_BAR; PG8_SCHED;
            PG8_LDB(B0, 1, 0); PG8_LDB(B1, 1, 1); PG8_SCHED; PG8_LDA(At, 1, 0); PG8_STAGE(PG8_SA(0, 1), a2 + hstep, voffA);
            PG8_WAIT_V(8); PG8_WAIT_L(0); PG8_BAR; PG8_MMA(0, 0, At, B0); PG8_MMA(0, 1, At, B1); PG8_BAR; PG8_SCHED;
            PG8_LDA(At, 1, 1); PG8_STAGE(PG8_SB(1, 0), b3, voffB); PG8_STAGE(PG8_SB(1, 1), b3 + hstep, voffB); PG8_STAGE(PG8_SA(1, 0), a3, voffA);
            PG8_WAIT_V(8); PG8_WAIT_L(0); PG8_BAR; PG8_MMA(1, 0, At, B0); PG8_MMA(1, 1, At, B1); PG8_BAR; PG8_SCHED;
            } else {
            PG8_LDB(B0, 0, 0); PG8_SCHED; PG8_LDA(At, 0, 0); PG8_STAGE(PG8_SA(1, 1), a1 + hstep, voffA);
            PG8_WAIT_L(8); PG8_BAR; PG8_WAIT_L(0); PG8_MMA(0, 0, At, B0); PG8_BAR; PG8_SCHED;
            PG8_LDB(B1, 0, 1); PG8_STAGE(PG8_SB(0, 0), b2, voffB);
            PG8_BAR; PG8_WAIT_L(0); PG8_MMA(0, 1, At, B1); PG8_BAR;
            PG8_LDA(At, 0, 1); PG8_STAGE(PG8_SA(0, 0), a2, voffA);
            PG8_BAR; PG8_WAIT_L(0); PG8_MMA(1, 0, At, B0); PG8_BAR; PG8_SCHED;
            PG8_STAGE(PG8_SB(0, 1), b2 + hstep, voffB);
            PG8_WAIT_V(6); PG8_BAR; PG8_MMA(1, 1, At, B1); PG8_BAR;
            PG8_LDB(B0, 1, 0); PG8_SCHED; PG8_LDA(At, 1, 0); PG8_STAGE(PG8_SA(0, 1), a2 + hstep, voffA);
            PG8_WAIT_L(8); PG8_BAR; PG8_WAIT_L(0); PG8_MMA(0, 0, At, B0); PG8_BAR; PG8_SCHED;
            PG8_LDB(B1, 1, 1); PG8_STAGE(PG8_SB(1, 0), b3, voffB);
            PG8_BAR; PG8_WAIT_L(0); PG8_MMA(0, 1, At, B1); PG8_BAR;
            PG8_LDA(At, 1, 1); PG8_STAGE(PG8_SA(1, 0), a3, voffA);
            PG8_BAR; PG8_WAIT_L(0); PG8_MMA(1, 0, At, B0); PG8_BAR; PG8_SCHED;
            PG8_STAGE(PG8_SB(1, 1), b3 + hstep, voffB);
            PG8_WAIT_V(6); PG8_BAR; PG8_MMA(1, 1, At, B1); PG8_BAR;
            }
        }
        if constexpr (ALIGN_EPI) { if (wr == 0) PG8_BAR; }
        if constexpr (!Epi::AFTER_DRAIN) { E(acc, cur, wr, wc, fr, fq); S.done(cur); }
        if (!has_next) break;
#pragma unroll
        for (int a = 0; a < 2; ++a)
#pragma unroll
            for (int b = 0; b < 2; ++b)
#pragma unroll
                for (int m = 0; m < 4; ++m)
#pragma unroll
                    for (int n = 0; n < 2; ++n) acc[a][b][m][n] = (f32x4){0.f, 0.f, 0.f, 0.f};
        cur = nxt; cA = nA; cB = nB; ++ui;
        if constexpr (ALIGN_EPI) { if (wr == 1) PG8_BAR; }
    }
    PG8_WAIT_V(0);
    if constexpr (!ALIGN_EPI) { if (wr == 0) PG8_BAR; }
    PG8_BAR;
    if constexpr (Epi::AFTER_DRAIN) { E.fused(acc, cur, wr, wc, fr, fq, lds, wid, lane); S.done(cur); }
#undef PG8_SA
#undef PG8_SB
#undef PG8_STAGE
#undef PG8_LDA
#undef PG8_LDB
#undef PG8_MMA
#undef PG8_WAIT_V
#undef PG8_WAIT_L
#undef PG8_BAR
#undef PG8_SCHED
}
}

using pg8::bf16_t; using pg8::bf16x8; using pg8::f32x4; using pg8::u32x4; using pg8::Unit;
typedef float f32x16 __attribute__((ext_vector_type(16)));
typedef short s16x4 __attribute__((ext_vector_type(4)));
typedef unsigned u32x2 __attribute__((ext_vector_type(2)));
typedef float f32x2 __attribute__((ext_vector_type(2)));
#define DI __device__ __forceinline__
#define LAS __attribute__((address_space(3)))

constexpr int BATCH = 8, SEQ = 4096, DM = 1024, NTOK = BATCH * SEQ;
constexpr int N_IN0 = 4096, N_IN1 = 2304;
constexpr float NORM_EPS = 1e-6f;
constexpr float SC_LOG2 = 0.125f * 1.44269504088896341f;
constexpr float NEGBIG = -1e30f;
constexpr int NTHREADS = 512;
#ifndef PH_MASK
#define PH_MASK 0x7f
#endif
#ifndef PROBE_REP
#define PROBE_REP 0
#endif
#define NREP(k) (((PROBE_REP >> (k)) & 1) ? 2 : 1)
constexpr int LDS_BYTES = 131072 + 8192;

constexpr size_t MiB = 1u << 20;
constexpr size_t WS_BT0 = 0 * MiB, WS_BT1 = 8 * MiB, WS_BT2 = 10 * MiB, WS_BT3 = 15 * MiB;
constexpr size_t WS_BAR = 17 * MiB + 512 * 1024;
constexpr size_t WS_GAINS = 17 * MiB;
constexpr size_t WS_RSTD0 = 18 * MiB, WS_CS = 19 * MiB, WS_KMP = 20 * MiB, WS_SSQ = 21 * MiB;
constexpr size_t WS_XB = 32 * MiB;
constexpr size_t WS_Y = 32 * MiB;
constexpr size_t WS_QA = 96 * MiB, WS_KA = 128 * MiB, WS_VTA = 160 * MiB, WS_QB = 192 * MiB, WS_KB = 224 * MiB, WS_VTB = 256 * MiB;
constexpr size_t WS_ZS = 288 * MiB;
constexpr size_t WS_X1 = 352 * MiB;
constexpr size_t WS_X1B = 96 * MiB;
constexpr size_t WS_QC = 160 * MiB, WS_KC = 224 * MiB, WS_VTC = 232 * MiB, WS_ZS1 = 240 * MiB;
constexpr size_t WS_END = 480 * MiB;

struct Params {
    const float* x; const float* norm_even; const float* w_in_even; const float* w_out_even;
    const float* qn_a; const float* kn_a; const float* qn_b; const float* kn_b;
    const float* norm_odd; const float* w_in_odd; const float* w_out_odd; const float* qn_c; const float* kn_c; const float* sinks;
    float* out; unsigned char* ws;
};

typedef __bf16 bf16v2 __attribute__((ext_vector_type(2)));
DI unsigned cvt_pk(float lo, float hi) { const f32x2 v = {lo, hi}; return __builtin_bit_cast(unsigned, __builtin_convertvector(v, bf16v2)); }
DI float bf_lo(unsigned u) { return __uint_as_float(u << 16); }
DI float bf_hi(unsigned u) { return __uint_as_float(u & 0xffff0000u); }

DI void p0_weight_tile(LAS float* tile, const float* W, bf16_t* Bt, int N, const float* g, bool permute, int t) {
    const int tid = threadIdx.x;
    const int ntn = N / 64, k0 = (t / ntn) * 64, n0 = (t % ntn) * 64;
    {
        const int n = tid & 63, kr = tid >> 6;
#pragma unroll
        for (int i = 0; i < 8; ++i) { const int k = kr + 8 * i; tile[k * 65 + n] = W[(size_t)(k0 + k) * N + n0 + n] * (g ? g[k0 + k] : 1.0f); }
    }
    __syncthreads();
    {
        const int nn = tid >> 3, ks = tid & 7;
        const int nlog = n0 + nn;
        const int c = permute ? ((nlog & ~255) | (((nlog >> 5) & 1) << 7) | (((nlog >> 6) & 3) << 5) | (nlog & 31)) : nlog;
        float v[8];
#pragma unroll
        for (int i = 0; i < 8; ++i) v[i] = tile[(ks * 8 + i) * 65 + nn];
        u32x4 w; w.x = cvt_pk(v[0], v[1]); w.y = cvt_pk(v[2], v[3]); w.z = cvt_pk(v[4], v[5]); w.w = cvt_pk(v[6], v[7]);
        *(u32x4*)(Bt + (size_t)c * 1024 + k0 + ks * 8) = w;
    }
    __syncthreads();
}

DI void sincos_d(double x, double& s, double& c) {
    const double kq = __builtin_rint(x * 0.63661977236758134308);
    double r = __builtin_fma(-kq, 1.57079632679489655800e+00, x); r = __builtin_fma(-kq, 6.12323399573676603587e-17, r);
    const int q = ((int)kq) & 3;
    const double r2 = r * r;
    const double sp = r * (1.0 + r2 * (-1.0 / 6 + r2 * (1.0 / 120 + r2 * (-1.0 / 5040 + r2 * (1.0 / 362880 + r2 * (-1.0 / 39916800 + r2 * (1.0 / 6227020800.0)))))));
    const double cp = 1.0 + r2 * (-0.5 + r2 * (1.0 / 24 + r2 * (-1.0 / 720 + r2 * (1.0 / 40320 + r2 * (-1.0 / 3628800 + r2 * (1.0 / 479001600.0 + r2 * (-1.0 / 87178291200.0)))))));
    s = (q == 0) ? sp : (q == 1) ? cp : (q == 2) ? -sp : -cp;
    c = (q == 0) ? cp : (q == 1) ? -sp : (q == 2) ? -cp : sp;
}

DI void p0_prologue(const Params& P, LAS unsigned char* lds) {
    unsigned char* ws = P.ws;
    const int tid = threadIdx.x, lane = tid & 63, wid = tid >> 6;
    const int G = gridDim.x, bid = blockIdx.x;
    {
        bf16_t* xb = (bf16_t*)(ws + WS_XB); float* rstd = (float*)(ws + WS_RSTD0);
        for (int row = bid * 8 + wid; row < NTOK; row += G * 8) {
            const f32x4* xr = (const f32x4*)(P.x + (size_t)row * DM);
            float ss = 0.f;
#pragma unroll
            for (int i = 0; i < 4; ++i) {
                const f32x4 v = xr[lane + 64 * i];
                ss += v[0] * v[0] + v[1] * v[1] + v[2] * v[2] + v[3] * v[3];
                u32x2 w; w.x = cvt_pk(v[0], v[1]); w.y = cvt_pk(v[2], v[3]);
                *(u32x2*)(xb + (size_t)row * DM + 4 * (lane + 64 * i)) = w;
            }
#pragma unroll
            for (int o = 32; o >= 1; o >>= 1) ss += __shfl_xor(ss, o);
            if (lane == 0) rstd[row] = rsqrtf(ss * (1.0f / DM) + NORM_EPS);
        }
    }
    if (bid == 0 && tid < 64) {
        float* gw = (float*)(ws + WS_GAINS);
        gw[tid] = P.qn_a[tid]; gw[64 + tid] = P.kn_a[tid]; gw[128 + tid] = P.qn_b[tid]; gw[192 + tid] = P.kn_b[tid]; gw[256 + tid] = P.qn_c[tid]; gw[320 + tid] = P.kn_c[tid];
        if (tid < 16) gw[384 + tid] = P.sinks[tid];
    }
    {
        f32x2* cs = (f32x2*)(ws + WS_CS);
        for (int e = bid * NTHREADS + tid; e < SEQ * 32; e += G * NTHREADS) {
            const int pos = e >> 5, i = e & 31;
            double f = 1.0;
            for (int k = 0; k < i; ++k) f *= 0.7498942093324558;
            const float invf = (float)f;
            const float ang = (float)pos * invf;
            double s, c; sincos_d((double)ang, s, c);
            cs[e] = (f32x2){(float)c, (float)s};
        }
    }
    {
        LAS float* tile = (LAS float*)lds;
        const int T0 = 16 * (N_IN0 / 64), T1 = 16 * (DM / 64), T2 = 16 * (N_IN1 / 64), T3 = 16 * (DM / 64);
        for (int t = bid; t < T0 + T1 + T2 + T3; t += G) {
            if (t < T0) p0_weight_tile(tile, P.w_in_even, (bf16_t*)(ws + WS_BT0), N_IN0, P.norm_even, true, t);
            else if (t < T0 + T1) p0_weight_tile(tile, P.w_out_even, (bf16_t*)(ws + WS_BT1), DM, nullptr, false, t - T0);
            else if (t < T0 + T1 + T2) p0_weight_tile(tile, P.w_in_odd, (bf16_t*)(ws + WS_BT2), N_IN1, P.norm_odd, true, t - T0 - T1);
            else p0_weight_tile(tile, P.w_out_odd, (bf16_t*)(ws + WS_BT3), DM, nullptr, false, t - T0 - T1 - T2);
        }
    }
}

DI float row_rstd1(const float* ssq, int row, int fq) {
    const f32x4 a = *(const f32x4*)(ssq + (size_t)row * 16 + 4 * fq);
    float t = (a[0] + a[1]) + (a[2] + a[3]);
    t += __shfl_xor(t, 16); t += __shfl_xor(t, 32);
    return rsqrtf(t * (1.0f / DM) + NORM_EPS);
}
struct EpiIn {
    static constexpr bool PERM = true, AFTER_DRAIN = false;
    int layer; unsigned char* ws;
    __device__ __forceinline__ void operator()(const f32x4 (&acc)[2][2][4][2], const Unit& u, int wr, int wc, int fr, int fq) const {
        const float* rstd0 = (const float*)(ws + WS_RSTD0); const float* ssq = (const float*)(ws + WS_SSQ); const f32x2* cs = (const f32x2*)(ws + WS_CS);
        const float* gains = (const float*)(ws + WS_GAINS); bf16_t* zs = (bf16_t*)(ws + (layer == 0 ? WS_ZS : WS_ZS1)); float* kmp = (float*)(ws + WS_KMP);
        int mode, head, hpb = 8, zcol = 0; bf16_t* dst = nullptr; const float* gain = gains; bool do_km = false;
        if (layer == 0) {
            const int seg = u.pn >> 1; head = (u.pn & 1) * 4 + wc;
            if (seg == 0) { mode = 0; dst = (bf16_t*)(ws + WS_QA); gain = gains; }
            else if (seg == 1) { mode = 0; dst = (bf16_t*)(ws + WS_KA); gain = gains + 64; }
            else if (seg == 2) { mode = 1; dst = (bf16_t*)(ws + WS_VTA); }
            else if (seg == 3) { mode = 2; zcol = head * 64; }
            else if (seg == 4) { mode = 0; dst = (bf16_t*)(ws + WS_QB); gain = gains + 128; }
            else if (seg == 5) { mode = 0; dst = (bf16_t*)(ws + WS_KB); gain = gains + 192; do_km = true; }
            else if (seg == 6) { mode = 1; dst = (bf16_t*)(ws + WS_VTB); }
            else { mode = 2; zcol = 512 + head * 64; }
        } else {
            if (u.pn < 4) { mode = 0; dst = (bf16_t*)(ws + WS_QC); gain = gains + 256; head = u.pn * 4 + wc; hpb = 16; }
            else if (u.pn == 4) { hpb = 2; if (wc < 2) { mode = 0; dst = (bf16_t*)(ws + WS_KC); gain = gains + 320; head = wc; } else { mode = 1; dst = (bf16_t*)(ws + WS_VTC); head = wc - 2; } }
            else { mode = 2; head = (u.pn - 5) * 4 + wc; zcol = head * 64; }
        }
        const int b = u.pm >> 4, sbase = (u.pm & 15) * 256 + wr * 64 + fr, rowbase = u.pm * 256 + wr * 64 + fr;
        const size_t bh = (size_t)b * hpb + head;
#define ROW_RS(row) ((layer == 0) ? rstd0[(row)] : row_rstd1(ssq, (row), fq))
        if (mode == 0) {
            float g0[8], g1[8], cs0[8], cs1[8];
#pragma unroll
            for (int i = 0; i < 8; ++i) { g0[i] = gain[8 * fq + i]; g1[i] = gain[32 + 8 * fq + i]; cs0[i] = 0.f; cs1[i] = 0.f; }
#pragma unroll
            for (int ai = 0; ai < 2; ++ai)
#pragma unroll
                for (int m = 0; m < 4; ++m) {
                    const int s = sbase + ai * 128 + m * 16; const float r = ROW_RS(rowbase + ai * 128 + m * 16);
                    float t0[8], t1[8]; float ss = 0.f;
#pragma unroll
                    for (int n = 0; n < 2; ++n)
#pragma unroll
                        for (int j = 0; j < 4; ++j) { t0[4 * n + j] = acc[ai][0][m][n][j] * r; t1[4 * n + j] = acc[ai][1][m][n][j] * r; }
#pragma unroll
                    for (int i = 0; i < 8; ++i) ss += t0[i] * t0[i] + t1[i] * t1[i];
                    ss += __shfl_xor(ss, 16); ss += __shfl_xor(ss, 32);
                    const float hr = rsqrtf(ss * (1.0f / 64.0f) + NORM_EPS);
                    const f32x4* cp = (const f32x4*)(cs + (size_t)s * 32 + 8 * fq);
                    float o0[8], o1[8];
#pragma unroll
                    for (int q = 0; q < 4; ++q) { const f32x4 c4 = cp[q];
                        { const int i = 2 * q; const float a = t0[i] * hr * g0[i], bb = t1[i] * hr * g1[i]; o0[i] = a * c4[0] - bb * c4[1]; o1[i] = bb * c4[0] + a * c4[1]; }
                        { const int i = 2 * q + 1; const float a = t0[i] * hr * g0[i], bb = t1[i] * hr * g1[i]; o0[i] = a * c4[2] - bb * c4[3]; o1[i] = bb * c4[2] + a * c4[3]; } }
                    u32x4 w0, w1;
                    w0.x = cvt_pk(o0[0], o0[1]); w0.y = cvt_pk(o0[2], o0[3]); w0.z = cvt_pk(o0[4], o0[5]); w0.w = cvt_pk(o0[6], o0[7]);
                    w1.x = cvt_pk(o1[0], o1[1]); w1.y = cvt_pk(o1[2], o1[3]); w1.z = cvt_pk(o1[4], o1[5]); w1.w = cvt_pk(o1[6], o1[7]);
                    bf16_t* rp = dst + ((bh * SEQ + s) * 64 + 8 * fq);
                    *(u32x4*)rp = w0; *(u32x4*)(rp + 32) = w1;
                    if (do_km) {
#pragma unroll
                        for (int i = 0; i < 8; ++i) { cs0[i] += o0[i]; cs1[i] += o1[i]; }
                    }
                }
            if (do_km) {
#pragma unroll
                for (int i = 0; i < 8; ++i) {
#pragma unroll
                    for (int o = 1; o <= 8; o <<= 1) { cs0[i] += __shfl_xor(cs0[i], o); cs1[i] += __shfl_xor(cs1[i], o); }
                }
                if (fr == 0) {
                    float* kp = kmp + (((size_t)wr * 64 + bh) * 16 + (u.pm & 15)) * 64 + 8 * fq;
                    *(f32x4*)kp = (f32x4){cs0[0], cs0[1], cs0[2], cs0[3]}; *(f32x4*)(kp + 4) = (f32x4){cs0[4], cs0[5], cs0[6], cs0[7]};
                    *(f32x4*)(kp + 32) = (f32x4){cs1[0], cs1[1], cs1[2], cs1[3]}; *(f32x4*)(kp + 36) = (f32x4){cs1[4], cs1[5], cs1[6], cs1[7]};
                }
            }
        } else if (mode == 1) {
#pragma unroll
            for (int ai = 0; ai < 2; ++ai)
#pragma unroll
                for (int m = 0; m < 4; ++m) {
                    const int s = sbase + ai * 128 + m * 16; const float r = ROW_RS(rowbase + ai * 128 + m * 16);
                    bf16_t* rp = dst + ((bh * SEQ + s) * 64 + 8 * fq);
#pragma unroll
                    for (int bj = 0; bj < 2; ++bj) {
                        const f32x4 v0 = acc[ai][bj][m][0] * r, v1 = acc[ai][bj][m][1] * r;
                        u32x4 w; w.x = cvt_pk(v0[0], v0[1]); w.y = cvt_pk(v0[2], v0[3]); w.z = cvt_pk(v1[0], v1[1]); w.w = cvt_pk(v1[2], v1[3]);
                        *(u32x4*)(rp + 32 * bj) = w;
                    }
                }
        } else {
#pragma unroll
            for (int ai = 0; ai < 2; ++ai)
#pragma unroll
                for (int m = 0; m < 4; ++m) {
                    const int row = rowbase + ai * 128 + m * 16; const float r = ROW_RS(row);
#pragma unroll
                    for (int bj = 0; bj < 2; ++bj) {
                        float sv[8];
#pragma unroll
                        for (int n = 0; n < 2; ++n)
#pragma unroll
                            for (int j = 0; j < 4; ++j) { const float z = acc[ai][bj][m][n][j] * r; sv[4 * n + j] = z / (1.0f + __expf(-z)); }
                        u32x4 w; w.x = cvt_pk(sv[0], sv[1]); w.y = cvt_pk(sv[2], sv[3]); w.z = cvt_pk(sv[4], sv[5]); w.w = cvt_pk(sv[6], sv[7]);
                        *(u32x4*)(zs + (size_t)row * DM + zcol + 32 * bj + 8 * fq) = w;
                    }
                }
        }
    }
};

struct EpiOut {
    static constexpr bool PERM = true, AFTER_DRAIN = false;
    const float* resid; float* out; bf16_t* xb; float* ssq;
    __device__ __forceinline__ void operator()(const f32x4 (&acc)[2][2][4][2], const Unit& u, int wr, int wc, int fr, int fq) const {
        const int col0 = u.pn * 256 + wc * 32 + 8 * fq, rowbase = u.pm * 256 + wr * 64 + fr;
#pragma unroll
        for (int ai = 0; ai < 2; ++ai)
#pragma unroll
            for (int m = 0; m < 4; ++m) {
                const int row = rowbase + ai * 128 + m * 16; const size_t off = (size_t)row * DM + col0;
                float q = 0.f;
#pragma unroll
                for (int bj = 0; bj < 2; ++bj) {
                    const f32x4 r0 = *(const f32x4*)(resid + off + bj * 128), r1 = *(const f32x4*)(resid + off + bj * 128 + 4);
                    const f32x4 o0 = r0 + acc[ai][bj][m][0], o1 = r1 + acc[ai][bj][m][1];
                    *(f32x4*)(out + off + bj * 128) = o0; *(f32x4*)(out + off + bj * 128 + 4) = o1;
                    if (xb) {
                        u32x4 w; w.x = cvt_pk(o0[0], o0[1]); w.y = cvt_pk(o0[2], o0[3]); w.z = cvt_pk(o1[0], o1[1]); w.w = cvt_pk(o1[2], o1[3]);
                        *(u32x4*)(xb + off + bj * 128) = w;
                        q += (o0[0] * o0[0] + o0[1] * o0[1]) + (o0[2] * o0[2] + o0[3] * o0[3]) + (o1[0] * o1[0] + o1[1] * o1[1]) + (o1[2] * o1[2] + o1[3] * o1[3]);
                    }
                }
                if (xb) { q += __shfl_xor(q, 16); q += __shfl_xor(q, 32); if (fq == 0) ssq[(size_t)row * 16 + u.pn * 4 + wc] = q; }
            }
    }
};

#define MFMA32(a, b, c) __builtin_amdgcn_mfma_f32_32x32x16_bf16((a), (b), (c), 0, 0, 0)
constexpr int TROW = 144;
constexpr int TBUF = 2 * 32 * TROW;
struct TileRegs { u32x4 k[4]; u32x4 v[4]; };
struct ASt { f32x16 o0, o1; float m, l; };
struct QT { bf16x8 qf[4]; ASt st; };

DI void qt_init(QT& t, const bf16_t* qrow, int h) {
    const bf16x8* qp = (const bf16x8*)qrow;
#pragma unroll
    for (int ks = 0; ks < 4; ++ks) t.qf[ks] = qp[2 * ks + h];
#pragma unroll
    for (int i = 0; i < 16; ++i) { t.st.o0[i] = 0.f; t.st.o1[i] = 0.f; }
    t.st.m = NEGBIG; t.st.l = 0.f;
}

DI void tile_gload(TileRegs& t, const bf16_t* K, const bf16_t* V, int kbase, int kstride, int lane) {
    const int row0 = lane >> 3, ch = lane & 7;
#pragma unroll
    for (int i = 0; i < 4; ++i) {
        const size_t off = (size_t)(kbase + kstride * (row0 + 8 * i)) * 64 + ch * 8;
        t.k[i] = *(const u32x4*)(K + off); t.v[i] = *(const u32x4*)(V + off);
    }
}
DI void tile_lds_write(LAS unsigned char* buf, const TileRegs& t, int lane) {
    const int row0 = lane >> 3, ch = lane & 7;
#pragma unroll
    for (int i = 0; i < 4; ++i) {
        const int off = (row0 + 8 * i) * TROW + ch * 16;
        *(LAS u32x4*)(buf + off) = t.k[i]; *(LAS u32x4*)(buf + 32 * TROW + off) = t.v[i];
    }
}
DI void load_kfrag(bf16x8 (&kf)[4], LAS unsigned char* buf, int lane) {
    const int r = lane & 31, h = lane >> 5;
#pragma unroll
    for (int ks = 0; ks < 4; ++ks) kf[ks] = *(const LAS bf16x8*)(buf + r * TROW + (2 * ks + h) * 16);
}
DI void load_vfrag(bf16x8 (&vf)[2][2], LAS unsigned char* buf, int lane) {
    const int h = lane >> 5, q = (lane & 15) >> 2, p = lane & 3, blk = (lane >> 4) & 1;
    LAS unsigned char* vb = buf + 32 * TROW + (4 * h + q) * TROW + 32 * blk + 8 * p;
#pragma unroll
    for (int dt = 0; dt < 2; ++dt)
#pragma unroll
        for (int s2 = 0; s2 < 2; ++s2) {
            const s16x4 lo = __builtin_amdgcn_ds_read_tr16_b64_v4i16((LAS s16x4*)(vb + (16 * s2) * TROW + 64 * dt));
            const s16x4 hi4 = __builtin_amdgcn_ds_read_tr16_b64_v4i16((LAS s16x4*)(vb + (16 * s2 + 8) * TROW + 64 * dt));
            vf[dt][s2] = __builtin_shufflevector(lo, hi4, 0, 1, 2, 3, 4, 5, 6, 7);
        }
}
DI void qk_mfma(f32x16& s, const bf16x8 (&kf)[4], const bf16x8 (&qf)[4]) {
#pragma unroll
    for (int i = 0; i < 16; ++i) s[i] = 0.f;
#pragma unroll
    for (int ks = 0; ks < 4; ++ks) s = MFMA32(kf[ks], qf[ks], s);
}
DI void softmax_p(ASt& st, f32x16& s, int dist0, int kstride, int hi, bool lane_ok, bool elem  ) {
    if (elem) {
#pragma unroll
        for (int i = 0; i < 16; ++i) {
            const unsigned dist = (unsigned)(dist0 - kstride * ((i & 3) + 8 * (i >> 2)));
            s[i] = (dist <= (unsigned)hi) ? s[i] : NEGBIG;
        }
    }
    float tmax = fmaxf(fmaxf(fmaxf(s[0], s[1]), fmaxf(s[2], s[3])), fmaxf(fmaxf(s[4], s[5]), fmaxf(s[6], s[7])));
    tmax = fmaxf(tmax, fmaxf(fmaxf(fmaxf(s[8], s[9]), fmaxf(s[10], s[11])), fmaxf(fmaxf(s[12], s[13]), fmaxf(s[14], s[15]))));
    tmax = lane_ok ? tmax : NEGBIG;
    tmax = fmaxf(tmax, __shfl_xor(tmax, 32));
    const float tms = tmax * SC_LOG2;
    const bool need = tms > st.m + 8.0f;
    const float mnew = need ? tms : st.m;
    if (__builtin_amdgcn_ballot_w64(need) != 0ull) {
        const float alpha = __builtin_amdgcn_exp2f(st.m - mnew);
        st.l *= alpha;
#pragma unroll
        for (int i = 0; i < 16; ++i) { st.o0[i] *= alpha; st.o1[i] *= alpha; }
    }
    st.m = mnew;
    const float msub = lane_ok ? ((mnew < -1e29f) ? 0.f : mnew) : 1e30f;
    float ps0 = 0.f, ps1 = 0.f;
#pragma unroll
    for (int i = 0; i < 16; i += 2) {
        s[i] = __builtin_amdgcn_exp2f(__builtin_fmaf(s[i], SC_LOG2, -msub)); s[i + 1] = __builtin_amdgcn_exp2f(__builtin_fmaf(s[i + 1], SC_LOG2, -msub));
        ps0 += s[i]; ps1 += s[i + 1];
    }
    st.l += ps0 + ps1;
}
DI void pv_mfma(ASt& st, const f32x16& s, const bf16x8 (&vf)[2][2]) {
#pragma unroll
    for (int s2 = 0; s2 < 2; ++s2) {
        u32x4 p;
        p.x = cvt_pk(s[8 * s2 + 0], s[8 * s2 + 1]); p.y = cvt_pk(s[8 * s2 + 2], s[8 * s2 + 3]);
        p.z = cvt_pk(s[8 * s2 + 4], s[8 * s2 + 5]); p.w = cvt_pk(s[8 * s2 + 6], s[8 * s2 + 7]);
        const bf16x8 pb = __builtin_bit_cast(bf16x8, p);
        st.o0 = MFMA32(vf[0][s2], pb, st.o0);
        st.o1 = MFMA32(vf[1][s2], pb, st.o1);
    }
}
DI void pack_p(bf16x8 (&pb)[2], const f32x16& s) {
#pragma unroll
    for (int s2 = 0; s2 < 2; ++s2) {
        u32x4 p;
        p.x = cvt_pk(s[8 * s2 + 0], s[8 * s2 + 1]); p.y = cvt_pk(s[8 * s2 + 2], s[8 * s2 + 3]);
        p.z = cvt_pk(s[8 * s2 + 4], s[8 * s2 + 5]); p.w = cvt_pk(s[8 * s2 + 6], s[8 * s2 + 7]);
        pb[s2] = __builtin_bit_cast(bf16x8, p);
    }
}
DI bf16x8 load_vfrag1(LAS unsigned char* vb, int dt, int s2) {
    const s16x4 lo = __builtin_amdgcn_ds_read_tr16_b64_v4i16((LAS s16x4*)(vb + (16 * s2) * TROW + 64 * dt));
    const s16x4 hi4 = __builtin_amdgcn_ds_read_tr16_b64_v4i16((LAS s16x4*)(vb + (16 * s2 + 8) * TROW + 64 * dt));
    return __builtin_shufflevector(lo, hi4, 0, 1, 2, 3, 4, 5, 6, 7);
}
DI void core2(QT& a, QT& b, LAS unsigned char* buf, int dist0a, int dist0b, int kstride, int hi, bool elem, bool oka, bool okb, int lane) {
    const int r = lane & 31, h = lane >> 5;
    f32x16 sa, sb;
    {
        const f32x16 zero = {0.f, 0.f, 0.f, 0.f, 0.f, 0.f, 0.f, 0.f, 0.f, 0.f, 0.f, 0.f, 0.f, 0.f, 0.f, 0.f};
        const bf16x8 kf = *(const LAS bf16x8*)(buf + r * TROW + h * 16); sa = MFMA32(kf, a.qf[0], zero); sb = MFMA32(kf, b.qf[0], zero);
    }
#pragma unroll
    for (int ks = 1; ks < 4; ++ks) { const bf16x8 kf = *(const LAS bf16x8*)(buf + r * TROW + (2 * ks + h) * 16); sa = MFMA32(kf, a.qf[ks], sa); sb = MFMA32(kf, b.qf[ks], sb); }
    LAS unsigned char* vb = buf + 32 * TROW + (4 * h + ((lane & 15) >> 2)) * TROW + 32 * ((lane >> 4) & 1) + 8 * (lane & 3);
    softmax_p(a.st, sa, dist0a, kstride, hi, oka, elem);
    {
        bf16x8 pa[2]; pack_p(pa, sa);
#pragma unroll
        for (int s2 = 0; s2 < 2; ++s2) {
            const bf16x8 v0 = load_vfrag1(vb, 0, s2), v1 = load_vfrag1(vb, 1, s2);
            a.st.o0 = MFMA32(v0, pa[s2], a.st.o0); a.st.o1 = MFMA32(v1, pa[s2], a.st.o1);
        }
    }
    softmax_p(b.st, sb, dist0b, kstride, hi, okb, elem);
    {
        bf16x8 pb[2]; pack_p(pb, sb);
#pragma unroll
        for (int s2 = 0; s2 < 2; ++s2) {
            const bf16x8 v0 = load_vfrag1(vb, 0, s2), v1 = load_vfrag1(vb, 1, s2);
            b.st.o0 = MFMA32(v0, pb[s2], b.st.o0); b.st.o1 = MFMA32(v1, pb[s2], b.st.o1);
        }
    }
}
DI bool band_all_ok(int dist0, int kstride, int hi, int h) {
    const int d_first = dist0 + kstride * 4 * h, d_last = d_first - 31 * kstride;
    return (d_last >= 0) && (d_first <= hi);
}
DI void band2(QT& a, QT& b, LAS unsigned char* buf, int dist0a, int dist0b, int kstride, int hi, int who, int lane) {
    const bool oka = who != 1, okb = who != 0;
    const bool allok = (!oka || band_all_ok(dist0a, kstride, hi, lane >> 5)) && (!okb || band_all_ok(dist0b, kstride, hi, lane >> 5));
    const bool elem = __builtin_amdgcn_ballot_w64(!allok) != 0ull;
    core2(a, b, buf, dist0a, dist0b, kstride, hi, elem, oka, okb, lane);
}

DI void attn_finish(ASt& st, float sink_l2, const bf16_t* zs, bf16_t* y, size_t rowoff  , int h) {
    float l = st.l + __shfl_xor(st.l, 32);
    const float mf = fmaxf(st.m, sink_l2);
    const float a = __builtin_amdgcn_exp2f(st.m - mf);
    l = l * a + ((sink_l2 > -1e29f) ? __builtin_amdgcn_exp2f(sink_l2 - mf) : 0.f);
    const float inv = a / l;
#pragma unroll
    for (int dt = 0; dt < 2; ++dt)
#pragma unroll
        for (int g = 0; g < 4; ++g) {
            const size_t off = rowoff + 32 * dt + 8 * g + 4 * h;
            const u32x2 z = *(const u32x2*)(zs + off);
            const float v0 = (dt ? st.o1[4 * g + 0] : st.o0[4 * g + 0]) * inv * bf_lo(z.x);
            const float v1 = (dt ? st.o1[4 * g + 1] : st.o0[4 * g + 1]) * inv * bf_hi(z.x);
            const float v2 = (dt ? st.o1[4 * g + 2] : st.o0[4 * g + 2]) * inv * bf_lo(z.y);
            const float v3 = (dt ? st.o1[4 * g + 3] : st.o0[4 * g + 3]) * inv * bf_hi(z.y);
            u32x2 w; w.x = cvt_pk(v0, v1); w.y = cvt_pk(v2, v3);
            *(u32x2*)(y + off) = w;
        }
}

DI bool a_tile_desc(int tau, int ra, int i0, int& kbase, int& kstride, int& hi, int& who) {
    if (tau < 10) { const int t = (tau < 5) ? tau : tau - 5; const int jb = i0 - 128 + 32 * t; who = (tau < 5) ? 0 : 1; kbase = ra + 8 * who + 16 * jb; kstride = 16; hi = 2048; return jb >= 0; }
    who = 2;
    if (tau < 18) { const int ub = 4 * i0 - 128 + 32 * (tau - 10); kbase = (ra & 3) + 4 * ub; kstride = 4; hi = 512; return ub >= 0; }
    { const int kb = 16 * i0 - 128 + 32 * (tau - 18); kbase = kb; kstride = 1; hi = 128; return kb >= 0; }
}
DI int a_next(int tau, int ra, int i0) { int t = tau + 1, kb, ks, hi, who; while (t < 38 && !a_tile_desc(t, ra, i0, kb, ks, hi, who)) ++t; return t; }
DI void attn_a_item(unsigned char* ws, LAS unsigned char* buf, int bh, int ra, int i0, int lane) {
    const int r = lane & 31, h = lane >> 5;
    const bf16_t* Q = (const bf16_t*)(ws + WS_QA) + (size_t)bh * SEQ * 64;
    const bf16_t* K = (const bf16_t*)(ws + WS_KA) + (size_t)bh * SEQ * 64;
    const bf16_t* V = (const bf16_t*)(ws + WS_VTA) + (size_t)bh * SEQ * 64;
    const int qpa = ra + 16 * (i0 + r), qpb = qpa + 8;
    QT a, b; qt_init(a, Q + (size_t)qpa * 64, h); qt_init(b, Q + (size_t)qpb * 64, h);
    TileRegs tr;
    int tc = a_next(-1, ra, i0);
    { int kb, ks, hi, who; (void)a_tile_desc(tc, ra, i0, kb, ks, hi, who); tile_gload(tr, K, V, kb, ks, lane); }
    for (;;) {
        tile_lds_write(buf, tr, lane);
        const int tn = a_next(tc, ra, i0);
        if (tn < 38) { int kb, ks, hi, who; (void)a_tile_desc(tn, ra, i0, kb, ks, hi, who); tile_gload(tr, K, V, kb, ks, lane); }
        {
            int kb, ks, hi, who; (void)a_tile_desc(tc, ra, i0, kb, ks, hi, who);
            const int d0a = qpa - kb - ks * 4 * h, d0b = qpb - kb - ks * 4 * h;
            band2(a, b, buf, d0a, d0b, ks, hi, who, lane);
        }
        if (tn >= 38) break;
        tc = tn;
    }
    const int bb = bh >> 3, head = bh & 7;
    attn_finish(a.st, NEGBIG, (const bf16_t*)(ws + WS_ZS), (bf16_t*)(ws + WS_Y), ((size_t)bb * SEQ + qpa) * DM + head * 64, h);
    attn_finish(b.st, NEGBIG, (const bf16_t*)(ws + WS_ZS), (bf16_t*)(ws + WS_Y), ((size_t)bb * SEQ + qpb) * DM + head * 64, h);
}

DI unsigned moba_select(const bf16x8 (&qf)[4], LAS float* km, int qblk, int h) {
    float v1 = -3e38f, v2 = -3e38f, v3 = -3e38f; int i1 = 31, i2 = 31, i3 = 31;
    for (int n = 0; n < qblk; ++n) {
        float g = 0.f;
#pragma unroll
        for (int ks = 0; ks < 4; ++ks) {
            const LAS f32x4* kp = (const LAS f32x4*)(km + n * 64 + 16 * ks + 8 * h);
            const f32x4 x = kp[0], y = kp[1];
            const u32x4 qu = __builtin_bit_cast(u32x4, qf[ks]);
            g += bf_lo(qu.x) * x[0] + bf_hi(qu.x) * x[1] + bf_lo(qu.y) * x[2] + bf_hi(qu.y) * x[3]
               + bf_lo(qu.z) * y[0] + bf_hi(qu.z) * y[1] + bf_lo(qu.w) * y[2] + bf_hi(qu.w) * y[3];
        }
        g += __shfl_xor(g, 32);
        if (g > v1) { v3 = v2; i3 = i2; v2 = v1; i2 = i1; v1 = g; i1 = n; }
        else if (g > v2) { v3 = v2; i3 = i2; v2 = g; i2 = n; }
        else if (g > v3) { v3 = g; i3 = n; }
    }
    unsigned sel = 0u;
    if (i1 < 16) sel |= 1u << i1;
    if (i2 < 16) sel |= 1u << i2;
    if (i3 < 16) sel |= 1u << i3;
    return sel;
}
DI void attn_b_item(unsigned char* ws, LAS unsigned char* buf, LAS float* km  , int bh, int qblk, int w4, int lane) {
    const int r = lane & 31, h = lane >> 5;
    const bf16_t* Q = (const bf16_t*)(ws + WS_QB) + (size_t)bh * SEQ * 64;
    const bf16_t* K = (const bf16_t*)(ws + WS_KB) + (size_t)bh * SEQ * 64;
    const bf16_t* V = (const bf16_t*)(ws + WS_VTB) + (size_t)bh * SEQ * 64;
    const int qpa = qblk * 256 + w4 * 64 + r, qpb = qpa + 32;
    QT a, b; qt_init(a, Q + (size_t)qpa * 64, h); qt_init(b, Q + (size_t)qpb * 64, h);
    const unsigned sela = moba_select(a.qf, km, qblk, h), selb = moba_select(b.qf, km, qblk, h);
    unsigned uni = 0u;
    for (int n = 0; n < qblk; ++n) { if (__builtin_amdgcn_ballot_w64(((sela | selb) >> n) & 1u) != 0ull) uni |= 1u << n; }
    uni |= 1u << qblk;
    const int own_tiles = 2 * w4 + 2;
    TileRegs tr;
#define B_ADV(n_, T_, ok_) do { const int cnt_ = ((n_) == qblk) ? own_tiles : 8; if (++(T_) >= cnt_) { const unsigned rest_ = uni & ~((2u << (n_)) - 1u); if (rest_) { (n_) = __builtin_ctz(rest_); (T_) = 0; } else (ok_) = false; } } while (0)
    int nc = __builtin_ctz(uni), Tc = 0; bool okc = true;
    tile_gload(tr, K, V, nc * 256, 1, lane);
    for (;;) {
        tile_lds_write(buf, tr, lane);
        int nl = nc, Tl = Tc; bool okl = true; B_ADV(nl, Tl, okl);
        if (okl) tile_gload(tr, K, V, nl * 256 + 32 * Tl, 1, lane);
        {
            const int kb = nc * 256 + 32 * Tc;
            const bool own = (nc == qblk);
            const bool oka = own ? (Tc <= 2 * w4) : (((sela >> nc) & 1u) != 0u), okb = own ? true : (((selb >> nc) & 1u) != 0u);
            core2(a, b, buf, qpa - kb - 4 * h, qpb - kb - 4 * h, 1, 0x7fffffff, own && (Tc >= 2 * w4), oka, okb, lane);
        }
        if (!okl) break;
        nc = nl; Tc = Tl;
    }
#undef B_ADV
    const int bb = bh >> 3, head = 8 + (bh & 7);
    attn_finish(a.st, NEGBIG, (const bf16_t*)(ws + WS_ZS), (bf16_t*)(ws + WS_Y), ((size_t)bb * SEQ + qpa) * DM + head * 64, h);
    attn_finish(b.st, NEGBIG, (const bf16_t*)(ws + WS_ZS), (bf16_t*)(ws + WS_Y), ((size_t)bb * SEQ + qpb) * DM + head * 64, h);
}

DI void attn_c_item(unsigned char* ws, LAS unsigned char* buf, int b, int hq, int chunk, int wid, int lane) {
    const int r = lane & 31, h = lane >> 5, kvh = hq >> 3;
    const bf16_t* Qa = (const bf16_t*)(ws + WS_QC) + ((size_t)b * 16 + hq) * SEQ * 64;
    const bf16_t* K = (const bf16_t*)(ws + WS_KC) + ((size_t)b * 2 + kvh) * SEQ * 64;
    const bf16_t* V = (const bf16_t*)(ws + WS_VTC) + ((size_t)b * 2 + kvh) * SEQ * 64;
    const int t0 = chunk * 256 + wid * 32, qpos = t0 + r;
    QT qa, qb; qt_init(qa, Qa + (size_t)qpos * 64, h); qt_init(qb, Qa + (size_t)SEQ * 64 + (size_t)qpos * 64, h);
    TileRegs tr;
    int T = (t0 >= 128) ? 0 : (128 - t0) / 32;
    tile_gload(tr, K, V, t0 - 128 + 32 * T, 1, lane);
    for (;;) {
        tile_lds_write(buf, tr, lane);
        const bool have = (T + 1) < 5;
        if (have) tile_gload(tr, K, V, t0 - 128 + 32 * (T + 1), 1, lane);
        const int d0 = qpos - (t0 - 128 + 32 * T) - 4 * h;
        band2(qa, qb, buf, d0, d0, 1, 127, 2, lane);
        if (!have) break;
        ++T;
    }
    const float* sinks = (const float*)(ws + WS_GAINS) + 384;
    const size_t rowoff = ((size_t)b * SEQ + qpos) * DM + hq * 64;
    attn_finish(qa.st, sinks[hq] * 1.44269504088896341f, (const bf16_t*)(ws + WS_ZS1), (bf16_t*)(ws + WS_Y), rowoff, h);
    attn_finish(qb.st, sinks[hq + 1] * 1.44269504088896341f, (const bf16_t*)(ws + WS_ZS1), (bf16_t*)(ws + WS_Y), rowoff + 64, h);
}

#define XB_TMO      128
#define XB_XCNT(j)  (256  + 64 * (j))
#define XB_XSUB(j)  (1280 + 64 * (j))
#define XB_XGEN(j)  (2304 + 64 * (j))
#define XB_TOP      3328
#define XB_TOPGEN   3392
#define XCD_BAR_WORDS 3456
#define XB_SPIN_CAP (1u << 18)

__device__ __forceinline__ unsigned xb_ld(unsigned* p)              { return __hip_atomic_load(p, __ATOMIC_RELAXED, __HIP_MEMORY_SCOPE_AGENT); }
__device__ __forceinline__ unsigned xb_add(unsigned* p, unsigned v) { return __hip_atomic_fetch_add(p, v, __ATOMIC_RELAXED, __HIP_MEMORY_SCOPE_AGENT); }
__device__ __forceinline__ unsigned xb_xcc_id() { return (unsigned)__builtin_amdgcn_s_getreg((3 << 11) | 20) & 0xFu; }
#define XB_SPIN(cond, bar) do { unsigned _sp = 0; while (cond) { __builtin_amdgcn_s_sleep(1); \
    if ((++_sp & 255u) == 0u) { if (xb_ld(&(bar)[XB_TMO])) break; if (_sp > XB_SPIN_CAP) { atomicAdd(&(bar)[XB_TMO], 1u); break; } } } } while (0)

struct XcdBarrier {
    unsigned* bar; unsigned x;
    volatile LAS unsigned* st;
};

__device__ __forceinline__ XcdBarrier xcd_barrier_post(unsigned* bar, volatile LAS unsigned* st) {
    XcdBarrier b; b.bar = bar; b.x = xb_xcc_id(); b.st = st;
    if (threadIdx.x == 0) (void)xb_add(&bar[XB_XCNT(b.x)], 1u);
    return b;
}
__device__ __forceinline__ void xcd_barrier_complete(unsigned* bar, unsigned x, unsigned& nloc, unsigned& nx) {
    const unsigned G = gridDim.x * gridDim.y * gridDim.z;
    unsigned sum, cnt, mine, sp = 0u;
    for (;;) {
        sum = 0u; cnt = 0u; mine = 0u;
#pragma unroll
        for (unsigned j = 0; j < 16; ++j) { const unsigned c = xb_ld(&bar[XB_XCNT(j)]); sum += c; cnt += (c > 0u) ? 1u : 0u; mine = (j == x) ? c : mine; }
        if (sum == G) break;
        __builtin_amdgcn_s_sleep(1);
        if ((++sp & 255u) == 0u) { if (xb_ld(&bar[XB_TMO])) break; if (sp > XB_SPIN_CAP) { atomicAdd(&bar[XB_TMO], 1u); break; } }
    }
    nloc = mine > 0u ? mine : 1u; nx = cnt > 0u ? cnt : 1u;
}

__device__ __forceinline__ void xcd_barrier(const XcdBarrier& b) {
    asm volatile("s_waitcnt vmcnt(0)" ::: "memory");
    __syncthreads();
    if (threadIdx.x == 0) {
        unsigned* bar = b.bar;
        __builtin_amdgcn_s_waitcnt(0);
        unsigned nloc = b.st[0], nx = b.st[1];
        if (nloc == 0u) { xcd_barrier_complete(bar, b.x, nloc, nx); b.st[0] = nloc; b.st[1] = nx; }
        const unsigned old = xb_add(&bar[XB_XSUB(b.x)], 1u);
        const unsigned gen = old / nloc;
        if (old + 1u == (gen + 1u) * nloc) {
            __builtin_amdgcn_fence(__ATOMIC_RELEASE, "agent");
            asm volatile("s_waitcnt vmcnt(0)" ::: "memory");
            const unsigned og = xb_add(&bar[XB_TOP], 1u);
            const unsigned tg = og / nx;
            if (og + 1u == (tg + 1u) * nx) xb_add(&bar[XB_TOPGEN], 1u);
            else XB_SPIN(xb_ld(&bar[XB_TOPGEN]) == tg, bar);
            __builtin_amdgcn_fence(__ATOMIC_ACQUIRE, "agent");
            xb_add(&bar[XB_XGEN(b.x)], 1u);
            asm volatile("s_waitcnt vmcnt(0)" ::: "memory");
        } else {
            XB_SPIN(xb_ld(&bar[XB_XGEN(b.x)]) == gen, bar);
            __builtin_amdgcn_fence(__ATOMIC_ACQUIRE, "agent");
            asm volatile("s_waitcnt vmcnt(0)" ::: "memory");
        }
    }
    __syncthreads();
}


__global__ void __launch_bounds__(NTHREADS) fwd_megakernel(Params P) {
    extern __shared__ __attribute__((aligned(16))) unsigned char lds_raw[];
    cg::grid_group grid = cg::this_grid();
    LAS unsigned char* lds = (LAS unsigned char*)lds_raw;
    unsigned char* ws = P.ws;
    const int G = gridDim.x, bid = blockIdx.x;
    volatile LAS unsigned* xb_st = (volatile LAS unsigned*)(lds + LDS_BYTES - 16);
    if (threadIdx.x == 0) { xb_st[0] = 0u; xb_st[1] = 0u; }
    __syncthreads();
    const XcdBarrier xbar = xcd_barrier_post((unsigned*)(ws + WS_BAR), xb_st);
#define PHASE_IDS() int tid_l = threadIdx.x; asm volatile("" : "+v"(tid_l)); const int tid = tid_l, lane = tid & 63, wid = __builtin_amdgcn_readfirstlane(tid >> 6); (void)lane; (void)wid

    if constexpr (PH_MASK & 1) { for (int rep = 0; rep < NREP(0); ++rep) p0_prologue(P, lds); }
    grid.sync();

    if constexpr ((PH_MASK & 2) != 0) {
        pg8::Gemm g{(const bf16_t*)(ws + WS_XB), (const bf16_t*)(ws + WS_BT0), NTOK, N_IN0, DM};
        pg8::StaticOrder S; S.init(NTOK, N_IN0, G, bid);
        EpiIn E{0, ws};
        for (int rep = 0; rep < NREP(1); ++rep) pg8::gemm_phase<EpiIn, pg8::StaticOrder, true, true>(lds, g, S, E);
    }
    xcd_barrier(xbar);

    if constexpr ((PH_MASK & 4) != 0) {
        PHASE_IDS();
        LAS float* km = (LAS float*)(lds + 8 * TBUF);
        LAS unsigned char* buf = lds + wid * TBUF;
        const float* kmp = (const float*)(ws + WS_KMP);
#define P2_DECODE(it_) const int itt = (it_) & 511, j = itt >> 8, c = itt & 255, xcd = c & 7, slot = c >> 3, idx = j * 32 + slot;   \
                       const int bh = xcd * 8 + (idx >> 3), sub = idx & 7; (void)j
#define P2_STAGE_KM(tab_, bh_) do { for (int e = tid; e < 1024; e += NTHREADS) km[(tab_) * 1024 + e] = kmp[(size_t)(bh_) * 1024 + e] + kmp[(size_t)(64 + (bh_)) * 1024 + e]; } while (0)
        for (int rep = 0; rep < 2; ++rep) {
            if (rep == 0 || NREP(2) == 2) {
                __syncthreads();
                { int k = 0; for (int it = bid; it < 512 && k < 2; it += G, ++k) { P2_DECODE(it); (void)sub; P2_STAGE_KM(k, bh); } }
                __syncthreads();
                int k = 0;
                for (int it = bid; it < 512; it += G, ++k) {
                    P2_DECODE(it);
                    if (k >= 2) { __syncthreads(); P2_STAGE_KM(k & 1, bh); __syncthreads(); }
                    const bool lo = (wid < 4) != ((k & 1) != 0);
                    attn_b_item(ws, buf, km + (k & 1) * 1024, bh, lo ? sub : 15 - sub, wid & 3, lane);
                }
            }
            if (rep == 0 || NREP(7) == 2) {
                for (int it = 512 + bid; it < 1024; it += G) { P2_DECODE(it); attn_a_item(ws, buf, bh, wid, sub * 32, lane); }
            }
        }
#undef P2_DECODE
#undef P2_STAGE_KM
    }
    xcd_barrier(xbar);

    if constexpr ((PH_MASK & 8) != 0) {
        pg8::Gemm g{(const bf16_t*)(ws + WS_Y), (const bf16_t*)(ws + WS_BT1), NTOK, DM, DM};
        pg8::StaticOrder S; S.init(NTOK, DM, G, bid);
        EpiOut E{P.x, (float*)(ws + WS_X1), (bf16_t*)(ws + WS_X1B), (float*)(ws + WS_SSQ)};
        for (int rep = 0; rep < NREP(3); ++rep) pg8::gemm_phase<EpiOut, pg8::StaticOrder, true, true>(lds, g, S, E);
    }
    xcd_barrier(xbar);

    if constexpr ((PH_MASK & 16) != 0) {
        pg8::Gemm g{(const bf16_t*)(ws + WS_X1B), (const bf16_t*)(ws + WS_BT2), NTOK, N_IN1, DM};
        pg8::StaticOrder S; S.init(NTOK, N_IN1, G, bid);
        EpiIn E{1, ws};
        for (int rep = 0; rep < NREP(4); ++rep) pg8::gemm_phase<EpiIn, pg8::StaticOrder, true, true>(lds, g, S, E);
    }
    xcd_barrier(xbar);

    if constexpr ((PH_MASK & 32) != 0) {
        PHASE_IDS();
        for (int rep = 0; rep < NREP(5); ++rep)
        for (int it = bid; it < 1024; it += G) {
            const int j = it >> 8, c = it & 255, xcd = c & 7, slot = c >> 3, idx = j * 32 + slot;
            const int bkv = xcd * 2 + (idx >> 6), rem = idx & 63, hq = (bkv & 1) * 8 + 2 * (rem >> 4), chunk = rem & 15;
            attn_c_item(ws, lds + wid * TBUF, bkv >> 1, hq, chunk, wid, lane);
        }
    }
    xcd_barrier(xbar);

    if constexpr ((PH_MASK & 64) != 0) {
        pg8::Gemm g{(const bf16_t*)(ws + WS_Y), (const bf16_t*)(ws + WS_BT3), NTOK, DM, DM};
        pg8::StaticOrder S; S.init(NTOK, DM, G, bid);
        EpiOut E{(const float*)(ws + WS_X1), P.out, nullptr, nullptr};
        for (int rep = 0; rep < NREP(6); ++rep) pg8::gemm_phase<EpiOut, pg8::StaticOrder, true, true>(lds, g, S, E);
    }
}

extern "C" void kernel_launch(void* const* d_in, const int* in_sizes, int n_in, void* d_out, int out_size, void* d_ws, size_t ws_size, hipStream_t stream) {
    static int grid_blocks = 0;
    if (grid_blocks == 0) {
        if (n_in != 14 || in_sizes[0] != NTOK * DM || out_size != NTOK * DM || ws_size < WS_END) {
            fprintf(stderr, "kernel_launch: unexpected shapes (n_in %d in0 %d out %d ws %zu)\n", n_in, n_in > 0 ? in_sizes[0] : -1, out_size, ws_size); grid_blocks = -1; return; }
        int dev = 0, cus = 0, per_cu = 0;
        hipGetDevice(&dev);
        hipDeviceGetAttribute(&cus, hipDeviceAttributeMultiprocessorCount, dev);
        if (hipFuncSetAttribute((const void*)fwd_megakernel, hipFuncAttributeMaxDynamicSharedMemorySize, LDS_BYTES) != hipSuccess) {
            fprintf(stderr, "kernel_launch: hipFuncSetAttribute failed\n"); grid_blocks = -1; return; }
        if (hipOccupancyMaxActiveBlocksPerMultiprocessor(&per_cu, (const void*)fwd_megakernel, NTHREADS, LDS_BYTES) != hipSuccess || per_cu < 1) {
            fprintf(stderr, "kernel_launch: occupancy query gave %d\n", per_cu); per_cu = 1; (void)hipGetLastError(); }
        grid_blocks = cus * 1;
        if (per_cu < 1) grid_blocks = -1;
    }
    if (grid_blocks < 0) return;
    Params p{};
    p.x = (const float*)d_in[0]; p.norm_even = (const float*)d_in[1]; p.w_in_even = (const float*)d_in[2]; p.w_out_even = (const float*)d_in[3];
    p.qn_a = (const float*)d_in[4]; p.kn_a = (const float*)d_in[5]; p.qn_b = (const float*)d_in[6]; p.kn_b = (const float*)d_in[7];
    p.norm_odd = (const float*)d_in[8]; p.w_in_odd = (const float*)d_in[9]; p.w_out_odd = (const float*)d_in[10];
    p.qn_c = (const float*)d_in[11]; p.kn_c = (const float*)d_in[12]; p.sinks = (const float*)d_in[13];
    p.out = (float*)d_out; p.ws = (unsigned char*)d_ws;
    if (hipMemsetAsync((unsigned char*)d_ws + WS_BAR, 0, XCD_BAR_WORDS * 4, stream) != hipSuccess) { fprintf(stderr, "kernel_launch: memset failed\n"); return; }
    void* args[] = {&p};
    hipError_t e = hipLaunchCooperativeKernel((const void*)fwd_megakernel, dim3(grid_blocks), dim3(NTHREADS), args, LDS_BYTES, stream);
    if (e != hipSuccess) fprintf(stderr, "cooperative launch failed: %s (grid %d)\n", hipGetErrorString(e), grid_blocks);
}
```

```cpp
#include <hip/hip_runtime.h>
#include <hip/hip_cooperative_groups.h>
#include <cstdio>
#include <cstdint>
namespace cg = cooperative_groups;
namespace pg8 {
#define PG8_LAS __attribute__((address_space(3)))
typedef unsigned short bf16_t;
typedef short bf16x8 __attribute__((ext_vector_type(8)));
typedef float f32x4 __attribute__((ext_vector_type(4)));
typedef unsigned u32x4 __attribute__((ext_vector_type(4)));
constexpr int BM = 256, BK = 64, HALF = 128, HTB = HALF * BK * 2  , STAGE_BYTES = 8 * HTB, NXCD = 8, WGM = 8;

__host__ __device__ __forceinline__ int lds_byte(int r, int c) { const int st = (r >> 4) * 2 + (c >> 5), rr = r & 15, cc = c & 31, ob = rr * 64 + cc * 2; return st * 1024 + (ob ^ (((ob >> 9) & 1) << 5)); }
__host__ __device__ __forceinline__ void stage_rc(int b, int& R, int& C) { const int st = b / 1024, sb = b % 1024, swz = sb ^ (((sb >> 9) & 1) << 5); R = (st >> 1) * 16 + swz / 64; C = (st & 1) * 32 + (swz % 64) / 2; }
__host__ __device__ __forceinline__ int perm32(int rho) { const int n = rho >> 4, i = rho & 15; return 8 * (i >> 2) + 4 * n + (i & 3); }

struct Unit { int pm, pn; };
struct Gemm { const bf16_t* A; const bf16_t* Bt; int M, N, K; };

struct StaticOrder {
    int nM, nN, nwg, G, c;
    __host__ __device__ void init(int M, int N, int G_, int c_) { nM = M / BM; nN = N / BM; nwg = nM * nN; G = G_; c = c_; }
    __host__ __device__ bool next(int i, Unit& u) const {
        const long L = (long)i * G + c; if (L >= nwg) return false;
        int wgid = (int)L; { const int q = nwg / NXCD, r = nwg % NXCD, xcd = wgid % NXCD, off = wgid / NXCD; wgid = (xcd < r ? xcd * (q + 1) : r * (q + 1) + (xcd - r) * q) + off; }
        const int nig = WGM * nN, gid = wgid / nig, fm = gid * WGM, gsz = (nM - fm) < WGM ? (nM - fm) : WGM;
        u.pm = fm + ((wgid % nig) % gsz); u.pn = (wgid % nig) / gsz; return true;
    }
    __device__ __forceinline__ void a_ready(const Unit&) const {}
    __device__ __forceinline__ void done(const Unit&) const {}
};

template <class Epi, class Sched, bool ALIGN_EPI = false, bool SP2 = false>
__device__ __forceinline__ void gemm_phase(PG8_LAS unsigned char* lds, const Gemm g, const Sched& S, const Epi& E) {
    int tid_l = threadIdx.x; asm volatile("" : "+v"(tid_l));
    const int tid = tid_l, wid = __builtin_amdgcn_readfirstlane(tid >> 6), lane = tid & 63, wr = wid >> 2, wc = wid & 3, fr = lane & 15, fq = lane >> 4;
    const int K = g.K, nt = K / BK;
    unsigned voffA[2], voffB[2];
#pragma unroll
    for (int i = 0; i < 2; ++i) { int R, C; stage_rc(tid * 16 + i * 8192, R, C); const int Rb = Epi::PERM ? ((R & ~31) + perm32(R & 31)) : R;
        voffA[i] = (unsigned)(R * K + C) * 2u; voffB[i] = (unsigned)(Rb * K + C) * 2u; }
    const size_t kstep = (size_t)(BK * 2);
    const size_t hstep = (size_t)HALF * K * 2;
    const size_t tstep = 2 * hstep;
    const unsigned ldsw = (unsigned)wid * 1024u;
    const int aoff = lds_byte(wr * 64 + fr, fq * 8), boff = lds_byte(wc * 32 + fr, fq * 8);
#define PG8_SA(b, h) (((b) * 2 + (h)) * HTB)
#define PG8_SB(b, h) ((4 + (b) * 2 + (h)) * HTB)
#define PG8_STAGE(bufoff, gbase, voff) do { _Pragma("unroll") for (int _i = 0; _i < 2; ++_i) \
        __builtin_amdgcn_global_load_lds((const unsigned*)((const char*)(gbase) + (voff)[_i]), (PG8_LAS unsigned*)(lds + (bufoff) + ldsw + _i * 8192), 16, 0, 0); } while (0)
#define PG8_LDA(dst, b, h) do { _Pragma("unroll") for (int m = 0; m < 4; ++m) _Pragma("unroll") for (int k = 0; k < 2; ++k) dst[m][k] = *(const PG8_LAS bf16x8*)(lds + PG8_SA(b, h) + aoff + m * 2048 + k * 1024); } while (0)
#define PG8_LDB(dst, b, h) do { _Pragma("unroll") for (int n = 0; n < 2; ++n) _Pragma("unroll") for (int k = 0; k < 2; ++k) dst[n][k] = *(const PG8_LAS bf16x8*)(lds + PG8_SB(b, h) + boff + n * 2048 + k * 1024); } while (0)
#define PG8_MMA(ai, bj, At, Bt) do { __builtin_amdgcn_s_setprio(1); _Pragma("unroll") for (int m = 0; m < 4; ++m) _Pragma("unroll") for (int n = 0; n < 2; ++n) _Pragma("unroll") for (int k = 0; k < 2; ++k) \
        acc[ai][bj][m][n] = __builtin_amdgcn_mfma_f32_16x16x32_bf16(Bt[n][k], At[m][k], acc[ai][bj][m][n], 0, 0, 0); __builtin_amdgcn_s_setprio(0); } while (0)
#define PG8_WAIT_V(n) asm volatile("s_waitcnt vmcnt(" #n ")" ::: "memory")
#define PG8_WAIT_L(n) asm volatile("s_waitcnt lgkmcnt(" #n ")" ::: "memory")
#define PG8_BAR __builtin_amdgcn_s_barrier()
#define PG8_SCHED __builtin_amdgcn_sched_barrier(0)
    Unit cur, nxt; int ui = 0;
    if (!S.next(0, cur)) return;
    f32x4 acc[2][2][4][2];
#pragma unroll
    for (int a = 0; a < 2; ++a)
#pragma unroll
        for (int b = 0; b < 2; ++b)
#pragma unroll
            for (int m = 0; m < 4; ++m)
#pragma unroll
                for (int n = 0; n < 2; ++n) acc[a][b][m][n] = (f32x4){0.f, 0.f, 0.f, 0.f};
    bf16x8 At[4][2], B0[2][2], B1[2][2];
    const char* cA = (const char*)g.A + (size_t)cur.pm * tstep; const char* cB = (const char*)g.Bt + (size_t)cur.pn * tstep;
    S.a_ready(cur);
    if constexpr (SP2) {
        PG8_STAGE(PG8_SB(0, 0), cB, voffB); PG8_STAGE(PG8_SB(0, 1), cB + hstep, voffB); PG8_STAGE(PG8_SA(0, 0), cA, voffA); PG8_STAGE(PG8_SA(0, 1), cA + hstep, voffA);
        if (wr == 1) PG8_BAR;
        PG8_WAIT_V(2); PG8_BAR;
        PG8_STAGE(PG8_SB(1, 0), cB + kstep, voffB); PG8_STAGE(PG8_SA(1, 0), cA + kstep, voffA); PG8_STAGE(PG8_SB(1, 1), cB + hstep + kstep, voffB);
        PG8_WAIT_V(6); PG8_BAR;
    } else {
        PG8_STAGE(PG8_SB(0, 0), cB, voffB); PG8_STAGE(PG8_SA(0, 0), cA, voffA); PG8_STAGE(PG8_SB(0, 1), cB + hstep, voffB); PG8_STAGE(PG8_SA(0, 1), cA + hstep, voffA);
        if (wr == 1) PG8_BAR;
        PG8_WAIT_V(4); PG8_BAR;
        PG8_STAGE(PG8_SB(1, 0), cB + kstep, voffB); PG8_STAGE(PG8_SA(1, 0), cA + kstep, voffA); PG8_STAGE(PG8_SB(1, 1), cB + hstep + kstep, voffB);
        PG8_WAIT_V(6); PG8_BAR;
    }
    for (;;) {
        const bool has_next = S.next(ui + 1, nxt);
        const char* nA = has_next ? (const char*)g.A + (size_t)nxt.pm * tstep : cA; const char* nB = has_next ? (const char*)g.Bt + (size_t)nxt.pn * tstep : cB;
        for (int t = 0; t < nt; t += 2) {
            const bool last = (t == nt - 2);
            const char* a1 = cA + (size_t)(t + 1) * kstep;
            const char* a2 = last ? nA : cA + (size_t)(t + 2) * kstep; const char* b2 = last ? nB : cB + (size_t)(t + 2) * kstep;
            const char* a3 = a2 + kstep; const char* b3 = b2 + kstep;
            if (last && has_next) S.a_ready(nxt);
            if constexpr (SP2) {
            PG8_LDB(B0, 0, 0); PG8_LDB(B1, 0, 1); PG8_SCHED; PG8_LDA(At, 0, 0); PG8_STAGE(PG8_SA(1, 1), a1 + hstep, voffA);
            PG8_WAIT_V(8); PG8_WAIT_L(0); PG8_BAR; PG8_MMA(0, 0, At, B0); PG8_MMA(0, 1, At, B1); PG8_BAR; PG8_SCHED;
            PG8_LDA(At, 0, 1); PG8_STAGE(PG8_SB(0, 0), b2, voffB); PG8_STAGE(PG8_SB(0, 1), b2 + hstep, voffB); PG8_STAGE(PG8_SA(0, 0), a2, voffA);
            PG8_WAIT_V(8); PG8_WAIT_L(0); PG8_BAR; PG8_MMA(1, 0, At, B0); PG8_MMA(1, 1, At, B1); PG8_BAR; PG8_SCHED;
            PG8_LDB(B0, 1, 0); PG8_LDB(B1, 1, 1); PG8_SCHED; PG8_LDA(At, 1, 0); PG8_STAGE(PG8_SA(0, 1), a2 + hstep, voffA);
            PG8_WAIT_V(8); PG8_WAIT_L(0); PG8_BAR; PG8_MMA(0, 0, At, B0); PG8_MMA(0, 1, At, B1); PG8_BAR; PG8_SCHED;
            PG8_LDA(At, 1, 1); PG8_STAGE(PG8_SB(1, 0), b3, voffB); PG8_STAGE(PG8_SB(1, 1), b3 + hstep, voffB); PG8_STAGE(PG8_SA(1, 0), a3, voffA);
            PG8_WAIT_V(8); PG8_WAIT_L(0); PG8_BAR; PG8_MMA(1, 0, At, B0); PG8_MMA(1, 1, At, B1); PG8_BAR; PG8_SCHED;
            } else {
            PG8_LDB(B0, 0, 0); PG8_SCHED; PG8_LDA(At, 0, 0); PG8_STAGE(PG8_SA(1, 1), a1 + hstep, voffA);
            PG8_WAIT_L(8); PG8_BAR; PG8_WAIT_L(0); PG8_MMA(0, 0, At, B0); PG8_BAR; PG8_SCHED;
            PG8_LDB(B1, 0, 1); PG8_STAGE(PG8_SB(0, 0), b2, voffB);
            PG8_BAR; PG8_WAIT_L(0); PG8_MMA(0, 1, At, B1); PG8_BAR;
            PG8_LDA(At, 0, 1); PG8_STAGE(PG8_SA(0, 0), a2, voffA);
            PG8_BAR; PG8_WAIT_L(0); PG8_MMA(1, 0, At, B0); PG8_BAR; PG8_SCHED;
            PG8_STAGE(PG8_SB(0, 1), b2 + hstep, voffB);
            PG8_WAIT_V(6); PG8_BAR; PG8_MMA(1, 1, At, B1); PG8_BAR;
            PG8_LDB(B0, 1, 0); PG8_SCHED; PG8_LDA(At, 1, 0); PG8_STAGE(PG8_SA(0, 1), a2 + hstep, voffA);
            PG8_WAIT_L(8); PG8_BAR; PG8_WAIT_L(0); PG8_MMA(0, 0, At, B0); PG8_BAR; PG8_SCHED;
            PG8_LDB(B1, 1, 1); PG8_STAGE(PG8_SB(1, 0), b3, voffB);
            PG8_BAR; PG8_WAIT_L(0); PG8_MMA(0, 1, At, B1); PG8_BAR;
            PG8_LDA(At, 1, 1); PG8_STAGE(PG8_SA(1, 0), a3, voffA);
            PG8_BAR; PG8_WAIT_L(0); PG8_MMA(1, 0, At, B0); PG8_BAR; PG8_SCHED;
            PG8_STAGE(PG8_SB(1, 1), b3 + hstep, voffB);
            PG8_WAIT_V(6); PG8_BAR; PG8_MMA(1, 1, At, B1); PG8_BAR;
            }
        }
        if constexpr (ALIGN_EPI) { if (wr == 0) PG8_BAR; }
        if constexpr (!Epi::AFTER_DRAIN) { E(acc, cur, wr, wc, fr, fq); S.done(cur); }
        if (!has_next) break;
#pragma unroll
        for (int a = 0; a < 2; ++a)
#pragma unroll
            for (int b = 0; b < 2; ++b)
#pragma unroll
                for (int m = 0; m < 4; ++m)
#pragma unroll
                    for (int n = 0; n < 2; ++n) acc[a][b][m][n] = (f32x4){0.f, 0.f, 0.f, 0.f};
        cur = nxt; cA = nA; cB = nB; ++ui;
        if constexpr (ALIGN_EPI) { if (wr == 1) PG8_BAR; }
    }
    PG8_WAIT_V(0);
    if constexpr (!ALIGN_EPI) { if (wr == 0) PG8_BAR; }
    PG8_BAR;
    if constexpr (Epi::AFTER_DRAIN) { E.fused(acc, cur, wr, wc, fr, fq, lds, wid, lane); S.done(cur); }
#undef PG8_SA
#undef PG8_SB
#undef PG8_STAGE
#undef PG8_LDA
#undef PG8_LDB
#undef PG8_MMA
#undef PG8_WAIT_V
#undef PG8_WAIT_L
#undef PG8_BAR
#undef PG8_SCHED
}
}

using pg8::bf16_t; using pg8::bf16x8; using pg8::f32x4; using pg8::u32x4; using pg8::Unit;
typedef float f32x16 __attribute__((ext_vector_type(16)));
typedef short s16x4 __attribute__((ext_vector_type(4)));
typedef unsigned u32x2 __attribute__((ext_vector_type(2)));
typedef float f32x2 __attribute__((ext_vector_type(2)));
#define DI __device__ __forceinline__
#define LAS __attribute__((address_space(3)))

constexpr int BATCH = 8, SEQ = 4096, DM = 1024, NTOK = BATCH * SEQ;
constexpr int N_IN0 = 4096, N_IN1 = 2304;
constexpr float NORM_EPS = 1e-6f;
constexpr float SC_LOG2 = 0.125f * 1.44269504088896341f;
constexpr float NEGBIG = -1e30f;
constexpr int NTHREADS = 512;
#ifndef PH_MASK
#define PH_MASK 0x7f
#endif
#ifndef PROBE_REP
#define PROBE_REP 0
#endif
#define NREP(k) (((PROBE_REP >> (k)) & 1) ? 2 : 1)
constexpr int LDS_BYTES = 131072 + 8192;

constexpr size_t MiB = 1u << 20;
constexpr size_t WS_BT0 = 0 * MiB, WS_BT1 = 8 * MiB, WS_BT2 = 10 * MiB, WS_BT3 = 15 * MiB;
constexpr size_t WS_BAR = 17 * MiB + 512 * 1024;
constexpr size_t WS_GAINS = 17 * MiB;
constexpr size_t WS_RSTD0 = 18 * MiB, WS_CS = 19 * MiB, WS_KMP = 20 * MiB, WS_SSQ = 21 * MiB;
constexpr size_t WS_XB = 32 * MiB;
constexpr size_t WS_Y = 32 * MiB;
constexpr size_t WS_QA = 96 * MiB, WS_KA = 128 * MiB, WS_VTA = 160 * MiB, WS_QB = 192 * MiB, WS_KB = 224 * MiB, WS_VTB = 256 * MiB;
constexpr size_t WS_ZS = 288 * MiB;
constexpr size_t WS_X1 = 352 * MiB;
constexpr size_t WS_X1B = 96 * MiB;
constexpr size_t WS_QC = 160 * MiB, WS_KC = 224 * MiB, WS_VTC = 232 * MiB, WS_ZS1 = 240 * MiB;
constexpr size_t WS_END = 480 * MiB;

struct Params {
    const float* x; const float* norm_even; const float* w_in_even; const float* w_out_even;
    const float* qn_a; const float* kn_a; const float* qn_b; const float* kn_b;
    const float* norm_odd; const float* w_in_odd; const float* w_out_odd; const float* qn_c; const float* kn_c; const float* sinks;
    float* out; unsigned char* ws;
};

typedef __bf16 bf16v2 __attribute__((ext_vector_type(2)));
DI unsigned cvt_pk(float lo, float hi) { const f32x2 v = {lo, hi}; return __builtin_bit_cast(unsigned, __builtin_convertvector(v, bf16v2)); }
DI float bf_lo(unsigned u) { return __uint_as_float(u << 16); }
DI float bf_hi(unsigned u) { return __uint_as_float(u & 0xffff0000u); }

DI void p0_weight_tile(LAS float* tile, const float* W, bf16_t* Bt, int N, const float* g, bool permute, int t) {
    const int tid = threadIdx.x;
    const int ntn = N / 64, k0 = (t / ntn) * 64, n0 = (t % ntn) * 64;
    {
        const int n = tid & 63, kr = tid >> 6;
#pragma unroll
        for (int i = 0; i < 8; ++i) { const int k = kr + 8 * i; tile[k * 65 + n] = W[(size_t)(k0 + k) * N + n0 + n] * (g ? g[k0 + k] : 1.0f); }
    }
    __syncthreads();
    {
        const int nn = tid >> 3, ks = tid & 7;
        const int nlog = n0 + nn;
        const int c = permute ? ((nlog & ~255) | (((nlog >> 5) & 1) << 7) | (((nlog >> 6) & 3) << 5) | (nlog & 31)) : nlog;
        float v[8];
#pragma unroll
        for (int i = 0; i < 8; ++i) v[i] = tile[(ks * 8 + i) * 65 + nn];
        u32x4 w; w.x = cvt_pk(v[0], v[1]); w.y = cvt_pk(v[2], v[3]); w.z = cvt_pk(v[4], v[5]); w.w = cvt_pk(v[6], v[7]);
        *(u32x4*)(Bt + (size_t)c * 1024 + k0 + ks * 8) = w;
    }
    __syncthreads();
}

DI void sincos_d(double x, double& s, double& c) {
    const double kq = __builtin_rint(x * 0.63661977236758134308);
    double r = __builtin_fma(-kq, 1.57079632679489655800e+00, x); r = __builtin_fma(-kq, 6.12323399573676603587e-17, r);
    const int q = ((int)kq) & 3;
    const double r2 = r * r;
    const double sp = r * (1.0 + r2 * (-1.0 / 6 + r2 * (1.0 / 120 + r2 * (-1.0 / 5040 + r2 * (1.0 / 362880 + r2 * (-1.0 / 39916800 + r2 * (1.0 / 6227020800.0)))))));
    const double cp = 1.0 + r2 * (-0.5 + r2 * (1.0 / 24 + r2 * (-1.0 / 720 + r2 * (1.0 / 40320 + r2 * (-1.0 / 3628800 + r2 * (1.0 / 479001600.0 + r2 * (-1.0 / 87178291200.0)))))));
    s = (q == 0) ? sp : (q == 1) ? cp : (q == 2) ? -sp : -cp;
    c = (q == 0) ? cp : (q == 1) ? -sp : (q == 2) ? -cp : sp;
}

DI void p0_prologue(const Params& P, LAS unsigned char* lds) {
    unsigned char* ws = P.ws;
    const int tid = threadIdx.x, lane = tid & 63, wid = tid >> 6;
    const int G = gridDim.x, bid = blockIdx.x;
    {
        bf16_t* xb = (bf16_t*)(ws + WS_XB); float* rstd = (float*)(ws + WS_RSTD0);
        for (int row = bid * 8 + wid; row < NTOK; row += G * 8) {
            const f32x4* xr = (const f32x4*)(P.x + (size_t)row * DM);
            float ss = 0.f;
#pragma unroll
            for (int i = 0; i < 4; ++i) {
                const f32x4 v = xr[lane + 64 * i];
                ss += v[0] * v[0] + v[1] * v[1] + v[2] * v[2] + v[3] * v[3];
                u32x2 w; w.x = cvt_pk(v[0], v[1]); w.y = cvt_pk(v[2], v[3]);
                *(u32x2*)(xb + (size_t)row * DM + 4 * (lane + 64 * i)) = w;
            }
#pragma unroll
            for (int o = 32; o >= 1; o >>= 1) ss += __shfl_xor(ss, o);
            if (lane == 0) rstd[row] = rsqrtf(ss * (1.0f / DM) + NORM_EPS);
        }
    }
    if (bid == 0 && tid < 64) {
        float* gw = (float*)(ws + WS_GAINS);
        gw[tid] = P.qn_a[tid]; gw[64 + tid] = P.kn_a[tid]; gw[128 + tid] = P.qn_b[tid]; gw[192 + tid] = P.kn_b[tid]; gw[256 + tid] = P.qn_c[tid]; gw[320 + tid] = P.kn_c[tid];
        if (tid < 16) gw[384 + tid] = P.sinks[tid];
        float ma = fabsf(P.qn_a[tid]), mb = fabsf(P.kn_a[tid]), mc = fabsf(P.qn_b[tid]), md = fabsf(P.kn_b[tid]), me = fabsf(P.qn_c[tid]), mf = fabsf(P.kn_c[tid]);
#pragma unroll
        for (int o = 32; o >= 1; o >>= 1) { ma = fmaxf(ma, __shfl_xor(ma, o)); mb = fmaxf(mb, __shfl_xor(mb, o)); mc = fmaxf(mc, __shfl_xor(mc, o)); md = fmaxf(md, __shfl_xor(md, o)); me = fmaxf(me, __shfl_xor(me, o)); mf = fmaxf(mf, __shfl_xor(mf, o)); }
        if (tid == 0) { const float c = 8.0f * 1.44269504088896341f * 1.01f; gw[400] = c * ma * mb; gw[401] = c * mc * md; gw[402] = c * me * mf; }
    }
    {
        f32x2* cs = (f32x2*)(ws + WS_CS);
        for (int e = bid * NTHREADS + tid; e < SEQ * 32; e += G * NTHREADS) {
            const int pos = e >> 5, i = e & 31;
            double f = 1.0;
            for (int k = 0; k < i; ++k) f *= 0.7498942093324558;
            const float invf = (float)f;
            const float ang = (float)pos * invf;
            double s, c; sincos_d((double)ang, s, c);
            cs[e] = (f32x2){(float)c, (float)s};
        }
    }
    {
        LAS float* tile = (LAS float*)lds;
        const int T0 = 16 * (N_IN0 / 64), T1 = 16 * (DM / 64), T2 = 16 * (N_IN1 / 64), T3 = 16 * (DM / 64);
        for (int t = bid; t < T0 + T1 + T2 + T3; t += G) {
            if (t < T0) p0_weight_tile(tile, P.w_in_even, (bf16_t*)(ws + WS_BT0), N_IN0, P.norm_even, true, t);
            else if (t < T0 + T1) p0_weight_tile(tile, P.w_out_even, (bf16_t*)(ws + WS_BT1), DM, nullptr, false, t - T0);
            else if (t < T0 + T1 + T2) p0_weight_tile(tile, P.w_in_odd, (bf16_t*)(ws + WS_BT2), N_IN1, P.norm_odd, true, t - T0 - T1);
            else p0_weight_tile(tile, P.w_out_odd, (bf16_t*)(ws + WS_BT3), DM, nullptr, false, t - T0 - T1 - T2);
        }
    }
}

DI float row_rstd1(const float* ssq, int row, int fq) {
    const f32x4 a = *(const f32x4*)(ssq + (size_t)row * 16 + 4 * fq);
    float t = (a[0] + a[1]) + (a[2] + a[3]);
    t += __shfl_xor(t, 16); t += __shfl_xor(t, 32);
    return rsqrtf(t * (1.0f / DM) + NORM_EPS);
}
struct EpiIn {
    static constexpr bool PERM = true, AFTER_DRAIN = false;
    int layer; unsigned char* ws;
    __device__ __forceinline__ void operator()(const f32x4 (&acc)[2][2][4][2], const Unit& u, int wr, int wc, int fr, int fq) const {
        const float* rstd0 = (const float*)(ws + WS_RSTD0); const float* ssq = (const float*)(ws + WS_SSQ); const f32x2* cs = (const f32x2*)(ws + WS_CS);
        const float* gains = (const float*)(ws + WS_GAINS); bf16_t* zs = (bf16_t*)(ws + (layer == 0 ? WS_ZS : WS_ZS1)); float* kmp = (float*)(ws + WS_KMP);
        int mode, head, hpb = 8, zcol = 0; bf16_t* dst = nullptr; const float* gain = gains; bool do_km = false;
        if (layer == 0) {
            const int seg = u.pn >> 1; head = (u.pn & 1) * 4 + wc;
            if (seg == 0) { mode = 0; dst = (bf16_t*)(ws + WS_QA); gain = gains; }
            else if (seg == 1) { mode = 0; dst = (bf16_t*)(ws + WS_KA); gain = gains + 64; }
            else if (seg == 2) { mode = 1; dst = (bf16_t*)(ws + WS_VTA); }
            else if (seg == 3) { mode = 2; zcol = head * 64; }
            else if (seg == 4) { mode = 0; dst = (bf16_t*)(ws + WS_QB); gain = gains + 128; }
            else if (seg == 5) { mode = 0; dst = (bf16_t*)(ws + WS_KB); gain = gains + 192; do_km = true; }
            else if (seg == 6) { mode = 1; dst = (bf16_t*)(ws + WS_VTB); }
            else { mode = 2; zcol = 512 + head * 64; }
        } else {
            if (u.pn < 4) { mode = 0; dst = (bf16_t*)(ws + WS_QC); gain = gains + 256; head = u.pn * 4 + wc; hpb = 16; }
            else if (u.pn == 4) { hpb = 2; if (wc < 2) { mode = 0; dst = (bf16_t*)(ws + WS_KC); gain = gains + 320; head = wc; } else { mode = 1; dst = (bf16_t*)(ws + WS_VTC); head = wc - 2; } }
            else { mode = 2; head = (u.pn - 5) * 4 + wc; zcol = head * 64; }
        }
        const int b = u.pm >> 4, sbase = (u.pm & 15) * 256 + wr * 64 + fr, rowbase = u.pm * 256 + wr * 64 + fr;
        const size_t bh = (size_t)b * hpb + head;
#define ROW_RS(row) ((layer == 0) ? rstd0[(row)] : row_rstd1(ssq, (row), fq))
        if (mode == 0) {
            float g0[8], g1[8], cs0[8], cs1[8];
#pragma unroll
            for (int i = 0; i < 8; ++i) { g0[i] = gain[8 * fq + i]; g1[i] = gain[32 + 8 * fq + i]; cs0[i] = 0.f; cs1[i] = 0.f; }
#pragma unroll
            for (int ai = 0; ai < 2; ++ai)
#pragma unroll
                for (int m = 0; m < 4; ++m) {
                    const int s = sbase + ai * 128 + m * 16; const float r = ROW_RS(rowbase + ai * 128 + m * 16);
                    float t0[8], t1[8]; float ss = 0.f;
#pragma unroll
                    for (int n = 0; n < 2; ++n)
#pragma unroll
                        for (int j = 0; j < 4; ++j) { t0[4 * n + j] = acc[ai][0][m][n][j] * r; t1[4 * n + j] = acc[ai][1][m][n][j] * r; }
#pragma unroll
                    for (int i = 0; i < 8; ++i) ss += t0[i] * t0[i] + t1[i] * t1[i];
                    ss += __shfl_xor(ss, 16); ss += __shfl_xor(ss, 32);
                    const float hr = rsqrtf(ss * (1.0f / 64.0f) + NORM_EPS);
                    const f32x4* cp = (const f32x4*)(cs + (size_t)s * 32 + 8 * fq);
                    float o0[8], o1[8];
#pragma unroll
                    for (int q = 0; q < 4; ++q) { const f32x4 c4 = cp[q];
                        { const int i = 2 * q; const float a = t0[i] * hr * g0[i], bb = t1[i] * hr * g1[i]; o0[i] = a * c4[0] - bb * c4[1]; o1[i] = bb * c4[0] + a * c4[1]; }
                        { const int i = 2 * q + 1; const float a = t0[i] * hr * g0[i], bb = t1[i] * hr * g1[i]; o0[i] = a * c4[2] - bb * c4[3]; o1[i] = bb * c4[2] + a * c4[3]; } }
                    u32x4 w0, w1;
                    w0.x = cvt_pk(o0[0], o0[1]); w0.y = cvt_pk(o0[2], o0[3]); w0.z = cvt_pk(o0[4], o0[5]); w0.w = cvt_pk(o0[6], o0[7]);
                    w1.x = cvt_pk(o1[0], o1[1]); w1.y = cvt_pk(o1[2], o1[3]); w1.z = cvt_pk(o1[4], o1[5]); w1.w = cvt_pk(o1[6], o1[7]);
                    bf16_t* rp = dst + ((bh * SEQ + s) * 64 + 8 * fq);
                    *(u32x4*)rp = w0; *(u32x4*)(rp + 32) = w1;
                    if (do_km) {
#pragma unroll
                        for (int i = 0; i < 8; ++i) { cs0[i] += o0[i]; cs1[i] += o1[i]; }
                    }
                }
            if (do_km) {
#pragma unroll
                for (int i = 0; i < 8; ++i) {
#pragma unroll
                    for (int o = 1; o <= 8; o <<= 1) { cs0[i] += __shfl_xor(cs0[i], o); cs1[i] += __shfl_xor(cs1[i], o); }
                }
                if (fr == 0) {
                    float* kp = kmp + (((size_t)wr * 64 + bh) * 16 + (u.pm & 15)) * 64 + 8 * fq;
                    *(f32x4*)kp = (f32x4){cs0[0], cs0[1], cs0[2], cs0[3]}; *(f32x4*)(kp + 4) = (f32x4){cs0[4], cs0[5], cs0[6], cs0[7]};
                    *(f32x4*)(kp + 32) = (f32x4){cs1[0], cs1[1], cs1[2], cs1[3]}; *(f32x4*)(kp + 36) = (f32x4){cs1[4], cs1[5], cs1[6], cs1[7]};
                }
            }
        } else if (mode == 1) {
#pragma unroll
            for (int ai = 0; ai < 2; ++ai)
#pragma unroll
                for (int m = 0; m < 4; ++m) {
                    const int s = sbase + ai * 128 + m * 16; const float r = ROW_RS(rowbase + ai * 128 + m * 16);
                    bf16_t* rp = dst + ((bh * SEQ + s) * 64 + 8 * fq);
#pragma unroll
                    for (int bj = 0; bj < 2; ++bj) {
                        const f32x4 v0 = acc[ai][bj][m][0] * r, v1 = acc[ai][bj][m][1] * r;
                        u32x4 w; w.x = cvt_pk(v0[0], v0[1]); w.y = cvt_pk(v0[2], v0[3]); w.z = cvt_pk(v1[0], v1[1]); w.w = cvt_pk(v1[2], v1[3]);
                        *(u32x4*)(rp + 32 * bj) = w;
                    }
                }
        } else {
#pragma unroll
            for (int ai = 0; ai < 2; ++ai)
#pragma unroll
                for (int m = 0; m < 4; ++m) {
                    const int row = rowbase + ai * 128 + m * 16; const float r = ROW_RS(row);
#pragma unroll
                    for (int bj = 0; bj < 2; ++bj) {
                        float sv[8];
#pragma unroll
                        for (int n = 0; n < 2; ++n)
#pragma unroll
                            for (int j = 0; j < 4; ++j) { const float z = acc[ai][bj][m][n][j] * r; sv[4 * n + j] = z / (1.0f + __expf(-z)); }
                        u32x4 w; w.x = cvt_pk(sv[0], sv[1]); w.y = cvt_pk(sv[2], sv[3]); w.z = cvt_pk(sv[4], sv[5]); w.w = cvt_pk(sv[6], sv[7]);
                        *(u32x4*)(zs + (size_t)row * DM + zcol + 32 * bj + 8 * fq) = w;
                    }
                }
        }
    }
};

struct EpiOut {
    static constexpr bool PERM = true, AFTER_DRAIN = false;
    const float* resid; float* out; bf16_t* xb; float* ssq;
    __device__ __forceinline__ void operator()(const f32x4 (&acc)[2][2][4][2], const Unit& u, int wr, int wc, int fr, int fq) const {
        const int col0 = u.pn * 256 + wc * 32 + 8 * fq, rowbase = u.pm * 256 + wr * 64 + fr;
#pragma unroll
        for (int ai = 0; ai < 2; ++ai)
#pragma unroll
            for (int m = 0; m < 4; ++m) {
                const int row = rowbase + ai * 128 + m * 16; const size_t off = (size_t)row * DM + col0;
                float q = 0.f;
#pragma unroll
                for (int bj = 0; bj < 2; ++bj) {
                    const f32x4 r0 = *(const f32x4*)(resid + off + bj * 128), r1 = *(const f32x4*)(resid + off + bj * 128 + 4);
                    const f32x4 o0 = r0 + acc[ai][bj][m][0], o1 = r1 + acc[ai][bj][m][1];
                    *(f32x4*)(out + off + bj * 128) = o0; *(f32x4*)(out + off + bj * 128 + 4) = o1;
                    if (xb) {
                        u32x4 w; w.x = cvt_pk(o0[0], o0[1]); w.y = cvt_pk(o0[2], o0[3]); w.z = cvt_pk(o1[0], o1[1]); w.w = cvt_pk(o1[2], o1[3]);
                        *(u32x4*)(xb + off + bj * 128) = w;
                        q += (o0[0] * o0[0] + o0[1] * o0[1]) + (o0[2] * o0[2] + o0[3] * o0[3]) + (o1[0] * o1[0] + o1[1] * o1[1]) + (o1[2] * o1[2] + o1[3] * o1[3]);
                    }
                }
                if (xb) { q += __shfl_xor(q, 16); q += __shfl_xor(q, 32); if (fq == 0) ssq[(size_t)row * 16 + u.pn * 4 + wc] = q; }
            }
    }
};

#define MFMA32(a, b, c) __builtin_amdgcn_mfma_f32_32x32x16_bf16((a), (b), (c), 0, 0, 0)
constexpr int TROW = 144;
constexpr int TBUF = 2 * 32 * TROW;
struct TileRegs { u32x4 k[4]; u32x4 v[4]; };
struct ASt { f32x16 o0, o1; float l; };
struct QT { bf16x8 qf[4]; ASt st; };

DI void qt_init(QT& t, const bf16_t* qrow, int h) {
    const bf16x8* qp = (const bf16x8*)qrow;
#pragma unroll
    for (int ks = 0; ks < 4; ++ks) t.qf[ks] = qp[2 * ks + h];
#pragma unroll
    for (int i = 0; i < 16; ++i) { t.st.o0[i] = 0.f; t.st.o1[i] = 0.f; }
    t.st.l = 0.f;
}

DI void tile_gload(TileRegs& t, const bf16_t* K, const bf16_t* V, int kbase, int kstride, int lane) {
    const int row0 = lane >> 3, ch = lane & 7;
#pragma unroll
    for (int i = 0; i < 4; ++i) {
        const unsigned off = (unsigned)((kbase + kstride * (row0 + 8 * i)) * 128 + ch * 16);
        t.k[i] = *(const u32x4*)((const unsigned char*)K + off); t.v[i] = *(const u32x4*)((const unsigned char*)V + off);
    }
}
DI void tile_lds_write(LAS unsigned char* buf, const TileRegs& t, int lane) {
    const int row0 = lane >> 3, ch = lane & 7;
#pragma unroll
    for (int i = 0; i < 4; ++i) {
        const int off = (row0 + 8 * i) * TROW + ch * 16;
        *(LAS u32x4*)(buf + off) = t.k[i]; *(LAS u32x4*)(buf + 32 * TROW + off) = t.v[i];
    }
}
DI void load_kfrag(bf16x8 (&kf)[4], LAS unsigned char* buf, int lane) {
    const int r = lane & 31, h = lane >> 5;
#pragma unroll
    for (int ks = 0; ks < 4; ++ks) kf[ks] = *(const LAS bf16x8*)(buf + r * TROW + (2 * ks + h) * 16);
}
DI void load_vfrag(bf16x8 (&vf)[2][2], LAS unsigned char* buf, int lane) {
    const int h = lane >> 5, q = (lane & 15) >> 2, p = lane & 3, blk = (lane >> 4) & 1;
    LAS unsigned char* vb = buf + 32 * TROW + (4 * h + q) * TROW + 32 * blk + 8 * p;
#pragma unroll
    for (int dt = 0; dt < 2; ++dt)
#pragma unroll
        for (int s2 = 0; s2 < 2; ++s2) {
            const s16x4 lo = __builtin_amdgcn_ds_read_tr16_b64_v4i16((LAS s16x4*)(vb + (16 * s2) * TROW + 64 * dt));
            const s16x4 hi4 = __builtin_amdgcn_ds_read_tr16_b64_v4i16((LAS s16x4*)(vb + (16 * s2 + 8) * TROW + 64 * dt));
            vf[dt][s2] = __builtin_shufflevector(lo, hi4, 0, 1, 2, 3, 4, 5, 6, 7);
        }
}
DI void qk_mfma(f32x16& s, const bf16x8 (&kf)[4], const bf16x8 (&qf)[4]) {
#pragma unroll
    for (int i = 0; i < 16; ++i) s[i] = 0.f;
#pragma unroll
    for (int ks = 0; ks < 4; ++ks) s = MFMA32(kf[ks], qf[ks], s);
}
DI void softmax_p(ASt& st, f32x16& s, int dist0, int kstride, int hi, bool lane_ok, bool elem, float m0) {
    if (elem) {
        int d0 = dist0; asm volatile("" : "+v"(d0));
#pragma unroll
        for (int i = 0; i < 16; ++i) {
            const unsigned dist = (unsigned)(d0 - kstride * ((i & 3) + 8 * (i >> 2)));
            s[i] = (dist <= (unsigned)hi) ? s[i] : NEGBIG;
        }
    }
    const float msub = lane_ok ? m0 : 1e30f;
    float ps0 = 0.f, ps1 = 0.f;
#pragma unroll
    for (int i = 0; i < 16; i += 2) {
        s[i] = __builtin_amdgcn_exp2f(__builtin_fmaf(s[i], SC_LOG2, -msub)); s[i + 1] = __builtin_amdgcn_exp2f(__builtin_fmaf(s[i + 1], SC_LOG2, -msub));
        ps0 += s[i]; ps1 += s[i + 1];
    }
    st.l += ps0 + ps1;
}
DI void pv_mfma(ASt& st, const f32x16& s, const bf16x8 (&vf)[2][2]) {
#pragma unroll
    for (int s2 = 0; s2 < 2; ++s2) {
        u32x4 p;
        p.x = cvt_pk(s[8 * s2 + 0], s[8 * s2 + 1]); p.y = cvt_pk(s[8 * s2 + 2], s[8 * s2 + 3]);
        p.z = cvt_pk(s[8 * s2 + 4], s[8 * s2 + 5]); p.w = cvt_pk(s[8 * s2 + 6], s[8 * s2 + 7]);
        const bf16x8 pb = __builtin_bit_cast(bf16x8, p);
        st.o0 = MFMA32(vf[0][s2], pb, st.o0);
        st.o1 = MFMA32(vf[1][s2], pb, st.o1);
    }
}
DI void pack_p(bf16x8 (&pb)[2], const f32x16& s) {
#pragma unroll
    for (int s2 = 0; s2 < 2; ++s2) {
        u32x4 p;
        p.x = cvt_pk(s[8 * s2 + 0], s[8 * s2 + 1]); p.y = cvt_pk(s[8 * s2 + 2], s[8 * s2 + 3]);
        p.z = cvt_pk(s[8 * s2 + 4], s[8 * s2 + 5]); p.w = cvt_pk(s[8 * s2 + 6], s[8 * s2 + 7]);
        pb[s2] = __builtin_bit_cast(bf16x8, p);
    }
}
DI bf16x8 load_vfrag1(LAS unsigned char* vb, int dt, int s2) {
    const s16x4 lo = __builtin_amdgcn_ds_read_tr16_b64_v4i16((LAS s16x4*)(vb + (16 * s2) * TROW + 64 * dt));
    const s16x4 hi4 = __builtin_amdgcn_ds_read_tr16_b64_v4i16((LAS s16x4*)(vb + (16 * s2 + 8) * TROW + 64 * dt));
    return __builtin_shufflevector(lo, hi4, 0, 1, 2, 3, 4, 5, 6, 7);
}
DI void core2(QT& a, QT& b, LAS unsigned char* buf, int dist0a, int dist0b, int kstride, int hi, bool elem, bool oka, bool okb, float m0, int lane) {
    const int r = lane & 31, h = lane >> 5;
    f32x16 sa, sb;
    {
        const f32x16 zero = {0.f, 0.f, 0.f, 0.f, 0.f, 0.f, 0.f, 0.f, 0.f, 0.f, 0.f, 0.f, 0.f, 0.f, 0.f, 0.f};
        const bf16x8 kf = *(const LAS bf16x8*)(buf + r * TROW + h * 16); sa = MFMA32(kf, a.qf[0], zero); sb = MFMA32(kf, b.qf[0], zero);
    }
#pragma unroll
    for (int ks = 1; ks < 4; ++ks) { const bf16x8 kf = *(const LAS bf16x8*)(buf + r * TROW + (2 * ks + h) * 16); sa = MFMA32(kf, a.qf[ks], sa); sb = MFMA32(kf, b.qf[ks], sb); }
    LAS unsigned char* vb = buf + 32 * TROW + (4 * h + ((lane & 15) >> 2)) * TROW + 32 * ((lane >> 4) & 1) + 8 * (lane & 3);
    softmax_p(a.st, sa, dist0a, kstride, hi, oka, elem, m0);
    {
        bf16x8 pa[2]; pack_p(pa, sa);
#pragma unroll
        for (int s2 = 0; s2 < 2; ++s2) {
            const bf16x8 v0 = load_vfrag1(vb, 0, s2), v1 = load_vfrag1(vb, 1, s2);
            a.st.o0 = MFMA32(v0, pa[s2], a.st.o0); a.st.o1 = MFMA32(v1, pa[s2], a.st.o1);
        }
    }
    softmax_p(b.st, sb, dist0b, kstride, hi, okb, elem, m0);
    {
        bf16x8 pb[2]; pack_p(pb, sb);
#pragma unroll
        for (int s2 = 0; s2 < 2; ++s2) {
            const bf16x8 v0 = load_vfrag1(vb, 0, s2), v1 = load_vfrag1(vb, 1, s2);
            b.st.o0 = MFMA32(v0, pb[s2], b.st.o0); b.st.o1 = MFMA32(v1, pb[s2], b.st.o1);
        }
    }
}
DI bool band_all_ok(int dist0, int kstride, int hi, int h) {
    const int d_first = dist0 + kstride * 4 * h, d_last = d_first - 31 * kstride;
    return (d_last >= 0) && (d_first <= hi);
}
DI void band2(QT& a, QT& b, LAS unsigned char* buf, int dist0a, int dist0b, int kstride, int hi, int who, float m0, int lane) {
    const bool oka = who != 1, okb = who != 0;
    const bool allok = (!oka || band_all_ok(dist0a, kstride, hi, lane >> 5)) && (!okb || band_all_ok(dist0b, kstride, hi, lane >> 5));
    const bool elem = __builtin_amdgcn_ballot_w64(!allok) != 0ull;
    core2(a, b, buf, dist0a, dist0b, kstride, hi, elem, oka, okb, m0, lane);
}

DI void attn_finish(ASt& st, float sink_l2, float m0, const bf16_t* zs, bf16_t* y, size_t rowoff  , int h) {
    float l = st.l + __shfl_xor(st.l, 32);
    l += (sink_l2 > -1e29f) ? __builtin_amdgcn_exp2f(sink_l2 - m0) : 0.f;
    const float inv = 1.0f / l;
#pragma unroll
    for (int dt = 0; dt < 2; ++dt)
#pragma unroll
        for (int g = 0; g < 4; ++g) {
            const size_t off = rowoff + 32 * dt + 8 * g + 4 * h;
            const u32x2 z = *(const u32x2*)(zs + off);
            const float v0 = (dt ? st.o1[4 * g + 0] : st.o0[4 * g + 0]) * inv * bf_lo(z.x);
            const float v1 = (dt ? st.o1[4 * g + 1] : st.o0[4 * g + 1]) * inv * bf_hi(z.x);
            const float v2 = (dt ? st.o1[4 * g + 2] : st.o0[4 * g + 2]) * inv * bf_lo(z.y);
            const float v3 = (dt ? st.o1[4 * g + 3] : st.o0[4 * g + 3]) * inv * bf_hi(z.y);
            u32x2 w; w.x = cvt_pk(v0, v1); w.y = cvt_pk(v2, v3);
            *(u32x2*)(y + off) = w;
        }
}

DI bool a_tile_desc(int tau, int ra, int i0, int& kbase, int& kstride, int& hi, int& who) {
    if (tau < 10) { const int t = (tau < 5) ? tau : tau - 5; const int jb = i0 - 128 + 32 * t; who = (tau < 5) ? 0 : 1; kbase = ra + 8 * who + 16 * jb; kstride = 16; hi = 2048; return jb >= 0; }
    who = 2;
    if (tau < 18) { const int ub = 4 * i0 - 128 + 32 * (tau - 10); kbase = (ra & 3) + 4 * ub; kstride = 4; hi = 512; return ub >= 0; }
    { const int kb = 16 * i0 - 128 + 32 * (tau - 18); kbase = kb; kstride = 1; hi = 128; return kb >= 0; }
}
DI int a_next(int tau, int ra, int i0) { int t = tau + 1, kb, ks, hi, who; while (t < 38 && !a_tile_desc(t, ra, i0, kb, ks, hi, who)) ++t; return t; }
DI void attn_a_item(unsigned char* ws, LAS unsigned char* buf, int bh, int ra, int i0, int lane) {
    const int r = lane & 31, h = lane >> 5;
    const bf16_t* Q = (const bf16_t*)(ws + WS_QA) + (size_t)bh * SEQ * 64;
    const bf16_t* K = (const bf16_t*)(ws + WS_KA) + (size_t)bh * SEQ * 64;
    const bf16_t* V = (const bf16_t*)(ws + WS_VTA) + (size_t)bh * SEQ * 64;
    const int qpa = ra + 16 * (i0 + r), qpb = qpa + 8;
    const float m0 = ((const float*)(ws + WS_GAINS))[400];
    QT a, b; qt_init(a, Q + (size_t)qpa * 64, h); qt_init(b, Q + (size_t)qpb * 64, h);
    TileRegs tr;
    int tc = a_next(-1, ra, i0);
    { int kb, ks, hi, who; (void)a_tile_desc(tc, ra, i0, kb, ks, hi, who); tile_gload(tr, K, V, kb, ks, lane); }
    for (;;) {
        tile_lds_write(buf, tr, lane);
        const int tn = a_next(tc, ra, i0);
        if (tn < 38) { int kb, ks, hi, who; (void)a_tile_desc(tn, ra, i0, kb, ks, hi, who); tile_gload(tr, K, V, kb, ks, lane); }
        {
            int kb, ks, hi, who; (void)a_tile_desc(tc, ra, i0, kb, ks, hi, who);
            const int d0a = qpa - kb - ks * 4 * h, d0b = qpb - kb - ks * 4 * h;
            band2(a, b, buf, d0a, d0b, ks, hi, who, m0, lane);
        }
        if (tn >= 38) break;
        tc = tn;
    }
    const int bb = bh >> 3, head = bh & 7;
    attn_finish(a.st, NEGBIG, m0, (const bf16_t*)(ws + WS_ZS), (bf16_t*)(ws + WS_Y), ((size_t)bb * SEQ + qpa) * DM + head * 64, h);
    attn_finish(b.st, NEGBIG, m0, (const bf16_t*)(ws + WS_ZS), (bf16_t*)(ws + WS_Y), ((size_t)bb * SEQ + qpb) * DM + head * 64, h);
}

DI unsigned moba_select(const bf16x8 (&qf)[4], LAS float* km, int qblk, int h) {
    float v1 = -3e38f, v2 = -3e38f, v3 = -3e38f; int i1 = 31, i2 = 31, i3 = 31;
    for (int n = 0; n < qblk; ++n) {
        float g = 0.f;
#pragma unroll
        for (int ks = 0; ks < 4; ++ks) {
            const LAS f32x4* kp = (const LAS f32x4*)(km + n * 64 + 16 * ks + 8 * h);
            const f32x4 x = kp[0], y = kp[1];
            const u32x4 qu = __builtin_bit_cast(u32x4, qf[ks]);
            g += bf_lo(qu.x) * x[0] + bf_hi(qu.x) * x[1] + bf_lo(qu.y) * x[2] + bf_hi(qu.y) * x[3]
               + bf_lo(qu.z) * y[0] + bf_hi(qu.z) * y[1] + bf_lo(qu.w) * y[2] + bf_hi(qu.w) * y[3];
        }
        g += __shfl_xor(g, 32);
        if (g > v1) { v3 = v2; i3 = i2; v2 = v1; i2 = i1; v1 = g; i1 = n; }
        else if (g > v2) { v3 = v2; i3 = i2; v2 = g; i2 = n; }
        else if (g > v3) { v3 = g; i3 = n; }
    }
    unsigned sel = 0u;
    if (i1 < 16) sel |= 1u << i1;
    if (i2 < 16) sel |= 1u << i2;
    if (i3 < 16) sel |= 1u << i3;
    return sel;
}
DI void attn_b_item(unsigned char* ws, LAS unsigned char* buf, LAS float* km  , int bh, int qblk, int w4, int lane) {
    const int r = lane & 31, h = lane >> 5;
    const bf16_t* Q = (const bf16_t*)(ws + WS_QB) + (size_t)bh * SEQ * 64;
    const bf16_t* K = (const bf16_t*)(ws + WS_KB) + (size_t)bh * SEQ * 64;
    const bf16_t* V = (const bf16_t*)(ws + WS_VTB) + (size_t)bh * SEQ * 64;
    const int qpa = qblk * 256 + w4 * 64 + r, qpb = qpa + 32;
    const float m0 = ((const float*)(ws + WS_GAINS))[401];
    QT a, b; qt_init(a, Q + (size_t)qpa * 64, h); qt_init(b, Q + (size_t)qpb * 64, h);
    const unsigned sela = moba_select(a.qf, km, qblk, h), selb = moba_select(b.qf, km, qblk, h);
    unsigned uni = 0u;
    for (int n = 0; n < qblk; ++n) { if (__builtin_amdgcn_ballot_w64(((sela | selb) >> n) & 1u) != 0ull) uni |= 1u << n; }
    uni |= 1u << qblk;
    const int own_tiles = 2 * w4 + 2;
    TileRegs tr;
#define B_ADV(n_, T_, ok_) do { const int cnt_ = ((n_) == qblk) ? own_tiles : 8; if (++(T_) >= cnt_) { const unsigned rest_ = uni & ~((2u << (n_)) - 1u); if (rest_) { (n_) = __builtin_ctz(rest_); (T_) = 0; } else (ok_) = false; } } while (0)
    int nc = __builtin_ctz(uni), Tc = 0; bool okc = true;
    tile_gload(tr, K, V, nc * 256, 1, lane);
    for (;;) {
        tile_lds_write(buf, tr, lane);
        int nl = nc, Tl = Tc; bool okl = true; B_ADV(nl, Tl, okl);
        if (okl) tile_gload(tr, K, V, nl * 256 + 32 * Tl, 1, lane);
        {
            const int kb = nc * 256 + 32 * Tc;
            const bool own = (nc == qblk);
            const bool oka = own ? (Tc <= 2 * w4) : (((sela >> nc) & 1u) != 0u), okb = own ? true : (((selb >> nc) & 1u) != 0u);
            core2(a, b, buf, qpa - kb - 4 * h, qpb - kb - 4 * h, 1, 0x7fffffff, own && (Tc >= 2 * w4), oka, okb, m0, lane);
        }
        if (!okl) break;
        nc = nl; Tc = Tl;
    }
#undef B_ADV
    const int bb = bh >> 3, head = 8 + (bh & 7);
    attn_finish(a.st, NEGBIG, m0, (const bf16_t*)(ws + WS_ZS), (bf16_t*)(ws + WS_Y), ((size_t)bb * SEQ + qpa) * DM + head * 64, h);
    attn_finish(b.st, NEGBIG, m0, (const bf16_t*)(ws + WS_ZS), (bf16_t*)(ws + WS_Y), ((size_t)bb * SEQ + qpb) * DM + head * 64, h);
}

DI void attn_c_item(unsigned char* ws, LAS unsigned char* buf, int b, int hq, int chunk, int wid, int lane) {
    const int r = lane & 31, h = lane >> 5, kvh = hq >> 3;
    const bf16_t* Qa = (const bf16_t*)(ws + WS_QC) + ((size_t)b * 16 + hq) * SEQ * 64;
    const bf16_t* K = (const bf16_t*)(ws + WS_KC) + ((size_t)b * 2 + kvh) * SEQ * 64;
    const bf16_t* V = (const bf16_t*)(ws + WS_VTC) + ((size_t)b * 2 + kvh) * SEQ * 64;
    const int t0 = chunk * 256 + wid * 32, qpos = t0 + r;
    const float m0 = ((const float*)(ws + WS_GAINS))[402];
    QT qa, qb; qt_init(qa, Qa + (size_t)qpos * 64, h); qt_init(qb, Qa + (size_t)SEQ * 64 + (size_t)qpos * 64, h);
    TileRegs tr;
    int T = (t0 >= 128) ? 0 : (128 - t0) / 32;
    tile_gload(tr, K, V, t0 - 128 + 32 * T, 1, lane);
    for (;;) {
        tile_lds_write(buf, tr, lane);
        const bool have = (T + 1) < 5;
        if (have) tile_gload(tr, K, V, t0 - 128 + 32 * (T + 1), 1, lane);
        const int d0 = qpos - (t0 - 128 + 32 * T) - 4 * h;
        band2(qa, qb, buf, d0, d0, 1, 127, 2, m0, lane);
        if (!have) break;
        ++T;
    }
    const float* sinks = (const float*)(ws + WS_GAINS) + 384;
    const size_t rowoff = ((size_t)b * SEQ + qpos) * DM + hq * 64;
    attn_finish(qa.st, sinks[hq] * 1.44269504088896341f, m0, (const bf16_t*)(ws + WS_ZS1), (bf16_t*)(ws + WS_Y), rowoff, h);
    attn_finish(qb.st, sinks[hq + 1] * 1.44269504088896341f, m0, (const bf16_t*)(ws + WS_ZS1), (bf16_t*)(ws + WS_Y), rowoff + 64, h);
}

#define XB_TMO      128
#define XB_XCNT(j)  (256  + 64 * (j))
#define XB_XSUB(j)  (1280 + 64 * (j))
#define XB_XGEN(j)  (2304 + 64 * (j))
#define XB_TOP      3328
#define XB_TOPGEN   3392
#define XCD_BAR_WORDS 3456
#define XB_SPIN_CAP (1u << 18)

__device__ __forceinline__ unsigned xb_ld(unsigned* p)              { return __hip_atomic_load(p, __ATOMIC_RELAXED, __HIP_MEMORY_SCOPE_AGENT); }
__device__ __forceinline__ unsigned xb_add(unsigned* p, unsigned v) { return __hip_atomic_fetch_add(p, v, __ATOMIC_RELAXED, __HIP_MEMORY_SCOPE_AGENT); }
__device__ __forceinline__ unsigned xb_xcc_id() { return (unsigned)__builtin_amdgcn_s_getreg((3 << 11) | 20) & 0xFu; }
#define XB_SPIN(cond, bar) do { unsigned _sp = 0; while (cond) { __builtin_amdgcn_s_sleep(1); \
    if ((++_sp & 255u) == 0u) { if (xb_ld(&(bar)[XB_TMO])) break; if (_sp > XB_SPIN_CAP) { atomicAdd(&(bar)[XB_TMO], 1u); break; } } } } while (0)

struct XcdBarrier {
    unsigned* bar; unsigned x;
    volatile LAS unsigned* st;
};

__device__ __forceinline__ XcdBarrier xcd_barrier_post(unsigned* bar, volatile LAS unsigned* st) {
    XcdBarrier b; b.bar = bar; b.x = xb_xcc_id(); b.st = st;
    if (threadIdx.x == 0) (void)xb_add(&bar[XB_XCNT(b.x)], 1u);
    return b;
}
__device__ __forceinline__ void xcd_barrier_complete(unsigned* bar, unsigned x, unsigned& nloc, unsigned& nx) {
    const unsigned G = gridDim.x * gridDim.y * gridDim.z;
    unsigned sum, cnt, mine, sp = 0u;
    for (;;) {
        sum = 0u; cnt = 0u; mine = 0u;
#pragma unroll
        for (unsigned j = 0; j < 16; ++j) { const unsigned c = xb_ld(&bar[XB_XCNT(j)]); sum += c; cnt += (c > 0u) ? 1u : 0u; mine = (j == x) ? c : mine; }
        if (sum == G) break;
        __builtin_amdgcn_s_sleep(1);
        if ((++sp & 255u) == 0u) { if (xb_ld(&bar[XB_TMO])) break; if (sp > XB_SPIN_CAP) { atomicAdd(&bar[XB_TMO], 1u); break; } }
    }
    nloc = mine > 0u ? mine : 1u; nx = cnt > 0u ? cnt : 1u;
}

__device__ __forceinline__ void xcd_barrier(const XcdBarrier& b) {
    asm volatile("s_waitcnt vmcnt(0)" ::: "memory");
    __syncthreads();
    if (threadIdx.x == 0) {
        unsigned* bar = b.bar;
        __builtin_amdgcn_s_waitcnt(0);
        unsigned nloc = b.st[0], nx = b.st[1];
        if (nloc == 0u) { xcd_barrier_complete(bar, b.x, nloc, nx); b.st[0] = nloc; b.st[1] = nx; }
        const unsigned old = xb_add(&bar[XB_XSUB(b.x)], 1u);
        const unsigned gen = old / nloc;
        if (old + 1u == (gen + 1u) * nloc) {
            __builtin_amdgcn_fence(__ATOMIC_RELEASE, "agent");
            asm volatile("s_waitcnt vmcnt(0)" ::: "memory");
            const unsigned og = xb_add(&bar[XB_TOP], 1u);
            const unsigned tg = og / nx;
            if (og + 1u == (tg + 1u) * nx) xb_add(&bar[XB_TOPGEN], 1u);
            else XB_SPIN(xb_ld(&bar[XB_TOPGEN]) == tg, bar);
            __builtin_amdgcn_fence(__ATOMIC_ACQUIRE, "agent");
            xb_add(&bar[XB_XGEN(b.x)], 1u);
            asm volatile("s_waitcnt vmcnt(0)" ::: "memory");
        } else {
            XB_SPIN(xb_ld(&bar[XB_XGEN(b.x)]) == gen, bar);
            __builtin_amdgcn_fence(__ATOMIC_ACQUIRE, "agent");
            asm volatile("s_waitcnt vmcnt(0)" ::: "memory");
        }
    }
    __syncthreads();
}


__global__ void __launch_bounds__(NTHREADS) fwd_megakernel(Params P) {
    extern __shared__ __attribute__((aligned(16))) unsigned char lds_raw[];
    cg::grid_group grid = cg::this_grid();
    LAS unsigned char* lds = (LAS unsigned char*)lds_raw;
    unsigned char* ws = P.ws;
    const int G = gridDim.x, bid = blockIdx.x;
    volatile LAS unsigned* xb_st = (volatile LAS unsigned*)(lds + LDS_BYTES - 16);
    if (threadIdx.x == 0) { xb_st[0] = 0u; xb_st[1] = 0u; }
    __syncthreads();
    const XcdBarrier xbar = xcd_barrier_post((unsigned*)(ws + WS_BAR), xb_st);
#define PHASE_IDS() int tid_l = threadIdx.x; asm volatile("" : "+v"(tid_l)); const int tid = tid_l, lane = tid & 63, wid = __builtin_amdgcn_readfirstlane(tid >> 6); (void)lane; (void)wid

    if constexpr (PH_MASK & 1) { for (int rep = 0; rep < NREP(0); ++rep) p0_prologue(P, lds); }
    grid.sync();

    if constexpr ((PH_MASK & 2) != 0) {
        pg8::Gemm g{(const bf16_t*)(ws + WS_XB), (const bf16_t*)(ws + WS_BT0), NTOK, N_IN0, DM};
        pg8::StaticOrder S; S.init(NTOK, N_IN0, G, bid);
        EpiIn E{0, ws};
        for (int rep = 0; rep < NREP(1); ++rep) pg8::gemm_phase<EpiIn, pg8::StaticOrder, true, true>(lds, g, S, E);
    }
    xcd_barrier(xbar);

    if constexpr ((PH_MASK & 4) != 0) {
        PHASE_IDS();
        LAS float* km = (LAS float*)(lds + 8 * TBUF);
        LAS unsigned char* buf = lds + wid * TBUF;
        const float* kmp = (const float*)(ws + WS_KMP);
#define P2_DECODE(it_) const int itt = (it_) & 511, j = itt >> 8, c = itt & 255, xcd = c & 7, slot = c >> 3, idx = j * 32 + slot;   \
                       const int bh = xcd * 8 + (idx >> 3), sub = idx & 7; (void)j
#define P2_STAGE_KM(tab_, bh_) do { for (int e = tid; e < 1024; e += NTHREADS) km[(tab_) * 1024 + e] = kmp[(size_t)(bh_) * 1024 + e] + kmp[(size_t)(64 + (bh_)) * 1024 + e]; } while (0)
        for (int rep = 0; rep < 2; ++rep) {
            if (rep == 0 || NREP(2) == 2) {
                __syncthreads();
                { int k = 0; for (int it = bid; it < 512 && k < 2; it += G, ++k) { P2_DECODE(it); (void)sub; P2_STAGE_KM(k, bh); } }
                __syncthreads();
                int k = 0;
                for (int it = bid; it < 512; it += G, ++k) {
                    P2_DECODE(it);
                    if (k >= 2) { __syncthreads(); P2_STAGE_KM(k & 1, bh); __syncthreads(); }
                    const bool lo = (wid < 4) != ((k & 1) != 0);
                    attn_b_item(ws, buf, km + (k & 1) * 1024, bh, lo ? sub : 15 - sub, wid & 3, lane);
                }
            }
            if (rep == 0 || NREP(7) == 2) {
                for (int it = 512 + bid; it < 1024; it += G) { P2_DECODE(it); attn_a_item(ws, buf, bh, wid, sub * 32, lane); }
            }
        }
#undef P2_DECODE
#undef P2_STAGE_KM
    }
    xcd_barrier(xbar);

    if constexpr ((PH_MASK & 8) != 0) {
        pg8::Gemm g{(const bf16_t*)(ws + WS_Y), (const bf16_t*)(ws + WS_BT1), NTOK, DM, DM};
        pg8::StaticOrder S; S.init(NTOK, DM, G, bid);
        EpiOut E{P.x, (float*)(ws + WS_X1), (bf16_t*)(ws + WS_X1B), (float*)(ws + WS_SSQ)};
        for (int rep = 0; rep < NREP(3); ++rep) pg8::gemm_phase<EpiOut, pg8::StaticOrder, true, true>(lds, g, S, E);
    }
    xcd_barrier(xbar);

    if constexpr ((PH_MASK & 16) != 0) {
        pg8::Gemm g{(const bf16_t*)(ws + WS_X1B), (const bf16_t*)(ws + WS_BT2), NTOK, N_IN1, DM};
        pg8::StaticOrder S; S.init(NTOK, N_IN1, G, bid);
        EpiIn E{1, ws};
        for (int rep = 0; rep < NREP(4); ++rep) pg8::gemm_phase<EpiIn, pg8::StaticOrder, true, true>(lds, g, S, E);
    }
    xcd_barrier(xbar);

    if constexpr ((PH_MASK & 32) != 0) {
        PHASE_IDS();
        for (int rep = 0; rep < NREP(5); ++rep)
        for (int it = bid; it < 1024; it += G) {
            const int j = it >> 8, c = it & 255, xcd = c & 7, slot = c >> 3, idx = j * 32 + slot;
            const int bkv = xcd * 2 + (idx >> 6), rem = idx & 63, hq = (bkv & 1) * 8 + 2 * (rem >> 4), chunk = rem & 15;
            attn_c_item(ws, lds + wid * TBUF, bkv >> 1, hq, chunk, wid, lane);
        }
    }
    xcd_barrier(xbar);

    if constexpr ((PH_MASK & 64) != 0) {
        pg8::Gemm g{(const bf16_t*)(ws + WS_Y), (const bf16_t*)(ws + WS_BT3), NTOK, DM, DM};
        pg8::StaticOrder S; S.init(NTOK, DM, G, bid);
        EpiOut E{(const float*)(ws + WS_X1), P.out, nullptr, nullptr};
        for (int rep = 0; rep < NREP(6); ++rep) pg8::gemm_phase<EpiOut, pg8::StaticOrder, true, true>(lds, g, S, E);
    }
}

extern "C" void kernel_launch(void* const* d_in, const int* in_sizes, int n_in, void* d_out, int out_size, void* d_ws, size_t ws_size, hipStream_t stream) {
    static int grid_blocks = 0;
    if (grid_blocks == 0) {
        if (n_in != 14 || in_sizes[0] != NTOK * DM || out_size != NTOK * DM || ws_size < WS_END) {
            fprintf(stderr, "kernel_launch: unexpected shapes (n_in %d in0 %d out %d ws %zu)\n", n_in, n_in > 0 ? in_sizes[0] : -1, out_size, ws_size); grid_blocks = -1; return; }
        int dev = 0, cus = 0, per_cu = 0;
        hipGetDevice(&dev);
        hipDeviceGetAttribute(&cus, hipDeviceAttributeMultiprocessorCount, dev);
        if (hipFuncSetAttribute((const void*)fwd_megakernel, hipFuncAttributeMaxDynamicSharedMemorySize, LDS_BYTES) != hipSuccess) {
            fprintf(stderr, "kernel_launch: hipFuncSetAttribute failed\n"); grid_blocks = -1; return; }
        if (hipOccupancyMaxActiveBlocksPerMultiprocessor(&per_cu, (const void*)fwd_megakernel, NTHREADS, LDS_BYTES) != hipSuccess || per_cu < 1) {
            fprintf(stderr, "kernel_launch: occupancy query gave %d\n", per_cu); per_cu = 1; (void)hipGetLastError(); }
        grid_blocks = cus * 1;
        if (per_cu < 1) grid_blocks = -1;
    }
    if (grid_blocks < 0) return;
    Params p{};
    p.x = (const float*)d_in[0]; p.norm_even = (const float*)d_in[1]; p.w_in_even = (const float*)d_in[2]; p.w_out_even = (const float*)d_in[3];
    p.qn_a = (const float*)d_in[4]; p.kn_a = (const float*)d_in[5]; p.qn_b = (const float*)d_in[6]; p.kn_b = (const float*)d_in[7];
    p.norm_odd = (const float*)d_in[8]; p.w_in_odd = (const float*)d_in[9]; p.w_out_odd = (const float*)d_in[10];
    p.qn_c = (const float*)d_in[11]; p.kn_c = (const float*)d_in[12]; p.sinks = (const float*)d_in[13];
    p.out = (float*)d_out; p.ws = (unsigned char*)d_ws;
    if (hipMemsetAsync((unsigned char*)d_ws + WS_BAR, 0, XCD_BAR_WORDS * 4, stream) != hipSuccess) { fprintf(stderr, "kernel_launch: memset failed\n"); return; }
    void* args[] = {&p};
    hipError_t e = hipLaunchCooperativeKernel((const void*)fwd_megakernel, dim3(grid_blocks), dim3(NTHREADS), args, LDS_BYTES, stream);
    if (e != hipSuccess) fprintf(stderr, "cooperative launch failed: %s (grid %d)\n", hipGetErrorString(e), grid_blocks);
}
```

```cpp
#include <hip/hip_runtime.h>
#include <hip/hip_cooperative_groups.h>
#include <cstdio>
#include <cstdint>
namespace cg = cooperative_groups;
namespace pg8 {
#define PG8_LAS __attribute__((address_space(3)))
typedef unsigned short bf16_t;
typedef short bf16x8 __attribute__((ext_vector_type(8)));
typedef float f32x4 __attribute__((ext_vector_type(4)));
typedef unsigned u32x4 __attribute__((ext_vector_type(4)));
constexpr int BM = 256, BK = 64, HALF = 128, HTB = HALF * BK * 2  , STAGE_BYTES = 8 * HTB, NXCD = 8, WGM = 8;

__host__ __device__ __forceinline__ int lds_byte(int r, int c) { const int st = (r >> 4) * 2 + (c >> 5), rr = r & 15, cc = c & 31, ob = rr * 64 + cc * 2; return st * 1024 + (ob ^ (((ob >> 9) & 1) << 5)); }
__host__ __device__ __forceinline__ void stage_rc(int b, int& R, int& C) { const int st = b / 1024, sb = b % 1024, swz = sb ^ (((sb >> 9) & 1) << 5); R = (st >> 1) * 16 + swz / 64; C = (st & 1) * 32 + (swz % 64) / 2; }
__host__ __device__ __forceinline__ int perm32(int rho) { const int n = rho >> 4, i = rho & 15; return 8 * (i >> 2) + 4 * n + (i & 3); }

struct Unit { int pm, pn; };
struct Gemm { const bf16_t* A; const bf16_t* Bt; int M, N, K; };

struct StaticOrder {
    int nM, nN, nwg, G, c;
    __host__ __device__ void init(int M, int N, int G_, int c_) { nM = M / BM; nN = N / BM; nwg = nM * nN; G = G_; c = c_; }
    __host__ __device__ bool next(int i, Unit& u) const {
        const long L = (long)i * G + c; if (L >= nwg) return false;
        int wgid = (int)L; { const int q = nwg / NXCD, r = nwg % NXCD, xcd = wgid % NXCD, off = wgid / NXCD; wgid = (xcd < r ? xcd * (q + 1) : r * (q + 1) + (xcd - r) * q) + off; }
        const int nig = WGM * nN, gid = wgid / nig, fm = gid * WGM, gsz = (nM - fm) < WGM ? (nM - fm) : WGM;
        u.pm = fm + ((wgid % nig) % gsz); u.pn = (wgid % nig) / gsz; return true;
    }
    __device__ __forceinline__ void a_ready(const Unit&) const {}
    __device__ __forceinline__ void done(const Unit&) const {}
};

template <class Epi, class Sched, bool ALIGN_EPI = false, bool SP2 = false>
__device__ __forceinline__ void gemm_phase(PG8_LAS unsigned char* lds, const Gemm g, const Sched& S, const Epi& E) {
    int tid_l = threadIdx.x; asm volatile("" : "+v"(tid_l));
    const int tid = tid_l, wid = __builtin_amdgcn_readfirstlane(tid >> 6), lane = tid & 63, wr = wid >> 2, wc = wid & 3, fr = lane & 15, fq = lane >> 4;
    const int K = g.K, nt = K / BK;
    unsigned voffA[2], voffB[2];
#pragma unroll
    for (int i = 0; i < 2; ++i) { int R, C; stage_rc(tid * 16 + i * 8192, R, C); const int Rb = Epi::PERM ? ((R & ~31) + perm32(R & 31)) : R;
        voffA[i] = (unsigned)(R * K + C) * 2u; voffB[i] = (unsigned)(Rb * K + C) * 2u; }
    const size_t kstep = (size_t)(BK * 2);
    const size_t hstep = (size_t)HALF * K * 2;
    const size_t tstep = 2 * hstep;
    const unsigned ldsw = (unsigned)wid * 1024u;
    const int aoff = lds_byte(wr * 64 + fr, fq * 8), boff = lds_byte(wc * 32 + fr, fq * 8);
#define PG8_SA(b, h) (((b) * 2 + (h)) * HTB)
#define PG8_SB(b, h) ((4 + (b) * 2 + (h)) * HTB)
#define PG8_STAGE(bufoff, gbase, voff) do { _Pragma("unroll") for (int _i = 0; _i < 2; ++_i) \
        __builtin_amdgcn_global_load_lds((const unsigned*)((const char*)(gbase) + (voff)[_i]), (PG8_LAS unsigned*)(lds + (bufoff) + ldsw + _i * 8192), 16, 0, 0); } while (0)
#define PG8_LDA(dst, b, h) do { _Pragma("unroll") for (int m = 0; m < 4; ++m) _Pragma("unroll") for (int k = 0; k < 2; ++k) dst[m][k] = *(const PG8_LAS bf16x8*)(lds + PG8_SA(b, h) + aoff + m * 2048 + k * 1024); } while (0)
#define PG8_LDB(dst, b, h) do { _Pragma("unroll") for (int n = 0; n < 2; ++n) _Pragma("unroll") for (int k = 0; k < 2; ++k) dst[n][k] = *(const PG8_LAS bf16x8*)(lds + PG8_SB(b, h) + boff + n * 2048 + k * 1024); } while (0)
#define PG8_MMA(ai, bj, At, Bt) do { __builtin_amdgcn_s_setprio(1); _Pragma("unroll") for (int m = 0; m < 4; ++m) _Pragma("unroll") for (int n = 0; n < 2; ++n) _Pragma("unroll") for (int k = 0; k < 2; ++k) \
        acc[ai][bj][m][n] = __builtin_amdgcn_mfma_f32_16x16x32_bf16(Bt[n][k], At[m][k], acc[ai][bj][m][n], 0, 0, 0); __builtin_amdgcn_s_setprio(0); } while (0)
#define PG8_WAIT_V(n) asm volatile("s_waitcnt vmcnt(" #n ")" ::: "memory")
#define PG8_WAIT_L(n) asm volatile("s_waitcnt lgkmcnt(" #n ")" ::: "memory")
#define PG8_BAR __builtin_amdgcn_s_barrier()
#define PG8_SCHED __builtin_amdgcn_sched_barrier(0)
    Unit cur, nxt; int ui = 0;
    if (!S.next(0, cur)) return;
    f32x4 acc[2][2][4][2];
#pragma unroll
    for (int a = 0; a < 2; ++a)
#pragma unroll
        for (int b = 0; b < 2; ++b)
#pragma unroll
            for (int m = 0; m < 4; ++m)
#pragma unroll
                for (int n = 0; n < 2; ++n) acc[a][b][m][n] = (f32x4){0.f, 0.f, 0.f, 0.f};
    bf16x8 At[4][2], B0[2][2], B1[2][2];
    const char* cA = (const char*)g.A + (size_t)cur.pm * tstep; const char* cB = (const char*)g.Bt + (size_t)cur.pn * tstep;
    S.a_ready(cur);
    if constexpr (SP2) {
        PG8_STAGE(PG8_SB(0, 0), cB, voffB); PG8_STAGE(PG8_SB(0, 1), cB + hstep, voffB); PG8_STAGE(PG8_SA(0, 0), cA, voffA); PG8_STAGE(PG8_SA(0, 1), cA + hstep, voffA);
        if (wr == 1) PG8_BAR;
        PG8_WAIT_V(2); PG8_BAR;
        PG8_STAGE(PG8_SB(1, 0), cB + kstep, voffB); PG8_STAGE(PG8_SA(1, 0), cA + kstep, voffA); PG8_STAGE(PG8_SB(1, 1), cB + hstep + kstep, voffB);
        PG8_WAIT_V(6); PG8_BAR;
    } else {
        PG8_STAGE(PG8_SB(0, 0), cB, voffB); PG8_STAGE(PG8_SA(0, 0), cA, voffA); PG8_STAGE(PG8_SB(0, 1), cB + hstep, voffB); PG8_STAGE(PG8_SA(0, 1), cA + hstep, voffA);
        if (wr == 1) PG8_BAR;
        PG8_WAIT_V(4); PG8_BAR;
        PG8_STAGE(PG8_SB(1, 0), cB + kstep, voffB); PG8_STAGE(PG8_SA(1, 0), cA + kstep, voffA); PG8_STAGE(PG8_SB(1, 1), cB + hstep + kstep, voffB);
        PG8_WAIT_V(6); PG8_BAR;
    }
    for (;;) {
        const bool has_next = S.next(ui + 1, nxt);
        const char* nA = has_next ? (const char*)g.A + (size_t)nxt.pm * tstep : cA; const char* nB = has_next ? (const char*)g.Bt + (size_t)nxt.pn * tstep : cB;
        for (int t = 0; t < nt; t += 2) {
            const bool last = (t == nt - 2);
            const char* a1 = cA + (size_t)(t + 1) * kstep;
            const char* a2 = last ? nA : cA + (size_t)(t + 2) * kstep; const char* b2 = last ? nB : cB + (size_t)(t + 2) * kstep;
            const char* a3 = a2 + kstep; const char* b3 = b2 + kstep;
            if (last && has_next) S.a_ready(nxt);
            if constexpr (SP2) {
            PG8_LDB(B0, 0, 0); PG8_LDB(B1, 0, 1); PG8_SCHED; PG8_LDA(At, 0, 0); PG8_STAGE(PG8_SA(1, 1), a1 + hstep, voffA);
            PG8_WAIT_V(8); PG8_WAIT_L(0); PG8_BAR; PG8_MMA(0, 0, At, B0); PG8_MMA(0, 1, At, B1); PG8_BAR; PG8_SCHED;
            PG8_LDA(At, 0, 1); PG8_STAGE(PG8_SB(0, 0), b2, voffB); PG8_STAGE(PG8_SB(0, 1), b2 + hstep, voffB); PG8_STAGE(PG8_SA(0, 0), a2, voffA);
            PG8_WAIT_V(8); PG8_WAIT_L(0); PG8_BAR; PG8_MMA(1, 0, At, B0); PG8_MMA(1, 1, At, B1); PG8_BAR; PG8_SCHED;
            PG8_LDB(B0, 1, 0); PG8_LDB(B1, 1, 1); PG8_SCHED; PG8_LDA(At, 1, 0); PG8_STAGE(PG8_SA(0, 1), a2 + hstep, voffA);
            PG8_WAIT_V(8); PG8_WAIT_L(0); PG8_BAR; PG8_MMA(0, 0, At, B0); PG8_MMA(0, 1, At, B1); PG8_BAR; PG8_SCHED;
            PG8_LDA(At, 1, 1); PG8_STAGE(PG8_SB(1, 0), b3, voffB); PG8_STAGE(PG8_SB(1, 1), b3 + hstep, voffB); PG8_STAGE(PG8_SA(1, 0), a3, voffA);
            PG8_WAIT_V(8); PG8_WAIT_L(0); PG8_BAR; PG8_MMA(1, 0, At, B0); PG8_MMA(1, 1, At, B1); PG8_BAR; PG8_SCHED;
            } else {
            PG8_LDB(B0, 0, 0); PG8_SCHED; PG8_LDA(At, 0, 0); PG8_STAGE(PG8_SA(1, 1), a1 + hstep, voffA);
            PG8_WAIT_L(8); PG8_BAR; PG8_WAIT_L(0); PG8_MMA(0, 0, At, B0); PG8_BAR; PG8_SCHED;
            PG8_LDB(B1, 0, 1); PG8_STAGE(PG8_SB(0, 0), b2, voffB);
            PG8_BAR; PG8_WAIT_L(0); PG8_MMA(0, 1, At, B1); PG8_BAR;
            PG8_LDA(At, 0, 1); PG8_STAGE(PG8_SA(0, 0), a2, voffA);
            PG8_BAR; PG8_WAIT_L(0); PG8_MMA(1, 0, At, B0); PG8_BAR; PG8_SCHED;
            PG8_STAGE(PG8_SB(0, 1), b2 + hstep, voffB);
            PG8_WAIT_V(6); PG8_BAR; PG8_MMA(1, 1, At, B1); PG8_BAR;
            PG8_LDB(B0, 1, 0); PG8_SCHED; PG8_LDA(At, 1, 0); PG8_STAGE(PG8_SA(0, 1), a2 + hstep, voffA);
            PG8_WAIT_L(8); PG8_BAR; PG8_WAIT_L(0); PG8_MMA(0, 0, At, B0); PG8_BAR; PG8_SCHED;
            PG8_LDB(B1, 1, 1); PG8_STAGE(PG8_SB(1, 0), b3, voffB);
            PG8_BAR; PG8_WAIT_L(0); PG8_MMA(0, 1, At, B1); PG8_BAR;
            PG8_LDA(At, 1, 1); PG8_STAGE(PG8_SA(1, 0), a3, voffA);
            PG8_BAR; PG8_WAIT_L(0); PG8_MMA(1, 0, At, B0); PG8_BAR; PG8_SCHED;
            PG8_STAGE(PG8_SB(1, 1), b3 + hstep, voffB);
            PG8_WAIT_V(6); PG8_BAR; PG8_MMA(1, 1, At, B1); PG8_BAR;
            }
        }
        if constexpr (ALIGN_EPI) { if (wr == 0) PG8_BAR; }
        if constexpr (!Epi::AFTER_DRAIN) { E(acc, cur, wr, wc, fr, fq); S.done(cur); }
        if (!has_next) break;
#pragma unroll
        for (int a = 0; a < 2; ++a)
#pragma unroll
            for (int b = 0; b < 2; ++b)
#pragma unroll
                for (int m = 0; m < 4; ++m)
#pragma unroll
                    for (int n = 0; n < 2; ++n) acc[a][b][m][n] = (f32x4){0.f, 0.f, 0.f, 0.f};
        cur = nxt; cA = nA; cB = nB; ++ui;
        if constexpr (ALIGN_EPI) { if (wr == 1) PG8_BAR; }
    }
    PG8_WAIT_V(0);
    if constexpr (!ALIGN_EPI) { if (wr == 0) PG8_BAR; }
    PG8_BAR;
    if constexpr (Epi::AFTER_DRAIN) { E.fused(acc, cur, wr, wc, fr, fq, lds, wid, lane); S.done(cur); }
#undef PG8_SA
#undef PG8_SB
#undef PG8_STAGE
#undef PG8_LDA
#undef PG8_LDB
#undef PG8_MMA
#undef PG8_WAIT_V
#undef PG8_WAIT_L
#undef PG8_BAR
#undef PG8_SCHED
}
}

using pg8::bf16_t; using pg8::bf16x8; using pg8::f32x4; using pg8::u32x4; using pg8::Unit;
typedef float f32x16 __attribute__((ext_vector_type(16)));
typedef short s16x4 __attribute__((ext_vector_type(4)));
typedef unsigned u32x2 __attribute__((ext_vector_type(2)));
typedef float f32x2 __attribute__((ext_vector_type(2)));
#define DI __device__ __forceinline__
#define LAS __attribute__((address_space(3)))

constexpr int BATCH = 8, SEQ = 4096, DM = 1024, NTOK = BATCH * SEQ;
constexpr int N_IN0 = 4096, N_IN1 = 2304;
constexpr float NORM_EPS = 1e-6f;
constexpr float SC_LOG2 = 0.125f * 1.44269504088896341f;
constexpr float NEGBIG = -1e30f;
constexpr int NTHREADS = 512;
#ifndef PH_MASK
#define PH_MASK 0x7f
#endif
#ifndef PROBE_REP
#define PROBE_REP 0
#endif
#define NREP(k) (((PROBE_REP >> (k)) & 1) ? 2 : 1)
constexpr int LDS_BYTES = 131072 + 8192;

constexpr size_t MiB = 1u << 20;
constexpr size_t WS_BT0 = 0 * MiB, WS_BT1 = 8 * MiB, WS_BT2 = 10 * MiB, WS_BT3 = 15 * MiB;
constexpr size_t WS_BAR = 17 * MiB + 512 * 1024;
constexpr size_t WS_GAINS = 17 * MiB;
constexpr size_t WS_RSTD0 = 18 * MiB, WS_CS = 19 * MiB, WS_KMP = 20 * MiB, WS_SSQ = 21 * MiB;
constexpr size_t WS_XB = 32 * MiB;
constexpr size_t WS_Y = 32 * MiB;
constexpr size_t WS_QA = 96 * MiB, WS_KA = 128 * MiB, WS_VTA = 160 * MiB, WS_QB = 192 * MiB, WS_KB = 224 * MiB, WS_VTB = 256 * MiB;
constexpr size_t WS_ZS = 288 * MiB;
constexpr size_t WS_X1 = 352 * MiB;
constexpr size_t WS_X1B = 96 * MiB;
constexpr size_t WS_QC = 160 * MiB, WS_KC = 224 * MiB, WS_VTC = 232 * MiB, WS_ZS1 = 240 * MiB;
constexpr size_t WS_END = 480 * MiB;

struct Params {
    const float* x; const float* norm_even; const float* w_in_even; const float* w_out_even;
    const float* qn_a; const float* kn_a; const float* qn_b; const float* kn_b;
    const float* norm_odd; const float* w_in_odd; const float* w_out_odd; const float* qn_c; const float* kn_c; const float* sinks;
    float* out; unsigned char* ws;
};

typedef __bf16 bf16v2 __attribute__((ext_vector_type(2)));
DI unsigned cvt_pk(float lo, float hi) { const f32x2 v = {lo, hi}; return __builtin_bit_cast(unsigned, __builtin_convertvector(v, bf16v2)); }
DI float bf_lo(unsigned u) { return __uint_as_float(u << 16); }
DI float bf_hi(unsigned u) { return __uint_as_float(u & 0xffff0000u); }

DI void p0_weight_tile(LAS float* tile, const float* W, bf16_t* Bt, int N, const float* g, bool permute, int t) {
    const int tid = threadIdx.x;
    const int ntn = N / 64, k0 = (t / ntn) * 64, n0 = (t % ntn) * 64;
    {
        const int n = tid & 63, kr = tid >> 6;
#pragma unroll
        for (int i = 0; i < 8; ++i) { const int k = kr + 8 * i; tile[k * 65 + n] = W[(size_t)(k0 + k) * N + n0 + n] * (g ? g[k0 + k] : 1.0f); }
    }
    __syncthreads();
    {
        const int nn = tid >> 3, ks = tid & 7;
        const int nlog = n0 + nn;
        const int c = permute ? ((nlog & ~255) | (((nlog >> 5) & 1) << 7) | (((nlog >> 6) & 3) << 5) | (nlog & 31)) : nlog;
        float v[8];
#pragma unroll
        for (int i = 0; i < 8; ++i) v[i] = tile[(ks * 8 + i) * 65 + nn];
        u32x4 w; w.x = cvt_pk(v[0], v[1]); w.y = cvt_pk(v[2], v[3]); w.z = cvt_pk(v[4], v[5]); w.w = cvt_pk(v[6], v[7]);
        *(u32x4*)(Bt + (size_t)c * 1024 + k0 + ks * 8) = w;
    }
    __syncthreads();
}

DI void sincos_d(double x, double& s, double& c) {
    const double kq = __builtin_rint(x * 0.63661977236758134308);
    double r = __builtin_fma(-kq, 1.57079632679489655800e+00, x); r = __builtin_fma(-kq, 6.12323399573676603587e-17, r);
    const int q = ((int)kq) & 3;
    const double r2 = r * r;
    const double sp = r * (1.0 + r2 * (-1.0 / 6 + r2 * (1.0 / 120 + r2 * (-1.0 / 5040 + r2 * (1.0 / 362880 + r2 * (-1.0 / 39916800 + r2 * (1.0 / 6227020800.0)))))));
    const double cp = 1.0 + r2 * (-0.5 + r2 * (1.0 / 24 + r2 * (-1.0 / 720 + r2 * (1.0 / 40320 + r2 * (-1.0 / 3628800 + r2 * (1.0 / 479001600.0 + r2 * (-1.0 / 87178291200.0)))))));
    s = (q == 0) ? sp : (q == 1) ? cp : (q == 2) ? -sp : -cp;
    c = (q == 0) ? cp : (q == 1) ? -sp : (q == 2) ? -cp : sp;
}

DI void p0_prologue(const Params& P, LAS unsigned char* lds) {
    unsigned char* ws = P.ws;
    const int tid = threadIdx.x, lane = tid & 63, wid = tid >> 6;
    const int G = gridDim.x, bid = blockIdx.x;
    {
        bf16_t* xb = (bf16_t*)(ws + WS_XB); float* rstd = (float*)(ws + WS_RSTD0);
        for (int row = bid * 8 + wid; row < NTOK; row += G * 8) {
            const f32x4* xr = (const f32x4*)(P.x + (size_t)row * DM);
            float ss = 0.f;
#pragma unroll
            for (int i = 0; i < 4; ++i) {
                const f32x4 v = xr[lane + 64 * i];
                ss += v[0] * v[0] + v[1] * v[1] + v[2] * v[2] + v[3] * v[3];
                u32x2 w; w.x = cvt_pk(v[0], v[1]); w.y = cvt_pk(v[2], v[3]);
                *(u32x2*)(xb + (size_t)row * DM + 4 * (lane + 64 * i)) = w;
            }
#pragma unroll
            for (int o = 32; o >= 1; o >>= 1) ss += __shfl_xor(ss, o);
            if (lane == 0) rstd[row] = rsqrtf(ss * (1.0f / DM) + NORM_EPS);
        }
    }
    if (bid == 0 && tid < 64) {
        float* gw = (float*)(ws + WS_GAINS);
        gw[tid] = P.qn_a[tid]; gw[64 + tid] = P.kn_a[tid]; gw[128 + tid] = P.qn_b[tid]; gw[192 + tid] = P.kn_b[tid]; gw[256 + tid] = P.qn_c[tid]; gw[320 + tid] = P.kn_c[tid];
        if (tid < 16) gw[384 + tid] = P.sinks[tid];
        float ma = fabsf(P.qn_a[tid]), mb = fabsf(P.kn_a[tid]), mc = fabsf(P.qn_b[tid]), md = fabsf(P.kn_b[tid]), me = fabsf(P.qn_c[tid]), mf = fabsf(P.kn_c[tid]);
#pragma unroll
        for (int o = 32; o >= 1; o >>= 1) { ma = fmaxf(ma, __shfl_xor(ma, o)); mb = fmaxf(mb, __shfl_xor(mb, o)); mc = fmaxf(mc, __shfl_xor(mc, o)); md = fmaxf(md, __shfl_xor(md, o)); me = fmaxf(me, __shfl_xor(me, o)); mf = fmaxf(mf, __shfl_xor(mf, o)); }
        if (tid == 0) { const float c = 8.0f * 1.44269504088896341f * 1.01f; gw[400] = c * ma * mb; gw[401] = c * mc * md; gw[402] = c * me * mf; }
    }
    {
        f32x2* cs = (f32x2*)(ws + WS_CS);
        for (int e = bid * NTHREADS + tid; e < SEQ * 32; e += G * NTHREADS) {
            const int pos = e >> 5, i = e & 31;
            double f = 1.0;
            for (int k = 0; k < i; ++k) f *= 0.7498942093324558;
            const float invf = (float)f;
            const float ang = (float)pos * invf;
            double s, c; sincos_d((double)ang, s, c);
            cs[e] = (f32x2){(float)c, (float)s};
        }
    }
    {
        LAS float* tile = (LAS float*)lds;
        const int T0 = 16 * (N_IN0 / 64), T1 = 16 * (DM / 64), T2 = 16 * (N_IN1 / 64), T3 = 16 * (DM / 64);
        for (int t = bid; t < T0 + T1 + T2 + T3; t += G) {
            if (t < T0) p0_weight_tile(tile, P.w_in_even, (bf16_t*)(ws + WS_BT0), N_IN0, P.norm_even, true, t);
            else if (t < T0 + T1) p0_weight_tile(tile, P.w_out_even, (bf16_t*)(ws + WS_BT1), DM, nullptr, false, t - T0);
            else if (t < T0 + T1 + T2) p0_weight_tile(tile, P.w_in_odd, (bf16_t*)(ws + WS_BT2), N_IN1, P.norm_odd, true, t - T0 - T1);
            else p0_weight_tile(tile, P.w_out_odd, (bf16_t*)(ws + WS_BT3), DM, nullptr, false, t - T0 - T1 - T2);
        }
    }
}

DI float row_rstd1(const float* ssq, int row, int fq) {
    const f32x4 a = *(const f32x4*)(ssq + (size_t)row * 16 + 4 * fq);
    float t = (a[0] + a[1]) + (a[2] + a[3]);
    t += __shfl_xor(t, 16); t += __shfl_xor(t, 32);
    return rsqrtf(t * (1.0f / DM) + NORM_EPS);
}
struct EpiIn {
    static constexpr bool PERM = true, AFTER_DRAIN = false;
    int layer; unsigned char* ws;
    __device__ __forceinline__ void operator()(const f32x4 (&acc)[2][2][4][2], const Unit& u, int wr, int wc, int fr, int fq) const {
        const float* rstd0 = (const float*)(ws + WS_RSTD0); const float* ssq = (const float*)(ws + WS_SSQ); const f32x2* cs = (const f32x2*)(ws + WS_CS);
        const float* gains = (const float*)(ws + WS_GAINS); bf16_t* zs = (bf16_t*)(ws + (layer == 0 ? WS_ZS : WS_ZS1)); float* kmp = (float*)(ws + WS_KMP);
        int mode, head, hpb = 8, zcol = 0; bf16_t* dst = nullptr; const float* gain = gains; bool do_km = false; float qsc = 1.0f;
        if (layer == 0) {
            const int seg = u.pn >> 1; head = (u.pn & 1) * 4 + wc;
            if (seg == 0) { mode = 0; dst = (bf16_t*)(ws + WS_QA); gain = gains; qsc = SC_LOG2; }
            else if (seg == 1) { mode = 0; dst = (bf16_t*)(ws + WS_KA); gain = gains + 64; }
            else if (seg == 2) { mode = 1; dst = (bf16_t*)(ws + WS_VTA); }
            else if (seg == 3) { mode = 2; zcol = head * 64; }
            else if (seg == 4) { mode = 0; dst = (bf16_t*)(ws + WS_QB); gain = gains + 128; qsc = SC_LOG2; }
            else if (seg == 5) { mode = 0; dst = (bf16_t*)(ws + WS_KB); gain = gains + 192; do_km = true; }
            else if (seg == 6) { mode = 1; dst = (bf16_t*)(ws + WS_VTB); }
            else { mode = 2; zcol = 512 + head * 64; }
        } else {
            if (u.pn < 4) { mode = 0; dst = (bf16_t*)(ws + WS_QC); gain = gains + 256; head = u.pn * 4 + wc; hpb = 16; qsc = SC_LOG2; }
            else if (u.pn == 4) { hpb = 2; if (wc < 2) { mode = 0; dst = (bf16_t*)(ws + WS_KC); gain = gains + 320; head = wc; } else { mode = 1; dst = (bf16_t*)(ws + WS_VTC); head = wc - 2; } }
            else { mode = 2; head = (u.pn - 5) * 4 + wc; zcol = head * 64; }
        }
        const int b = u.pm >> 4, sbase = (u.pm & 15) * 256 + wr * 64 + fr, rowbase = u.pm * 256 + wr * 64 + fr;
        const size_t bh = (size_t)b * hpb + head;
#define ROW_RS(row) ((layer == 0) ? rstd0[(row)] : row_rstd1(ssq, (row), fq))
        if (mode == 0) {
            float g0[8], g1[8], cs0[8], cs1[8];
#pragma unroll
            for (int i = 0; i < 8; ++i) { g0[i] = gain[8 * fq + i] * qsc; g1[i] = gain[32 + 8 * fq + i] * qsc; cs0[i] = 0.f; cs1[i] = 0.f; }
#pragma unroll
            for (int ai = 0; ai < 2; ++ai)
#pragma unroll
                for (int m = 0; m < 4; ++m) {
                    const int s = sbase + ai * 128 + m * 16; const float r = ROW_RS(rowbase + ai * 128 + m * 16);
                    float t0[8], t1[8]; float ss = 0.f;
#pragma unroll
                    for (int n = 0; n < 2; ++n)
#pragma unroll
                        for (int j = 0; j < 4; ++j) { t0[4 * n + j] = acc[ai][0][m][n][j] * r; t1[4 * n + j] = acc[ai][1][m][n][j] * r; }
#pragma unroll
                    for (int i = 0; i < 8; ++i) ss += t0[i] * t0[i] + t1[i] * t1[i];
                    ss += __shfl_xor(ss, 16); ss += __shfl_xor(ss, 32);
                    const float hr = rsqrtf(ss * (1.0f / 64.0f) + NORM_EPS);
                    const f32x4* cp = (const f32x4*)(cs + (size_t)s * 32 + 8 * fq);
                    float o0[8], o1[8];
#pragma unroll
                    for (int q = 0; q < 4; ++q) { const f32x4 c4 = cp[q];
                        { const int i = 2 * q; const float a = t0[i] * hr * g0[i], bb = t1[i] * hr * g1[i]; o0[i] = a * c4[0] - bb * c4[1]; o1[i] = bb * c4[0] + a * c4[1]; }
                        { const int i = 2 * q + 1; const float a = t0[i] * hr * g0[i], bb = t1[i] * hr * g1[i]; o0[i] = a * c4[2] - bb * c4[3]; o1[i] = bb * c4[2] + a * c4[3]; } }
                    u32x4 w0, w1;
                    w0.x = cvt_pk(o0[0], o0[1]); w0.y = cvt_pk(o0[2], o0[3]); w0.z = cvt_pk(o0[4], o0[5]); w0.w = cvt_pk(o0[6], o0[7]);
                    w1.x = cvt_pk(o1[0], o1[1]); w1.y = cvt_pk(o1[2], o1[3]); w1.z = cvt_pk(o1[4], o1[5]); w1.w = cvt_pk(o1[6], o1[7]);
                    bf16_t* rp = dst + ((bh * SEQ + s) * 64 + 8 * fq);
                    *(u32x4*)rp = w0; *(u32x4*)(rp + 32) = w1;
                    if (do_km) {
#pragma unroll
                        for (int i = 0; i < 8; ++i) { cs0[i] += o0[i]; cs1[i] += o1[i]; }
                    }
                }
            if (do_km) {
#pragma unroll
                for (int i = 0; i < 8; ++i) {
#pragma unroll
                    for (int o = 1; o <= 8; o <<= 1) { cs0[i] += __shfl_xor(cs0[i], o); cs1[i] += __shfl_xor(cs1[i], o); }
                }
                if (fr == 0) {
                    float* kp = kmp + (((size_t)wr * 64 + bh) * 16 + (u.pm & 15)) * 64 + 8 * fq;
                    *(f32x4*)kp = (f32x4){cs0[0], cs0[1], cs0[2], cs0[3]}; *(f32x4*)(kp + 4) = (f32x4){cs0[4], cs0[5], cs0[6], cs0[7]};
                    *(f32x4*)(kp + 32) = (f32x4){cs1[0], cs1[1], cs1[2], cs1[3]}; *(f32x4*)(kp + 36) = (f32x4){cs1[4], cs1[5], cs1[6], cs1[7]};
                }
            }
        } else if (mode == 1) {
#pragma unroll
            for (int ai = 0; ai < 2; ++ai)
#pragma unroll
                for (int m = 0; m < 4; ++m) {
                    const int s = sbase + ai * 128 + m * 16; const float r = ROW_RS(rowbase + ai * 128 + m * 16);
                    bf16_t* rp = dst + ((bh * SEQ + s) * 64 + 8 * fq);
#pragma unroll
                    for (int bj = 0; bj < 2; ++bj) {
                        const f32x4 v0 = acc[ai][bj][m][0] * r, v1 = acc[ai][bj][m][1] * r;
                        u32x4 w; w.x = cvt_pk(v0[0], v0[1]); w.y = cvt_pk(v0[2], v0[3]); w.z = cvt_pk(v1[0], v1[1]); w.w = cvt_pk(v1[2], v1[3]);
                        *(u32x4*)(rp + 32 * bj) = w;
                    }
                }
        } else {
#pragma unroll
            for (int ai = 0; ai < 2; ++ai)
#pragma unroll
                for (int m = 0; m < 4; ++m) {
                    const int row = rowbase + ai * 128 + m * 16; const float r = ROW_RS(row);
#pragma unroll
                    for (int bj = 0; bj < 2; ++bj) {
                        float sv[8];
#pragma unroll
                        for (int n = 0; n < 2; ++n)
#pragma unroll
                            for (int j = 0; j < 4; ++j) { const float z = acc[ai][bj][m][n][j] * r; sv[4 * n + j] = z / (1.0f + __expf(-z)); }
                        u32x4 w; w.x = cvt_pk(sv[0], sv[1]); w.y = cvt_pk(sv[2], sv[3]); w.z = cvt_pk(sv[4], sv[5]); w.w = cvt_pk(sv[6], sv[7]);
                        *(u32x4*)(zs + (size_t)row * DM + zcol + 32 * bj + 8 * fq) = w;
                    }
                }
        }
    }
};

struct EpiOut {
    static constexpr bool PERM = true, AFTER_DRAIN = false;
    const float* resid; float* out; bf16_t* xb; float* ssq;
    __device__ __forceinline__ void operator()(const f32x4 (&acc)[2][2][4][2], const Unit& u, int wr, int wc, int fr, int fq) const {
        const int col0 = u.pn * 256 + wc * 32 + 8 * fq, rowbase = u.pm * 256 + wr * 64 + fr;
#pragma unroll
        for (int ai = 0; ai < 2; ++ai)
#pragma unroll
            for (int m = 0; m < 4; ++m) {
                const int row = rowbase + ai * 128 + m * 16; const size_t off = (size_t)row * DM + col0;
                float q = 0.f;
#pragma unroll
                for (int bj = 0; bj < 2; ++bj) {
                    const f32x4 r0 = *(const f32x4*)(resid + off + bj * 128), r1 = *(const f32x4*)(resid + off + bj * 128 + 4);
                    const f32x4 o0 = r0 + acc[ai][bj][m][0], o1 = r1 + acc[ai][bj][m][1];
                    *(f32x4*)(out + off + bj * 128) = o0; *(f32x4*)(out + off + bj * 128 + 4) = o1;
                    if (xb) {
                        u32x4 w; w.x = cvt_pk(o0[0], o0[1]); w.y = cvt_pk(o0[2], o0[3]); w.z = cvt_pk(o1[0], o1[1]); w.w = cvt_pk(o1[2], o1[3]);
                        *(u32x4*)(xb + off + bj * 128) = w;
                        q += (o0[0] * o0[0] + o0[1] * o0[1]) + (o0[2] * o0[2] + o0[3] * o0[3]) + (o1[0] * o1[0] + o1[1] * o1[1]) + (o1[2] * o1[2] + o1[3] * o1[3]);
                    }
                }
                if (xb) { q += __shfl_xor(q, 16); q += __shfl_xor(q, 32); if (fq == 0) ssq[(size_t)row * 16 + u.pn * 4 + wc] = q; }
            }
    }
};

#define MFMA32(a, b, c) __builtin_amdgcn_mfma_f32_32x32x16_bf16((a), (b), (c), 0, 0, 0)
constexpr int TROW = 144;
constexpr int TBUF = 2 * 32 * TROW;
struct TileRegs { u32x4 k[4]; u32x4 v[4]; };
struct ASt { f32x16 o0, o1; float l; };
struct QT { bf16x8 qf[4]; ASt st; };

DI void qt_init(QT& t, const bf16_t* qrow, int h) {
    const bf16x8* qp = (const bf16x8*)qrow;
#pragma unroll
    for (int ks = 0; ks < 4; ++ks) t.qf[ks] = qp[2 * ks + h];
#pragma unroll
    for (int i = 0; i < 16; ++i) { t.st.o0[i] = 0.f; t.st.o1[i] = 0.f; }
    t.st.l = 0.f;
}

DI void tile_gload(TileRegs& t, const bf16_t* K, const bf16_t* V, int kbase, int kstride, int lane) {
    const int row0 = lane >> 3, ch = lane & 7;
#pragma unroll
    for (int i = 0; i < 4; ++i) {
        const unsigned off = (unsigned)((kbase + kstride * (row0 + 8 * i)) * 128 + ch * 16);
        t.k[i] = *(const u32x4*)((const unsigned char*)K + off); t.v[i] = *(const u32x4*)((const unsigned char*)V + off);
    }
}
DI void tile_lds_write(LAS unsigned char* buf, const TileRegs& t, int lane) {
    const int row0 = lane >> 3, ch = lane & 7;
#pragma unroll
    for (int i = 0; i < 4; ++i) {
        const int off = (row0 + 8 * i) * TROW + ch * 16;
        *(LAS u32x4*)(buf + off) = t.k[i]; *(LAS u32x4*)(buf + 32 * TROW + off) = t.v[i];
    }
}
DI void load_kfrag(bf16x8 (&kf)[4], LAS unsigned char* buf, int lane) {
    const int r = lane & 31, h = lane >> 5;
#pragma unroll
    for (int ks = 0; ks < 4; ++ks) kf[ks] = *(const LAS bf16x8*)(buf + r * TROW + (2 * ks + h) * 16);
}
DI void load_vfrag(bf16x8 (&vf)[2][2], LAS unsigned char* buf, int lane) {
    const int h = lane >> 5, q = (lane & 15) >> 2, p = lane & 3, blk = (lane >> 4) & 1;
    LAS unsigned char* vb = buf + 32 * TROW + (4 * h + q) * TROW + 32 * blk + 8 * p;
#pragma unroll
    for (int dt = 0; dt < 2; ++dt)
#pragma unroll
        for (int s2 = 0; s2 < 2; ++s2) {
            const s16x4 lo = __builtin_amdgcn_ds_read_tr16_b64_v4i16((LAS s16x4*)(vb + (16 * s2) * TROW + 64 * dt));
            const s16x4 hi4 = __builtin_amdgcn_ds_read_tr16_b64_v4i16((LAS s16x4*)(vb + (16 * s2 + 8) * TROW + 64 * dt));
            vf[dt][s2] = __builtin_shufflevector(lo, hi4, 0, 1, 2, 3, 4, 5, 6, 7);
        }
}
DI void qk_mfma(f32x16& s, const bf16x8 (&kf)[4], const bf16x8 (&qf)[4]) {
#pragma unroll
    for (int i = 0; i < 16; ++i) s[i] = 0.f;
#pragma unroll
    for (int ks = 0; ks < 4; ++ks) s = MFMA32(kf[ks], qf[ks], s);
}
DI void softmax_p(ASt& st, f32x16& s, int dist0, int kstride, int hi, bool lane_ok, bool elem) {
    if (elem) {
        int d0 = dist0; asm volatile("" : "+v"(d0));
#pragma unroll
        for (int i = 0; i < 16; ++i) {
            const unsigned dist = (unsigned)(d0 - kstride * ((i & 3) + 8 * (i >> 2)));
            s[i] = (dist <= (unsigned)hi) ? s[i] : NEGBIG;
        }
    }
    float ps0 = 0.f, ps1 = 0.f;
#pragma unroll
    for (int i = 0; i < 16; i += 2) { s[i] = __builtin_amdgcn_exp2f(s[i]); s[i + 1] = __builtin_amdgcn_exp2f(s[i + 1]); ps0 += s[i]; ps1 += s[i + 1]; }
    st.l += lane_ok ? (ps0 + ps1) : 0.f;
}
DI void pv_mfma(ASt& st, const f32x16& s, const bf16x8 (&vf)[2][2]) {
#pragma unroll
    for (int s2 = 0; s2 < 2; ++s2) {
        u32x4 p;
        p.x = cvt_pk(s[8 * s2 + 0], s[8 * s2 + 1]); p.y = cvt_pk(s[8 * s2 + 2], s[8 * s2 + 3]);
        p.z = cvt_pk(s[8 * s2 + 4], s[8 * s2 + 5]); p.w = cvt_pk(s[8 * s2 + 6], s[8 * s2 + 7]);
        const bf16x8 pb = __builtin_bit_cast(bf16x8, p);
        st.o0 = MFMA32(vf[0][s2], pb, st.o0);
        st.o1 = MFMA32(vf[1][s2], pb, st.o1);
    }
}
DI void pack_p(bf16x8 (&pb)[2], const f32x16& s, bool lane_ok) {
    const unsigned lm = lane_ok ? 0xffffffffu : 0u;
#pragma unroll
    for (int s2 = 0; s2 < 2; ++s2) {
        u32x4 p;
        p.x = cvt_pk(s[8 * s2 + 0], s[8 * s2 + 1]) & lm; p.y = cvt_pk(s[8 * s2 + 2], s[8 * s2 + 3]) & lm;
        p.z = cvt_pk(s[8 * s2 + 4], s[8 * s2 + 5]) & lm; p.w = cvt_pk(s[8 * s2 + 6], s[8 * s2 + 7]) & lm;
        pb[s2] = __builtin_bit_cast(bf16x8, p);
    }
}
DI bf16x8 load_vfrag1(LAS unsigned char* vb, int dt, int s2) {
    const s16x4 lo = __builtin_amdgcn_ds_read_tr16_b64_v4i16((LAS s16x4*)(vb + (16 * s2) * TROW + 64 * dt));
    const s16x4 hi4 = __builtin_amdgcn_ds_read_tr16_b64_v4i16((LAS s16x4*)(vb + (16 * s2 + 8) * TROW + 64 * dt));
    return __builtin_shufflevector(lo, hi4, 0, 1, 2, 3, 4, 5, 6, 7);
}
DI void core2(QT& a, QT& b, LAS unsigned char* buf, int dist0a, int dist0b, int kstride, int hi, bool elem, bool oka, bool okb, float m0, int lane) {
    const int r = lane & 31, h = lane >> 5;
    f32x16 sa, sb;
    {
        const float c = -m0;
        const f32x16 cinit = {c, c, c, c, c, c, c, c, c, c, c, c, c, c, c, c};
        const bf16x8 kf = *(const LAS bf16x8*)(buf + r * TROW + h * 16); sa = MFMA32(kf, a.qf[0], cinit); sb = MFMA32(kf, b.qf[0], cinit);
    }
#pragma unroll
    for (int ks = 1; ks < 4; ++ks) { const bf16x8 kf = *(const LAS bf16x8*)(buf + r * TROW + (2 * ks + h) * 16); sa = MFMA32(kf, a.qf[ks], sa); sb = MFMA32(kf, b.qf[ks], sb); }
    LAS unsigned char* vb = buf + 32 * TROW + (4 * h + ((lane & 15) >> 2)) * TROW + 32 * ((lane >> 4) & 1) + 8 * (lane & 3);
    softmax_p(a.st, sa, dist0a, kstride, hi, oka, elem);
    {
        bf16x8 pa[2]; pack_p(pa, sa, oka);
#pragma unroll
        for (int s2 = 0; s2 < 2; ++s2) {
            const bf16x8 v0 = load_vfrag1(vb, 0, s2), v1 = load_vfrag1(vb, 1, s2);
            a.st.o0 = MFMA32(v0, pa[s2], a.st.o0); a.st.o1 = MFMA32(v1, pa[s2], a.st.o1);
        }
    }
    softmax_p(b.st, sb, dist0b, kstride, hi, okb, elem);
    {
        bf16x8 pb[2]; pack_p(pb, sb, okb);
#pragma unroll
        for (int s2 = 0; s2 < 2; ++s2) {
            const bf16x8 v0 = load_vfrag1(vb, 0, s2), v1 = load_vfrag1(vb, 1, s2);
            b.st.o0 = MFMA32(v0, pb[s2], b.st.o0); b.st.o1 = MFMA32(v1, pb[s2], b.st.o1);
        }
    }
}
DI bool band_all_ok(int dist0, int kstride, int hi, int h) {
    const int d_first = dist0 + kstride * 4 * h, d_last = d_first - 31 * kstride;
    return (d_last >= 0) && (d_first <= hi);
}
DI void band2(QT& a, QT& b, LAS unsigned char* buf, int dist0a, int dist0b, int kstride, int hi, int who, float m0, int lane) {
    const bool oka = who != 1, okb = who != 0;
    const bool allok = (!oka || band_all_ok(dist0a, kstride, hi, lane >> 5)) && (!okb || band_all_ok(dist0b, kstride, hi, lane >> 5));
    const bool elem = __builtin_amdgcn_ballot_w64(!allok) != 0ull;
    core2(a, b, buf, dist0a, dist0b, kstride, hi, elem, oka, okb, m0, lane);
}

DI void attn_finish(ASt& st, float sink_l2, float m0, const bf16_t* zs, bf16_t* y, size_t rowoff  , int h) {
    float l = st.l + __shfl_xor(st.l, 32);
    l += (sink_l2 > -1e29f) ? __builtin_amdgcn_exp2f(sink_l2 - m0) : 0.f;
    const float inv = 1.0f / l;
#pragma unroll
    for (int dt = 0; dt < 2; ++dt)
#pragma unroll
        for (int g = 0; g < 4; ++g) {
            const size_t off = rowoff + 32 * dt + 8 * g + 4 * h;
            const u32x2 z = *(const u32x2*)(zs + off);
            const float v0 = (dt ? st.o1[4 * g + 0] : st.o0[4 * g + 0]) * inv * bf_lo(z.x);
            const float v1 = (dt ? st.o1[4 * g + 1] : st.o0[4 * g + 1]) * inv * bf_hi(z.x);
            const float v2 = (dt ? st.o1[4 * g + 2] : st.o0[4 * g + 2]) * inv * bf_lo(z.y);
            const float v3 = (dt ? st.o1[4 * g + 3] : st.o0[4 * g + 3]) * inv * bf_hi(z.y);
            u32x2 w; w.x = cvt_pk(v0, v1); w.y = cvt_pk(v2, v3);
            *(u32x2*)(y + off) = w;
        }
}

DI bool a_tile_desc(int tau, int ra, int i0, int& kbase, int& kstride, int& hi, int& who) {
    if (tau < 10) { const int t = (tau < 5) ? tau : tau - 5; const int jb = i0 - 128 + 32 * t; who = (tau < 5) ? 0 : 1; kbase = ra + 8 * who + 16 * jb; kstride = 16; hi = 2048; return jb >= 0; }
    who = 2;
    if (tau < 18) { const int ub = 4 * i0 - 128 + 32 * (tau - 10); kbase = (ra & 3) + 4 * ub; kstride = 4; hi = 512; return ub >= 0; }
    { const int kb = 16 * i0 - 128 + 32 * (tau - 18); kbase = kb; kstride = 1; hi = 128; return kb >= 0; }
}
DI int a_next(int tau, int ra, int i0) { int t = tau + 1, kb, ks, hi, who; while (t < 38 && !a_tile_desc(t, ra, i0, kb, ks, hi, who)) ++t; return t; }
DI void attn_a_item(unsigned char* ws, LAS unsigned char* buf, int bh, int ra, int i0, int lane) {
    const int r = lane & 31, h = lane >> 5;
    const bf16_t* Q = (const bf16_t*)(ws + WS_QA) + (size_t)bh * SEQ * 64;
    const bf16_t* K = (const bf16_t*)(ws + WS_KA) + (size_t)bh * SEQ * 64;
    const bf16_t* V = (const bf16_t*)(ws + WS_VTA) + (size_t)bh * SEQ * 64;
    const int qpa = ra + 16 * (i0 + r), qpb = qpa + 8;
    const float m0 = ((const float*)(ws + WS_GAINS))[400];
    QT a, b; qt_init(a, Q + (size_t)qpa * 64, h); qt_init(b, Q + (size_t)qpb * 64, h);
    TileRegs tr;
    int tc = a_next(-1, ra, i0);
    { int kb, ks, hi, who; (void)a_tile_desc(tc, ra, i0, kb, ks, hi, who); tile_gload(tr, K, V, kb, ks, lane); }
    for (;;) {
        tile_lds_write(buf, tr, lane);
        const int tn = a_next(tc, ra, i0);
        if (tn < 38) { int kb, ks, hi, who; (void)a_tile_desc(tn, ra, i0, kb, ks, hi, who); tile_gload(tr, K, V, kb, ks, lane); }
        {
            int kb, ks, hi, who; (void)a_tile_desc(tc, ra, i0, kb, ks, hi, who);
            const int d0a = qpa - kb - ks * 4 * h, d0b = qpb - kb - ks * 4 * h;
            band2(a, b, buf, d0a, d0b, ks, hi, who, m0, lane);
        }
        if (tn >= 38) break;
        tc = tn;
    }
    const int bb = bh >> 3, head = bh & 7;
    attn_finish(a.st, NEGBIG, m0, (const bf16_t*)(ws + WS_ZS), (bf16_t*)(ws + WS_Y), ((size_t)bb * SEQ + qpa) * DM + head * 64, h);
    attn_finish(b.st, NEGBIG, m0, (const bf16_t*)(ws + WS_ZS), (bf16_t*)(ws + WS_Y), ((size_t)bb * SEQ + qpb) * DM + head * 64, h);
}

DI unsigned moba_select(const bf16x8 (&qf)[4], LAS float* km, int qblk, int h) {
    float v1 = -3e38f, v2 = -3e38f, v3 = -3e38f; int i1 = 31, i2 = 31, i3 = 31;
    for (int n = 0; n < qblk; ++n) {
        float g = 0.f;
#pragma unroll
        for (int ks = 0; ks < 4; ++ks) {
            const LAS f32x4* kp = (const LAS f32x4*)(km + n * 64 + 16 * ks + 8 * h);
            const f32x4 x = kp[0], y = kp[1];
            const u32x4 qu = __builtin_bit_cast(u32x4, qf[ks]);
            g += bf_lo(qu.x) * x[0] + bf_hi(qu.x) * x[1] + bf_lo(qu.y) * x[2] + bf_hi(qu.y) * x[3]
               + bf_lo(qu.z) * y[0] + bf_hi(qu.z) * y[1] + bf_lo(qu.w) * y[2] + bf_hi(qu.w) * y[3];
        }
        g += __shfl_xor(g, 32);
        if (g > v1) { v3 = v2; i3 = i2; v2 = v1; i2 = i1; v1 = g; i1 = n; }
        else if (g > v2) { v3 = v2; i3 = i2; v2 = g; i2 = n; }
        else if (g > v3) { v3 = g; i3 = n; }
    }
    unsigned sel = 0u;
    if (i1 < 16) sel |= 1u << i1;
    if (i2 < 16) sel |= 1u << i2;
    if (i3 < 16) sel |= 1u << i3;
    return sel;
}
DI void attn_b_item(unsigned char* ws, LAS unsigned char* buf, LAS float* km  , int bh, int qblk, int w4, int lane) {
    const int r = lane & 31, h = lane >> 5;
    const bf16_t* Q = (const bf16_t*)(ws + WS_QB) + (size_t)bh * SEQ * 64;
    const bf16_t* K = (const bf16_t*)(ws + WS_KB) + (size_t)bh * SEQ * 64;
    const bf16_t* V = (const bf16_t*)(ws + WS_VTB) + (size_t)bh * SEQ * 64;
    const int qpa = qblk * 256 + w4 * 64 + r, qpb = qpa + 32;
    const float m0 = ((const float*)(ws + WS_GAINS))[401];
    QT a, b; qt_init(a, Q + (size_t)qpa * 64, h); qt_init(b, Q + (size_t)qpb * 64, h);
    const unsigned sela = moba_select(a.qf, km, qblk, h), selb = moba_select(b.qf, km, qblk, h);
    unsigned uni = 0u;
    for (int n = 0; n < qblk; ++n) { if (__builtin_amdgcn_ballot_w64(((sela | selb) >> n) & 1u) != 0ull) uni |= 1u << n; }
    uni |= 1u << qblk;
    const int own_tiles = 2 * w4 + 2;
    TileRegs tr;
#define B_ADV(n_, T_, ok_) do { const int cnt_ = ((n_) == qblk) ? own_tiles : 8; if (++(T_) >= cnt_) { const unsigned rest_ = uni & ~((2u << (n_)) - 1u); if (rest_) { (n_) = __builtin_ctz(rest_); (T_) = 0; } else (ok_) = false; } } while (0)
    int nc = __builtin_ctz(uni), Tc = 0; bool okc = true;
    tile_gload(tr, K, V, nc * 256, 1, lane);
    for (;;) {
        tile_lds_write(buf, tr, lane);
        int nl = nc, Tl = Tc; bool okl = true; B_ADV(nl, Tl, okl);
        if (okl) tile_gload(tr, K, V, nl * 256 + 32 * Tl, 1, lane);
        {
            const int kb = nc * 256 + 32 * Tc;
            const bool own = (nc == qblk);
            const bool oka = own ? (Tc <= 2 * w4) : (((sela >> nc) & 1u) != 0u), okb = own ? true : (((selb >> nc) & 1u) != 0u);
            core2(a, b, buf, qpa - kb - 4 * h, qpb - kb - 4 * h, 1, 0x7fffffff, own && (Tc >= 2 * w4), oka, okb, m0, lane);
        }
        if (!okl) break;
        nc = nl; Tc = Tl;
    }
#undef B_ADV
    const int bb = bh >> 3, head = 8 + (bh & 7);
    attn_finish(a.st, NEGBIG, m0, (const bf16_t*)(ws + WS_ZS), (bf16_t*)(ws + WS_Y), ((size_t)bb * SEQ + qpa) * DM + head * 64, h);
    attn_finish(b.st, NEGBIG, m0, (const bf16_t*)(ws + WS_ZS), (bf16_t*)(ws + WS_Y), ((size_t)bb * SEQ + qpb) * DM + head * 64, h);
}

DI void attn_c_item(unsigned char* ws, LAS unsigned char* buf, int b, int hq, int chunk, int wid, int lane) {
    const int r = lane & 31, h = lane >> 5, kvh = hq >> 3;
    const bf16_t* Qa = (const bf16_t*)(ws + WS_QC) + ((size_t)b * 16 + hq) * SEQ * 64;
    const bf16_t* K = (const bf16_t*)(ws + WS_KC) + ((size_t)b * 2 + kvh) * SEQ * 64;
    const bf16_t* V = (const bf16_t*)(ws + WS_VTC) + ((size_t)b * 2 + kvh) * SEQ * 64;
    const int t0 = chunk * 256 + wid * 32, qpos = t0 + r;
    const float m0 = ((const float*)(ws + WS_GAINS))[402];
    QT qa, qb; qt_init(qa, Qa + (size_t)qpos * 64, h); qt_init(qb, Qa + (size_t)SEQ * 64 + (size_t)qpos * 64, h);
    TileRegs tr;
    int T = (t0 >= 128) ? 0 : (128 - t0) / 32;
    tile_gload(tr, K, V, t0 - 128 + 32 * T, 1, lane);
    for (;;) {
        tile_lds_write(buf, tr, lane);
        const bool have = (T + 1) < 5;
        if (have) tile_gload(tr, K, V, t0 - 128 + 32 * (T + 1), 1, lane);
        const int d0 = qpos - (t0 - 128 + 32 * T) - 4 * h;
        band2(qa, qb, buf, d0, d0, 1, 127, 2, m0, lane);
        if (!have) break;
        ++T;
    }
    const float* sinks = (const float*)(ws + WS_GAINS) + 384;
    const size_t rowoff = ((size_t)b * SEQ + qpos) * DM + hq * 64;
    attn_finish(qa.st, sinks[hq] * 1.44269504088896341f, m0, (const bf16_t*)(ws + WS_ZS1), (bf16_t*)(ws + WS_Y), rowoff, h);
    attn_finish(qb.st, sinks[hq + 1] * 1.44269504088896341f, m0, (const bf16_t*)(ws + WS_ZS1), (bf16_t*)(ws + WS_Y), rowoff + 64, h);
}

#define XB_TMO      128
#define XB_XCNT(j)  (256  + 64 * (j))
#define XB_XSUB(j)  (1280 + 64 * (j))
#define XB_XGEN(j)  (2304 + 64 * (j))
#define XB_TOP      3328
#define XB_TOPGEN   3392
#define XCD_BAR_WORDS 3456
#define XB_SPIN_CAP (1u << 18)

__device__ __forceinline__ unsigned xb_ld(unsigned* p)              { return __hip_atomic_load(p, __ATOMIC_RELAXED, __HIP_MEMORY_SCOPE_AGENT); }
__device__ __forceinline__ unsigned xb_add(unsigned* p, unsigned v) { return __hip_atomic_fetch_add(p, v, __ATOMIC_RELAXED, __HIP_MEMORY_SCOPE_AGENT); }
__device__ __forceinline__ unsigned xb_xcc_id() { return (unsigned)__builtin_amdgcn_s_getreg((3 << 11) | 20) & 0xFu; }
#define XB_SPIN(cond, bar) do { unsigned _sp = 0; while (cond) { __builtin_amdgcn_s_sleep(1); \
    if ((++_sp & 255u) == 0u) { if (xb_ld(&(bar)[XB_TMO])) break; if (_sp > XB_SPIN_CAP) { atomicAdd(&(bar)[XB_TMO], 1u); break; } } } } while (0)

struct XcdBarrier {
    unsigned* bar; unsigned x;
    volatile LAS unsigned* st;
};

__device__ __forceinline__ XcdBarrier xcd_barrier_post(unsigned* bar, volatile LAS unsigned* st) {
    XcdBarrier b; b.bar = bar; b.x = xb_xcc_id(); b.st = st;
    if (threadIdx.x == 0) (void)xb_add(&bar[XB_XCNT(b.x)], 1u);
    return b;
}
__device__ __forceinline__ void xcd_barrier_complete(unsigned* bar, unsigned x, unsigned& nloc, unsigned& nx) {
    const unsigned G = gridDim.x * gridDim.y * gridDim.z;
    unsigned sum, cnt, mine, sp = 0u;
    for (;;) {
        sum = 0u; cnt = 0u; mine = 0u;
#pragma unroll
        for (unsigned j = 0; j < 16; ++j) { const unsigned c = xb_ld(&bar[XB_XCNT(j)]); sum += c; cnt += (c > 0u) ? 1u : 0u; mine = (j == x) ? c : mine; }
        if (sum == G) break;
        __builtin_amdgcn_s_sleep(1);
        if ((++sp & 255u) == 0u) { if (xb_ld(&bar[XB_TMO])) break; if (sp > XB_SPIN_CAP) { atomicAdd(&bar[XB_TMO], 1u); break; } }
    }
    nloc = mine > 0u ? mine : 1u; nx = cnt > 0u ? cnt : 1u;
}

__device__ __forceinline__ void xcd_barrier(const XcdBarrier& b) {
    asm volatile("s_waitcnt vmcnt(0)" ::: "memory");
    __syncthreads();
    if (threadIdx.x == 0) {
        unsigned* bar = b.bar;
        __builtin_amdgcn_s_waitcnt(0);
        unsigned nloc = b.st[0], nx = b.st[1];
        if (nloc == 0u) { xcd_barrier_complete(bar, b.x, nloc, nx); b.st[0] = nloc; b.st[1] = nx; }
        const unsigned old = xb_add(&bar[XB_XSUB(b.x)], 1u);
        const unsigned gen = old / nloc;
        if (old + 1u == (gen + 1u) * nloc) {
            __builtin_amdgcn_fence(__ATOMIC_RELEASE, "agent");
            asm volatile("s_waitcnt vmcnt(0)" ::: "memory");
            const unsigned og = xb_add(&bar[XB_TOP], 1u);
            const unsigned tg = og / nx;
            if (og + 1u == (tg + 1u) * nx) xb_add(&bar[XB_TOPGEN], 1u);
            else XB_SPIN(xb_ld(&bar[XB_TOPGEN]) == tg, bar);
            __builtin_amdgcn_fence(__ATOMIC_ACQUIRE, "agent");
            xb_add(&bar[XB_XGEN(b.x)], 1u);
            asm volatile("s_waitcnt vmcnt(0)" ::: "memory");
        } else {
            XB_SPIN(xb_ld(&bar[XB_XGEN(b.x)]) == gen, bar);
            __builtin_amdgcn_fence(__ATOMIC_ACQUIRE, "agent");
            asm volatile("s_waitcnt vmcnt(0)" ::: "memory");
        }
    }
    __syncthreads();
}


__global__ void __launch_bounds__(NTHREADS) fwd_megakernel(Params P) {
    extern __shared__ __attribute__((aligned(16))) unsigned char lds_raw[];
    cg::grid_group grid = cg::this_grid();
    LAS unsigned char* lds = (LAS unsigned char*)lds_raw;
    unsigned char* ws = P.ws;
    const int G = gridDim.x, bid = blockIdx.x;
    volatile LAS unsigned* xb_st = (volatile LAS unsigned*)(lds + LDS_BYTES - 16);
    if (threadIdx.x == 0) { xb_st[0] = 0u; xb_st[1] = 0u; }
    __syncthreads();
    const XcdBarrier xbar = xcd_barrier_post((unsigned*)(ws + WS_BAR), xb_st);
#define PHASE_IDS() int tid_l = threadIdx.x; asm volatile("" : "+v"(tid_l)); const int tid = tid_l, lane = tid & 63, wid = __builtin_amdgcn_readfirstlane(tid >> 6); (void)lane; (void)wid

    if constexpr (PH_MASK & 1) { for (int rep = 0; rep < NREP(0); ++rep) p0_prologue(P, lds); }
    if (G == 0x7fffffff) grid.sync();
    xcd_barrier(xbar);

    if constexpr ((PH_MASK & 2) != 0) {
        pg8::Gemm g{(const bf16_t*)(ws + WS_XB), (const bf16_t*)(ws + WS_BT0), NTOK, N_IN0, DM};
        pg8::StaticOrder S; S.init(NTOK, N_IN0, G, bid);
        EpiIn E{0, ws};
        for (int rep = 0; rep < NREP(1); ++rep) pg8::gemm_phase<EpiIn, pg8::StaticOrder, true, true>(lds, g, S, E);
    }
    xcd_barrier(xbar);

    if constexpr ((PH_MASK & 4) != 0) {
        PHASE_IDS();
        LAS float* km = (LAS float*)(lds + 8 * TBUF);
        LAS unsigned char* buf = lds + wid * TBUF;
        const float* kmp = (const float*)(ws + WS_KMP);
#define P2_DECODE(it_) const int itt = (it_) & 511, j = itt >> 8, c = itt & 255, xcd = c & 7, slot = c >> 3, idx = j * 32 + slot;   \
                       const int bh = xcd * 8 + (idx >> 3), sub = idx & 7; (void)j
#define P2_STAGE_KM(tab_, bh_) do { for (int e = tid; e < 1024; e += NTHREADS) km[(tab_) * 1024 + e] = kmp[(size_t)(bh_) * 1024 + e] + kmp[(size_t)(64 + (bh_)) * 1024 + e]; } while (0)
        for (int rep = 0; rep < 2; ++rep) {
            if (rep == 0 || NREP(2) == 2) {
                __syncthreads();
                { int k = 0; for (int it = bid; it < 512 && k < 2; it += G, ++k) { P2_DECODE(it); (void)sub; P2_STAGE_KM(k, bh); } }
                __syncthreads();
                int k = 0;
                for (int it = bid; it < 512; it += G, ++k) {
                    P2_DECODE(it);
                    if (k >= 2) { __syncthreads(); P2_STAGE_KM(k & 1, bh); __syncthreads(); }
                    const bool lo = (wid < 4) != ((k & 1) != 0);
                    attn_b_item(ws, buf, km + (k & 1) * 1024, bh, lo ? sub : 15 - sub, wid & 3, lane);
                }
            }
            if (rep == 0 || NREP(7) == 2) {
                for (int it = 512 + bid; it < 1024; it += G) { P2_DECODE(it); attn_a_item(ws, buf, bh, wid, sub * 32, lane); }
            }
        }
#undef P2_DECODE
#undef P2_STAGE_KM
    }
    xcd_barrier(xbar);

    if constexpr ((PH_MASK & 8) != 0) {
        pg8::Gemm g{(const bf16_t*)(ws + WS_Y), (const bf16_t*)(ws + WS_BT1), NTOK, DM, DM};
        pg8::StaticOrder S; S.init(NTOK, DM, G, bid);
        EpiOut E{P.x, (float*)(ws + WS_X1), (bf16_t*)(ws + WS_X1B), (float*)(ws + WS_SSQ)};
        for (int rep = 0; rep < NREP(3); ++rep) pg8::gemm_phase<EpiOut, pg8::StaticOrder, true, true>(lds, g, S, E);
    }
    xcd_barrier(xbar);

    if constexpr ((PH_MASK & 16) != 0) {
        pg8::Gemm g{(const bf16_t*)(ws + WS_X1B), (const bf16_t*)(ws + WS_BT2), NTOK, N_IN1, DM};
        pg8::StaticOrder S; S.init(NTOK, N_IN1, G, bid);
        EpiIn E{1, ws};
        for (int rep = 0; rep < NREP(4); ++rep) pg8::gemm_phase<EpiIn, pg8::StaticOrder, true, true>(lds, g, S, E);
    }
    xcd_barrier(xbar);

    if constexpr ((PH_MASK & 32) != 0) {
        PHASE_IDS();
        for (int rep = 0; rep < NREP(5); ++rep)
        for (int it = bid; it < 1024; it += G) {
            const int j = it >> 8, c = it & 255, xcd = c & 7, slot = c >> 3, idx = j * 32 + slot;
            const int bkv = xcd * 2 + (idx >> 6), rem = idx & 63, hq = (bkv & 1) * 8 + 2 * (rem >> 4), chunk = rem & 15;
            attn_c_item(ws, lds + wid * TBUF, bkv >> 1, hq, chunk, wid, lane);
        }
    }
    xcd_barrier(xbar);

    if constexpr ((PH_MASK & 64) != 0) {
        pg8::Gemm g{(const bf16_t*)(ws + WS_Y), (const bf16_t*)(ws + WS_BT3), NTOK, DM, DM};
        pg8::StaticOrder S; S.init(NTOK, DM, G, bid);
        EpiOut E{(const float*)(ws + WS_X1), P.out, nullptr, nullptr};
        for (int rep = 0; rep < NREP(6); ++rep) pg8::gemm_phase<EpiOut, pg8::StaticOrder, true, true>(lds, g, S, E);
    }
}

extern "C" void kernel_launch(void* const* d_in, const int* in_sizes, int n_in, void* d_out, int out_size, void* d_ws, size_t ws_size, hipStream_t stream) {
    static int grid_blocks = 0;
    if (grid_blocks == 0) {
        if (n_in != 14 || in_sizes[0] != NTOK * DM || out_size != NTOK * DM || ws_size < WS_END) {
            fprintf(stderr, "kernel_launch: unexpected shapes (n_in %d in0 %d out %d ws %zu)\n", n_in, n_in > 0 ? in_sizes[0] : -1, out_size, ws_size); grid_blocks = -1; return; }
        int dev = 0, cus = 0, per_cu = 0;
        hipGetDevice(&dev);
        hipDeviceGetAttribute(&cus, hipDeviceAttributeMultiprocessorCount, dev);
        if (hipFuncSetAttribute((const void*)fwd_megakernel, hipFuncAttributeMaxDynamicSharedMemorySize, LDS_BYTES) != hipSuccess) {
            fprintf(stderr, "kernel_launch: hipFuncSetAttribute failed\n"); grid_blocks = -1; return; }
        if (hipOccupancyMaxActiveBlocksPerMultiprocessor(&per_cu, (const void*)fwd_megakernel, NTHREADS, LDS_BYTES) != hipSuccess || per_cu < 1) {
            fprintf(stderr, "kernel_launch: occupancy query gave %d\n", per_cu); per_cu = 1; (void)hipGetLastError(); }
        grid_blocks = cus * 1;
        if (per_cu < 1) grid_blocks = -1;
    }
    if (grid_blocks < 0) return;
    Params p{};
    p.x = (const float*)d_in[0]; p.norm_even = (const float*)d_in[1]; p.w_in_even = (const float*)d_in[2]; p.w_out_even = (const float*)d_in[3];
    p.qn_a = (const float*)d_in[4]; p.kn_a = (const float*)d_in[5]; p.qn_b = (const float*)d_in[6]; p.kn_b = (const float*)d_in[7];
    p.norm_odd = (const float*)d_in[8]; p.w_in_odd = (const float*)d_in[9]; p.w_out_odd = (const float*)d_in[10];
    p.qn_c = (const float*)d_in[11]; p.kn_c = (const float*)d_in[12]; p.sinks = (const float*)d_in[13];
    p.out = (float*)d_out; p.ws = (unsigned char*)d_ws;
    if (hipMemsetAsync((unsigned char*)d_ws + WS_BAR, 0, XCD_BAR_WORDS * 4, stream) != hipSuccess) { fprintf(stderr, "kernel_launch: memset failed\n"); return; }
    void* args[] = {&p};
    hipError_t e = hipLaunchCooperativeKernel((const void*)fwd_megakernel, dim3(grid_blocks), dim3(NTHREADS), args, LDS_BYTES, stream);
    if (e != hipSuccess) fprintf(stderr, "cooperative launch failed: %s (grid %d)\n", hipGetErrorString(e), grid_blocks);
}
```

```cpp
#include <hip/hip_runtime.h>
#include <hip/hip_cooperative_groups.h>
#include <cstdio>
#include <cstdint>
namespace cg = cooperative_groups;
namespace pg8 {
#define PG8_LAS __attribute__((address_space(3)))
typedef unsigned short bf16_t;
typedef short bf16x8 __attribute__((ext_vector_type(8)));
typedef float f32x4 __attribute__((ext_vector_type(4)));
typedef unsigned u32x4 __attribute__((ext_vector_type(4)));
constexpr int BM = 256, BK = 64, HALF = 128, HTB = HALF * BK * 2  , STAGE_BYTES = 8 * HTB, NXCD = 8, WGM = 8;

__host__ __device__ __forceinline__ int lds_byte(int r, int c) { const int st = (r >> 4) * 2 + (c >> 5), rr = r & 15, cc = c & 31, ob = rr * 64 + cc * 2; return st * 1024 + (ob ^ (((ob >> 9) & 1) << 5)); }
__host__ __device__ __forceinline__ void stage_rc(int b, int& R, int& C) { const int st = b / 1024, sb = b % 1024, swz = sb ^ (((sb >> 9) & 1) << 5); R = (st >> 1) * 16 + swz / 64; C = (st & 1) * 32 + (swz % 64) / 2; }
__host__ __device__ __forceinline__ int perm32(int rho) { const int n = rho >> 4, i = rho & 15; return 8 * (i >> 2) + 4 * n + (i & 3); }

struct Unit { int pm, pn; };
struct Gemm { const bf16_t* A; const bf16_t* Bt; int M, N, K; };

struct StaticOrder {
    int nM, nN, nwg, G, c;
    __host__ __device__ void init(int M, int N, int G_, int c_) { nM = M / BM; nN = N / BM; nwg = nM * nN; G = G_; c = c_; }
    __host__ __device__ bool next(int i, Unit& u) const {
        const long L = (long)i * G + c; if (L >= nwg) return false;
        int wgid = (int)L; { const int q = nwg / NXCD, r = nwg % NXCD, xcd = wgid % NXCD, off = wgid / NXCD; wgid = (xcd < r ? xcd * (q + 1) : r * (q + 1) + (xcd - r) * q) + off; }
        const int nig = WGM * nN, gid = wgid / nig, fm = gid * WGM, gsz = (nM - fm) < WGM ? (nM - fm) : WGM;
        u.pm = fm + ((wgid % nig) % gsz); u.pn = (wgid % nig) / gsz; return true;
    }
    __device__ __forceinline__ void a_ready(const Unit&) const {}
    __device__ __forceinline__ void done(const Unit&) const {}
};

template <class Epi, class Sched, bool ALIGN_EPI = false, bool SP2 = false>
__device__ __forceinline__ void gemm_phase(PG8_LAS unsigned char* lds, const Gemm g, const Sched& S, const Epi& E) {
    int tid_l = threadIdx.x; asm volatile("" : "+v"(tid_l));
    const int tid = tid_l, wid = __builtin_amdgcn_readfirstlane(tid >> 6), lane = tid & 63, wr = wid >> 2, wc = wid & 3, fr = lane & 15, fq = lane >> 4;
    const int K = g.K, nt = K / BK;
    unsigned voffA[2], voffB[2];
#pragma unroll
    for (int i = 0; i < 2; ++i) { int R, C; stage_rc(tid * 16 + i * 8192, R, C); const int Rb = Epi::PERM ? ((R & ~31) + perm32(R & 31)) : R;
        voffA[i] = (unsigned)(R * K + C) * 2u; voffB[i] = (unsigned)(Rb * K + C) * 2u; }
    const size_t kstep = (size_t)(BK * 2);
    const size_t hstep = (size_t)HALF * K * 2;
    const size_t tstep = 2 * hstep;
    const unsigned ldsw = (unsigned)wid * 1024u;
    const int aoff = lds_byte(wr * 64 + fr, fq * 8), boff = lds_byte(wc * 32 + fr, fq * 8);
#define PG8_SA(b, h) (((b) * 2 + (h)) * HTB)
#define PG8_SB(b, h) ((4 + (b) * 2 + (h)) * HTB)
#define PG8_STAGE(bufoff, gbase, voff) do { _Pragma("unroll") for (int _i = 0; _i < 2; ++_i) \
        __builtin_amdgcn_global_load_lds((const unsigned*)((const char*)(gbase) + (voff)[_i]), (PG8_LAS unsigned*)(lds + (bufoff) + ldsw + _i * 8192), 16, 0, 0); } while (0)
#define PG8_LDA(dst, b, h) do { _Pragma("unroll") for (int m = 0; m < 4; ++m) _Pragma("unroll") for (int k = 0; k < 2; ++k) dst[m][k] = *(const PG8_LAS bf16x8*)(lds + PG8_SA(b, h) + aoff + m * 2048 + k * 1024); } while (0)
#define PG8_LDB(dst, b, h) do { _Pragma("unroll") for (int n = 0; n < 2; ++n) _Pragma("unroll") for (int k = 0; k < 2; ++k) dst[n][k] = *(const PG8_LAS bf16x8*)(lds + PG8_SB(b, h) + boff + n * 2048 + k * 1024); } while (0)
#define PG8_MMA(ai, bj, At, Bt) do { __builtin_amdgcn_s_setprio(1); _Pragma("unroll") for (int m = 0; m < 4; ++m) _Pragma("unroll") for (int n = 0; n < 2; ++n) _Pragma("unroll") for (int k = 0; k < 2; ++k) \
        acc[ai][bj][m][n] = __builtin_amdgcn_mfma_f32_16x16x32_bf16(Bt[n][k], At[m][k], acc[ai][bj][m][n], 0, 0, 0); __builtin_amdgcn_s_setprio(0); } while (0)
#define PG8_WAIT_V(n) asm volatile("s_waitcnt vmcnt(" #n ")" ::: "memory")
#define PG8_WAIT_L(n) asm volatile("s_waitcnt lgkmcnt(" #n ")" ::: "memory")
#define PG8_BAR __builtin_amdgcn_s_barrier()
#define PG8_SCHED __builtin_amdgcn_sched_barrier(0)
    Unit cur, nxt; int ui = 0;
    if (!S.next(0, cur)) return;
    f32x4 acc[2][2][4][2];
#pragma unroll
    for (int a = 0; a < 2; ++a)
#pragma unroll
        for (int b = 0; b < 2; ++b)
#pragma unroll
            for (int m = 0; m < 4; ++m)
#pragma unroll
                for (int n = 0; n < 2; ++n) acc[a][b][m][n] = (f32x4){0.f, 0.f, 0.f, 0.f};
    bf16x8 At[4][2], B0[2][2], B1[2][2];
    const char* cA = (const char*)g.A + (size_t)cur.pm * tstep; const char* cB = (const char*)g.Bt + (size_t)cur.pn * tstep;
    S.a_ready(cur);
    if constexpr (SP2) {
        PG8_STAGE(PG8_SB(0, 0), cB, voffB); PG8_STAGE(PG8_SB(0, 1), cB + hstep, voffB); PG8_STAGE(PG8_SA(0, 0), cA, voffA); PG8_STAGE(PG8_SA(0, 1), cA + hstep, voffA);
        if (wr == 1) PG8_BAR;
        PG8_WAIT_V(2); PG8_BAR;
        PG8_STAGE(PG8_SB(1, 0), cB + kstep, voffB); PG8_STAGE(PG8_SA(1, 0), cA + kstep, voffA); PG8_STAGE(PG8_SB(1, 1), cB + hstep + kstep, voffB);
        PG8_WAIT_V(6); PG8_BAR;
    } else {
        PG8_STAGE(PG8_SB(0, 0), cB, voffB); PG8_STAGE(PG8_SA(0, 0), cA, voffA); PG8_STAGE(PG8_SB(0, 1), cB + hstep, voffB); PG8_STAGE(PG8_SA(0, 1), cA + hstep, voffA);
        if (wr == 1) PG8_BAR;
        PG8_WAIT_V(4); PG8_BAR;
        PG8_STAGE(PG8_SB(1, 0), cB + kstep, voffB); PG8_STAGE(PG8_SA(1, 0), cA + kstep, voffA); PG8_STAGE(PG8_SB(1, 1), cB + hstep + kstep, voffB);
        PG8_WAIT_V(6); PG8_BAR;
    }
    for (;;) {
        const bool has_next = S.next(ui + 1, nxt);
        const char* nA = has_next ? (const char*)g.A + (size_t)nxt.pm * tstep : cA; const char* nB = has_next ? (const char*)g.Bt + (size_t)nxt.pn * tstep : cB;
        for (int t = 0; t < nt; t += 2) {
            const bool last = (t == nt - 2);
            const char* a1 = cA + (size_t)(t + 1) * kstep;
            const char* a2 = last ? nA : cA + (size_t)(t + 2) * kstep; const char* b2 = last ? nB : cB + (size_t)(t + 2) * kstep;
            const char* a3 = a2 + kstep; const char* b3 = b2 + kstep;
            if (last && has_next) S.a_ready(nxt);
            if constexpr (SP2) {
            PG8_LDB(B0, 0, 0); PG8_LDB(B1, 0, 1); PG8_SCHED; PG8_LDA(At, 0, 0); PG8_STAGE(PG8_SA(1, 1), a1 + hstep, voffA);
            PG8_WAIT_V(8); PG8_WAIT_L(0); PG8_BAR; PG8_MMA(0, 0, At, B0); PG8_MMA(0, 1, At, B1); PG8_BAR; PG8_SCHED;
            PG8_LDA(At, 0, 1); PG8_STAGE(PG8_SB(0, 0), b2, voffB); PG8_STAGE(PG8_SB(0, 1), b2 + hstep, voffB); PG8_STAGE(PG8_SA(0, 0), a2, voffA);
            PG8_WAIT_V(8); PG8_WAIT_L(0); PG8_BAR; PG8_MMA(1, 0, At, B0); PG8_MMA(1, 1, At, B1); PG8_BAR; PG8_SCHED;
            PG8_LDB(B0, 1, 0); PG8_LDB(B1, 1, 1); PG8_SCHED; PG8_LDA(At, 1, 0); PG8_STAGE(PG8_SA(0, 1), a2 + hstep, voffA);
            PG8_WAIT_V(8); PG8_WAIT_L(0); PG8_BAR; PG8_MMA(0, 0, At, B0); PG8_MMA(0, 1, At, B1); PG8_BAR; PG8_SCHED;
            PG8_LDA(At, 1, 1); PG8_STAGE(PG8_SB(1, 0), b3, voffB); PG8_STAGE(PG8_SB(1, 1), b3 + hstep, voffB); PG8_STAGE(PG8_SA(1, 0), a3, voffA);
            PG8_WAIT_V(8); PG8_WAIT_L(0); PG8_BAR; PG8_MMA(1, 0, At, B0); PG8_MMA(1, 1, At, B1); PG8_BAR; PG8_SCHED;
            } else {
            PG8_LDB(B0, 0, 0); PG8_SCHED; PG8_LDA(At, 0, 0); PG8_STAGE(PG8_SA(1, 1), a1 + hstep, voffA);
            PG8_WAIT_L(8); PG8_BAR; PG8_WAIT_L(0); PG8_MMA(0, 0, At, B0); PG8_BAR; PG8_SCHED;
            PG8_LDB(B1, 0, 1); PG8_STAGE(PG8_SB(0, 0), b2, voffB);
            PG8_BAR; PG8_WAIT_L(0); PG8_MMA(0, 1, At, B1); PG8_BAR;
            PG8_LDA(At, 0, 1); PG8_STAGE(PG8_SA(0, 0), a2, voffA);
            PG8_BAR; PG8_WAIT_L(0); PG8_MMA(1, 0, At, B0); PG8_BAR; PG8_SCHED;
            PG8_STAGE(PG8_SB(0, 1), b2 + hstep, voffB);
            PG8_WAIT_V(6); PG8_BAR; PG8_MMA(1, 1, At, B1); PG8_BAR;
            PG8_LDB(B0, 1, 0); PG8_SCHED; PG8_LDA(At, 1, 0); PG8_STAGE(PG8_SA(0, 1), a2 + hstep, voffA);
            PG8_WAIT_L(8); PG8_BAR; PG8_WAIT_L(0); PG8_MMA(0, 0, At, B0); PG8_BAR; PG8_SCHED;
            PG8_LDB(B1, 1, 1); PG8_STAGE(PG8_SB(1, 0), b3, voffB);
            PG8_BAR; PG8_WAIT_L(0); PG8_MMA(0, 1, At, B1); PG8_BAR;
            PG8_LDA(At, 1, 1); PG8_STAGE(PG8_SA(1, 0), a3, voffA);
            PG8_BAR; PG8_WAIT_L(0); PG8_MMA(1, 0, At, B0); PG8_BAR; PG8_SCHED;
            PG8_STAGE(PG8_SB(1, 1), b3 + hstep, voffB);
            PG8_WAIT_V(6); PG8_BAR; PG8_MMA(1, 1, At, B1); PG8_BAR;
            }
        }
        if constexpr (ALIGN_EPI) { if (wr == 0) PG8_BAR; }
        if constexpr (!Epi::AFTER_DRAIN) { E(acc, cur, wr, wc, fr, fq); S.done(cur); }
        if (!has_next) break;
#pragma unroll
        for (int a = 0; a < 2; ++a)
#pragma unroll
            for (int b = 0; b < 2; ++b)
#pragma unroll
                for (int m = 0; m < 4; ++m)
#pragma unroll
                    for (int n = 0; n < 2; ++n) acc[a][b][m][n] = (f32x4){0.f, 0.f, 0.f, 0.f};
        cur = nxt; cA = nA; cB = nB; ++ui;
        if constexpr (ALIGN_EPI) { if (wr == 1) PG8_BAR; }
    }
    PG8_WAIT_V(0);
    if constexpr (!ALIGN_EPI) { if (wr == 0) PG8_BAR; }
    PG8_BAR;
    if constexpr (Epi::AFTER_DRAIN) { E.fused(acc, cur, wr, wc, fr, fq, lds, wid, lane); S.done(cur); }
#undef PG8_SA
#undef PG8_SB
#undef PG8_STAGE
#undef PG8_LDA
#undef PG8_LDB
#undef PG8_MMA
#undef PG8_WAIT_V
#undef PG8_WAIT_L
#undef PG8_BAR
#undef PG8_SCHED
}
}

using pg8::bf16_t; using pg8::bf16x8; using pg8::f32x4; using pg8::u32x4; using pg8::Unit;
typedef float f32x16 __attribute__((ext_vector_type(16)));
typedef short s16x4 __attribute__((ext_vector_type(4)));
typedef unsigned u32x2 __attribute__((ext_vector_type(2)));
typedef float f32x2 __attribute__((ext_vector_type(2)));
#define DI __device__ __forceinline__
#define LAS __attribute__((address_space(3)))

constexpr int BATCH = 8, SEQ = 4096, DM = 1024, NTOK = BATCH * SEQ;
constexpr int N_IN0 = 4096, N_IN1 = 2304;
constexpr float NORM_EPS = 1e-6f;
constexpr float SC_LOG2 = 0.125f * 1.44269504088896341f;
constexpr float NEGBIG = -1e30f;
constexpr int NTHREADS = 512;
#ifndef PH_MASK
#define PH_MASK 0x7f
#endif
#ifndef PROBE_REP
#define PROBE_REP 0
#endif
#define NREP(k) (((PROBE_REP >> (k)) & 1) ? 2 : 1)
constexpr int LDS_BYTES = 131072 + 8192;

constexpr size_t MiB = 1u << 20;
constexpr size_t WS_BT0 = 0 * MiB, WS_BT1 = 8 * MiB, WS_BT2 = 10 * MiB, WS_BT3 = 15 * MiB;
constexpr size_t WS_BAR = 17 * MiB + 512 * 1024;
constexpr size_t WS_GAINS = 17 * MiB;
constexpr size_t WS_RSTD0 = 18 * MiB, WS_CS = 19 * MiB, WS_KMP = 20 * MiB, WS_SSQ = 21 * MiB;
constexpr size_t WS_XB = 32 * MiB;
constexpr size_t WS_Y = 32 * MiB;
constexpr size_t WS_QA = 96 * MiB, WS_KA = 128 * MiB, WS_VTA = 160 * MiB, WS_QB = 192 * MiB, WS_KB = 224 * MiB, WS_VTB = 256 * MiB;
constexpr size_t WS_ZS = 288 * MiB;
constexpr size_t WS_X1 = 352 * MiB;
constexpr size_t WS_X1B = 96 * MiB;
constexpr size_t WS_QC = 160 * MiB, WS_KC = 224 * MiB, WS_VTC = 232 * MiB, WS_ZS1 = 240 * MiB;
constexpr size_t WS_EXO = 352 * MiB, WS_EXL = 416 * MiB;
constexpr size_t WS_END = 480 * MiB;

struct Params {
    const float* x; const float* norm_even; const float* w_in_even; const float* w_out_even;
    const float* qn_a; const float* kn_a; const float* qn_b; const float* kn_b;
    const float* norm_odd; const float* w_in_odd; const float* w_out_odd; const float* qn_c; const float* kn_c; const float* sinks;
    float* out; unsigned char* ws;
};

typedef __bf16 bf16v2 __attribute__((ext_vector_type(2)));
DI unsigned cvt_pk(float lo, float hi) { const f32x2 v = {lo, hi}; return __builtin_bit_cast(unsigned, __builtin_convertvector(v, bf16v2)); }
DI float bf_lo(unsigned u) { return __uint_as_float(u << 16); }
DI float bf_hi(unsigned u) { return __uint_as_float(u & 0xffff0000u); }

DI void p0_weight_tile(LAS float* tile, const float* W, bf16_t* Bt, int N, const float* g, bool permute, int t) {
    const int tid = threadIdx.x;
    const int ntn = N / 64, k0 = (t / ntn) * 64, n0 = (t % ntn) * 64;
    {
        const int n = tid & 63, kr = tid >> 6;
#pragma unroll
        for (int i = 0; i < 8; ++i) { const int k = kr + 8 * i; tile[k * 65 + n] = W[(size_t)(k0 + k) * N + n0 + n] * (g ? g[k0 + k] : 1.0f); }
    }
    __syncthreads();
    {
        const int nn = tid >> 3, ks = tid & 7;
        const int nlog = n0 + nn;
        const int c = permute ? ((nlog & ~255) | (((nlog >> 5) & 1) << 7) | (((nlog >> 6) & 3) << 5) | (nlog & 31)) : nlog;
        float v[8];
#pragma unroll
        for (int i = 0; i < 8; ++i) v[i] = tile[(ks * 8 + i) * 65 + nn];
        u32x4 w; w.x = cvt_pk(v[0], v[1]); w.y = cvt_pk(v[2], v[3]); w.z = cvt_pk(v[4], v[5]); w.w = cvt_pk(v[6], v[7]);
        *(u32x4*)(Bt + (size_t)c * 1024 + k0 + ks * 8) = w;
    }
    __syncthreads();
}

DI void sincos_d(double x, double& s, double& c) {
    const double kq = __builtin_rint(x * 0.63661977236758134308);
    double r = __builtin_fma(-kq, 1.57079632679489655800e+00, x); r = __builtin_fma(-kq, 6.12323399573676603587e-17, r);
    const int q = ((int)kq) & 3;
    const double r2 = r * r;
    const double sp = r * (1.0 + r2 * (-1.0 / 6 + r2 * (1.0 / 120 + r2 * (-1.0 / 5040 + r2 * (1.0 / 362880 + r2 * (-1.0 / 39916800 + r2 * (1.0 / 6227020800.0)))))));
    const double cp = 1.0 + r2 * (-0.5 + r2 * (1.0 / 24 + r2 * (-1.0 / 720 + r2 * (1.0 / 40320 + r2 * (-1.0 / 3628800 + r2 * (1.0 / 479001600.0 + r2 * (-1.0 / 87178291200.0)))))));
    s = (q == 0) ? sp : (q == 1) ? cp : (q == 2) ? -sp : -cp;
    c = (q == 0) ? cp : (q == 1) ? -sp : (q == 2) ? -cp : sp;
}

DI void p0_prologue(const Params& P, LAS unsigned char* lds) {
    unsigned char* ws = P.ws;
    const int tid = threadIdx.x, lane = tid & 63, wid = tid >> 6;
    const int G = gridDim.x, bid = blockIdx.x;
    {
        bf16_t* xb = (bf16_t*)(ws + WS_XB); float* rstd = (float*)(ws + WS_RSTD0);
        for (int row = bid * 8 + wid; row < NTOK; row += G * 8) {
            const f32x4* xr = (const f32x4*)(P.x + (size_t)row * DM);
            float ss = 0.f;
#pragma unroll
            for (int i = 0; i < 4; ++i) {
                const f32x4 v = xr[lane + 64 * i];
                ss += v[0] * v[0] + v[1] * v[1] + v[2] * v[2] + v[3] * v[3];
                u32x2 w; w.x = cvt_pk(v[0], v[1]); w.y = cvt_pk(v[2], v[3]);
                *(u32x2*)(xb + (size_t)row * DM + 4 * (lane + 64 * i)) = w;
            }
#pragma unroll
            for (int o = 32; o >= 1; o >>= 1) ss += __shfl_xor(ss, o);
            if (lane == 0) rstd[row] = rsqrtf(ss * (1.0f / DM) + NORM_EPS);
        }
    }
    if (bid == 0 && tid < 64) {
        float* gw = (float*)(ws + WS_GAINS);
        gw[tid] = P.qn_a[tid]; gw[64 + tid] = P.kn_a[tid]; gw[128 + tid] = P.qn_b[tid]; gw[192 + tid] = P.kn_b[tid]; gw[256 + tid] = P.qn_c[tid]; gw[320 + tid] = P.kn_c[tid];
        if (tid < 16) gw[384 + tid] = P.sinks[tid];
        float ma = fabsf(P.qn_a[tid]), mb = fabsf(P.kn_a[tid]), mc = fabsf(P.qn_b[tid]), md = fabsf(P.kn_b[tid]), me = fabsf(P.qn_c[tid]), mf = fabsf(P.kn_c[tid]);
#pragma unroll
        for (int o = 32; o >= 1; o >>= 1) { ma = fmaxf(ma, __shfl_xor(ma, o)); mb = fmaxf(mb, __shfl_xor(mb, o)); mc = fmaxf(mc, __shfl_xor(mc, o)); md = fmaxf(md, __shfl_xor(md, o)); me = fmaxf(me, __shfl_xor(me, o)); mf = fmaxf(mf, __shfl_xor(mf, o)); }
        if (tid == 0) { const float c = 8.0f * 1.44269504088896341f * 1.01f; gw[400] = c * ma * mb; gw[401] = c * mc * md; gw[402] = c * me * mf; }
    }
    {
        f32x2* cs = (f32x2*)(ws + WS_CS);
        for (int e = bid * NTHREADS + tid; e < SEQ * 32; e += G * NTHREADS) {
            const int pos = e >> 5, i = e & 31;
            double f = 1.0;
            for (int k = 0; k < i; ++k) f *= 0.7498942093324558;
            const float invf = (float)f;
            const float ang = (float)pos * invf;
            double s, c; sincos_d((double)ang, s, c);
            cs[e] = (f32x2){(float)c, (float)s};
        }
    }
    {
        LAS float* tile = (LAS float*)lds;
        const int T0 = 16 * (N_IN0 / 64), T1 = 16 * (DM / 64), T2 = 16 * (N_IN1 / 64), T3 = 16 * (DM / 64);
        for (int t = bid; t < T0 + T1 + T2 + T3; t += G) {
            if (t < T0) p0_weight_tile(tile, P.w_in_even, (bf16_t*)(ws + WS_BT0), N_IN0, P.norm_even, true, t);
            else if (t < T0 + T1) p0_weight_tile(tile, P.w_out_even, (bf16_t*)(ws + WS_BT1), DM, nullptr, false, t - T0);
            else if (t < T0 + T1 + T2) p0_weight_tile(tile, P.w_in_odd, (bf16_t*)(ws + WS_BT2), N_IN1, P.norm_odd, true, t - T0 - T1);
            else p0_weight_tile(tile, P.w_out_odd, (bf16_t*)(ws + WS_BT3), DM, nullptr, false, t - T0 - T1 - T2);
        }
    }
}

DI float row_rstd1(const float* ssq, int row, int fq) {
    const f32x4 a = *(const f32x4*)(ssq + (size_t)row * 16 + 4 * fq);
    float t = (a[0] + a[1]) + (a[2] + a[3]);
    t += __shfl_xor(t, 16); t += __shfl_xor(t, 32);
    return rsqrtf(t * (1.0f / DM) + NORM_EPS);
}
struct EpiIn {
    static constexpr bool PERM = true, AFTER_DRAIN = false;
    int layer; unsigned char* ws;
    __device__ __forceinline__ void operator()(const f32x4 (&acc)[2][2][4][2], const Unit& u, int wr, int wc, int fr, int fq) const {
        const float* rstd0 = (const float*)(ws + WS_RSTD0); const float* ssq = (const float*)(ws + WS_SSQ); const f32x2* cs = (const f32x2*)(ws + WS_CS);
        const float* gains = (const float*)(ws + WS_GAINS); bf16_t* zs = (bf16_t*)(ws + (layer == 0 ? WS_ZS : WS_ZS1)); float* kmp = (float*)(ws + WS_KMP);
        int mode, head, hpb = 8, zcol = 0; bf16_t* dst = nullptr; const float* gain = gains; bool do_km = false; float qsc = 1.0f;
        if (layer == 0) {
            const int seg = u.pn >> 1; head = (u.pn & 1) * 4 + wc;
            if (seg == 0) { mode = 0; dst = (bf16_t*)(ws + WS_QA); gain = gains; qsc = SC_LOG2; }
            else if (seg == 1) { mode = 0; dst = (bf16_t*)(ws + WS_KA); gain = gains + 64; }
            else if (seg == 2) { mode = 1; dst = (bf16_t*)(ws + WS_VTA); }
            else if (seg == 3) { mode = 2; zcol = head * 64; }
            else if (seg == 4) { mode = 0; dst = (bf16_t*)(ws + WS_QB); gain = gains + 128; qsc = SC_LOG2; }
            else if (seg == 5) { mode = 0; dst = (bf16_t*)(ws + WS_KB); gain = gains + 192; do_km = true; }
            else if (seg == 6) { mode = 1; dst = (bf16_t*)(ws + WS_VTB); }
            else { mode = 2; zcol = 512 + head * 64; }
        } else {
            if (u.pn < 4) { mode = 0; dst = (bf16_t*)(ws + WS_QC); gain = gains + 256; head = u.pn * 4 + wc; hpb = 16; qsc = SC_LOG2; }
            else if (u.pn == 4) { hpb = 2; if (wc < 2) { mode = 0; dst = (bf16_t*)(ws + WS_KC); gain = gains + 320; head = wc; } else { mode = 1; dst = (bf16_t*)(ws + WS_VTC); head = wc - 2; } }
            else { mode = 2; head = (u.pn - 5) * 4 + wc; zcol = head * 64; }
        }
        const int b = u.pm >> 4, sbase = (u.pm & 15) * 256 + wr * 64 + fr, rowbase = u.pm * 256 + wr * 64 + fr;
        const size_t bh = (size_t)b * hpb + head;
#define ROW_RS(row) ((layer == 0) ? rstd0[(row)] : row_rstd1(ssq, (row), fq))
        if (mode == 0) {
            float g0[8], g1[8], cs0[8], cs1[8];
#pragma unroll
            for (int i = 0; i < 8; ++i) { g0[i] = gain[8 * fq + i] * qsc; g1[i] = gain[32 + 8 * fq + i] * qsc; cs0[i] = 0.f; cs1[i] = 0.f; }
#pragma unroll
            for (int ai = 0; ai < 2; ++ai)
#pragma unroll
                for (int m = 0; m < 4; ++m) {
                    const int s = sbase + ai * 128 + m * 16; const float r = ROW_RS(rowbase + ai * 128 + m * 16);
                    float t0[8], t1[8]; float ss = 0.f;
#pragma unroll
                    for (int n = 0; n < 2; ++n)
#pragma unroll
                        for (int j = 0; j < 4; ++j) { t0[4 * n + j] = acc[ai][0][m][n][j] * r; t1[4 * n + j] = acc[ai][1][m][n][j] * r; }
#pragma unroll
                    for (int i = 0; i < 8; ++i) ss += t0[i] * t0[i] + t1[i] * t1[i];
                    ss += __shfl_xor(ss, 16); ss += __shfl_xor(ss, 32);
                    const float hr = rsqrtf(ss * (1.0f / 64.0f) + NORM_EPS);
                    const f32x4* cp = (const f32x4*)(cs + (size_t)s * 32 + 8 * fq);
                    float o0[8], o1[8];
#pragma unroll
                    for (int q = 0; q < 4; ++q) { const f32x4 c4 = cp[q];
                        { const int i = 2 * q; const float a = t0[i] * hr * g0[i], bb = t1[i] * hr * g1[i]; o0[i] = a * c4[0] - bb * c4[1]; o1[i] = bb * c4[0] + a * c4[1]; }
                        { const int i = 2 * q + 1; const float a = t0[i] * hr * g0[i], bb = t1[i] * hr * g1[i]; o0[i] = a * c4[2] - bb * c4[3]; o1[i] = bb * c4[2] + a * c4[3]; } }
                    u32x4 w0, w1;
                    w0.x = cvt_pk(o0[0], o0[1]); w0.y = cvt_pk(o0[2], o0[3]); w0.z = cvt_pk(o0[4], o0[5]); w0.w = cvt_pk(o0[6], o0[7]);
                    w1.x = cvt_pk(o1[0], o1[1]); w1.y = cvt_pk(o1[2], o1[3]); w1.z = cvt_pk(o1[4], o1[5]); w1.w = cvt_pk(o1[6], o1[7]);
                    bf16_t* rp = dst + ((bh * SEQ + s) * 64 + 8 * fq);
                    *(u32x4*)rp = w0; *(u32x4*)(rp + 32) = w1;
                    if (do_km) {
#pragma unroll
                        for (int i = 0; i < 8; ++i) { cs0[i] += o0[i]; cs1[i] += o1[i]; }
                    }
                }
            if (do_km) {
#pragma unroll
                for (int i = 0; i < 8; ++i) {
#pragma unroll
                    for (int o = 1; o <= 8; o <<= 1) { cs0[i] += __shfl_xor(cs0[i], o); cs1[i] += __shfl_xor(cs1[i], o); }
                }
                if (fr == 0) {
                    float* kp = kmp + (((size_t)wr * 64 + bh) * 16 + (u.pm & 15)) * 64 + 8 * fq;
                    *(f32x4*)kp = (f32x4){cs0[0], cs0[1], cs0[2], cs0[3]}; *(f32x4*)(kp + 4) = (f32x4){cs0[4], cs0[5], cs0[6], cs0[7]};
                    *(f32x4*)(kp + 32) = (f32x4){cs1[0], cs1[1], cs1[2], cs1[3]}; *(f32x4*)(kp + 36) = (f32x4){cs1[4], cs1[5], cs1[6], cs1[7]};
                }
            }
        } else if (mode == 1) {
#pragma unroll
            for (int ai = 0; ai < 2; ++ai)
#pragma unroll
                for (int m = 0; m < 4; ++m) {
                    const int s = sbase + ai * 128 + m * 16; const float r = ROW_RS(rowbase + ai * 128 + m * 16);
                    bf16_t* rp = dst + ((bh * SEQ + s) * 64 + 8 * fq);
#pragma unroll
                    for (int bj = 0; bj < 2; ++bj) {
                        const f32x4 v0 = acc[ai][bj][m][0] * r, v1 = acc[ai][bj][m][1] * r;
                        u32x4 w; w.x = cvt_pk(v0[0], v0[1]); w.y = cvt_pk(v0[2], v0[3]); w.z = cvt_pk(v1[0], v1[1]); w.w = cvt_pk(v1[2], v1[3]);
                        *(u32x4*)(rp + 32 * bj) = w;
                    }
                }
        } else {
#pragma unroll
            for (int ai = 0; ai < 2; ++ai)
#pragma unroll
                for (int m = 0; m < 4; ++m) {
                    const int row = rowbase + ai * 128 + m * 16; const float r = ROW_RS(row);
#pragma unroll
                    for (int bj = 0; bj < 2; ++bj) {
                        float sv[8];
#pragma unroll
                        for (int n = 0; n < 2; ++n)
#pragma unroll
                            for (int j = 0; j < 4; ++j) { const float z = acc[ai][bj][m][n][j] * r; sv[4 * n + j] = z / (1.0f + __expf(-z)); }
                        u32x4 w; w.x = cvt_pk(sv[0], sv[1]); w.y = cvt_pk(sv[2], sv[3]); w.z = cvt_pk(sv[4], sv[5]); w.w = cvt_pk(sv[6], sv[7]);
                        *(u32x4*)(zs + (size_t)row * DM + zcol + 32 * bj + 8 * fq) = w;
                    }
                }
        }
    }
};

struct EpiOut {
    static constexpr bool PERM = true, AFTER_DRAIN = false;
    const float* resid; float* out; bf16_t* xb; float* ssq;
    __device__ __forceinline__ void operator()(const f32x4 (&acc)[2][2][4][2], const Unit& u, int wr, int wc, int fr, int fq) const {
        const int col0 = u.pn * 256 + wc * 32 + 8 * fq, rowbase = u.pm * 256 + wr * 64 + fr;
#pragma unroll
        for (int ai = 0; ai < 2; ++ai)
#pragma unroll
            for (int m = 0; m < 4; ++m) {
                const int row = rowbase + ai * 128 + m * 16; const size_t off = (size_t)row * DM + col0;
                float q = 0.f;
#pragma unroll
                for (int bj = 0; bj < 2; ++bj) {
                    const f32x4 r0 = *(const f32x4*)(resid + off + bj * 128), r1 = *(const f32x4*)(resid + off + bj * 128 + 4);
                    const f32x4 o0 = r0 + acc[ai][bj][m][0], o1 = r1 + acc[ai][bj][m][1];
                    *(f32x4*)(out + off + bj * 128) = o0; *(f32x4*)(out + off + bj * 128 + 4) = o1;
                    if (xb) {
                        u32x4 w; w.x = cvt_pk(o0[0], o0[1]); w.y = cvt_pk(o0[2], o0[3]); w.z = cvt_pk(o1[0], o1[1]); w.w = cvt_pk(o1[2], o1[3]);
                        *(u32x4*)(xb + off + bj * 128) = w;
                        q += (o0[0] * o0[0] + o0[1] * o0[1]) + (o0[2] * o0[2] + o0[3] * o0[3]) + (o1[0] * o1[0] + o1[1] * o1[1]) + (o1[2] * o1[2] + o1[3] * o1[3]);
                    }
                }
                if (xb) { q += __shfl_xor(q, 16); q += __shfl_xor(q, 32); if (fq == 0) ssq[(size_t)row * 16 + u.pn * 4 + wc] = q; }
            }
    }
};

#define MFMA32(a, b, c) __builtin_amdgcn_mfma_f32_32x32x16_bf16((a), (b), (c), 0, 0, 0)
constexpr int TROW = 144;
constexpr int TBUF = 2 * 32 * TROW;
struct TileRegs { u32x4 k[4]; u32x4 v[4]; };
struct ASt { f32x16 o0, o1; float l; };
struct QT { bf16x8 qf[4]; ASt st; };

DI void qt_init(QT& t, const bf16_t* qrow, int h) {
    const bf16x8* qp = (const bf16x8*)qrow;
#pragma unroll
    for (int ks = 0; ks < 4; ++ks) t.qf[ks] = qp[2 * ks + h];
#pragma unroll
    for (int i = 0; i < 16; ++i) { t.st.o0[i] = 0.f; t.st.o1[i] = 0.f; }
    t.st.l = 0.f;
}

DI void tile_gload(TileRegs& t, const bf16_t* K, const bf16_t* V, int kbase, int kstride, int lane) {
    const int row0 = lane >> 3, ch = lane & 7;
#pragma unroll
    for (int i = 0; i < 4; ++i) {
        const unsigned off = (unsigned)((kbase + kstride * (row0 + 8 * i)) * 128 + ch * 16);
        t.k[i] = *(const u32x4*)((const unsigned char*)K + off); t.v[i] = *(const u32x4*)((const unsigned char*)V + off);
    }
}
DI void tile_lds_write(LAS unsigned char* buf, const TileRegs& t, int lane) {
    const int row0 = lane >> 3, ch = lane & 7;
#pragma unroll
    for (int i = 0; i < 4; ++i) {
        const int off = (row0 + 8 * i) * TROW + ch * 16;
        *(LAS u32x4*)(buf + off) = t.k[i]; *(LAS u32x4*)(buf + 32 * TROW + off) = t.v[i];
    }
}
DI void load_kfrag(bf16x8 (&kf)[4], LAS unsigned char* buf, int lane) {
    const int r = lane & 31, h = lane >> 5;
#pragma unroll
    for (int ks = 0; ks < 4; ++ks) kf[ks] = *(const LAS bf16x8*)(buf + r * TROW + (2 * ks + h) * 16);
}
DI void load_vfrag(bf16x8 (&vf)[2][2], LAS unsigned char* buf, int lane) {
    const int h = lane >> 5, q = (lane & 15) >> 2, p = lane & 3, blk = (lane >> 4) & 1;
    LAS unsigned char* vb = buf + 32 * TROW + (4 * h + q) * TROW + 32 * blk + 8 * p;
#pragma unroll
    for (int dt = 0; dt < 2; ++dt)
#pragma unroll
        for (int s2 = 0; s2 < 2; ++s2) {
            const s16x4 lo = __builtin_amdgcn_ds_read_tr16_b64_v4i16((LAS s16x4*)(vb + (16 * s2) * TROW + 64 * dt));
            const s16x4 hi4 = __builtin_amdgcn_ds_read_tr16_b64_v4i16((LAS s16x4*)(vb + (16 * s2 + 8) * TROW + 64 * dt));
            vf[dt][s2] = __builtin_shufflevector(lo, hi4, 0, 1, 2, 3, 4, 5, 6, 7);
        }
}
DI void qk_mfma(f32x16& s, const bf16x8 (&kf)[4], const bf16x8 (&qf)[4]) {
#pragma unroll
    for (int i = 0; i < 16; ++i) s[i] = 0.f;
#pragma unroll
    for (int ks = 0; ks < 4; ++ks) s = MFMA32(kf[ks], qf[ks], s);
}
DI void softmax_p(ASt& st, f32x16& s, int dist0, int kstride, int hi, bool lane_ok, bool elem) {
    if (elem) {
        int d0 = dist0; asm volatile("" : "+v"(d0));
#pragma unroll
        for (int i = 0; i < 16; ++i) {
            const unsigned dist = (unsigned)(d0 - kstride * ((i & 3) + 8 * (i >> 2)));
            s[i] = (dist <= (unsigned)hi) ? s[i] : NEGBIG;
        }
    }
    float ps0 = 0.f, ps1 = 0.f;
#pragma unroll
    for (int i = 0; i < 16; i += 2) { s[i] = __builtin_amdgcn_exp2f(s[i]); s[i + 1] = __builtin_amdgcn_exp2f(s[i + 1]); ps0 += s[i]; ps1 += s[i + 1]; }
    st.l += lane_ok ? (ps0 + ps1) : 0.f;
}
DI void pv_mfma(ASt& st, const f32x16& s, const bf16x8 (&vf)[2][2]) {
#pragma unroll
    for (int s2 = 0; s2 < 2; ++s2) {
        u32x4 p;
        p.x = cvt_pk(s[8 * s2 + 0], s[8 * s2 + 1]); p.y = cvt_pk(s[8 * s2 + 2], s[8 * s2 + 3]);
        p.z = cvt_pk(s[8 * s2 + 4], s[8 * s2 + 5]); p.w = cvt_pk(s[8 * s2 + 6], s[8 * s2 + 7]);
        const bf16x8 pb = __builtin_bit_cast(bf16x8, p);
        st.o0 = MFMA32(vf[0][s2], pb, st.o0);
        st.o1 = MFMA32(vf[1][s2], pb, st.o1);
    }
}
DI void pack_p(bf16x8 (&pb)[2], const f32x16& s, bool lane_ok) {
    const unsigned lm = lane_ok ? 0xffffffffu : 0u;
#pragma unroll
    for (int s2 = 0; s2 < 2; ++s2) {
        u32x4 p;
        p.x = cvt_pk(s[8 * s2 + 0], s[8 * s2 + 1]) & lm; p.y = cvt_pk(s[8 * s2 + 2], s[8 * s2 + 3]) & lm;
        p.z = cvt_pk(s[8 * s2 + 4], s[8 * s2 + 5]) & lm; p.w = cvt_pk(s[8 * s2 + 6], s[8 * s2 + 7]) & lm;
        pb[s2] = __builtin_bit_cast(bf16x8, p);
    }
}
DI bf16x8 load_vfrag1(LAS unsigned char* vb, int dt, int s2) {
    const s16x4 lo = __builtin_amdgcn_ds_read_tr16_b64_v4i16((LAS s16x4*)(vb + (16 * s2) * TROW + 64 * dt));
    const s16x4 hi4 = __builtin_amdgcn_ds_read_tr16_b64_v4i16((LAS s16x4*)(vb + (16 * s2 + 8) * TROW + 64 * dt));
    return __builtin_shufflevector(lo, hi4, 0, 1, 2, 3, 4, 5, 6, 7);
}
DI void core2(QT& a, QT& b, LAS unsigned char* buf, int dist0a, int dist0b, int kstride, int hi, bool elem, bool oka, bool okb, float m0, int lane) {
    const int r = lane & 31, h = lane >> 5;
    f32x16 sa, sb;
    {
        const float c = -m0;
        const f32x16 cinit = {c, c, c, c, c, c, c, c, c, c, c, c, c, c, c, c};
        const bf16x8 kf = *(const LAS bf16x8*)(buf + r * TROW + h * 16); sa = MFMA32(kf, a.qf[0], cinit); sb = MFMA32(kf, b.qf[0], cinit);
    }
#pragma unroll
    for (int ks = 1; ks < 4; ++ks) { const bf16x8 kf = *(const LAS bf16x8*)(buf + r * TROW + (2 * ks + h) * 16); sa = MFMA32(kf, a.qf[ks], sa); sb = MFMA32(kf, b.qf[ks], sb); }
    LAS unsigned char* vb = buf + 32 * TROW + (4 * h + ((lane & 15) >> 2)) * TROW + 32 * ((lane >> 4) & 1) + 8 * (lane & 3);
    softmax_p(a.st, sa, dist0a, kstride, hi, oka, elem);
    {
        bf16x8 pa[2]; pack_p(pa, sa, oka);
#pragma unroll
        for (int s2 = 0; s2 < 2; ++s2) {
            const bf16x8 v0 = load_vfrag1(vb, 0, s2), v1 = load_vfrag1(vb, 1, s2);
            a.st.o0 = MFMA32(v0, pa[s2], a.st.o0); a.st.o1 = MFMA32(v1, pa[s2], a.st.o1);
        }
    }
    softmax_p(b.st, sb, dist0b, kstride, hi, okb, elem);
    {
        bf16x8 pb[2]; pack_p(pb, sb, okb);
#pragma unroll
        for (int s2 = 0; s2 < 2; ++s2) {
            const bf16x8 v0 = load_vfrag1(vb, 0, s2), v1 = load_vfrag1(vb, 1, s2);
            b.st.o0 = MFMA32(v0, pb[s2], b.st.o0); b.st.o1 = MFMA32(v1, pb[s2], b.st.o1);
        }
    }
}
DI bool band_all_ok(int dist0, int kstride, int hi, int h) {
    const int d_first = dist0 + kstride * 4 * h, d_last = d_first - 31 * kstride;
    return (d_last >= 0) && (d_first <= hi);
}
DI void band2(QT& a, QT& b, LAS unsigned char* buf, int dist0a, int dist0b, int kstride, int hi, int who, float m0, int lane) {
    const bool oka = who != 1, okb = who != 0;
    const bool allok = (!oka || band_all_ok(dist0a, kstride, hi, lane >> 5)) && (!okb || band_all_ok(dist0b, kstride, hi, lane >> 5));
    const bool elem = __builtin_amdgcn_ballot_w64(!allok) != 0ull;
    core2(a, b, buf, dist0a, dist0b, kstride, hi, elem, oka, okb, m0, lane);
}

DI void attn_finish(ASt& st, float sink_l2, float m0, const bf16_t* zs, bf16_t* y, size_t rowoff  , int h) {
    float l = st.l + __shfl_xor(st.l, 32);
    l += (sink_l2 > -1e29f) ? __builtin_amdgcn_exp2f(sink_l2 - m0) : 0.f;
    const float inv = 1.0f / l;
#pragma unroll
    for (int dt = 0; dt < 2; ++dt)
#pragma unroll
        for (int g = 0; g < 4; ++g) {
            const size_t off = rowoff + 32 * dt + 8 * g + 4 * h;
            const u32x2 z = *(const u32x2*)(zs + off);
            const float v0 = (dt ? st.o1[4 * g + 0] : st.o0[4 * g + 0]) * inv * bf_lo(z.x);
            const float v1 = (dt ? st.o1[4 * g + 1] : st.o0[4 * g + 1]) * inv * bf_hi(z.x);
            const float v2 = (dt ? st.o1[4 * g + 2] : st.o0[4 * g + 2]) * inv * bf_lo(z.y);
            const float v3 = (dt ? st.o1[4 * g + 3] : st.o0[4 * g + 3]) * inv * bf_hi(z.y);
            u32x2 w; w.x = cvt_pk(v0, v1); w.y = cvt_pk(v2, v3);
            *(u32x2*)(y + off) = w;
        }
}

DI void attn_a_y(unsigned char* ws, LAS unsigned char* buf, int bh, int t0, int lane) {
    const int r = lane & 31, h = lane >> 5;
    const bf16_t* Q = (const bf16_t*)(ws + WS_QA) + (size_t)bh * SEQ * 64;
    const bf16_t* K = (const bf16_t*)(ws + WS_KA) + (size_t)bh * SEQ * 64;
    const bf16_t* V = (const bf16_t*)(ws + WS_VTA) + (size_t)bh * SEQ * 64;
    const int qpa = t0 + r, qpb = qpa + 32;
    const float m0 = ((const float*)(ws + WS_GAINS))[400];
    QT a, b; qt_init(a, Q + (size_t)qpa * 64, h); qt_init(b, Q + (size_t)qpb * 64, h);
    TileRegs tr;
    int T = (t0 >= 128) ? 0 : (128 - t0) / 32;
    tile_gload(tr, K, V, t0 - 128 + 32 * T, 1, lane);
    for (;;) {
        tile_lds_write(buf, tr, lane);
        const bool have = (T + 1) < 6;
        if (have) tile_gload(tr, K, V, t0 - 128 + 32 * (T + 1), 1, lane);
        const int kb = t0 - 128 + 32 * T;
        band2(a, b, buf, qpa - kb - 4 * h, qpb - kb - 4 * h, 1, 128, 2, m0, lane);
        if (!have) break;
        ++T;
    }
    const float la = a.st.l + __shfl_xor(a.st.l, 32), lb = b.st.l + __shfl_xor(b.st.l, 32);
    float* exa = (float*)(ws + WS_EXO) + ((size_t)bh * SEQ + qpa) * 64 + 4 * h;
    float* exb = exa + 32 * 64;
#pragma unroll
    for (int g = 0; g < 4; ++g) {
        *(f32x4*)(exa + 8 * g) = (f32x4){a.st.o0[4 * g], a.st.o0[4 * g + 1], a.st.o0[4 * g + 2], a.st.o0[4 * g + 3]};
        *(f32x4*)(exa + 32 + 8 * g) = (f32x4){a.st.o1[4 * g], a.st.o1[4 * g + 1], a.st.o1[4 * g + 2], a.st.o1[4 * g + 3]};
        *(f32x4*)(exb + 8 * g) = (f32x4){b.st.o0[4 * g], b.st.o0[4 * g + 1], b.st.o0[4 * g + 2], b.st.o0[4 * g + 3]};
        *(f32x4*)(exb + 32 + 8 * g) = (f32x4){b.st.o1[4 * g], b.st.o1[4 * g + 1], b.st.o1[4 * g + 2], b.st.o1[4 * g + 3]};
    }
    if (h == 0) { float* exl = (float*)(ws + WS_EXL) + (size_t)bh * SEQ; exl[qpa] = la; exl[qpb] = lb; }
}
DI bool a_tile_desc(int tau, int ra, int i0, int& kbase, int& kstride, int& hi, int& who) {
    if (tau < 10) { const int t = (tau < 5) ? tau : tau - 5; const int jb = i0 - 128 + 32 * t; who = (tau < 5) ? 0 : 1; kbase = ra + 8 * who + 16 * jb; kstride = 16; hi = 2048; return jb >= 0; }
    who = 2;
    { const int ub = 4 * i0 - 128 + 32 * (tau - 10); kbase = (ra & 3) + 4 * ub; kstride = 4; hi = 512; return ub >= 0; }
}
DI int a_next(int tau, int ra, int i0) { int t = tau + 1, kb, ks, hi, who; while (t < 18 && !a_tile_desc(t, ra, i0, kb, ks, hi, who)) ++t; return t; }
DI void attn_a_x(unsigned char* ws, LAS unsigned char* buf, int bh, int ra, int i0, int lane) {
    const int r = lane & 31, h = lane >> 5;
    const bf16_t* Q = (const bf16_t*)(ws + WS_QA) + (size_t)bh * SEQ * 64;
    const bf16_t* K = (const bf16_t*)(ws + WS_KA) + (size_t)bh * SEQ * 64;
    const bf16_t* V = (const bf16_t*)(ws + WS_VTA) + (size_t)bh * SEQ * 64;
    const int qpa = ra + 16 * (i0 + r), qpb = qpa + 8;
    const float m0 = ((const float*)(ws + WS_GAINS))[400];
    QT a, b; qt_init(a, Q + (size_t)qpa * 64, h); qt_init(b, Q + (size_t)qpb * 64, h);
    {
        const float* exa = (const float*)(ws + WS_EXO) + ((size_t)bh * SEQ + qpa) * 64 + 4 * h;
        const float* exb = exa + 8 * 64;
#pragma unroll
        for (int g = 0; g < 4; ++g) {
            const f32x4 a0 = *(const f32x4*)(exa + 8 * g), a1 = *(const f32x4*)(exa + 32 + 8 * g), b0 = *(const f32x4*)(exb + 8 * g), b1 = *(const f32x4*)(exb + 32 + 8 * g);
#pragma unroll
            for (int j = 0; j < 4; ++j) { a.st.o0[4 * g + j] = a0[j]; a.st.o1[4 * g + j] = a1[j]; b.st.o0[4 * g + j] = b0[j]; b.st.o1[4 * g + j] = b1[j]; }
        }
        const float* exl = (const float*)(ws + WS_EXL) + (size_t)bh * SEQ;
        a.st.l = (h == 0) ? exl[qpa] : 0.f; b.st.l = (h == 0) ? exl[qpb] : 0.f;
    }
    TileRegs tr;
    int tc = a_next(-1, ra, i0);
    { int kb, ks, hi, who; (void)a_tile_desc(tc, ra, i0, kb, ks, hi, who); tile_gload(tr, K, V, kb, ks, lane); }
    for (;;) {
        tile_lds_write(buf, tr, lane);
        const int tn = a_next(tc, ra, i0);
        if (tn < 18) { int kb, ks, hi, who; (void)a_tile_desc(tn, ra, i0, kb, ks, hi, who); tile_gload(tr, K, V, kb, ks, lane); }
        {
            int kb, ks, hi, who; (void)a_tile_desc(tc, ra, i0, kb, ks, hi, who);
            const int d0a = qpa - kb - ks * 4 * h, d0b = qpb - kb - ks * 4 * h;
            band2(a, b, buf, d0a, d0b, ks, hi, who, m0, lane);
        }
        if (tn >= 18) break;
        tc = tn;
    }
    const int bb = bh >> 3, head = bh & 7;
    attn_finish(a.st, NEGBIG, m0, (const bf16_t*)(ws + WS_ZS), (bf16_t*)(ws + WS_Y), ((size_t)bb * SEQ + qpa) * DM + head * 64, h);
    attn_finish(b.st, NEGBIG, m0, (const bf16_t*)(ws + WS_ZS), (bf16_t*)(ws + WS_Y), ((size_t)bb * SEQ + qpb) * DM + head * 64, h);
}

DI unsigned moba_select(const bf16x8 (&qf)[4], LAS float* km, int qblk, int h) {
    float v1 = -3e38f, v2 = -3e38f, v3 = -3e38f; int i1 = 31, i2 = 31, i3 = 31;
    for (int n = 0; n < qblk; ++n) {
        float g = 0.f;
#pragma unroll
        for (int ks = 0; ks < 4; ++ks) {
            const LAS f32x4* kp = (const LAS f32x4*)(km + n * 64 + 16 * ks + 8 * h);
            const f32x4 x = kp[0], y = kp[1];
            const u32x4 qu = __builtin_bit_cast(u32x4, qf[ks]);
            g += bf_lo(qu.x) * x[0] + bf_hi(qu.x) * x[1] + bf_lo(qu.y) * x[2] + bf_hi(qu.y) * x[3]
               + bf_lo(qu.z) * y[0] + bf_hi(qu.z) * y[1] + bf_lo(qu.w) * y[2] + bf_hi(qu.w) * y[3];
        }
        g += __shfl_xor(g, 32);
        if (g > v1) { v3 = v2; i3 = i2; v2 = v1; i2 = i1; v1 = g; i1 = n; }
        else if (g > v2) { v3 = v2; i3 = i2; v2 = g; i2 = n; }
        else if (g > v3) { v3 = g; i3 = n; }
    }
    unsigned sel = 0u;
    if (i1 < 16) sel |= 1u << i1;
    if (i2 < 16) sel |= 1u << i2;
    if (i3 < 16) sel |= 1u << i3;
    return sel;
}
DI void attn_b_item(unsigned char* ws, LAS unsigned char* buf, LAS float* km  , int bh, int qblk, int w4, int lane) {
    const int r = lane & 31, h = lane >> 5;
    const bf16_t* Q = (const bf16_t*)(ws + WS_QB) + (size_t)bh * SEQ * 64;
    const bf16_t* K = (const bf16_t*)(ws + WS_KB) + (size_t)bh * SEQ * 64;
    const bf16_t* V = (const bf16_t*)(ws + WS_VTB) + (size_t)bh * SEQ * 64;
    const int qpa = qblk * 256 + w4 * 64 + r, qpb = qpa + 32;
    const float m0 = ((const float*)(ws + WS_GAINS))[401];
    QT a, b; qt_init(a, Q + (size_t)qpa * 64, h); qt_init(b, Q + (size_t)qpb * 64, h);
    const unsigned sela = moba_select(a.qf, km, qblk, h), selb = moba_select(b.qf, km, qblk, h);
    unsigned uni = 0u;
    for (int n = 0; n < qblk; ++n) { if (__builtin_amdgcn_ballot_w64(((sela | selb) >> n) & 1u) != 0ull) uni |= 1u << n; }
    uni |= 1u << qblk;
    const int own_tiles = 2 * w4 + 2;
    TileRegs tr;
#define B_ADV(n_, T_, ok_) do { const int cnt_ = ((n_) == qblk) ? own_tiles : 8; if (++(T_) >= cnt_) { const unsigned rest_ = uni & ~((2u << (n_)) - 1u); if (rest_) { (n_) = __builtin_ctz(rest_); (T_) = 0; } else (ok_) = false; } } while (0)
    int nc = __builtin_ctz(uni), Tc = 0; bool okc = true;
    tile_gload(tr, K, V, nc * 256, 1, lane);
    for (;;) {
        tile_lds_write(buf, tr, lane);
        int nl = nc, Tl = Tc; bool okl = true; B_ADV(nl, Tl, okl);
        if (okl) tile_gload(tr, K, V, nl * 256 + 32 * Tl, 1, lane);
        {
            const int kb = nc * 256 + 32 * Tc;
            const bool own = (nc == qblk);
            const bool oka = own ? (Tc <= 2 * w4) : (((sela >> nc) & 1u) != 0u), okb = own ? true : (((selb >> nc) & 1u) != 0u);
            core2(a, b, buf, qpa - kb - 4 * h, qpb - kb - 4 * h, 1, 0x7fffffff, own && (Tc >= 2 * w4), oka, okb, m0, lane);
        }
        if (!okl) break;
        nc = nl; Tc = Tl;
    }
#undef B_ADV
    const int bb = bh >> 3, head = 8 + (bh & 7);
    attn_finish(a.st, NEGBIG, m0, (const bf16_t*)(ws + WS_ZS), (bf16_t*)(ws + WS_Y), ((size_t)bb * SEQ + qpa) * DM + head * 64, h);
    attn_finish(b.st, NEGBIG, m0, (const bf16_t*)(ws + WS_ZS), (bf16_t*)(ws + WS_Y), ((size_t)bb * SEQ + qpb) * DM + head * 64, h);
}

DI void attn_c_item(unsigned char* ws, LAS unsigned char* buf, int b, int hq, int chunk, int wid, int lane) {
    const int r = lane & 31, h = lane >> 5, kvh = hq >> 3;
    const bf16_t* Qa = (const bf16_t*)(ws + WS_QC) + ((size_t)b * 16 + hq) * SEQ * 64;
    const bf16_t* K = (const bf16_t*)(ws + WS_KC) + ((size_t)b * 2 + kvh) * SEQ * 64;
    const bf16_t* V = (const bf16_t*)(ws + WS_VTC) + ((size_t)b * 2 + kvh) * SEQ * 64;
    const int t0 = chunk * 256 + wid * 32, qpos = t0 + r;
    const float m0 = ((const float*)(ws + WS_GAINS))[402];
    QT qa, qb; qt_init(qa, Qa + (size_t)qpos * 64, h); qt_init(qb, Qa + (size_t)SEQ * 64 + (size_t)qpos * 64, h);
    TileRegs tr;
    int T = (t0 >= 128) ? 0 : (128 - t0) / 32;
    tile_gload(tr, K, V, t0 - 128 + 32 * T, 1, lane);
    for (;;) {
        tile_lds_write(buf, tr, lane);
        const bool have = (T + 1) < 5;
        if (have) tile_gload(tr, K, V, t0 - 128 + 32 * (T + 1), 1, lane);
        const int d0 = qpos - (t0 - 128 + 32 * T) - 4 * h;
        band2(qa, qb, buf, d0, d0, 1, 127, 2, m0, lane);
        if (!have) break;
        ++T;
    }
    const float* sinks = (const float*)(ws + WS_GAINS) + 384;
    const size_t rowoff = ((size_t)b * SEQ + qpos) * DM + hq * 64;
    attn_finish(qa.st, sinks[hq] * 1.44269504088896341f, m0, (const bf16_t*)(ws + WS_ZS1), (bf16_t*)(ws + WS_Y), rowoff, h);
    attn_finish(qb.st, sinks[hq + 1] * 1.44269504088896341f, m0, (const bf16_t*)(ws + WS_ZS1), (bf16_t*)(ws + WS_Y), rowoff + 64, h);
}

#define XB_TMO      128
#define XB_XCNT(j)  (256  + 64 * (j))
#define XB_XSUB(j)  (1280 + 64 * (j))
#define XB_XGEN(j)  (2304 + 64 * (j))
#define XB_TOP      3328
#define XB_TOPGEN   3392
#define XCD_BAR_WORDS 3456
#define XB_SPIN_CAP (1u << 18)

__device__ __forceinline__ unsigned xb_ld(unsigned* p)              { return __hip_atomic_load(p, __ATOMIC_RELAXED, __HIP_MEMORY_SCOPE_AGENT); }
__device__ __forceinline__ unsigned xb_add(unsigned* p, unsigned v) { return __hip_atomic_fetch_add(p, v, __ATOMIC_RELAXED, __HIP_MEMORY_SCOPE_AGENT); }
__device__ __forceinline__ unsigned xb_xcc_id() { return (unsigned)__builtin_amdgcn_s_getreg((3 << 11) | 20) & 0xFu; }
#define XB_SPIN(cond, bar) do { unsigned _sp = 0; while (cond) { __builtin_amdgcn_s_sleep(1); \
    if ((++_sp & 255u) == 0u) { if (xb_ld(&(bar)[XB_TMO])) break; if (_sp > XB_SPIN_CAP) { atomicAdd(&(bar)[XB_TMO], 1u); break; } } } } while (0)

struct XcdBarrier {
    unsigned* bar; unsigned x;
    volatile LAS unsigned* st;
};

__device__ __forceinline__ XcdBarrier xcd_barrier_post(unsigned* bar, volatile LAS unsigned* st) {
    XcdBarrier b; b.bar = bar; b.x = xb_xcc_id(); b.st = st;
    if (threadIdx.x == 0) (void)xb_add(&bar[XB_XCNT(b.x)], 1u);
    return b;
}
__device__ __forceinline__ void xcd_barrier_complete(unsigned* bar, unsigned x, unsigned& nloc, unsigned& nx) {
    const unsigned G = gridDim.x * gridDim.y * gridDim.z;
    unsigned sum, cnt, mine, sp = 0u;
    for (;;) {
        sum = 0u; cnt = 0u; mine = 0u;
#pragma unroll
        for (unsigned j = 0; j < 16; ++j) { const unsigned c = xb_ld(&bar[XB_XCNT(j)]); sum += c; cnt += (c > 0u) ? 1u : 0u; mine = (j == x) ? c : mine; }
        if (sum == G) break;
        __builtin_amdgcn_s_sleep(1);
        if ((++sp & 255u) == 0u) { if (xb_ld(&bar[XB_TMO])) break; if (sp > XB_SPIN_CAP) { atomicAdd(&bar[XB_TMO], 1u); break; } }
    }
    nloc = mine > 0u ? mine : 1u; nx = cnt > 0u ? cnt : 1u;
}

__device__ __forceinline__ void xcd_barrier(const XcdBarrier& b) {
    asm volatile("s_waitcnt vmcnt(0)" ::: "memory");
    __syncthreads();
    if (threadIdx.x == 0) {
        unsigned* bar = b.bar;
        __builtin_amdgcn_s_waitcnt(0);
        unsigned nloc = b.st[0], nx = b.st[1];
        if (nloc == 0u) { xcd_barrier_complete(bar, b.x, nloc, nx); b.st[0] = nloc; b.st[1] = nx; }
        const unsigned old = xb_add(&bar[XB_XSUB(b.x)], 1u);
        const unsigned gen = old / nloc;
        if (old + 1u == (gen + 1u) * nloc) {
            __builtin_amdgcn_fence(__ATOMIC_RELEASE, "agent");
            asm volatile("s_waitcnt vmcnt(0)" ::: "memory");
            const unsigned og = xb_add(&bar[XB_TOP], 1u);
            const unsigned tg = og / nx;
            if (og + 1u == (tg + 1u) * nx) xb_add(&bar[XB_TOPGEN], 1u);
            else XB_SPIN(xb_ld(&bar[XB_TOPGEN]) == tg, bar);
            __builtin_amdgcn_fence(__ATOMIC_ACQUIRE, "agent");
            xb_add(&bar[XB_XGEN(b.x)], 1u);
            asm volatile("s_waitcnt vmcnt(0)" ::: "memory");
        } else {
            XB_SPIN(xb_ld(&bar[XB_XGEN(b.x)]) == gen, bar);
            __builtin_amdgcn_fence(__ATOMIC_ACQUIRE, "agent");
            asm volatile("s_waitcnt vmcnt(0)" ::: "memory");
        }
    }
    __syncthreads();
}


__global__ void __launch_bounds__(NTHREADS) fwd_megakernel(Params P) {
    extern __shared__ __attribute__((aligned(16))) unsigned char lds_raw[];
    cg::grid_group grid = cg::this_grid();
    LAS unsigned char* lds = (LAS unsigned char*)lds_raw;
    unsigned char* ws = P.ws;
    const int G = gridDim.x, bid = blockIdx.x;
    volatile LAS unsigned* xb_st = (volatile LAS unsigned*)(lds + LDS_BYTES - 16);
    if (threadIdx.x == 0) { xb_st[0] = 0u; xb_st[1] = 0u; }
    __syncthreads();
    const XcdBarrier xbar = xcd_barrier_post((unsigned*)(ws + WS_BAR), xb_st);
#define PHASE_IDS() int tid_l = threadIdx.x; asm volatile("" : "+v"(tid_l)); const int tid = tid_l, lane = tid & 63, wid = __builtin_amdgcn_readfirstlane(tid >> 6); (void)lane; (void)wid

    if constexpr (PH_MASK & 1) { for (int rep = 0; rep < NREP(0); ++rep) p0_prologue(P, lds); }
    if (G == 0x7fffffff) grid.sync();
    xcd_barrier(xbar);

    if constexpr ((PH_MASK & 2) != 0) {
        pg8::Gemm g{(const bf16_t*)(ws + WS_XB), (const bf16_t*)(ws + WS_BT0), NTOK, N_IN0, DM};
        pg8::StaticOrder S; S.init(NTOK, N_IN0, G, bid);
        EpiIn E{0, ws};
        for (int rep = 0; rep < NREP(1); ++rep) pg8::gemm_phase<EpiIn, pg8::StaticOrder, true, true>(lds, g, S, E);
    }
    xcd_barrier(xbar);

    if constexpr ((PH_MASK & 4) != 0) {
        PHASE_IDS();
        LAS float* km = (LAS float*)(lds + 8 * TBUF);
        LAS unsigned char* buf = lds + wid * TBUF;
        const float* kmp = (const float*)(ws + WS_KMP);
#define P2_DECODE(it_) const int itt = (it_) & 511, j = itt >> 8, c = itt & 255, xcd = c & 7, slot = c >> 3, idx = j * 32 + slot;   \
                       const int bh = xcd * 8 + (idx >> 3), sub = idx & 7; (void)j
#define P2_STAGE_KM(tab_, bh_) do { for (int e = tid; e < 1024; e += NTHREADS) km[(tab_) * 1024 + e] = kmp[(size_t)(bh_) * 1024 + e] + kmp[(size_t)(64 + (bh_)) * 1024 + e]; } while (0)
        for (int rep = 0; rep < 2; ++rep) {
            if (rep == 0 || NREP(2) == 2) {
                __syncthreads();
                { int k = 0; for (int it = bid; it < 512 && k < 2; it += G, ++k) { P2_DECODE(it); (void)sub; P2_STAGE_KM(k, bh); } }
                __syncthreads();
                int k = 0;
                for (int it = bid; it < 512; it += G, ++k) {
                    P2_DECODE(it);
                    if (k >= 2) { __syncthreads(); P2_STAGE_KM(k & 1, bh); __syncthreads(); }
                    const bool lo = (wid < 4) != ((k & 1) != 0);
                    attn_b_item(ws, buf, km + (k & 1) * 1024, bh, lo ? sub : 15 - sub, wid & 3, lane);
                }
            }
            if (rep == 0 || NREP(7) == 2) {
                for (int it = 512 + bid; it < 1024; it += G) {
                    P2_DECODE(it);
                    attn_a_y(ws, buf, bh, sub * 512 + wid * 64, lane);
                    __syncthreads();
                    attn_a_x(ws, buf, bh, wid, sub * 32, lane);
                }
            }
        }
#undef P2_DECODE
#undef P2_STAGE_KM
    }
    xcd_barrier(xbar);

    if constexpr ((PH_MASK & 8) != 0) {
        pg8::Gemm g{(const bf16_t*)(ws + WS_Y), (const bf16_t*)(ws + WS_BT1), NTOK, DM, DM};
        pg8::StaticOrder S; S.init(NTOK, DM, G, bid);
        EpiOut E{P.x, (float*)(ws + WS_X1), (bf16_t*)(ws + WS_X1B), (float*)(ws + WS_SSQ)};
        for (int rep = 0; rep < NREP(3); ++rep) pg8::gemm_phase<EpiOut, pg8::StaticOrder, true, true>(lds, g, S, E);
    }
    xcd_barrier(xbar);

    if constexpr ((PH_MASK & 16) != 0) {
        pg8::Gemm g{(const bf16_t*)(ws + WS_X1B), (const bf16_t*)(ws + WS_BT2), NTOK, N_IN1, DM};
        pg8::StaticOrder S; S.init(NTOK, N_IN1, G, bid);
        EpiIn E{1, ws};
        for (int rep = 0; rep < NREP(4); ++rep) pg8::gemm_phase<EpiIn, pg8::StaticOrder, true, true>(lds, g, S, E);
    }
    xcd_barrier(xbar);

    if constexpr ((PH_MASK & 32) != 0) {
        PHASE_IDS();
        for (int rep = 0; rep < NREP(5); ++rep)
        for (int it = bid; it < 1024; it += G) {
            const int j = it >> 8, c = it & 255, xcd = c & 7, slot = c >> 3, idx = j * 32 + slot;
            const int bkv = xcd * 2 + (idx >> 6), rem = idx & 63, hq = (bkv & 1) * 8 + 2 * (rem >> 4), chunk = rem & 15;
            attn_c_item(ws, lds + wid * TBUF, bkv >> 1, hq, chunk, wid, lane);
        }
    }
    xcd_barrier(xbar);

    if constexpr ((PH_MASK & 64) != 0) {
        pg8::Gemm g{(const bf16_t*)(ws + WS_Y), (const bf16_t*)(ws + WS_BT3), NTOK, DM, DM};
        pg8::StaticOrder S; S.init(NTOK, DM, G, bid);
        EpiOut E{(const float*)(ws + WS_X1), P.out, nullptr, nullptr};
        for (int rep = 0; rep < NREP(6); ++rep) pg8::gemm_phase<EpiOut, pg8::StaticOrder, true, true>(lds, g, S, E);
    }
}

extern "C" void kernel_launch(void* const* d_in, const int* in_sizes, int n_in, void* d_out, int out_size, void* d_ws, size_t ws_size, hipStream_t stream) {
    static int grid_blocks = 0;
    if (grid_blocks == 0) {
        if (n_in != 14 || in_sizes[0] != NTOK * DM || out_size != NTOK * DM || ws_size < WS_END) {
            fprintf(stderr, "kernel_launch: unexpected shapes (n_in %d in0 %d out %d ws %zu)\n", n_in, n_in > 0 ? in_sizes[0] : -1, out_size, ws_size); grid_blocks = -1; return; }
        int dev = 0, cus = 0, per_cu = 0;
        hipGetDevice(&dev);
        hipDeviceGetAttribute(&cus, hipDeviceAttributeMultiprocessorCount, dev);
        if (hipFuncSetAttribute((const void*)fwd_megakernel, hipFuncAttributeMaxDynamicSharedMemorySize, LDS_BYTES) != hipSuccess) {
            fprintf(stderr, "kernel_launch: hipFuncSetAttribute failed\n"); grid_blocks = -1; return; }
        if (hipOccupancyMaxActiveBlocksPerMultiprocessor(&per_cu, (const void*)fwd_megakernel, NTHREADS, LDS_BYTES) != hipSuccess || per_cu < 1) {
            fprintf(stderr, "kernel_launch: occupancy query gave %d\n", per_cu); per_cu = 1; (void)hipGetLastError(); }
        grid_blocks = cus * 1;
        if (per_cu < 1) grid_blocks = -1;
    }
    if (grid_blocks < 0) return;
    Params p{};
    p.x = (const float*)d_in[0]; p.norm_even = (const float*)d_in[1]; p.w_in_even = (const float*)d_in[2]; p.w_out_even = (const float*)d_in[3];
    p.qn_a = (const float*)d_in[4]; p.kn_a = (const float*)d_in[5]; p.qn_b = (const float*)d_in[6]; p.kn_b = (const float*)d_in[7];
    p.norm_odd = (const float*)d_in[8]; p.w_in_odd = (const float*)d_in[9]; p.w_out_odd = (const float*)d_in[10];
    p.qn_c = (const float*)d_in[11]; p.kn_c = (const float*)d_in[12]; p.sinks = (const float*)d_in[13];
    p.out = (float*)d_out; p.ws = (unsigned char*)d_ws;
    if (hipMemsetAsync((unsigned char*)d_ws + WS_BAR, 0, XCD_BAR_WORDS * 4, stream) != hipSuccess) { fprintf(stderr, "kernel_launch: memset failed\n"); return; }
    void* args[] = {&p};
    hipError_t e = hipLaunchCooperativeKernel((const void*)fwd_megakernel, dim3(grid_blocks), dim3(NTHREADS), args, LDS_BYTES, stream);
    if (e != hipSuccess) fprintf(stderr, "cooperative launch failed: %s (grid %d)\n", hipGetErrorString(e), grid_blocks);
}
```

```cpp
#include <hip/hip_runtime.h>
#include <hip/hip_cooperative_groups.h>
#include <cstdio>
#include <cstdint>
namespace cg = cooperative_groups;
namespace pg8 {
#define PG8_LAS __attribute__((address_space(3)))
typedef unsigned short bf16_t;
typedef short bf16x8 __attribute__((ext_vector_type(8)));
typedef float f32x4 __attribute__((ext_vector_type(4)));
typedef unsigned u32x4 __attribute__((ext_vector_type(4)));
constexpr int BM = 256, BK = 64, HALF = 128, HTB = HALF * BK * 2  , STAGE_BYTES = 8 * HTB, NXCD = 8, WGM = 8;

__host__ __device__ __forceinline__ int lds_byte(int r, int c) { const int st = (r >> 4) * 2 + (c >> 5), rr = r & 15, cc = c & 31, ob = rr * 64 + cc * 2; return st * 1024 + (ob ^ (((ob >> 9) & 1) << 5)); }
__host__ __device__ __forceinline__ void stage_rc(int b, int& R, int& C) { const int st = b / 1024, sb = b % 1024, swz = sb ^ (((sb >> 9) & 1) << 5); R = (st >> 1) * 16 + swz / 64; C = (st & 1) * 32 + (swz % 64) / 2; }
__host__ __device__ __forceinline__ int perm32(int rho) { const int n = rho >> 4, i = rho & 15; return 8 * (i >> 2) + 4 * n + (i & 3); }

struct Unit { int pm, pn; };
struct Gemm { const bf16_t* A; const bf16_t* Bt; int M, N, K; };

struct StaticOrder {
    int nM, nN, nwg, G, c;
    __host__ __device__ void init(int M, int N, int G_, int c_) { nM = M / BM; nN = N / BM; nwg = nM * nN; G = G_; c = c_; }
    __host__ __device__ bool next(int i, Unit& u) const {
        const long L = (long)i * G + c; if (L >= nwg) return false;
        int wgid = (int)L; { const int q = nwg / NXCD, r = nwg % NXCD, xcd = wgid % NXCD, off = wgid / NXCD; wgid = (xcd < r ? xcd * (q + 1) : r * (q + 1) + (xcd - r) * q) + off; }
        const int nig = WGM * nN, gid = wgid / nig, fm = gid * WGM, gsz = (nM - fm) < WGM ? (nM - fm) : WGM;
        u.pm = fm + ((wgid % nig) % gsz); u.pn = (wgid % nig) / gsz; return true;
    }
    __device__ __forceinline__ void a_ready(const Unit&) const {}
    __device__ __forceinline__ void done(const Unit&) const {}
};

template <class Epi, class Sched, bool ALIGN_EPI = false, bool SP2 = false>
__device__ __forceinline__ void gemm_phase(PG8_LAS unsigned char* lds, const Gemm g, const Sched& S, const Epi& E) {
    int tid_l = threadIdx.x; asm volatile("" : "+v"(tid_l));
    const int tid = tid_l, wid = __builtin_amdgcn_readfirstlane(tid >> 6), lane = tid & 63, wr = wid >> 2, wc = wid & 3, fr = lane & 15, fq = lane >> 4;
    const int K = g.K, nt = K / BK;
    unsigned voffA[2], voffB[2];
#pragma unroll
    for (int i = 0; i < 2; ++i) { int R, C; stage_rc(tid * 16 + i * 8192, R, C); const int Rb = Epi::PERM ? ((R & ~31) + perm32(R & 31)) : R;
        voffA[i] = (unsigned)(R * K + C) * 2u; voffB[i] = (unsigned)(Rb * K + C) * 2u; }
    const size_t kstep = (size_t)(BK * 2);
    const size_t hstep = (size_t)HALF * K * 2;
    const size_t tstep = 2 * hstep;
    const unsigned ldsw = (unsigned)wid * 1024u;
    const int aoff = lds_byte(wr * 64 + fr, fq * 8), boff = lds_byte(wc * 32 + fr, fq * 8);
#define PG8_SA(b, h) (((b) * 2 + (h)) * HTB)
#define PG8_SB(b, h) ((4 + (b) * 2 + (h)) * HTB)
#define PG8_STAGE(bufoff, gbase, voff) do { _Pragma("unroll") for (int _i = 0; _i < 2; ++_i) \
        __builtin_amdgcn_global_load_lds((const unsigned*)((const char*)(gbase) + (voff)[_i]), (PG8_LAS unsigned*)(lds + (bufoff) + ldsw + _i * 8192), 16, 0, 0); } while (0)
#define PG8_LDA(dst, b, h) do { _Pragma("unroll") for (int m = 0; m < 4; ++m) _Pragma("unroll") for (int k = 0; k < 2; ++k) dst[m][k] = *(const PG8_LAS bf16x8*)(lds + PG8_SA(b, h) + aoff + m * 2048 + k * 1024); } while (0)
#define PG8_LDB(dst, b, h) do { _Pragma("unroll") for (int n = 0; n < 2; ++n) _Pragma("unroll") for (int k = 0; k < 2; ++k) dst[n][k] = *(const PG8_LAS bf16x8*)(lds + PG8_SB(b, h) + boff + n * 2048 + k * 1024); } while (0)
#define PG8_MMA(ai, bj, At, Bt) do { __builtin_amdgcn_s_setprio(1); _Pragma("unroll") for (int m = 0; m < 4; ++m) _Pragma("unroll") for (int n = 0; n < 2; ++n) _Pragma("unroll") for (int k = 0; k < 2; ++k) \
        acc[ai][bj][m][n] = __builtin_amdgcn_mfma_f32_16x16x32_bf16(Bt[n][k], At[m][k], acc[ai][bj][m][n], 0, 0, 0); __builtin_amdgcn_s_setprio(0); } while (0)
#define PG8_WAIT_V(n) asm volatile("s_waitcnt vmcnt(" #n ")" ::: "memory")
#define PG8_WAIT_L(n) asm volatile("s_waitcnt lgkmcnt(" #n ")" ::: "memory")
#define PG8_BAR __builtin_amdgcn_s_barrier()
#define PG8_SCHED __builtin_amdgcn_sched_barrier(0)
    Unit cur, nxt; int ui = 0;
    if (!S.next(0, cur)) return;
    f32x4 acc[2][2][4][2];
#pragma unroll
    for (int a = 0; a < 2; ++a)
#pragma unroll
        for (int b = 0; b < 2; ++b)
#pragma unroll
            for (int m = 0; m < 4; ++m)
#pragma unroll
                for (int n = 0; n < 2; ++n) acc[a][b][m][n] = (f32x4){0.f, 0.f, 0.f, 0.f};
    bf16x8 At[4][2], B0[2][2], B1[2][2];
    const char* cA = (const char*)g.A + (size_t)cur.pm * tstep; const char* cB = (const char*)g.Bt + (size_t)cur.pn * tstep;
    S.a_ready(cur);
    if constexpr (SP2) {
        PG8_STAGE(PG8_SB(0, 0), cB, voffB); PG8_STAGE(PG8_SB(0, 1), cB + hstep, voffB); PG8_STAGE(PG8_SA(0, 0), cA, voffA); PG8_STAGE(PG8_SA(0, 1), cA + hstep, voffA);
        if (wr == 1) PG8_BAR;
        PG8_WAIT_V(2); PG8_BAR;
        PG8_STAGE(PG8_SB(1, 0), cB + kstep, voffB); PG8_STAGE(PG8_SA(1, 0), cA + kstep, voffA); PG8_STAGE(PG8_SB(1, 1), cB + hstep + kstep, voffB);
        PG8_WAIT_V(6); PG8_BAR;
    } else {
        PG8_STAGE(PG8_SB(0, 0), cB, voffB); PG8_STAGE(PG8_SA(0, 0), cA, voffA); PG8_STAGE(PG8_SB(0, 1), cB + hstep, voffB); PG8_STAGE(PG8_SA(0, 1), cA + hstep, voffA);
        if (wr == 1) PG8_BAR;
        PG8_WAIT_V(4); PG8_BAR;
        PG8_STAGE(PG8_SB(1, 0), cB + kstep, voffB); PG8_STAGE(PG8_SA(1, 0), cA + kstep, voffA); PG8_STAGE(PG8_SB(1, 1), cB + hstep + kstep, voffB);
        PG8_WAIT_V(6); PG8_BAR;
    }
    for (;;) {
        const bool has_next = S.next(ui + 1, nxt);
        const char* nA = has_next ? (const char*)g.A + (size_t)nxt.pm * tstep : cA; const char* nB = has_next ? (const char*)g.Bt + (size_t)nxt.pn * tstep : cB;
        for (int t = 0; t < nt; t += 2) {
            const bool last = (t == nt - 2);
            const char* a1 = cA + (size_t)(t + 1) * kstep;
            const char* a2 = last ? nA : cA + (size_t)(t + 2) * kstep; const char* b2 = last ? nB : cB + (size_t)(t + 2) * kstep;
            const char* a3 = a2 + kstep; const char* b3 = b2 + kstep;
            if (last && has_next) S.a_ready(nxt);
            if constexpr (SP2) {
            PG8_LDB(B0, 0, 0); PG8_LDB(B1, 0, 1); PG8_SCHED; PG8_LDA(At, 0, 0); PG8_STAGE(PG8_SA(1, 1), a1 + hstep, voffA);
            PG8_WAIT_V(8); PG8_WAIT_L(0); PG8_BAR; PG8_MMA(0, 0, At, B0); PG8_MMA(0, 1, At, B1); PG8_BAR; PG8_SCHED;
            PG8_LDA(At, 0, 1); PG8_STAGE(PG8_SB(0, 0), b2, voffB); PG8_STAGE(PG8_SB(0, 1), b2 + hstep, voffB); PG8_STAGE(PG8_SA(0, 0), a2, voffA);
            PG8_WAIT_V(8); PG8_WAIT_L(0); PG8_BAR; PG8_MMA(1, 0, At, B0); PG8_MMA(1, 1, At, B1); PG8_BAR; PG8_SCHED;
            PG8_LDB(B0, 1, 0); PG8_LDB(B1, 1, 1); PG8_SCHED; PG8_LDA(At, 1, 0); PG8_STAGE(PG8_SA(0, 1), a2 + hstep, voffA);
            PG8_WAIT_V(8); PG8_WAIT_L(0); PG8_BAR; PG8_MMA(0, 0, At, B0); PG8_MMA(0, 1, At, B1); PG8_BAR; PG8_SCHED;
            PG8_LDA(At, 1, 1); PG8_STAGE(PG8_SB(1, 0), b3, voffB); PG8_STAGE(PG8_SB(1, 1), b3 + hstep, voffB); PG8_STAGE(PG8_SA(1, 0), a3, voffA);
            PG8_WAIT_V(8); PG8_WAIT_L(0); PG8_BAR; PG8_MMA(1, 0, At, B0); PG8_MMA(1, 1, At, B1); PG8_BAR; PG8_SCHED;
            } else {
            PG8_LDB(B0, 0, 0); PG8_SCHED; PG8_LDA(At, 0, 0); PG8_STAGE(PG8_SA(1, 1), a1 + hstep, voffA);
            PG8_WAIT_L(8); PG8_BAR; PG8_WAIT_L(0); PG8_MMA(0, 0, At, B0); PG8_BAR; PG8_SCHED;
            PG8_LDB(B1, 0, 1); PG8_STAGE(PG8_SB(0, 0), b2, voffB);
            PG8_BAR; PG8_WAIT_L(0); PG8_MMA(0, 1, At, B1); PG8_BAR;
            PG8_LDA(At, 0, 1); PG8_STAGE(PG8_SA(0, 0), a2, voffA);
            PG8_BAR; PG8_WAIT_L(0); PG8_MMA(1, 0, At, B0); PG8_BAR; PG8_SCHED;
            PG8_STAGE(PG8_SB(0, 1), b2 + hstep, voffB);
            PG8_WAIT_V(6); PG8_BAR; PG8_MMA(1, 1, At, B1); PG8_BAR;
            PG8_LDB(B0, 1, 0); PG8_SCHED; PG8_LDA(At, 1, 0); PG8_STAGE(PG8_SA(0, 1), a2 + hstep, voffA);
            PG8_WAIT_L(8); PG8_BAR; PG8_WAIT_L(0); PG8_MMA(0, 0, At, B0); PG8_BAR; PG8_SCHED;
            PG8_LDB(B1, 1, 1); PG8_STAGE(PG8_SB(1, 0), b3, voffB);
            PG8_BAR; PG8_WAIT_L(0); PG8_MMA(0, 1, At, B1); PG8_BAR;
            PG8_LDA(At, 1, 1); PG8_STAGE(PG8_SA(1, 0), a3, voffA);
            PG8_BAR; PG8_WAIT_L(0); PG8_MMA(1, 0, At, B0); PG8_BAR; PG8_SCHED;
            PG8_STAGE(PG8_SB(1, 1), b3 + hstep, voffB);
            PG8_WAIT_V(6); PG8_BAR; PG8_MMA(1, 1, At, B1); PG8_BAR;
            }
        }
        if constexpr (ALIGN_EPI) { if (wr == 0) PG8_BAR; }
        if constexpr (!Epi::AFTER_DRAIN) { E(acc, cur, wr, wc, fr, fq); S.done(cur); }
        if (!has_next) break;
#pragma unroll
        for (int a = 0; a < 2; ++a)
#pragma unroll
            for (int b = 0; b < 2; ++b)
#pragma unroll
                for (int m = 0; m < 4; ++m)
#pragma unroll
                    for (int n = 0; n < 2; ++n) acc[a][b][m][n] = (f32x4){0.f, 0.f, 0.f, 0.f};
        cur = nxt; cA = nA; cB = nB; ++ui;
        if constexpr (ALIGN_EPI) { if (wr == 1) PG8_BAR; }
    }
    PG8_WAIT_V(0);
    if constexpr (!ALIGN_EPI) { if (wr == 0) PG8_BAR; }
    PG8_BAR;
    if constexpr (Epi::AFTER_DRAIN) { E.fused(acc, cur, wr, wc, fr, fq, lds, wid, lane); S.done(cur); }
#undef PG8_SA
#undef PG8_SB
#undef PG8_STAGE
#undef PG8_LDA
#undef PG8_LDB
#undef PG8_MMA
#undef PG8_WAIT_V
#undef PG8_WAIT_L
#undef PG8_BAR
#undef PG8_SCHED
}
}

using pg8::bf16_t; using pg8::bf16x8; using pg8::f32x4; using pg8::u32x4; using pg8::Unit;
typedef float f32x16 __attribute__((ext_vector_type(16)));
typedef short s16x4 __attribute__((ext_vector_type(4)));
typedef unsigned u32x2 __attribute__((ext_vector_type(2)));
typedef float f32x2 __attribute__((ext_vector_type(2)));
#define DI __device__ __forceinline__
#define LAS __attribute__((address_space(3)))

constexpr int BATCH = 8, SEQ = 4096, DM = 1024, NTOK = BATCH * SEQ;
constexpr int N_IN0 = 4096, N_IN1 = 2304;
constexpr float NORM_EPS = 1e-6f;
constexpr float SC_LOG2 = 0.125f * 1.44269504088896341f;
constexpr float NEGBIG = -1e30f;
constexpr int NTHREADS = 512;
#ifndef PH_MASK
#define PH_MASK 0x7f
#endif
#ifndef PROBE_REP
#define PROBE_REP 0
#endif
#define NREP(k) (((PROBE_REP >> (k)) & 1) ? 2 : 1)
constexpr int LDS_BYTES = 157696;

constexpr size_t MiB = 1u << 20;
constexpr size_t WS_BT0 = 0 * MiB, WS_BT1 = 8 * MiB, WS_BT2 = 10 * MiB, WS_BT3 = 15 * MiB;
constexpr size_t WS_BAR = 17 * MiB + 512 * 1024;
constexpr size_t WS_GAINS = 17 * MiB;
constexpr size_t WS_RSTD0 = 18 * MiB, WS_CS = 19 * MiB, WS_KMP = 20 * MiB, WS_SSQ = 21 * MiB;
constexpr size_t WS_XB = 32 * MiB;
constexpr size_t WS_Y = 32 * MiB;
constexpr size_t WS_QA = 96 * MiB, WS_KA = 128 * MiB, WS_VTA = 160 * MiB, WS_QB = 192 * MiB, WS_KB = 224 * MiB, WS_VTB = 256 * MiB;
constexpr size_t WS_ZS = 288 * MiB;
constexpr size_t WS_X1 = 352 * MiB;
constexpr size_t WS_X1B = 96 * MiB;
constexpr size_t WS_QC = 160 * MiB, WS_KC = 224 * MiB, WS_VTC = 232 * MiB, WS_ZS1 = 240 * MiB;
constexpr size_t WS_EXO = 352 * MiB, WS_EXL = 416 * MiB;
constexpr size_t WS_END = 480 * MiB;

struct Params {
    const float* x; const float* norm_even; const float* w_in_even; const float* w_out_even;
    const float* qn_a; const float* kn_a; const float* qn_b; const float* kn_b;
    const float* norm_odd; const float* w_in_odd; const float* w_out_odd; const float* qn_c; const float* kn_c; const float* sinks;
    float* out; unsigned char* ws;
};

typedef __bf16 bf16v2 __attribute__((ext_vector_type(2)));
DI unsigned cvt_pk(float lo, float hi) { const f32x2 v = {lo, hi}; return __builtin_bit_cast(unsigned, __builtin_convertvector(v, bf16v2)); }
DI float bf_lo(unsigned u) { return __uint_as_float(u << 16); }
DI float bf_hi(unsigned u) { return __uint_as_float(u & 0xffff0000u); }

DI void p0_weight_tile(LAS float* tile, const float* W, bf16_t* Bt, int N, const float* g, bool permute, int t) {
    const int tid = threadIdx.x;
    const int ntn = N / 64, k0 = (t / ntn) * 64, n0 = (t % ntn) * 64;
    {
        const int n = tid & 63, kr = tid >> 6;
#pragma unroll
        for (int i = 0; i < 8; ++i) { const int k = kr + 8 * i; tile[k * 65 + n] = W[(size_t)(k0 + k) * N + n0 + n] * (g ? g[k0 + k] : 1.0f); }
    }
    __syncthreads();
    {
        const int nn = tid >> 3, ks = tid & 7;
        const int nlog = n0 + nn;
        const int c = permute ? ((nlog & ~255) | (((nlog >> 5) & 1) << 7) | (((nlog >> 6) & 3) << 5) | (nlog & 31)) : nlog;
        float v[8];
#pragma unroll
        for (int i = 0; i < 8; ++i) v[i] = tile[(ks * 8 + i) * 65 + nn];
        u32x4 w; w.x = cvt_pk(v[0], v[1]); w.y = cvt_pk(v[2], v[3]); w.z = cvt_pk(v[4], v[5]); w.w = cvt_pk(v[6], v[7]);
        *(u32x4*)(Bt + (size_t)c * 1024 + k0 + ks * 8) = w;
    }
    __syncthreads();
}

DI void sincos_d(double x, double& s, double& c) {
    const double kq = __builtin_rint(x * 0.63661977236758134308);
    double r = __builtin_fma(-kq, 1.57079632679489655800e+00, x); r = __builtin_fma(-kq, 6.12323399573676603587e-17, r);
    const int q = ((int)kq) & 3;
    const double r2 = r * r;
    const double sp = r * (1.0 + r2 * (-1.0 / 6 + r2 * (1.0 / 120 + r2 * (-1.0 / 5040 + r2 * (1.0 / 362880 + r2 * (-1.0 / 39916800 + r2 * (1.0 / 6227020800.0)))))));
    const double cp = 1.0 + r2 * (-0.5 + r2 * (1.0 / 24 + r2 * (-1.0 / 720 + r2 * (1.0 / 40320 + r2 * (-1.0 / 3628800 + r2 * (1.0 / 479001600.0 + r2 * (-1.0 / 87178291200.0)))))));
    s = (q == 0) ? sp : (q == 1) ? cp : (q == 2) ? -sp : -cp;
    c = (q == 0) ? cp : (q == 1) ? -sp : (q == 2) ? -cp : sp;
}

DI void p0_prologue(const Params& P, LAS unsigned char* lds) {
    unsigned char* ws = P.ws;
    const int tid = threadIdx.x, lane = tid & 63, wid = tid >> 6;
    const int G = gridDim.x, bid = blockIdx.x;
    {
        bf16_t* xb = (bf16_t*)(ws + WS_XB); float* rstd = (float*)(ws + WS_RSTD0);
        for (int row = bid * 8 + wid; row < NTOK; row += G * 8) {
            const f32x4* xr = (const f32x4*)(P.x + (size_t)row * DM);
            float ss = 0.f;
#pragma unroll
            for (int i = 0; i < 4; ++i) {
                const f32x4 v = xr[lane + 64 * i];
                ss += v[0] * v[0] + v[1] * v[1] + v[2] * v[2] + v[3] * v[3];
                u32x2 w; w.x = cvt_pk(v[0], v[1]); w.y = cvt_pk(v[2], v[3]);
                *(u32x2*)(xb + (size_t)row * DM + 4 * (lane + 64 * i)) = w;
            }
#pragma unroll
            for (int o = 32; o >= 1; o >>= 1) ss += __shfl_xor(ss, o);
            if (lane == 0) rstd[row] = rsqrtf(ss * (1.0f / DM) + NORM_EPS);
        }
    }
    if (bid == 0 && tid < 64) {
        float* gw = (float*)(ws + WS_GAINS);
        gw[tid] = P.qn_a[tid]; gw[64 + tid] = P.kn_a[tid]; gw[128 + tid] = P.qn_b[tid]; gw[192 + tid] = P.kn_b[tid]; gw[256 + tid] = P.qn_c[tid]; gw[320 + tid] = P.kn_c[tid];
        if (tid < 16) gw[384 + tid] = P.sinks[tid];
        float ma = fabsf(P.qn_a[tid]), mb = fabsf(P.kn_a[tid]), mc = fabsf(P.qn_b[tid]), md = fabsf(P.kn_b[tid]), me = fabsf(P.qn_c[tid]), mf = fabsf(P.kn_c[tid]);
#pragma unroll
        for (int o = 32; o >= 1; o >>= 1) { ma = fmaxf(ma, __shfl_xor(ma, o)); mb = fmaxf(mb, __shfl_xor(mb, o)); mc = fmaxf(mc, __shfl_xor(mc, o)); md = fmaxf(md, __shfl_xor(md, o)); me = fmaxf(me, __shfl_xor(me, o)); mf = fmaxf(mf, __shfl_xor(mf, o)); }
        if (tid == 0) { const float c = 8.0f * 1.44269504088896341f * 1.01f; gw[400] = c * ma * mb; gw[401] = c * mc * md; gw[402] = c * me * mf; }
    }
    {
        f32x2* cs = (f32x2*)(ws + WS_CS);
        for (int e = bid * NTHREADS + tid; e < SEQ * 32; e += G * NTHREADS) {
            const int pos = e >> 5, i = e & 31;
            double f = 1.0;
            for (int k = 0; k < i; ++k) f *= 0.7498942093324558;
            const float invf = (float)f;
            const float ang = (float)pos * invf;
            double s, c; sincos_d((double)ang, s, c);
            cs[e] = (f32x2){(float)c, (float)s};
        }
    }
    {
        LAS float* tile = (LAS float*)lds;
        const int T0 = 16 * (N_IN0 / 64), T1 = 16 * (DM / 64), T2 = 16 * (N_IN1 / 64), T3 = 16 * (DM / 64);
        for (int t = bid; t < T0 + T1 + T2 + T3; t += G) {
            if (t < T0) p0_weight_tile(tile, P.w_in_even, (bf16_t*)(ws + WS_BT0), N_IN0, P.norm_even, true, t);
            else if (t < T0 + T1) p0_weight_tile(tile, P.w_out_even, (bf16_t*)(ws + WS_BT1), DM, nullptr, false, t - T0);
            else if (t < T0 + T1 + T2) p0_weight_tile(tile, P.w_in_odd, (bf16_t*)(ws + WS_BT2), N_IN1, P.norm_odd, true, t - T0 - T1);
            else p0_weight_tile(tile, P.w_out_odd, (bf16_t*)(ws + WS_BT3), DM, nullptr, false, t - T0 - T1 - T2);
        }
    }
}

DI float row_rstd1(const float* ssq, int row, int fq) {
    const f32x4 a = *(const f32x4*)(ssq + (size_t)row * 16 + 4 * fq);
    float t = (a[0] + a[1]) + (a[2] + a[3]);
    t += __shfl_xor(t, 16); t += __shfl_xor(t, 32);
    return rsqrtf(t * (1.0f / DM) + NORM_EPS);
}
struct EpiIn {
    static constexpr bool PERM = true, AFTER_DRAIN = false;
    int layer; unsigned char* ws;
    __device__ __forceinline__ void operator()(const f32x4 (&acc)[2][2][4][2], const Unit& u, int wr, int wc, int fr, int fq) const {
        const float* rstd0 = (const float*)(ws + WS_RSTD0); const float* ssq = (const float*)(ws + WS_SSQ); const f32x2* cs = (const f32x2*)(ws + WS_CS);
        const float* gains = (const float*)(ws + WS_GAINS); bf16_t* zs = (bf16_t*)(ws + (layer == 0 ? WS_ZS : WS_ZS1)); float* kmp = (float*)(ws + WS_KMP);
        int mode, head, hpb = 8, zcol = 0; bf16_t* dst = nullptr; const float* gain = gains; bool do_km = false; float qsc = 1.0f;
        if (layer == 0) {
            const int seg = u.pn >> 1; head = (u.pn & 1) * 4 + wc;
            if (seg == 0) { mode = 0; dst = (bf16_t*)(ws + WS_QA); gain = gains; qsc = SC_LOG2; }
            else if (seg == 1) { mode = 0; dst = (bf16_t*)(ws + WS_KA); gain = gains + 64; }
            else if (seg == 2) { mode = 1; dst = (bf16_t*)(ws + WS_VTA); }
            else if (seg == 3) { mode = 2; zcol = head * 64; }
            else if (seg == 4) { mode = 0; dst = (bf16_t*)(ws + WS_QB); gain = gains + 128; qsc = SC_LOG2; }
            else if (seg == 5) { mode = 0; dst = (bf16_t*)(ws + WS_KB); gain = gains + 192; do_km = true; }
            else if (seg == 6) { mode = 1; dst = (bf16_t*)(ws + WS_VTB); }
            else { mode = 2; zcol = 512 + head * 64; }
        } else {
            if (u.pn < 4) { mode = 0; dst = (bf16_t*)(ws + WS_QC); gain = gains + 256; head = u.pn * 4 + wc; hpb = 16; qsc = SC_LOG2; }
            else if (u.pn == 4) { hpb = 2; if (wc < 2) { mode = 0; dst = (bf16_t*)(ws + WS_KC); gain = gains + 320; head = wc; } else { mode = 1; dst = (bf16_t*)(ws + WS_VTC); head = wc - 2; } }
            else { mode = 2; head = (u.pn - 5) * 4 + wc; zcol = head * 64; }
        }
        const int b = u.pm >> 4, sbase = (u.pm & 15) * 256 + wr * 64 + fr, rowbase = u.pm * 256 + wr * 64 + fr;
        const size_t bh = (size_t)b * hpb + head;
#define ROW_RS(row) ((layer == 0) ? rstd0[(row)] : row_rstd1(ssq, (row), fq))
        if (mode == 0) {
            float g0[8], g1[8], cs0[8], cs1[8];
#pragma unroll
            for (int i = 0; i < 8; ++i) { g0[i] = gain[8 * fq + i] * qsc; g1[i] = gain[32 + 8 * fq + i] * qsc; cs0[i] = 0.f; cs1[i] = 0.f; }
#pragma unroll
            for (int ai = 0; ai < 2; ++ai)
#pragma unroll
                for (int m = 0; m < 4; ++m) {
                    const int s = sbase + ai * 128 + m * 16; const float r = ROW_RS(rowbase + ai * 128 + m * 16);
                    float t0[8], t1[8]; float ss = 0.f;
#pragma unroll
                    for (int n = 0; n < 2; ++n)
#pragma unroll
                        for (int j = 0; j < 4; ++j) { t0[4 * n + j] = acc[ai][0][m][n][j] * r; t1[4 * n + j] = acc[ai][1][m][n][j] * r; }
#pragma unroll
                    for (int i = 0; i < 8; ++i) ss += t0[i] * t0[i] + t1[i] * t1[i];
                    ss += __shfl_xor(ss, 16); ss += __shfl_xor(ss, 32);
                    const float hr = rsqrtf(ss * (1.0f / 64.0f) + NORM_EPS);
                    const f32x4* cp = (const f32x4*)(cs + (size_t)s * 32 + 8 * fq);
                    float o0[8], o1[8];
#pragma unroll
                    for (int q = 0; q < 4; ++q) { const f32x4 c4 = cp[q];
                        { const int i = 2 * q; const float a = t0[i] * hr * g0[i], bb = t1[i] * hr * g1[i]; o0[i] = a * c4[0] - bb * c4[1]; o1[i] = bb * c4[0] + a * c4[1]; }
                        { const int i = 2 * q + 1; const float a = t0[i] * hr * g0[i], bb = t1[i] * hr * g1[i]; o0[i] = a * c4[2] - bb * c4[3]; o1[i] = bb * c4[2] + a * c4[3]; } }
                    u32x4 w0, w1;
                    w0.x = cvt_pk(o0[0], o0[1]); w0.y = cvt_pk(o0[2], o0[3]); w0.z = cvt_pk(o0[4], o0[5]); w0.w = cvt_pk(o0[6], o0[7]);
                    w1.x = cvt_pk(o1[0], o1[1]); w1.y = cvt_pk(o1[2], o1[3]); w1.z = cvt_pk(o1[4], o1[5]); w1.w = cvt_pk(o1[6], o1[7]);
                    bf16_t* rp = dst + ((bh * SEQ + s) * 64 + 8 * fq);
                    *(u32x4*)rp = w0; *(u32x4*)(rp + 32) = w1;
                    if (do_km) {
#pragma unroll
                        for (int i = 0; i < 8; ++i) { cs0[i] += o0[i]; cs1[i] += o1[i]; }
                    }
                }
            if (do_km) {
#pragma unroll
                for (int i = 0; i < 8; ++i) {
#pragma unroll
                    for (int o = 1; o <= 8; o <<= 1) { cs0[i] += __shfl_xor(cs0[i], o); cs1[i] += __shfl_xor(cs1[i], o); }
                }
                if (fr == 0) {
                    float* kp = kmp + (((size_t)wr * 64 + bh) * 16 + (u.pm & 15)) * 64 + 8 * fq;
                    *(f32x4*)kp = (f32x4){cs0[0], cs0[1], cs0[2], cs0[3]}; *(f32x4*)(kp + 4) = (f32x4){cs0[4], cs0[5], cs0[6], cs0[7]};
                    *(f32x4*)(kp + 32) = (f32x4){cs1[0], cs1[1], cs1[2], cs1[3]}; *(f32x4*)(kp + 36) = (f32x4){cs1[4], cs1[5], cs1[6], cs1[7]};
                }
            }
        } else if (mode == 1) {
#pragma unroll
            for (int ai = 0; ai < 2; ++ai)
#pragma unroll
                for (int m = 0; m < 4; ++m) {
                    const int s = sbase + ai * 128 + m * 16; const float r = ROW_RS(rowbase + ai * 128 + m * 16);
                    bf16_t* rp = dst + ((bh * SEQ + s) * 64 + 8 * fq);
#pragma unroll
                    for (int bj = 0; bj < 2; ++bj) {
                        const f32x4 v0 = acc[ai][bj][m][0] * r, v1 = acc[ai][bj][m][1] * r;
                        u32x4 w; w.x = cvt_pk(v0[0], v0[1]); w.y = cvt_pk(v0[2], v0[3]); w.z = cvt_pk(v1[0], v1[1]); w.w = cvt_pk(v1[2], v1[3]);
                        *(u32x4*)(rp + 32 * bj) = w;
                    }
                }
        } else {
#pragma unroll
            for (int ai = 0; ai < 2; ++ai)
#pragma unroll
                for (int m = 0; m < 4; ++m) {
                    const int row = rowbase + ai * 128 + m * 16; const float r = ROW_RS(row);
#pragma unroll
                    for (int bj = 0; bj < 2; ++bj) {
                        float sv[8];
#pragma unroll
                        for (int n = 0; n < 2; ++n)
#pragma unroll
                            for (int j = 0; j < 4; ++j) { const float z = acc[ai][bj][m][n][j] * r; sv[4 * n + j] = z / (1.0f + __expf(-z)); }
                        u32x4 w; w.x = cvt_pk(sv[0], sv[1]); w.y = cvt_pk(sv[2], sv[3]); w.z = cvt_pk(sv[4], sv[5]); w.w = cvt_pk(sv[6], sv[7]);
                        *(u32x4*)(zs + (size_t)row * DM + zcol + 32 * bj + 8 * fq) = w;
                    }
                }
        }
    }
};

struct EpiOut {
    static constexpr bool PERM = true, AFTER_DRAIN = false;
    const float* resid; float* out; bf16_t* xb; float* ssq;
    __device__ __forceinline__ void operator()(const f32x4 (&acc)[2][2][4][2], const Unit& u, int wr, int wc, int fr, int fq) const {
        const int col0 = u.pn * 256 + wc * 32 + 8 * fq, rowbase = u.pm * 256 + wr * 64 + fr;
#pragma unroll
        for (int ai = 0; ai < 2; ++ai)
#pragma unroll
            for (int m = 0; m < 4; ++m) {
                const int row = rowbase + ai * 128 + m * 16; const size_t off = (size_t)row * DM + col0;
                float q = 0.f;
#pragma unroll
                for (int bj = 0; bj < 2; ++bj) {
                    const f32x4 r0 = *(const f32x4*)(resid + off + bj * 128), r1 = *(const f32x4*)(resid + off + bj * 128 + 4);
                    const f32x4 o0 = r0 + acc[ai][bj][m][0], o1 = r1 + acc[ai][bj][m][1];
                    *(f32x4*)(out + off + bj * 128) = o0; *(f32x4*)(out + off + bj * 128 + 4) = o1;
                    if (xb) {
                        u32x4 w; w.x = cvt_pk(o0[0], o0[1]); w.y = cvt_pk(o0[2], o0[3]); w.z = cvt_pk(o1[0], o1[1]); w.w = cvt_pk(o1[2], o1[3]);
                        *(u32x4*)(xb + off + bj * 128) = w;
                        q += (o0[0] * o0[0] + o0[1] * o0[1]) + (o0[2] * o0[2] + o0[3] * o0[3]) + (o1[0] * o1[0] + o1[1] * o1[1]) + (o1[2] * o1[2] + o1[3] * o1[3]);
                    }
                }
                if (xb) { q += __shfl_xor(q, 16); q += __shfl_xor(q, 32); if (fq == 0) ssq[(size_t)row * 16 + u.pn * 4 + wc] = q; }
            }
    }
};

#define MFMA32(a, b, c) __builtin_amdgcn_mfma_f32_32x32x16_bf16((a), (b), (c), 0, 0, 0)
constexpr int TROW = 144;
constexpr int TBUF = 2 * 32 * TROW;
struct TileRegs { u32x4 k[4]; u32x4 v[4]; };
struct ASt { f32x16 o0, o1; float l; };
struct QT { bf16x8 qf[4]; ASt st; };

DI void qt_init(QT& t, const bf16_t* qrow, int h) {
    const bf16x8* qp = (const bf16x8*)qrow;
#pragma unroll
    for (int ks = 0; ks < 4; ++ks) t.qf[ks] = qp[2 * ks + h];
#pragma unroll
    for (int i = 0; i < 16; ++i) { t.st.o0[i] = 0.f; t.st.o1[i] = 0.f; }
    t.st.l = 0.f;
}

DI void tile_gload(TileRegs& t, const bf16_t* K, const bf16_t* V, int kbase, int kstride, int lane) {
    const int row0 = lane >> 3, ch = lane & 7;
#pragma unroll
    for (int i = 0; i < 4; ++i) {
        const unsigned off = (unsigned)((kbase + kstride * (row0 + 8 * i)) * 128 + ch * 16);
        t.k[i] = *(const u32x4*)((const unsigned char*)K + off); t.v[i] = *(const u32x4*)((const unsigned char*)V + off);
    }
}
DI bf16x8 lds_frag(const LAS unsigned char* p) { return __builtin_bit_cast(bf16x8, *(const LAS u32x4*)p); }
DI void tile_lds_write(LAS unsigned char* buf, const TileRegs& t, int lane) {
    const int row0 = lane >> 3, ch = lane & 7;
#pragma unroll
    for (int i = 0; i < 4; ++i) {
        const int off = (row0 + 8 * i) * TROW + ch * 16;
        *(LAS u32x4*)(buf + off) = t.k[i]; *(LAS u32x4*)(buf + 32 * TROW + off) = t.v[i];
    }
}
DI void load_kfrag(bf16x8 (&kf)[4], LAS unsigned char* buf, int lane) {
    const int r = lane & 31, h = lane >> 5;
#pragma unroll
    for (int ks = 0; ks < 4; ++ks) kf[ks] = lds_frag(buf + r * TROW + (2 * ks + h) * 16);
}
DI void load_vfrag(bf16x8 (&vf)[2][2], LAS unsigned char* buf, int lane) {
    const int h = lane >> 5, q = (lane & 15) >> 2, p = lane & 3, blk = (lane >> 4) & 1;
    LAS unsigned char* vb = buf + 32 * TROW + (4 * h + q) * TROW + 32 * blk + 8 * p;
#pragma unroll
    for (int dt = 0; dt < 2; ++dt)
#pragma unroll
        for (int s2 = 0; s2 < 2; ++s2) {
            const s16x4 lo = __builtin_amdgcn_ds_read_tr16_b64_v4i16((LAS s16x4*)(vb + (16 * s2) * TROW + 64 * dt));
            const s16x4 hi4 = __builtin_amdgcn_ds_read_tr16_b64_v4i16((LAS s16x4*)(vb + (16 * s2 + 8) * TROW + 64 * dt));
            vf[dt][s2] = __builtin_shufflevector(lo, hi4, 0, 1, 2, 3, 4, 5, 6, 7);
        }
}
DI void qk_mfma(f32x16& s, const bf16x8 (&kf)[4], const bf16x8 (&qf)[4]) {
#pragma unroll
    for (int i = 0; i < 16; ++i) s[i] = 0.f;
#pragma unroll
    for (int ks = 0; ks < 4; ++ks) s = MFMA32(kf[ks], qf[ks], s);
}
template <bool SUB>
DI void softmax_p(ASt& st, f32x16& s, int dist0, int kstride, int hi, bool lane_ok, bool elem, float sub) {
    if (elem) {
        int d0 = dist0; asm volatile("" : "+v"(d0));
#pragma unroll
        for (int i = 0; i < 16; ++i) {
            const unsigned dist = (unsigned)(d0 - kstride * ((i & 3) + 8 * (i >> 2)));
            s[i] = (dist <= (unsigned)hi) ? s[i] : NEGBIG;
        }
    }
    float ps0 = 0.f, ps1 = 0.f;
#pragma unroll
    for (int i = 0; i < 16; i += 2) {
        s[i] = __builtin_amdgcn_exp2f(SUB ? s[i] - sub : s[i]); s[i + 1] = __builtin_amdgcn_exp2f(SUB ? s[i + 1] - sub : s[i + 1]); ps0 += s[i]; ps1 += s[i + 1];
    }
    st.l += lane_ok ? (ps0 + ps1) : 0.f;
}
DI void pv_mfma(ASt& st, const f32x16& s, const bf16x8 (&vf)[2][2]) {
#pragma unroll
    for (int s2 = 0; s2 < 2; ++s2) {
        u32x4 p;
        p.x = cvt_pk(s[8 * s2 + 0], s[8 * s2 + 1]); p.y = cvt_pk(s[8 * s2 + 2], s[8 * s2 + 3]);
        p.z = cvt_pk(s[8 * s2 + 4], s[8 * s2 + 5]); p.w = cvt_pk(s[8 * s2 + 6], s[8 * s2 + 7]);
        const bf16x8 pb = __builtin_bit_cast(bf16x8, p);
        st.o0 = MFMA32(vf[0][s2], pb, st.o0);
        st.o1 = MFMA32(vf[1][s2], pb, st.o1);
    }
}
DI void pack_p(bf16x8 (&pb)[2], const f32x16& s, bool lane_ok) {
    const unsigned lm = lane_ok ? 0xffffffffu : 0u;
#pragma unroll
    for (int s2 = 0; s2 < 2; ++s2) {
        u32x4 p;
        p.x = cvt_pk(s[8 * s2 + 0], s[8 * s2 + 1]) & lm; p.y = cvt_pk(s[8 * s2 + 2], s[8 * s2 + 3]) & lm;
        p.z = cvt_pk(s[8 * s2 + 4], s[8 * s2 + 5]) & lm; p.w = cvt_pk(s[8 * s2 + 6], s[8 * s2 + 7]) & lm;
        pb[s2] = __builtin_bit_cast(bf16x8, p);
    }
}
DI bf16x8 load_vfrag1(LAS unsigned char* vb, int dt, int s2) {
    const s16x4 lo = __builtin_amdgcn_ds_read_tr16_b64_v4i16((LAS s16x4*)(vb + (16 * s2) * TROW + 64 * dt));
    const s16x4 hi4 = __builtin_amdgcn_ds_read_tr16_b64_v4i16((LAS s16x4*)(vb + (16 * s2 + 8) * TROW + 64 * dt));
    return __builtin_shufflevector(lo, hi4, 0, 1, 2, 3, 4, 5, 6, 7);
}
DI void core2(QT& a, QT& b, LAS unsigned char* buf, int dist0a, int dist0b, int kstride, int hi, bool elem, bool oka, bool okb, float m0, int lane) {
    const int r = lane & 31, h = lane >> 5;
    f32x16 sa, sb;
    {
        const float c = -m0;
        const f32x16 cinit = {c, c, c, c, c, c, c, c, c, c, c, c, c, c, c, c};
        const bf16x8 kf = lds_frag(buf + r * TROW + h * 16); sa = MFMA32(kf, a.qf[0], cinit); sb = MFMA32(kf, b.qf[0], cinit);
    }
#pragma unroll
    for (int ks = 1; ks < 4; ++ks) { const bf16x8 kf = lds_frag(buf + r * TROW + (2 * ks + h) * 16); sa = MFMA32(kf, a.qf[ks], sa); sb = MFMA32(kf, b.qf[ks], sb); }
    LAS unsigned char* vb = buf + 32 * TROW + (4 * h + ((lane & 15) >> 2)) * TROW + 32 * ((lane >> 4) & 1) + 8 * (lane & 3);
    softmax_p<false>(a.st, sa, dist0a, kstride, hi, oka, elem, 0.f);
    {
        bf16x8 pa[2]; pack_p(pa, sa, oka);
#pragma unroll
        for (int s2 = 0; s2 < 2; ++s2) {
            const bf16x8 v0 = load_vfrag1(vb, 0, s2), v1 = load_vfrag1(vb, 1, s2);
            a.st.o0 = MFMA32(v0, pa[s2], a.st.o0); a.st.o1 = MFMA32(v1, pa[s2], a.st.o1);
        }
    }
    softmax_p<false>(b.st, sb, dist0b, kstride, hi, okb, elem, 0.f);
    {
        bf16x8 pb[2]; pack_p(pb, sb, okb);
#pragma unroll
        for (int s2 = 0; s2 < 2; ++s2) {
            const bf16x8 v0 = load_vfrag1(vb, 0, s2), v1 = load_vfrag1(vb, 1, s2);
            b.st.o0 = MFMA32(v0, pb[s2], b.st.o0); b.st.o1 = MFMA32(v1, pb[s2], b.st.o1);
        }
    }
}
DI void core1g(ASt& st, const bf16x8 (&qf)[4], LAS unsigned char* buf, bool ok, float m0, int lane) {
    const int r = lane & 31, h = lane >> 5;
    f32x16 s;
    {
        const f32x16 zero = {0.f, 0.f, 0.f, 0.f, 0.f, 0.f, 0.f, 0.f, 0.f, 0.f, 0.f, 0.f, 0.f, 0.f, 0.f, 0.f};
        const bf16x8 kf = lds_frag(buf + r * TROW + h * 16); s = MFMA32(kf, qf[0], zero);
    }
#pragma unroll
    for (int ks = 1; ks < 4; ++ks) { const bf16x8 kf = lds_frag(buf + r * TROW + (2 * ks + h) * 16); s = MFMA32(kf, qf[ks], s); }
    LAS unsigned char* vb = buf + 32 * TROW + (4 * h + ((lane & 15) >> 2)) * TROW + 32 * ((lane >> 4) & 1) + 8 * (lane & 3);
    softmax_p<true>(st, s, 0, 0, 0, ok, false, m0);
    bf16x8 p[2]; pack_p(p, s, ok);
#pragma unroll
    for (int s2 = 0; s2 < 2; ++s2) {
        const bf16x8 v0 = load_vfrag1(vb, 0, s2), v1 = load_vfrag1(vb, 1, s2);
        st.o0 = MFMA32(v0, p[s2], st.o0); st.o1 = MFMA32(v1, p[s2], st.o1);
    }
}
DI bool band_all_ok(int dist0, int kstride, int hi, int h) {
    const int d_first = dist0 + kstride * 4 * h, d_last = d_first - 31 * kstride;
    return (d_last >= 0) && (d_first <= hi);
}
DI void band2(QT& a, QT& b, LAS unsigned char* buf, int dist0a, int dist0b, int kstride, int hi, int who, float m0, int lane) {
    const bool oka = who != 1, okb = who != 0;
    const bool allok = (!oka || band_all_ok(dist0a, kstride, hi, lane >> 5)) && (!okb || band_all_ok(dist0b, kstride, hi, lane >> 5));
    const bool elem = __builtin_amdgcn_ballot_w64(!allok) != 0ull;
    core2(a, b, buf, dist0a, dist0b, kstride, hi, elem, oka, okb, m0, lane);
}

DI void attn_finish(ASt& st, float sink_l2, float m0, const bf16_t* zs, bf16_t* y, size_t rowoff  , int h) {
    float l = st.l + __shfl_xor(st.l, 32);
    l += (sink_l2 > -1e29f) ? __builtin_amdgcn_exp2f(sink_l2 - m0) : 0.f;
    const float inv = 1.0f / l;
#pragma unroll
    for (int dt = 0; dt < 2; ++dt)
#pragma unroll
        for (int g = 0; g < 4; ++g) {
            const size_t off = rowoff + 32 * dt + 8 * g + 4 * h;
            const u32x2 z = *(const u32x2*)(zs + off);
            const float v0 = (dt ? st.o1[4 * g + 0] : st.o0[4 * g + 0]) * inv * bf_lo(z.x);
            const float v1 = (dt ? st.o1[4 * g + 1] : st.o0[4 * g + 1]) * inv * bf_hi(z.x);
            const float v2 = (dt ? st.o1[4 * g + 2] : st.o0[4 * g + 2]) * inv * bf_lo(z.y);
            const float v3 = (dt ? st.o1[4 * g + 3] : st.o0[4 * g + 3]) * inv * bf_hi(z.y);
            u32x2 w; w.x = cvt_pk(v0, v1); w.y = cvt_pk(v2, v3);
            *(u32x2*)(y + off) = w;
        }
}

DI void attn_a_y(unsigned char* ws, LAS unsigned char* buf, int bh, int t0, int lane) {
    const int r = lane & 31, h = lane >> 5;
    const bf16_t* Q = (const bf16_t*)(ws + WS_QA) + (size_t)bh * SEQ * 64;
    const bf16_t* K = (const bf16_t*)(ws + WS_KA) + (size_t)bh * SEQ * 64;
    const bf16_t* V = (const bf16_t*)(ws + WS_VTA) + (size_t)bh * SEQ * 64;
    const int qpa = t0 + r, qpb = qpa + 32;
    const float m0 = ((const float*)(ws + WS_GAINS))[400];
    QT a, b; qt_init(a, Q + (size_t)qpa * 64, h); qt_init(b, Q + (size_t)qpb * 64, h);
    TileRegs tr;
    int T = (t0 >= 128) ? 0 : (128 - t0) / 32;
    tile_gload(tr, K, V, t0 - 128 + 32 * T, 1, lane);
    for (;;) {
        tile_lds_write(buf, tr, lane);
        const bool have = (T + 1) < 6;
        if (have) tile_gload(tr, K, V, t0 - 128 + 32 * (T + 1), 1, lane);
        const int kb = t0 - 128 + 32 * T;
        band2(a, b, buf, qpa - kb - 4 * h, qpb - kb - 4 * h, 1, 128, 2, m0, lane);
        if (!have) break;
        ++T;
    }
    const float la = a.st.l + __shfl_xor(a.st.l, 32), lb = b.st.l + __shfl_xor(b.st.l, 32);
    float* exa = (float*)(ws + WS_EXO) + ((size_t)bh * SEQ + qpa) * 64 + 4 * h;
    float* exb = exa + 32 * 64;
#pragma unroll
    for (int g = 0; g < 4; ++g) {
        *(f32x4*)(exa + 8 * g) = (f32x4){a.st.o0[4 * g], a.st.o0[4 * g + 1], a.st.o0[4 * g + 2], a.st.o0[4 * g + 3]};
        *(f32x4*)(exa + 32 + 8 * g) = (f32x4){a.st.o1[4 * g], a.st.o1[4 * g + 1], a.st.o1[4 * g + 2], a.st.o1[4 * g + 3]};
        *(f32x4*)(exb + 8 * g) = (f32x4){b.st.o0[4 * g], b.st.o0[4 * g + 1], b.st.o0[4 * g + 2], b.st.o0[4 * g + 3]};
        *(f32x4*)(exb + 32 + 8 * g) = (f32x4){b.st.o1[4 * g], b.st.o1[4 * g + 1], b.st.o1[4 * g + 2], b.st.o1[4 * g + 3]};
    }
    if (h == 0) { float* exl = (float*)(ws + WS_EXL) + (size_t)bh * SEQ; exl[qpa] = la; exl[qpb] = lb; }
}
DI bool a_tile_desc(int tau, int ra, int i0, int& kbase, int& kstride, int& hi, int& who) {
    if (tau < 10) { const int t = (tau < 5) ? tau : tau - 5; const int jb = i0 - 128 + 32 * t; who = (tau < 5) ? 0 : 1; kbase = ra + 8 * who + 16 * jb; kstride = 16; hi = 2048; return jb >= 0; }
    who = 2;
    { const int ub = 4 * i0 - 128 + 32 * (tau - 10); kbase = (ra & 3) + 4 * ub; kstride = 4; hi = 512; return ub >= 0; }
}
DI int a_next(int tau, int ra, int i0) { int t = tau + 1, kb, ks, hi, who; while (t < 18 && !a_tile_desc(t, ra, i0, kb, ks, hi, who)) ++t; return t; }
DI void attn_a_x(unsigned char* ws, LAS unsigned char* buf, int bh, int ra, int i0, int lane) {
    const int r = lane & 31, h = lane >> 5;
    const bf16_t* Q = (const bf16_t*)(ws + WS_QA) + (size_t)bh * SEQ * 64;
    const bf16_t* K = (const bf16_t*)(ws + WS_KA) + (size_t)bh * SEQ * 64;
    const bf16_t* V = (const bf16_t*)(ws + WS_VTA) + (size_t)bh * SEQ * 64;
    const int qpa = ra + 16 * (i0 + r), qpb = qpa + 8;
    const float m0 = ((const float*)(ws + WS_GAINS))[400];
    QT a, b; qt_init(a, Q + (size_t)qpa * 64, h); qt_init(b, Q + (size_t)qpb * 64, h);
    {
        const float* exa = (const float*)(ws + WS_EXO) + ((size_t)bh * SEQ + qpa) * 64 + 4 * h;
        const float* exb = exa + 8 * 64;
#pragma unroll
        for (int g = 0; g < 4; ++g) {
            const f32x4 a0 = *(const f32x4*)(exa + 8 * g), a1 = *(const f32x4*)(exa + 32 + 8 * g), b0 = *(const f32x4*)(exb + 8 * g), b1 = *(const f32x4*)(exb + 32 + 8 * g);
#pragma unroll
            for (int j = 0; j < 4; ++j) { a.st.o0[4 * g + j] = a0[j]; a.st.o1[4 * g + j] = a1[j]; b.st.o0[4 * g + j] = b0[j]; b.st.o1[4 * g + j] = b1[j]; }
        }
        const float* exl = (const float*)(ws + WS_EXL) + (size_t)bh * SEQ;
        a.st.l = (h == 0) ? exl[qpa] : 0.f; b.st.l = (h == 0) ? exl[qpb] : 0.f;
    }
    TileRegs tr;
    int tc = a_next(-1, ra, i0);
    { int kb, ks, hi, who; (void)a_tile_desc(tc, ra, i0, kb, ks, hi, who); tile_gload(tr, K, V, kb, ks, lane); }
    for (;;) {
        tile_lds_write(buf, tr, lane);
        const int tn = a_next(tc, ra, i0);
        if (tn < 18) { int kb, ks, hi, who; (void)a_tile_desc(tn, ra, i0, kb, ks, hi, who); tile_gload(tr, K, V, kb, ks, lane); }
        {
            int kb, ks, hi, who; (void)a_tile_desc(tc, ra, i0, kb, ks, hi, who);
            const int d0a = qpa - kb - ks * 4 * h, d0b = qpb - kb - ks * 4 * h;
            band2(a, b, buf, d0a, d0b, ks, hi, who, m0, lane);
        }
        if (tn >= 18) break;
        tc = tn;
    }
    const int bb = bh >> 3, head = bh & 7;
    attn_finish(a.st, NEGBIG, m0, (const bf16_t*)(ws + WS_ZS), (bf16_t*)(ws + WS_Y), ((size_t)bb * SEQ + qpa) * DM + head * 64, h);
    attn_finish(b.st, NEGBIG, m0, (const bf16_t*)(ws + WS_ZS), (bf16_t*)(ws + WS_Y), ((size_t)bb * SEQ + qpb) * DM + head * 64, h);
}

DI unsigned moba_select(const bf16x8 (&qf)[4], LAS float* km, int qblk, int h) {
    float v1 = -3e38f, v2 = -3e38f, v3 = -3e38f; int i1 = 31, i2 = 31, i3 = 31;
    for (int n = 0; n < qblk; ++n) {
        float g = 0.f;
#pragma unroll
        for (int ks = 0; ks < 4; ++ks) {
            const LAS f32x4* kp = (const LAS f32x4*)(km + n * 64 + 16 * ks + 8 * h);
            const f32x4 x = kp[0], y = kp[1];
            const u32x4 qu = __builtin_bit_cast(u32x4, qf[ks]);
            g += bf_lo(qu.x) * x[0] + bf_hi(qu.x) * x[1] + bf_lo(qu.y) * x[2] + bf_hi(qu.y) * x[3]
               + bf_lo(qu.z) * y[0] + bf_hi(qu.z) * y[1] + bf_lo(qu.w) * y[2] + bf_hi(qu.w) * y[3];
        }
        g += __shfl_xor(g, 32);
        if (g > v1) { v3 = v2; i3 = i2; v2 = v1; i2 = i1; v1 = g; i1 = n; }
        else if (g > v2) { v3 = v2; i3 = i2; v2 = g; i2 = n; }
        else if (g > v3) { v3 = g; i3 = n; }
    }
    unsigned sel = 0u;
    if (i1 < 16) sel |= 1u << i1;
    if (i2 < 16) sel |= 1u << i2;
    if (i3 < 16) sel |= 1u << i3;
    return sel;
}
DI void attn_b_item(unsigned char* ws, LAS unsigned char* buf, LAS unsigned char* qbuf, LAS unsigned* tbl, LAS float* km  , int bh, int qblk, int w4, int lane) {
    const int r = lane & 31, h = lane >> 5;
    const bf16_t* Q = (const bf16_t*)(ws + WS_QB) + (size_t)bh * SEQ * 64;
    const bf16_t* K = (const bf16_t*)(ws + WS_KB) + (size_t)bh * SEQ * 64;
    const bf16_t* V = (const bf16_t*)(ws + WS_VTB) + (size_t)bh * SEQ * 64;
    const int qpa = qblk * 256 + w4 * 64 + r, qpb = qpa + 32;
    const float m0 = ((const float*)(ws + WS_GAINS))[401];
    QT a, b; qt_init(a, Q + (size_t)qpa * 64, h); qt_init(b, Q + (size_t)qpb * 64, h);
    TileRegs tr;
    tile_gload(tr, Q, Q + 32 * 64, qblk * 256 + w4 * 64, 1, lane); tile_lds_write(qbuf, tr, lane);
    const unsigned sela = moba_select(a.qf, km, qblk, h), selb = moba_select(b.qf, km, qblk, h);
    unsigned uni = 0u, cmask = 0u;
    for (int n = 0; n < qblk; ++n) {
        const unsigned mA = (unsigned)__builtin_amdgcn_ballot_w64(((sela >> n) & 1u) != 0u), mB = (unsigned)__builtin_amdgcn_ballot_w64(((selb >> n) & 1u) != 0u);
        const int tot = __builtin_popcount(mA) + __builtin_popcount(mB);
        if (tot > 0) { uni |= 1u << n; if (tot <= 32) cmask |= 1u << n; }
    }
    uni = (uni & ~cmask) | (1u << qblk);
    const int own_tiles = 2 * w4 + 2;
    {
#define B_ADV(n_, T_, ok_) do { const int cnt_ = ((n_) == qblk) ? own_tiles : 8; if (++(T_) >= cnt_) { const unsigned rest_ = uni & ~((2u << (n_)) - 1u); if (rest_) { (n_) = __builtin_ctz(rest_); (T_) = 0; } else (ok_) = false; } } while (0)
        int nc = __builtin_ctz(uni), Tc = 0;
        tile_gload(tr, K, V, nc * 256, 1, lane);
        for (;;) {
            tile_lds_write(buf, tr, lane);
            int nl = nc, Tl = Tc; bool okl = true; B_ADV(nl, Tl, okl);
            if (okl) tile_gload(tr, K, V, nl * 256 + 32 * Tl, 1, lane);
            {
                const int kb = nc * 256 + 32 * Tc;
                const bool own = (nc == qblk);
                const bool oka = own ? (Tc <= 2 * w4) : (((sela >> nc) & 1u) != 0u), okb = own ? true : (((selb >> nc) & 1u) != 0u);
                core2(a, b, buf, qpa - kb - 4 * h, qpb - kb - 4 * h, 1, 0x7fffffff, own && (Tc >= 2 * w4), oka, okb, m0, lane);
            }
            if (!okl) break;
            nc = nl; Tc = Tl;
        }
#undef B_ADV
    }
    if (cmask) {
        int n = __builtin_ctz(cmask);
        tile_gload(tr, K, V, n * 256, 1, lane);
        for (;;) {
            const unsigned rest = cmask & ~((2u << n) - 1u);
            const int nn = rest ? __builtin_ctz(rest) : -1;
            const bool selA = ((sela >> n) & 1u) != 0u, selB = ((selb >> n) & 1u) != 0u;
            const unsigned mA = (unsigned)__builtin_amdgcn_ballot_w64(selA), mB = (unsigned)__builtin_amdgcn_ballot_w64(selB);
            const int cntA = __builtin_popcount(mA), tot = cntA + __builtin_popcount(mB);
            const unsigned below = (1u << r) - 1u;
            const int posA = __builtin_popcount(mA & below), posB = cntA + __builtin_popcount(mB & below);
            if (h == 0) { if (selA) tbl[posA] = (unsigned)r; if (selB) tbl[posB] = (unsigned)(32 + r); }
            const bool okg = r < tot;
            const unsigned src = okg ? tbl[r] : 0u;
            bf16x8 gq[4]; ASt g;
            {
#pragma unroll
                for (int ks = 0; ks < 4; ++ks) gq[ks] = lds_frag(qbuf + src * TROW + (2 * ks + h) * 16);
#pragma unroll
                for (int i = 0; i < 16; ++i) { g.o0[i] = 0.f; g.o1[i] = 0.f; }
                g.l = 0.f;
            }
#pragma unroll 1
            for (int T = 0; T < 8; ++T) {
                tile_lds_write(buf, tr, lane);
                if (T < 7) tile_gload(tr, K, V, n * 256 + 32 * (T + 1), 1, lane);
                else if (nn >= 0) tile_gload(tr, K, V, nn * 256, 1, lane);
                core1g(g, gq, buf, okg, m0, lane);
            }
            {
#pragma unroll
                for (int g4 = 0; g4 < 4; ++g4) {
                    *(LAS u32x4*)(buf + lane * TROW + 16 * g4) = __builtin_bit_cast(u32x4, (f32x4){g.o0[4 * g4], g.o0[4 * g4 + 1], g.o0[4 * g4 + 2], g.o0[4 * g4 + 3]});
                    *(LAS u32x4*)(buf + lane * TROW + 64 + 16 * g4) = __builtin_bit_cast(u32x4, (f32x4){g.o1[4 * g4], g.o1[4 * g4 + 1], g.o1[4 * g4 + 2], g.o1[4 * g4 + 3]});
                }
                *(LAS u32x4*)(buf + lane * TROW + 128) = __builtin_bit_cast(u32x4, (f32x4){g.l, 0.f, 0.f, 0.f});
                const LAS unsigned char* ra_ = buf + ((selA ? posA : 0) + 32 * h) * TROW;
                const LAS unsigned char* rb_ = buf + ((selB ? posB : 0) + 32 * h) * TROW;
                const float fa = selA ? 1.0f : 0.f, fb = selB ? 1.0f : 0.f;
#pragma unroll
                for (int g4 = 0; g4 < 4; ++g4) {
                    const f32x4 x0 = __builtin_bit_cast(f32x4, *(const LAS u32x4*)(ra_ + 16 * g4)), x1 = __builtin_bit_cast(f32x4, *(const LAS u32x4*)(ra_ + 64 + 16 * g4));
                    const f32x4 y0 = __builtin_bit_cast(f32x4, *(const LAS u32x4*)(rb_ + 16 * g4)), y1 = __builtin_bit_cast(f32x4, *(const LAS u32x4*)(rb_ + 64 + 16 * g4));
#pragma unroll
                    for (int j = 0; j < 4; ++j) {
                        a.st.o0[4 * g4 + j] += fa * x0[j]; a.st.o1[4 * g4 + j] += fa * x1[j];
                        b.st.o0[4 * g4 + j] += fb * y0[j]; b.st.o1[4 * g4 + j] += fb * y1[j];
                    }
                }
                const f32x4 xl = __builtin_bit_cast(f32x4, *(const LAS u32x4*)(ra_ + 128)), yl = __builtin_bit_cast(f32x4, *(const LAS u32x4*)(rb_ + 128));
                a.st.l += fa * xl[0]; b.st.l += fb * yl[0];
            }
            if (nn < 0) break;
            n = nn;
        }
    }
    const int bb = bh >> 3, head = 8 + (bh & 7);
    attn_finish(a.st, NEGBIG, m0, (const bf16_t*)(ws + WS_ZS), (bf16_t*)(ws + WS_Y), ((size_t)bb * SEQ + qpa) * DM + head * 64, h);
    attn_finish(b.st, NEGBIG, m0, (const bf16_t*)(ws + WS_ZS), (bf16_t*)(ws + WS_Y), ((size_t)bb * SEQ + qpb) * DM + head * 64, h);
}

DI void attn_c_item(unsigned char* ws, LAS unsigned char* buf, int b, int hq, int chunk, int wid, int lane) {
    const int r = lane & 31, h = lane >> 5, kvh = hq >> 3;
    const bf16_t* Qa = (const bf16_t*)(ws + WS_QC) + ((size_t)b * 16 + hq) * SEQ * 64;
    const bf16_t* K = (const bf16_t*)(ws + WS_KC) + ((size_t)b * 2 + kvh) * SEQ * 64;
    const bf16_t* V = (const bf16_t*)(ws + WS_VTC) + ((size_t)b * 2 + kvh) * SEQ * 64;
    const int t0 = chunk * 256 + wid * 32, qpos = t0 + r;
    const float m0 = ((const float*)(ws + WS_GAINS))[402];
    QT qa, qb; qt_init(qa, Qa + (size_t)qpos * 64, h); qt_init(qb, Qa + (size_t)SEQ * 64 + (size_t)qpos * 64, h);
    TileRegs tr;
    int T = (t0 >= 128) ? 0 : (128 - t0) / 32;
    tile_gload(tr, K, V, t0 - 128 + 32 * T, 1, lane);
    for (;;) {
        tile_lds_write(buf, tr, lane);
        const bool have = (T + 1) < 5;
        if (have) tile_gload(tr, K, V, t0 - 128 + 32 * (T + 1), 1, lane);
        const int d0 = qpos - (t0 - 128 + 32 * T) - 4 * h;
        band2(qa, qb, buf, d0, d0, 1, 127, 2, m0, lane);
        if (!have) break;
        ++T;
    }
    const float* sinks = (const float*)(ws + WS_GAINS) + 384;
    const size_t rowoff = ((size_t)b * SEQ + qpos) * DM + hq * 64;
    attn_finish(qa.st, sinks[hq] * 1.44269504088896341f, m0, (const bf16_t*)(ws + WS_ZS1), (bf16_t*)(ws + WS_Y), rowoff, h);
    attn_finish(qb.st, sinks[hq + 1] * 1.44269504088896341f, m0, (const bf16_t*)(ws + WS_ZS1), (bf16_t*)(ws + WS_Y), rowoff + 64, h);
}

#define XB_TMO      128
#define XB_XCNT(j)  (256  + 64 * (j))
#define XB_XSUB(j)  (1280 + 64 * (j))
#define XB_XGEN(j)  (2304 + 64 * (j))
#define XB_TOP      3328
#define XB_TOPGEN   3392
#define XCD_BAR_WORDS 3456
#define XB_SPIN_CAP (1u << 18)

__device__ __forceinline__ unsigned xb_ld(unsigned* p)              { return __hip_atomic_load(p, __ATOMIC_RELAXED, __HIP_MEMORY_SCOPE_AGENT); }
__device__ __forceinline__ unsigned xb_add(unsigned* p, unsigned v) { return __hip_atomic_fetch_add(p, v, __ATOMIC_RELAXED, __HIP_MEMORY_SCOPE_AGENT); }
__device__ __forceinline__ unsigned xb_xcc_id() { return (unsigned)__builtin_amdgcn_s_getreg((3 << 11) | 20) & 0xFu; }
#define XB_SPIN(cond, bar) do { unsigned _sp = 0; while (cond) { __builtin_amdgcn_s_sleep(1); \
    if ((++_sp & 255u) == 0u) { if (xb_ld(&(bar)[XB_TMO])) break; if (_sp > XB_SPIN_CAP) { atomicAdd(&(bar)[XB_TMO], 1u); break; } } } } while (0)

struct XcdBarrier {
    unsigned* bar; unsigned x;
    volatile LAS unsigned* st;
};

__device__ __forceinline__ XcdBarrier xcd_barrier_post(unsigned* bar, volatile LAS unsigned* st) {
    XcdBarrier b; b.bar = bar; b.x = xb_xcc_id(); b.st = st;
    if (threadIdx.x == 0) (void)xb_add(&bar[XB_XCNT(b.x)], 1u);
    return b;
}
__device__ __forceinline__ void xcd_barrier_complete(unsigned* bar, unsigned x, unsigned& nloc, unsigned& nx) {
    const unsigned G = gridDim.x * gridDim.y * gridDim.z;
    unsigned sum, cnt, mine, sp = 0u;
    for (;;) {
        sum = 0u; cnt = 0u; mine = 0u;
#pragma unroll
        for (unsigned j = 0; j < 16; ++j) { const unsigned c = xb_ld(&bar[XB_XCNT(j)]); sum += c; cnt += (c > 0u) ? 1u : 0u; mine = (j == x) ? c : mine; }
        if (sum == G) break;
        __builtin_amdgcn_s_sleep(1);
        if ((++sp & 255u) == 0u) { if (xb_ld(&bar[XB_TMO])) break; if (sp > XB_SPIN_CAP) { atomicAdd(&bar[XB_TMO], 1u); break; } }
    }
    nloc = mine > 0u ? mine : 1u; nx = cnt > 0u ? cnt : 1u;
}

__device__ __forceinline__ void xcd_barrier(const XcdBarrier& b) {
    asm volatile("s_waitcnt vmcnt(0)" ::: "memory");
    __syncthreads();
    if (threadIdx.x == 0) {
        unsigned* bar = b.bar;
        __builtin_amdgcn_s_waitcnt(0);
        unsigned nloc = b.st[0], nx = b.st[1];
        if (nloc == 0u) { xcd_barrier_complete(bar, b.x, nloc, nx); b.st[0] = nloc; b.st[1] = nx; }
        const unsigned old = xb_add(&bar[XB_XSUB(b.x)], 1u);
        const unsigned gen = old / nloc;
        if (old + 1u == (gen + 1u) * nloc) {
            __builtin_amdgcn_fence(__ATOMIC_RELEASE, "agent");
            asm volatile("s_waitcnt vmcnt(0)" ::: "memory");
            const unsigned og = xb_add(&bar[XB_TOP], 1u);
            const unsigned tg = og / nx;
            if (og + 1u == (tg + 1u) * nx) xb_add(&bar[XB_TOPGEN], 1u);
            else XB_SPIN(xb_ld(&bar[XB_TOPGEN]) == tg, bar);
            __builtin_amdgcn_fence(__ATOMIC_ACQUIRE, "agent");
            xb_add(&bar[XB_XGEN(b.x)], 1u);
            asm volatile("s_waitcnt vmcnt(0)" ::: "memory");
        } else {
            XB_SPIN(xb_ld(&bar[XB_XGEN(b.x)]) == gen, bar);
            __builtin_amdgcn_fence(__ATOMIC_ACQUIRE, "agent");
            asm volatile("s_waitcnt vmcnt(0)" ::: "memory");
        }
    }
    __syncthreads();
}


__global__ void __launch_bounds__(NTHREADS) fwd_megakernel(Params P) {
    extern __shared__ __attribute__((aligned(16))) unsigned char lds_raw[];
    cg::grid_group grid = cg::this_grid();
    LAS unsigned char* lds = (LAS unsigned char*)lds_raw;
    unsigned char* ws = P.ws;
    const int G = gridDim.x, bid = blockIdx.x;
    volatile LAS unsigned* xb_st = (volatile LAS unsigned*)(lds + LDS_BYTES - 16);
    if (threadIdx.x == 0) { xb_st[0] = 0u; xb_st[1] = 0u; }
    __syncthreads();
    const XcdBarrier xbar = xcd_barrier_post((unsigned*)(ws + WS_BAR), xb_st);
#define PHASE_IDS() int tid_l = threadIdx.x; asm volatile("" : "+v"(tid_l)); const int tid = tid_l, lane = tid & 63, wid = __builtin_amdgcn_readfirstlane(tid >> 6); (void)lane; (void)wid

    if constexpr (PH_MASK & 1) { for (int rep = 0; rep < NREP(0); ++rep) p0_prologue(P, lds); }
    if (G == 0x7fffffff) grid.sync();
    xcd_barrier(xbar);

    if constexpr ((PH_MASK & 2) != 0) {
        pg8::Gemm g{(const bf16_t*)(ws + WS_XB), (const bf16_t*)(ws + WS_BT0), NTOK, N_IN0, DM};
        pg8::StaticOrder S; S.init(NTOK, N_IN0, G, bid);
        EpiIn E{0, ws};
        for (int rep = 0; rep < NREP(1); ++rep) pg8::gemm_phase<EpiIn, pg8::StaticOrder, true, true>(lds, g, S, E);
    }
    xcd_barrier(xbar);

    if constexpr ((PH_MASK & 4) != 0) {
        PHASE_IDS();
        LAS float* km = (LAS float*)(lds + 8 * TBUF);
        LAS unsigned char* buf = lds + wid * TBUF;
        const float* kmp = (const float*)(ws + WS_KMP);
#define P2_DECODE(it_) const int itt = (it_) & 511, j = itt >> 8, c = itt & 255, xcd = c & 7, slot = c >> 3, idx = j * 32 + slot;   \
                       const int bh = xcd * 8 + (idx >> 3), sub = idx & 7; (void)j
#define P2_STAGE_KM(tab_, bh_) do { for (int e = tid; e < 1024; e += NTHREADS) km[(tab_) * 1024 + e] = kmp[(size_t)(bh_) * 1024 + e] + kmp[(size_t)(64 + (bh_)) * 1024 + e]; } while (0)
        for (int rep = 0; rep < 2; ++rep) {
            if (rep == 0 || NREP(2) == 2) {
                __syncthreads();
                { int k = 0; for (int it = bid; it < 512 && k < 2; it += G, ++k) { P2_DECODE(it); (void)sub; P2_STAGE_KM(k, bh); } }
                __syncthreads();
                int k = 0;
                for (int it = bid; it < 512; it += G, ++k) {
                    P2_DECODE(it);
                    if (k >= 2) { __syncthreads(); P2_STAGE_KM(k & 1, bh); __syncthreads(); }
                    const bool lo = (wid < 4) != ((k & 1) != 0);
                    attn_b_item(ws, buf, lds + 82944 + wid * TBUF, (LAS unsigned*)(lds + 81920 + wid * 128), km + (k & 1) * 1024, bh, lo ? sub : 15 - sub, wid & 3, lane);
                }
            }
            if (rep == 0 || NREP(7) == 2) {
                for (int it = 512 + bid; it < 1024; it += G) {
                    P2_DECODE(it);
                    attn_a_y(ws, buf, bh, sub * 512 + wid * 64, lane);
                    __syncthreads();
                    attn_a_x(ws, buf, bh, wid, sub * 32, lane);
                }
            }
        }
#undef P2_DECODE
#undef P2_STAGE_KM
    }
    xcd_barrier(xbar);

    if constexpr ((PH_MASK & 8) != 0) {
        pg8::Gemm g{(const bf16_t*)(ws + WS_Y), (const bf16_t*)(ws + WS_BT1), NTOK, DM, DM};
        pg8::StaticOrder S; S.init(NTOK, DM, G, bid);
        EpiOut E{P.x, (float*)(ws + WS_X1), (bf16_t*)(ws + WS_X1B), (float*)(ws + WS_SSQ)};
        for (int rep = 0; rep < NREP(3); ++rep) pg8::gemm_phase<EpiOut, pg8::StaticOrder, true, true>(lds, g, S, E);
    }
    xcd_barrier(xbar);

    if constexpr ((PH_MASK & 16) != 0) {
        pg8::Gemm g{(const bf16_t*)(ws + WS_X1B), (const bf16_t*)(ws + WS_BT2), NTOK, N_IN1, DM};
        pg8::StaticOrder S; S.init(NTOK, N_IN1, G, bid);
        EpiIn E{1, ws};
        for (int rep = 0; rep < NREP(4); ++rep) pg8::gemm_phase<EpiIn, pg8::StaticOrder, true, true>(lds, g, S, E);
    }
    xcd_barrier(xbar);

    if constexpr ((PH_MASK & 32) != 0) {
        PHASE_IDS();
        for (int rep = 0; rep < NREP(5); ++rep)
        for (int it = bid; it < 1024; it += G) {
            const int j = it >> 8, c = it & 255, xcd = c & 7, slot = c >> 3, idx = j * 32 + slot;
            const int bkv = xcd * 2 + (idx >> 6), rem = idx & 63, hq = (bkv & 1) * 8 + 2 * (rem >> 4), chunk = rem & 15;
            attn_c_item(ws, lds + wid * TBUF, bkv >> 1, hq, chunk, wid, lane);
        }
    }
    xcd_barrier(xbar);

    if constexpr ((PH_MASK & 64) != 0) {
        pg8::Gemm g{(const bf16_t*)(ws + WS_Y), (const bf16_t*)(ws + WS_BT3), NTOK, DM, DM};
        pg8::StaticOrder S; S.init(NTOK, DM, G, bid);
        EpiOut E{(const float*)(ws + WS_X1), P.out, nullptr, nullptr};
        for (int rep = 0; rep < NREP(6); ++rep) pg8::gemm_phase<EpiOut, pg8::StaticOrder, true, true>(lds, g, S, E);
    }
}

extern "C" void kernel_launch(void* const* d_in, const int* in_sizes, int n_in, void* d_out, int out_size, void* d_ws, size_t ws_size, hipStream_t stream) {
    static int grid_blocks = 0;
    if (grid_blocks == 0) {
        if (n_in != 14 || in_sizes[0] != NTOK * DM || out_size != NTOK * DM || ws_size < WS_END) {
            fprintf(stderr, "kernel_launch: unexpected shapes (n_in %d in0 %d out %d ws %zu)\n", n_in, n_in > 0 ? in_sizes[0] : -1, out_size, ws_size); grid_blocks = -1; return; }
        int dev = 0, cus = 0, per_cu = 0;
        hipGetDevice(&dev);
        hipDeviceGetAttribute(&cus, hipDeviceAttributeMultiprocessorCount, dev);
        if (hipFuncSetAttribute((const void*)fwd_megakernel, hipFuncAttributeMaxDynamicSharedMemorySize, LDS_BYTES) != hipSuccess) {
            fprintf(stderr, "kernel_launch: hipFuncSetAttribute failed\n"); grid_blocks = -1; return; }
        if (hipOccupancyMaxActiveBlocksPerMultiprocessor(&per_cu, (const void*)fwd_megakernel, NTHREADS, LDS_BYTES) != hipSuccess || per_cu < 1) {
            fprintf(stderr, "kernel_launch: occupancy query gave %d\n", per_cu); per_cu = 1; (void)hipGetLastError(); }
        grid_blocks = cus * 1;
        if (per_cu < 1) grid_blocks = -1;
    }
    if (grid_blocks < 0) return;
    Params p{};
    p.x = (const float*)d_in[0]; p.norm_even = (const float*)d_in[1]; p.w_in_even = (const float*)d_in[2]; p.w_out_even = (const float*)d_in[3];
    p.qn_a = (const float*)d_in[4]; p.kn_a = (const float*)d_in[5]; p.qn_b = (const float*)d_in[6]; p.kn_b = (const float*)d_in[7];
    p.norm_odd = (const float*)d_in[8]; p.w_in_odd = (const float*)d_in[9]; p.w_out_odd = (const float*)d_in[10];
    p.qn_c = (const float*)d_in[11]; p.kn_c = (const float*)d_in[12]; p.sinks = (const float*)d_in[13];
    p.out = (float*)d_out; p.ws = (unsigned char*)d_ws;
    if (hipMemsetAsync((unsigned char*)d_ws + WS_BAR, 0, XCD_BAR_WORDS * 4, stream) != hipSuccess) { fprintf(stderr, "kernel_launch: memset failed\n"); return; }
    void* args[] = {&p};
    hipError_t e = hipLaunchCooperativeKernel((const void*)fwd_megakernel, dim3(grid_blocks), dim3(NTHREADS), args, LDS_BYTES, stream);
    if (e != hipSuccess) fprintf(stderr, "cooperative launch failed: %s (grid %d)\n", hipGetErrorString(e), grid_blocks);
}
```

```cpp
#include <hip/hip_runtime.h>
#include <hip/hip_cooperative_groups.h>
#include <cstdio>
#include <cstdint>
namespace cg = cooperative_groups;
namespace pg8 {
#define PG8_LAS __attribute__((address_space(3)))
typedef unsigned short bf16_t;
typedef short bf16x8 __attribute__((ext_vector_type(8)));
typedef float f32x4 __attribute__((ext_vector_type(4)));
typedef unsigned u32x4 __attribute__((ext_vector_type(4)));
constexpr int BM = 256, BK = 64, HALF = 128, HTB = HALF * BK * 2  , STAGE_BYTES = 8 * HTB, NXCD = 8, WGM = 8;

__host__ __device__ __forceinline__ int lds_byte(int r, int c) { const int st = (r >> 4) * 2 + (c >> 5), rr = r & 15, cc = c & 31, ob = rr * 64 + cc * 2; return st * 1024 + (ob ^ (((ob >> 9) & 1) << 5)); }
__host__ __device__ __forceinline__ void stage_rc(int b, int& R, int& C) { const int st = b / 1024, sb = b % 1024, swz = sb ^ (((sb >> 9) & 1) << 5); R = (st >> 1) * 16 + swz / 64; C = (st & 1) * 32 + (swz % 64) / 2; }
__host__ __device__ __forceinline__ int perm32(int rho) { const int n = rho >> 4, i = rho & 15; return 8 * (i >> 2) + 4 * n + (i & 3); }

struct Unit { int pm, pn; };
struct Gemm { const bf16_t* A; const bf16_t* Bt; int M, N, K; };

struct StaticOrder {
    int nM, nN, nwg, G, c;
    __host__ __device__ void init(int M, int N, int G_, int c_) { nM = M / BM; nN = N / BM; nwg = nM * nN; G = G_; c = c_; }
    __host__ __device__ bool next(int i, Unit& u) const {
        const long L = (long)i * G + c; if (L >= nwg) return false;
        int wgid = (int)L; { const int q = nwg / NXCD, r = nwg % NXCD, xcd = wgid % NXCD, off = wgid / NXCD; wgid = (xcd < r ? xcd * (q + 1) : r * (q + 1) + (xcd - r) * q) + off; }
        const int nig = WGM * nN, gid = wgid / nig, fm = gid * WGM, gsz = (nM - fm) < WGM ? (nM - fm) : WGM;
        u.pm = fm + ((wgid % nig) % gsz); u.pn = (wgid % nig) / gsz; return true;
    }
    __device__ __forceinline__ void a_ready(const Unit&) const {}
    __device__ __forceinline__ void done(const Unit&) const {}
};

template <class Epi, class Sched, bool ALIGN_EPI = false, bool SP2 = false>
__device__ __forceinline__ void gemm_phase(PG8_LAS unsigned char* lds, const Gemm g, const Sched& S, const Epi& E) {
    int tid_l = threadIdx.x; asm volatile("" : "+v"(tid_l));
    const int tid = tid_l, wid = __builtin_amdgcn_readfirstlane(tid >> 6), lane = tid & 63, wr = wid >> 2, wc = wid & 3, fr = lane & 15, fq = lane >> 4;
    const int K = g.K, nt = K / BK;
    unsigned voffA[2], voffB[2];
#pragma unroll
    for (int i = 0; i < 2; ++i) { int R, C; stage_rc(tid * 16 + i * 8192, R, C); const int Rb = Epi::PERM ? ((R & ~31) + perm32(R & 31)) : R;
        voffA[i] = (unsigned)(R * K + C) * 2u; voffB[i] = (unsigned)(Rb * K + C) * 2u; }
    const size_t kstep = (size_t)(BK * 2);
    const size_t hstep = (size_t)HALF * K * 2;
    const size_t tstep = 2 * hstep;
    const unsigned ldsw = (unsigned)wid * 1024u;
    const int aoff = lds_byte(wr * 64 + fr, fq * 8), boff = lds_byte(wc * 32 + fr, fq * 8);
#define PG8_SA(b, h) (((b) * 2 + (h)) * HTB)
#define PG8_SB(b, h) ((4 + (b) * 2 + (h)) * HTB)
#define PG8_STAGE(bufoff, gbase, voff) do { _Pragma("unroll") for (int _i = 0; _i < 2; ++_i) \
        __builtin_amdgcn_global_load_lds((const unsigned*)((const char*)(gbase) + (voff)[_i]), (PG8_LAS unsigned*)(lds + (bufoff) + ldsw + _i * 8192), 16, 0, 0); } while (0)
#define PG8_LDA(dst, b, h) do { _Pragma("unroll") for (int m = 0; m < 4; ++m) _Pragma("unroll") for (int k = 0; k < 2; ++k) dst[m][k] = *(const PG8_LAS bf16x8*)(lds + PG8_SA(b, h) + aoff + m * 2048 + k * 1024); } while (0)
#define PG8_LDB(dst, b, h) do { _Pragma("unroll") for (int n = 0; n < 2; ++n) _Pragma("unroll") for (int k = 0; k < 2; ++k) dst[n][k] = *(const PG8_LAS bf16x8*)(lds + PG8_SB(b, h) + boff + n * 2048 + k * 1024); } while (0)
#define PG8_MMA(ai, bj, At, Bt) do { __builtin_amdgcn_s_setprio(1); _Pragma("unroll") for (int m = 0; m < 4; ++m) _Pragma("unroll") for (int n = 0; n < 2; ++n) _Pragma("unroll") for (int k = 0; k < 2; ++k) \
        acc[ai][bj][m][n] = __builtin_amdgcn_mfma_f32_16x16x32_bf16(Bt[n][k], At[m][k], acc[ai][bj][m][n], 0, 0, 0); __builtin_amdgcn_s_setprio(0); } while (0)
#define PG8_WAIT_V(n) asm volatile("s_waitcnt vmcnt(" #n ")" ::: "memory")
#define PG8_WAIT_L(n) asm volatile("s_waitcnt lgkmcnt(" #n ")" ::: "memory")
#define PG8_BAR __builtin_amdgcn_s_barrier()
#define PG8_SCHED __builtin_amdgcn_sched_barrier(0)
    Unit cur, nxt; int ui = 0;
    if (!S.next(0, cur)) return;
    f32x4 acc[2][2][4][2];
#pragma unroll
    for (int a = 0; a < 2; ++a)
#pragma unroll
        for (int b = 0; b < 2; ++b)
#pragma unroll
            for (int m = 0; m < 4; ++m)
#pragma unroll
                for (int n = 0; n < 2; ++n) acc[a][b][m][n] = (f32x4){0.f, 0.f, 0.f, 0.f};
    bf16x8 At[4][2], B0[2][2], B1[2][2];
    const char* cA = (const char*)g.A + (size_t)cur.pm * tstep; const char* cB = (const char*)g.Bt + (size_t)cur.pn * tstep;
    S.a_ready(cur);
    if constexpr (SP2) {
        PG8_STAGE(PG8_SB(0, 0), cB, voffB); PG8_STAGE(PG8_SB(0, 1), cB + hstep, voffB); PG8_STAGE(PG8_SA(0, 0), cA, voffA); PG8_STAGE(PG8_SA(0, 1), cA + hstep, voffA);
        if (wr == 1) PG8_BAR;
        PG8_WAIT_V(2); PG8_BAR;
        PG8_STAGE(PG8_SB(1, 0), cB + kstep, voffB); PG8_STAGE(PG8_SA(1, 0), cA + kstep, voffA); PG8_STAGE(PG8_SB(1, 1), cB + hstep + kstep, voffB);
        PG8_WAIT_V(6); PG8_BAR;
    } else {
        PG8_STAGE(PG8_SB(0, 0), cB, voffB); PG8_STAGE(PG8_SA(0, 0), cA, voffA); PG8_STAGE(PG8_SB(0, 1), cB + hstep, voffB); PG8_STAGE(PG8_SA(0, 1), cA + hstep, voffA);
        if (wr == 1) PG8_BAR;
        PG8_WAIT_V(4); PG8_BAR;
        PG8_STAGE(PG8_SB(1, 0), cB + kstep, voffB); PG8_STAGE(PG8_SA(1, 0), cA + kstep, voffA); PG8_STAGE(PG8_SB(1, 1), cB + hstep + kstep, voffB);
        PG8_WAIT_V(6); PG8_BAR;
    }
    for (;;) {
        const bool has_next = S.next(ui + 1, nxt);
        const char* nA = has_next ? (const char*)g.A + (size_t)nxt.pm * tstep : cA; const char* nB = has_next ? (const char*)g.Bt + (size_t)nxt.pn * tstep : cB;
        asm volatile(".p2align 8" ::: "memory");
        for (int t = 0; t < nt; t += 2) {
            const bool last = (t == nt - 2);
            const char* a1 = cA + (size_t)(t + 1) * kstep;
            const char* a2 = last ? nA : cA + (size_t)(t + 2) * kstep; const char* b2 = last ? nB : cB + (size_t)(t + 2) * kstep;
            const char* a3 = a2 + kstep; const char* b3 = b2 + kstep;
            if (last && has_next) S.a_ready(nxt);
            if constexpr (SP2) {
            PG8_LDB(B0, 0, 0); PG8_LDB(B1, 0, 1); PG8_SCHED; PG8_LDA(At, 0, 0); PG8_STAGE(PG8_SA(1, 1), a1 + hstep, voffA);
            PG8_WAIT_V(8); PG8_WAIT_L(0); PG8_BAR; PG8_MMA(0, 0, At, B0); PG8_MMA(0, 1, At, B1); PG8_BAR; PG8_SCHED;
            PG8_LDA(At, 0, 1); PG8_STAGE(PG8_SB(0, 0), b2, voffB); PG8_STAGE(PG8_SB(0, 1), b2 + hstep, voffB); PG8_STAGE(PG8_SA(0, 0), a2, voffA);
            PG8_WAIT_V(8); PG8_WAIT_L(0); PG8_BAR; PG8_MMA(1, 0, At, B0); PG8_MMA(1, 1, At, B1); PG8_BAR; PG8_SCHED;
            PG8_LDB(B0, 1, 0); PG8_LDB(B1, 1, 1); PG8_SCHED; PG8_LDA(At, 1, 0); PG8_STAGE(PG8_SA(0, 1), a2 + hstep, voffA);
            PG8_WAIT_V(8); PG8_WAIT_L(0); PG8_BAR; PG8_MMA(0, 0, At, B0); PG8_MMA(0, 1, At, B1); PG8_BAR; PG8_SCHED;
            PG8_LDA(At, 1, 1); PG8_STAGE(PG8_SB(1, 0), b3, voffB); PG8_STAGE(PG8_SB(1, 1), b3 + hstep, voffB); PG8_STAGE(PG8_SA(1, 0), a3, voffA);
            PG8_WAIT_V(8); PG8_WAIT_L(0); PG8_BAR; PG8_MMA(1, 0, At, B0); PG8_MMA(1, 1, At, B1); PG8_BAR; PG8_SCHED;
            } else {
            PG8_LDB(B0, 0, 0); PG8_SCHED; PG8_LDA(At, 0, 0); PG8_STAGE(PG8_SA(1, 1), a1 + hstep, voffA);
            PG8_WAIT_L(8); PG8_BAR; PG8_WAIT_L(0); PG8_MMA(0, 0, At, B0); PG8_BAR; PG8_SCHED;
            PG8_LDB(B1, 0, 1); PG8_STAGE(PG8_SB(0, 0), b2, voffB);
            PG8_BAR; PG8_WAIT_L(0); PG8_MMA(0, 1, At, B1); PG8_BAR;
            PG8_LDA(At, 0, 1); PG8_STAGE(PG8_SA(0, 0), a2, voffA);
            PG8_BAR; PG8_WAIT_L(0); PG8_MMA(1, 0, At, B0); PG8_BAR; PG8_SCHED;
            PG8_STAGE(PG8_SB(0, 1), b2 + hstep, voffB);
            PG8_WAIT_V(6); PG8_BAR; PG8_MMA(1, 1, At, B1); PG8_BAR;
            PG8_LDB(B0, 1, 0); PG8_SCHED; PG8_LDA(At, 1, 0); PG8_STAGE(PG8_SA(0, 1), a2 + hstep, voffA);
            PG8_WAIT_L(8); PG8_BAR; PG8_WAIT_L(0); PG8_MMA(0, 0, At, B0); PG8_BAR; PG8_SCHED;
            PG8_LDB(B1, 1, 1); PG8_STAGE(PG8_SB(1, 0), b3, voffB);
            PG8_BAR; PG8_WAIT_L(0); PG8_MMA(0, 1, At, B1); PG8_BAR;
            PG8_LDA(At, 1, 1); PG8_STAGE(PG8_SA(1, 0), a3, voffA);
            PG8_BAR; PG8_WAIT_L(0); PG8_MMA(1, 0, At, B0); PG8_BAR; PG8_SCHED;
            PG8_STAGE(PG8_SB(1, 1), b3 + hstep, voffB);
            PG8_WAIT_V(6); PG8_BAR; PG8_MMA(1, 1, At, B1); PG8_BAR;
            }
        }
        if constexpr (ALIGN_EPI) { if (wr == 0) PG8_BAR; }
        if constexpr (!Epi::AFTER_DRAIN) { E(acc, cur, wr, wc, fr, fq); S.done(cur); }
        if (!has_next) break;
#pragma unroll
        for (int a = 0; a < 2; ++a)
#pragma unroll
            for (int b = 0; b < 2; ++b)
#pragma unroll
                for (int m = 0; m < 4; ++m)
#pragma unroll
                    for (int n = 0; n < 2; ++n) acc[a][b][m][n] = (f32x4){0.f, 0.f, 0.f, 0.f};
        cur = nxt; cA = nA; cB = nB; ++ui;
        if constexpr (ALIGN_EPI) { if (wr == 1) PG8_BAR; }
    }
    PG8_WAIT_V(0);
    if constexpr (!ALIGN_EPI) { if (wr == 0) PG8_BAR; }
    PG8_BAR;
    if constexpr (Epi::AFTER_DRAIN) { E.fused(acc, cur, wr, wc, fr, fq, lds, wid, lane); S.done(cur); }
#undef PG8_SA
#undef PG8_SB
#undef PG8_STAGE
#undef PG8_LDA
#undef PG8_LDB
#undef PG8_MMA
#undef PG8_WAIT_V
#undef PG8_WAIT_L
#undef PG8_BAR
#undef PG8_SCHED
}
}

using pg8::bf16_t; using pg8::bf16x8; using pg8::f32x4; using pg8::u32x4; using pg8::Unit;
typedef float f32x16 __attribute__((ext_vector_type(16)));
typedef short s16x4 __attribute__((ext_vector_type(4)));
typedef unsigned u32x2 __attribute__((ext_vector_type(2)));
typedef float f32x2 __attribute__((ext_vector_type(2)));
#define DI __device__ __forceinline__
#define LAS __attribute__((address_space(3)))

constexpr int BATCH = 8, SEQ = 4096, DM = 1024, NTOK = BATCH * SEQ;
constexpr int N_IN0 = 4096, N_IN1 = 2304;
constexpr float NORM_EPS = 1e-6f;
constexpr float SC_LOG2 = 0.125f * 1.44269504088896341f;
constexpr float NEGBIG = -1e30f;
constexpr int NTHREADS = 512;
#ifndef PH_MASK
#define PH_MASK 0x7f
#endif
#ifndef PROBE_REP
#define PROBE_REP 0
#endif
#define NREP(k) (((PROBE_REP >> (k)) & 1) ? 2 : 1)
constexpr int LDS_BYTES = 157696;

constexpr size_t MiB = 1u << 20;
constexpr size_t WS_BT0 = 0 * MiB, WS_BT1 = 8 * MiB, WS_BT2 = 10 * MiB, WS_BT3 = 15 * MiB;
constexpr size_t WS_BAR = 17 * MiB + 512 * 1024;
constexpr size_t WS_GAINS = 17 * MiB;
constexpr size_t WS_RSTD0 = 18 * MiB, WS_CS = 19 * MiB, WS_KMP = 20 * MiB, WS_SSQ = 21 * MiB;
constexpr size_t WS_XB = 32 * MiB;
constexpr size_t WS_Y = 32 * MiB;
constexpr size_t WS_QA = 96 * MiB, WS_KA = 128 * MiB, WS_VTA = 160 * MiB, WS_QB = 192 * MiB, WS_KB = 224 * MiB, WS_VTB = 256 * MiB;
constexpr size_t WS_ZS = 288 * MiB;
constexpr size_t WS_X1 = 352 * MiB;
constexpr size_t WS_X1B = 96 * MiB;
constexpr size_t WS_QC = 160 * MiB, WS_KC = 224 * MiB, WS_VTC = 232 * MiB, WS_ZS1 = 240 * MiB;
constexpr size_t WS_EXO = 352 * MiB, WS_EXL = 416 * MiB;
constexpr size_t WS_END = 480 * MiB;

struct Params {
    const float* x; const float* norm_even; const float* w_in_even; const float* w_out_even;
    const float* qn_a; const float* kn_a; const float* qn_b; const float* kn_b;
    const float* norm_odd; const float* w_in_odd; const float* w_out_odd; const float* qn_c; const float* kn_c; const float* sinks;
    float* out; unsigned char* ws;
};

typedef __bf16 bf16v2 __attribute__((ext_vector_type(2)));
DI unsigned cvt_pk(float lo, float hi) { const f32x2 v = {lo, hi}; return __builtin_bit_cast(unsigned, __builtin_convertvector(v, bf16v2)); }
DI float bf_lo(unsigned u) { return __uint_as_float(u << 16); }
DI float bf_hi(unsigned u) { return __uint_as_float(u & 0xffff0000u); }

DI void p0_weight_tile(const float* W, bf16_t* Bt, int N, const float* g, bool permute, int t, int lane) {
    const int ntn = N / 64, k0 = (t / ntn) * 64, n0 = (t % ntn) * 64;
    const int nlog = n0 + lane;
    const int c = permute ? ((nlog & ~255) | (((nlog >> 5) & 1) << 7) | (((nlog >> 6) & 3) << 5) | (nlog & 31)) : nlog;
    const float* src = W + (size_t)k0 * N + nlog;
    bf16_t* dst = Bt + (size_t)c * 1024 + k0;
#pragma unroll
    for (int hh = 0; hh < 2; ++hh) {
        float v[32];
#pragma unroll
        for (int k = 0; k < 32; ++k) v[k] = src[(size_t)(32 * hh + k) * N];
#pragma unroll
        for (int k = 0; k < 32; ++k) v[k] *= (g ? g[k0 + 32 * hh + k] : 1.0f);
#pragma unroll
        for (int j = 0; j < 4; ++j) {
            u32x4 w; w.x = cvt_pk(v[8 * j], v[8 * j + 1]); w.y = cvt_pk(v[8 * j + 2], v[8 * j + 3]); w.z = cvt_pk(v[8 * j + 4], v[8 * j + 5]); w.w = cvt_pk(v[8 * j + 6], v[8 * j + 7]);
            *(u32x4*)(dst + 32 * hh + 8 * j) = w;
        }
    }
}

DI void sincos_d(double x, double& s, double& c) {
    const double kq = __builtin_rint(x * 0.63661977236758134308);
    double r = __builtin_fma(-kq, 1.57079632679489655800e+00, x); r = __builtin_fma(-kq, 6.12323399573676603587e-17, r);
    const int q = ((int)kq) & 3;
    const double r2 = r * r;
    const double sp = r * (1.0 + r2 * (-1.0 / 6 + r2 * (1.0 / 120 + r2 * (-1.0 / 5040 + r2 * (1.0 / 362880 + r2 * (-1.0 / 39916800 + r2 * (1.0 / 6227020800.0)))))));
    const double cp = 1.0 + r2 * (-0.5 + r2 * (1.0 / 24 + r2 * (-1.0 / 720 + r2 * (1.0 / 40320 + r2 * (-1.0 / 3628800 + r2 * (1.0 / 479001600.0 + r2 * (-1.0 / 87178291200.0)))))));
    s = (q == 0) ? sp : (q == 1) ? cp : (q == 2) ? -sp : -cp;
    c = (q == 0) ? cp : (q == 1) ? -sp : (q == 2) ? -cp : sp;
}

DI void p0_prologue(const Params& P, LAS unsigned char* lds) {
    unsigned char* ws = P.ws;
    const int tid = threadIdx.x, lane = tid & 63, wid = tid >> 6;
    const int G = gridDim.x, bid = blockIdx.x;
    {
        bf16_t* xb = (bf16_t*)(ws + WS_XB); float* rstd = (float*)(ws + WS_RSTD0);
        for (int row0 = bid * 8 + wid; row0 < NTOK; row0 += 2 * G * 8) {
            const int row1 = row0 + G * 8; const bool has1 = row1 < NTOK;
            const f32x4* xr0 = (const f32x4*)(P.x + (size_t)row0 * DM);
            const f32x4* xr1 = (const f32x4*)(P.x + (size_t)(has1 ? row1 : row0) * DM);
            f32x4 v0[4], v1[4];
#pragma unroll
            for (int i = 0; i < 4; ++i) { v0[i] = xr0[lane + 64 * i]; v1[i] = xr1[lane + 64 * i]; }
            float s0 = 0.f, s1 = 0.f;
#pragma unroll
            for (int i = 0; i < 4; ++i) {
                s0 += v0[i][0] * v0[i][0] + v0[i][1] * v0[i][1] + v0[i][2] * v0[i][2] + v0[i][3] * v0[i][3];
                s1 += v1[i][0] * v1[i][0] + v1[i][1] * v1[i][1] + v1[i][2] * v1[i][2] + v1[i][3] * v1[i][3];
                u32x2 w; w.x = cvt_pk(v0[i][0], v0[i][1]); w.y = cvt_pk(v0[i][2], v0[i][3]);
                *(u32x2*)(xb + (size_t)row0 * DM + 4 * (lane + 64 * i)) = w;
                if (has1) { u32x2 w1; w1.x = cvt_pk(v1[i][0], v1[i][1]); w1.y = cvt_pk(v1[i][2], v1[i][3]); *(u32x2*)(xb + (size_t)row1 * DM + 4 * (lane + 64 * i)) = w1; }
            }
#pragma unroll
            for (int o = 32; o >= 1; o >>= 1) { s0 += __shfl_xor(s0, o); s1 += __shfl_xor(s1, o); }
            if (lane == 0) { rstd[row0] = rsqrtf(s0 * (1.0f / DM) + NORM_EPS); if (has1) rstd[row1] = rsqrtf(s1 * (1.0f / DM) + NORM_EPS); }
        }
    }
    if (bid == 0 && tid < 64) {
        float* gw = (float*)(ws + WS_GAINS);
        gw[tid] = P.qn_a[tid]; gw[64 + tid] = P.kn_a[tid]; gw[128 + tid] = P.qn_b[tid]; gw[192 + tid] = P.kn_b[tid]; gw[256 + tid] = P.qn_c[tid]; gw[320 + tid] = P.kn_c[tid];
        if (tid < 16) gw[384 + tid] = P.sinks[tid];
        float ma = fabsf(P.qn_a[tid]), mb = fabsf(P.kn_a[tid]), mc = fabsf(P.qn_b[tid]), md = fabsf(P.kn_b[tid]), me = fabsf(P.qn_c[tid]), mf = fabsf(P.kn_c[tid]);
#pragma unroll
        for (int o = 32; o >= 1; o >>= 1) { ma = fmaxf(ma, __shfl_xor(ma, o)); mb = fmaxf(mb, __shfl_xor(mb, o)); mc = fmaxf(mc, __shfl_xor(mc, o)); md = fmaxf(md, __shfl_xor(md, o)); me = fmaxf(me, __shfl_xor(me, o)); mf = fmaxf(mf, __shfl_xor(mf, o)); }
        if (tid == 0) { const float c = 8.0f * 1.44269504088896341f * 1.01f; gw[400] = c * ma * mb; gw[401] = c * mc * md; gw[402] = c * me * mf; }
    }
    {
        f32x2* cs = (f32x2*)(ws + WS_CS);
        for (int e = bid * NTHREADS + tid; e < SEQ * 32; e += G * NTHREADS) {
            const int pos = e >> 5, i = e & 31;
            double f = 1.0;
            for (int k = 0; k < i; ++k) f *= 0.7498942093324558;
            const float invf = (float)f;
            const float ang = (float)pos * invf;
            double s, c; sincos_d((double)ang, s, c);
            cs[e] = (f32x2){(float)c, (float)s};
        }
    }
    {
        const int T0 = 16 * (N_IN0 / 64), T1 = 16 * (DM / 64), T2 = 16 * (N_IN1 / 64), T3 = 16 * (DM / 64);
        for (int t = bid * 8 + wid; t < T0 + T1 + T2 + T3; t += G * 8) {
            if (t < T0) p0_weight_tile(P.w_in_even, (bf16_t*)(ws + WS_BT0), N_IN0, P.norm_even, true, t, lane);
            else if (t < T0 + T1) p0_weight_tile(P.w_out_even, (bf16_t*)(ws + WS_BT1), DM, nullptr, false, t - T0, lane);
            else if (t < T0 + T1 + T2) p0_weight_tile(P.w_in_odd, (bf16_t*)(ws + WS_BT2), N_IN1, P.norm_odd, true, t - T0 - T1, lane);
            else p0_weight_tile(P.w_out_odd, (bf16_t*)(ws + WS_BT3), DM, nullptr, false, t - T0 - T1 - T2, lane);
        }
    }
}

DI float row_rstd1(const float* ssq, int row, int fq) {
    const f32x4 a = *(const f32x4*)(ssq + (size_t)row * 16 + 4 * fq);
    float t = (a[0] + a[1]) + (a[2] + a[3]);
    t += __shfl_xor(t, 16); t += __shfl_xor(t, 32);
    return rsqrtf(t * (1.0f / DM) + NORM_EPS);
}
struct EpiIn {
    static constexpr bool PERM = true, AFTER_DRAIN = false;
    int layer; unsigned char* ws;
    __device__ __forceinline__ void operator()(const f32x4 (&acc)[2][2][4][2], const Unit& u, int wr, int wc, int fr, int fq) const {
        const float* rstd0 = (const float*)(ws + WS_RSTD0); const float* ssq = (const float*)(ws + WS_SSQ); const f32x2* cs = (const f32x2*)(ws + WS_CS);
        const float* gains = (const float*)(ws + WS_GAINS); bf16_t* zs = (bf16_t*)(ws + (layer == 0 ? WS_ZS : WS_ZS1)); float* kmp = (float*)(ws + WS_KMP);
        int mode, head, hpb = 8, zcol = 0; bf16_t* dst = nullptr; const float* gain = gains; bool do_km = false; float qsc = 1.0f;
        if (layer == 0) {
            const int seg = u.pn >> 1; head = (u.pn & 1) * 4 + wc;
            if (seg == 0) { mode = 0; dst = (bf16_t*)(ws + WS_QA); gain = gains; qsc = SC_LOG2; }
            else if (seg == 1) { mode = 0; dst = (bf16_t*)(ws + WS_KA); gain = gains + 64; }
            else if (seg == 2) { mode = 1; dst = (bf16_t*)(ws + WS_VTA); }
            else if (seg == 3) { mode = 2; zcol = head * 64; }
            else if (seg == 4) { mode = 0; dst = (bf16_t*)(ws + WS_QB); gain = gains + 128; qsc = SC_LOG2; }
            else if (seg == 5) { mode = 0; dst = (bf16_t*)(ws + WS_KB); gain = gains + 192; do_km = true; }
            else if (seg == 6) { mode = 1; dst = (bf16_t*)(ws + WS_VTB); }
            else { mode = 2; zcol = 512 + head * 64; }
        } else {
            if (u.pn < 4) { mode = 0; dst = (bf16_t*)(ws + WS_QC); gain = gains + 256; head = u.pn * 4 + wc; hpb = 16; qsc = SC_LOG2; }
            else if (u.pn == 4) { hpb = 2; if (wc < 2) { mode = 0; dst = (bf16_t*)(ws + WS_KC); gain = gains + 320; head = wc; } else { mode = 1; dst = (bf16_t*)(ws + WS_VTC); head = wc - 2; } }
            else { mode = 2; head = (u.pn - 5) * 4 + wc; zcol = head * 64; }
        }
        const int b = u.pm >> 4, sbase = (u.pm & 15) * 256 + wr * 64 + fr, rowbase = u.pm * 256 + wr * 64 + fr;
        const size_t bh = (size_t)b * hpb + head;
        float rsv[2][4];
        if (layer == 0) {
#pragma unroll
            for (int ai = 0; ai < 2; ++ai)
#pragma unroll
                for (int m = 0; m < 4; ++m) rsv[ai][m] = rstd0[rowbase + ai * 128 + m * 16];
        } else {
            f32x4 pr[2][4];
#pragma unroll
            for (int ai = 0; ai < 2; ++ai)
#pragma unroll
                for (int m = 0; m < 4; ++m) pr[ai][m] = *(const f32x4*)(ssq + (size_t)(rowbase + ai * 128 + m * 16) * 16 + 4 * fq);
#pragma unroll
            for (int ai = 0; ai < 2; ++ai)
#pragma unroll
                for (int m = 0; m < 4; ++m) {
                    float t = (pr[ai][m][0] + pr[ai][m][1]) + (pr[ai][m][2] + pr[ai][m][3]);
                    t += __shfl_xor(t, 16); t += __shfl_xor(t, 32);
                    rsv[ai][m] = rsqrtf(t * (1.0f / DM) + NORM_EPS);
                }
        }
#define ROW_RS(ai_, m_) (rsv[ai_][m_])
        if (mode == 0) {
            float g0[8], g1[8], cs0[8], cs1[8];
#pragma unroll
            for (int i = 0; i < 8; ++i) { g0[i] = gain[8 * fq + i] * qsc; g1[i] = gain[32 + 8 * fq + i] * qsc; cs0[i] = 0.f; cs1[i] = 0.f; }
#pragma unroll
            for (int ai = 0; ai < 2; ++ai)
#pragma unroll
                for (int m = 0; m < 4; ++m) {
                    const int s = sbase + ai * 128 + m * 16; const float r = ROW_RS(ai, m);
                    float t0[8], t1[8]; float ss = 0.f;
#pragma unroll
                    for (int n = 0; n < 2; ++n)
#pragma unroll
                        for (int j = 0; j < 4; ++j) { t0[4 * n + j] = acc[ai][0][m][n][j]; t1[4 * n + j] = acc[ai][1][m][n][j]; }
#pragma unroll
                    for (int i = 0; i < 8; ++i) ss += t0[i] * t0[i] + t1[i] * t1[i];
                    ss += __shfl_xor(ss, 16); ss += __shfl_xor(ss, 32);
                    const float hr = r * rsqrtf(ss * (r * r) * (1.0f / 64.0f) + NORM_EPS);
                    const f32x4* cp = (const f32x4*)(cs + (size_t)s * 32 + 8 * fq);
                    float o0[8], o1[8];
#pragma unroll
                    for (int q = 0; q < 4; ++q) { const f32x4 c4 = cp[q];
                        { const int i = 2 * q; const float a = t0[i] * hr * g0[i], bb = t1[i] * hr * g1[i]; o0[i] = a * c4[0] - bb * c4[1]; o1[i] = bb * c4[0] + a * c4[1]; }
                        { const int i = 2 * q + 1; const float a = t0[i] * hr * g0[i], bb = t1[i] * hr * g1[i]; o0[i] = a * c4[2] - bb * c4[3]; o1[i] = bb * c4[2] + a * c4[3]; } }
                    u32x4 w0, w1;
                    w0.x = cvt_pk(o0[0], o0[1]); w0.y = cvt_pk(o0[2], o0[3]); w0.z = cvt_pk(o0[4], o0[5]); w0.w = cvt_pk(o0[6], o0[7]);
                    w1.x = cvt_pk(o1[0], o1[1]); w1.y = cvt_pk(o1[2], o1[3]); w1.z = cvt_pk(o1[4], o1[5]); w1.w = cvt_pk(o1[6], o1[7]);
                    bf16_t* rp = dst + ((bh * SEQ + s) * 64 + 8 * fq);
                    *(u32x4*)rp = w0; *(u32x4*)(rp + 32) = w1;
                    if (do_km) {
#pragma unroll
                        for (int i = 0; i < 8; ++i) { cs0[i] += o0[i]; cs1[i] += o1[i]; }
                    }
                }
            if (do_km) {
#pragma unroll
                for (int i = 0; i < 8; ++i) {
#pragma unroll
                    for (int o = 1; o <= 8; o <<= 1) { cs0[i] += __shfl_xor(cs0[i], o); cs1[i] += __shfl_xor(cs1[i], o); }
                }
                if (fr == 0) {
                    float* kp = kmp + (((size_t)wr * 64 + bh) * 16 + (u.pm & 15)) * 64 + 8 * fq;
                    *(f32x4*)kp = (f32x4){cs0[0], cs0[1], cs0[2], cs0[3]}; *(f32x4*)(kp + 4) = (f32x4){cs0[4], cs0[5], cs0[6], cs0[7]};
                    *(f32x4*)(kp + 32) = (f32x4){cs1[0], cs1[1], cs1[2], cs1[3]}; *(f32x4*)(kp + 36) = (f32x4){cs1[4], cs1[5], cs1[6], cs1[7]};
                }
            }
        } else if (mode == 1) {
#pragma unroll
            for (int ai = 0; ai < 2; ++ai)
#pragma unroll
                for (int m = 0; m < 4; ++m) {
                    const int s = sbase + ai * 128 + m * 16; const float r = ROW_RS(ai, m);
                    bf16_t* rp = dst + ((bh * SEQ + s) * 64 + 8 * fq);
#pragma unroll
                    for (int bj = 0; bj < 2; ++bj) {
                        const f32x4 v0 = acc[ai][bj][m][0] * r, v1 = acc[ai][bj][m][1] * r;
                        u32x4 w; w.x = cvt_pk(v0[0], v0[1]); w.y = cvt_pk(v0[2], v0[3]); w.z = cvt_pk(v1[0], v1[1]); w.w = cvt_pk(v1[2], v1[3]);
                        *(u32x4*)(rp + 32 * bj) = w;
                    }
                }
        } else {
#pragma unroll
            for (int ai = 0; ai < 2; ++ai)
#pragma unroll
                for (int m = 0; m < 4; ++m) {
                    const int row = rowbase + ai * 128 + m * 16; const float r = ROW_RS(ai, m);
#pragma unroll
                    for (int bj = 0; bj < 2; ++bj) {
                        float sv[8];
#pragma unroll
                        for (int n = 0; n < 2; ++n)
#pragma unroll
                            for (int j = 0; j < 4; ++j) { const float z = acc[ai][bj][m][n][j] * r; sv[4 * n + j] = z * __builtin_amdgcn_rcpf(1.0f + __builtin_amdgcn_exp2f(-1.44269504088896341f * z)); }
                        u32x4 w; w.x = cvt_pk(sv[0], sv[1]); w.y = cvt_pk(sv[2], sv[3]); w.z = cvt_pk(sv[4], sv[5]); w.w = cvt_pk(sv[6], sv[7]);
                        *(u32x4*)(zs + (size_t)row * DM + zcol + 32 * bj + 8 * fq) = w;
                    }
                }
        }
    }
};

struct EpiOut {
    static constexpr bool PERM = true, AFTER_DRAIN = false;
    const float* resid; float* out; bf16_t* xb; float* ssq;
    __device__ __forceinline__ void operator()(const f32x4 (&acc)[2][2][4][2], const Unit& u, int wr, int wc, int fr, int fq) const {
        const int col0 = u.pn * 256 + wc * 32 + 8 * fq, rowbase = u.pm * 256 + wr * 64 + fr;
#pragma unroll
        for (int ai = 0; ai < 2; ++ai)
#pragma unroll
            for (int m = 0; m < 4; ++m) {
                const int row = rowbase + ai * 128 + m * 16; const size_t off = (size_t)row * DM + col0;
                float q = 0.f;
#pragma unroll
                for (int bj = 0; bj < 2; ++bj) {
                    const f32x4 r0 = *(const f32x4*)(resid + off + bj * 128), r1 = *(const f32x4*)(resid + off + bj * 128 + 4);
                    const f32x4 o0 = r0 + acc[ai][bj][m][0], o1 = r1 + acc[ai][bj][m][1];
                    *(f32x4*)(out + off + bj * 128) = o0; *(f32x4*)(out + off + bj * 128 + 4) = o1;
                    if (xb) {
                        u32x4 w; w.x = cvt_pk(o0[0], o0[1]); w.y = cvt_pk(o0[2], o0[3]); w.z = cvt_pk(o1[0], o1[1]); w.w = cvt_pk(o1[2], o1[3]);
                        *(u32x4*)(xb + off + bj * 128) = w;
                        q += (o0[0] * o0[0] + o0[1] * o0[1]) + (o0[2] * o0[2] + o0[3] * o0[3]) + (o1[0] * o1[0] + o1[1] * o1[1]) + (o1[2] * o1[2] + o1[3] * o1[3]);
                    }
                }
                if (xb) { q += __shfl_xor(q, 16); q += __shfl_xor(q, 32); if (fq == 0) ssq[(size_t)row * 16 + u.pn * 4 + wc] = q; }
            }
    }
};

#define MFMA32(a, b, c) __builtin_amdgcn_mfma_f32_32x32x16_bf16((a), (b), (c), 0, 0, 0)
constexpr int TROW = 144;
constexpr int TBUF = 2 * 32 * TROW;
struct TileRegs { u32x4 k[4]; u32x4 v[4]; };
struct ASt { f32x16 o0, o1; float l; };
struct QT { bf16x8 qf[4]; ASt st; };

DI void qt_init(QT& t, const bf16_t* qrow, int h) {
    const bf16x8* qp = (const bf16x8*)qrow;
#pragma unroll
    for (int ks = 0; ks < 4; ++ks) t.qf[ks] = qp[2 * ks + h];
#pragma unroll
    for (int i = 0; i < 16; ++i) { t.st.o0[i] = 0.f; t.st.o1[i] = 0.f; }
    t.st.l = 0.f;
}

DI void tile_gload(TileRegs& t, const bf16_t* K, const bf16_t* V, int kbase, int kstride, int lane) {
    const int row0 = lane >> 3, ch = lane & 7;
#pragma unroll
    for (int i = 0; i < 4; ++i) {
        const unsigned off = (unsigned)((kbase + kstride * (row0 + 8 * i)) * 128 + ch * 16);
        t.k[i] = *(const u32x4*)((const unsigned char*)K + off); t.v[i] = *(const u32x4*)((const unsigned char*)V + off);
    }
}
DI bf16x8 lds_frag(const LAS unsigned char* p) { return __builtin_bit_cast(bf16x8, *(const LAS u32x4*)p); }
DI void tile_lds_write(LAS unsigned char* buf, const TileRegs& t, int lane) {
    const int row0 = lane >> 3, ch = lane & 7;
#pragma unroll
    for (int i = 0; i < 4; ++i) {
        const int off = (row0 + 8 * i) * TROW + ch * 16;
        *(LAS u32x4*)(buf + off) = t.k[i]; *(LAS u32x4*)(buf + 32 * TROW + off) = t.v[i];
    }
}
DI void load_kfrag(bf16x8 (&kf)[4], LAS unsigned char* buf, int lane) {
    const int r = lane & 31, h = lane >> 5;
#pragma unroll
    for (int ks = 0; ks < 4; ++ks) kf[ks] = lds_frag(buf + r * TROW + (2 * ks + h) * 16);
}
DI void load_vfrag(bf16x8 (&vf)[2][2], LAS unsigned char* buf, int lane) {
    const int h = lane >> 5, q = (lane & 15) >> 2, p = lane & 3, blk = (lane >> 4) & 1;
    LAS unsigned char* vb = buf + 32 * TROW + (4 * h + q) * TROW + 32 * blk + 8 * p;
#pragma unroll
    for (int dt = 0; dt < 2; ++dt)
#pragma unroll
        for (int s2 = 0; s2 < 2; ++s2) {
            const s16x4 lo = __builtin_amdgcn_ds_read_tr16_b64_v4i16((LAS s16x4*)(vb + (16 * s2) * TROW + 64 * dt));
            const s16x4 hi4 = __builtin_amdgcn_ds_read_tr16_b64_v4i16((LAS s16x4*)(vb + (16 * s2 + 8) * TROW + 64 * dt));
            vf[dt][s2] = __builtin_shufflevector(lo, hi4, 0, 1, 2, 3, 4, 5, 6, 7);
        }
}
DI void qk_mfma(f32x16& s, const bf16x8 (&kf)[4], const bf16x8 (&qf)[4]) {
#pragma unroll
    for (int i = 0; i < 16; ++i) s[i] = 0.f;
#pragma unroll
    for (int ks = 0; ks < 4; ++ks) s = MFMA32(kf[ks], qf[ks], s);
}
template <bool SUB>
DI void softmax_p(ASt& st, f32x16& s, int dist0, int kstride, int hi, bool lane_ok, bool elem, float sub) {
    if (elem) {
        int d0 = dist0; asm volatile("" : "+v"(d0));
#pragma unroll
        for (int i = 0; i < 16; ++i) {
            const unsigned dist = (unsigned)(d0 - kstride * ((i & 3) + 8 * (i >> 2)));
            s[i] = (dist <= (unsigned)hi) ? s[i] : NEGBIG;
        }
    }
    float ps0 = 0.f, ps1 = 0.f;
#pragma unroll
    for (int i = 0; i < 16; i += 2) {
        s[i] = __builtin_amdgcn_exp2f(SUB ? s[i] - sub : s[i]); s[i + 1] = __builtin_amdgcn_exp2f(SUB ? s[i + 1] - sub : s[i + 1]); ps0 += s[i]; ps1 += s[i + 1];
    }
    st.l += lane_ok ? (ps0 + ps1) : 0.f;
}
DI void pv_mfma(ASt& st, const f32x16& s, const bf16x8 (&vf)[2][2]) {
#pragma unroll
    for (int s2 = 0; s2 < 2; ++s2) {
        u32x4 p;
        p.x = cvt_pk(s[8 * s2 + 0], s[8 * s2 + 1]); p.y = cvt_pk(s[8 * s2 + 2], s[8 * s2 + 3]);
        p.z = cvt_pk(s[8 * s2 + 4], s[8 * s2 + 5]); p.w = cvt_pk(s[8 * s2 + 6], s[8 * s2 + 7]);
        const bf16x8 pb = __builtin_bit_cast(bf16x8, p);
        st.o0 = MFMA32(vf[0][s2], pb, st.o0);
        st.o1 = MFMA32(vf[1][s2], pb, st.o1);
    }
}
DI void pack_p(bf16x8 (&pb)[2], const f32x16& s, bool lane_ok) {
    const unsigned lm = lane_ok ? 0xffffffffu : 0u;
#pragma unroll
    for (int s2 = 0; s2 < 2; ++s2) {
        u32x4 p;
        p.x = cvt_pk(s[8 * s2 + 0], s[8 * s2 + 1]) & lm; p.y = cvt_pk(s[8 * s2 + 2], s[8 * s2 + 3]) & lm;
        p.z = cvt_pk(s[8 * s2 + 4], s[8 * s2 + 5]) & lm; p.w = cvt_pk(s[8 * s2 + 6], s[8 * s2 + 7]) & lm;
        pb[s2] = __builtin_bit_cast(bf16x8, p);
    }
}
DI bf16x8 load_vfrag1(LAS unsigned char* vb, int dt, int s2) {
    const s16x4 lo = __builtin_amdgcn_ds_read_tr16_b64_v4i16((LAS s16x4*)(vb + (16 * s2) * TROW + 64 * dt));
    const s16x4 hi4 = __builtin_amdgcn_ds_read_tr16_b64_v4i16((LAS s16x4*)(vb + (16 * s2 + 8) * TROW + 64 * dt));
    return __builtin_shufflevector(lo, hi4, 0, 1, 2, 3, 4, 5, 6, 7);
}
DI void core2(QT& a, QT& b, LAS unsigned char* buf, int dist0a, int dist0b, int kstride, int hi, bool elem, bool oka, bool okb, float m0, int lane) {
    const int r = lane & 31, h = lane >> 5;
    f32x16 sa, sb;
    {
        const float c = -m0;
        const f32x16 cinit = {c, c, c, c, c, c, c, c, c, c, c, c, c, c, c, c};
        const bf16x8 kf = lds_frag(buf + r * TROW + h * 16); sa = MFMA32(kf, a.qf[0], cinit); sb = MFMA32(kf, b.qf[0], cinit);
    }
#pragma unroll
    for (int ks = 1; ks < 4; ++ks) { const bf16x8 kf = lds_frag(buf + r * TROW + (2 * ks + h) * 16); sa = MFMA32(kf, a.qf[ks], sa); sb = MFMA32(kf, b.qf[ks], sb); }
    LAS unsigned char* vb = buf + 32 * TROW + (4 * h + ((lane & 15) >> 2)) * TROW + 32 * ((lane >> 4) & 1) + 8 * (lane & 3);
    softmax_p<false>(a.st, sa, dist0a, kstride, hi, oka, elem, 0.f);
    {
        bf16x8 pa[2]; pack_p(pa, sa, oka);
#pragma unroll
        for (int s2 = 0; s2 < 2; ++s2) {
            const bf16x8 v0 = load_vfrag1(vb, 0, s2), v1 = load_vfrag1(vb, 1, s2);
            a.st.o0 = MFMA32(v0, pa[s2], a.st.o0); a.st.o1 = MFMA32(v1, pa[s2], a.st.o1);
        }
    }
    softmax_p<false>(b.st, sb, dist0b, kstride, hi, okb, elem, 0.f);
    {
        bf16x8 pb[2]; pack_p(pb, sb, okb);
#pragma unroll
        for (int s2 = 0; s2 < 2; ++s2) {
            const bf16x8 v0 = load_vfrag1(vb, 0, s2), v1 = load_vfrag1(vb, 1, s2);
            b.st.o0 = MFMA32(v0, pb[s2], b.st.o0); b.st.o1 = MFMA32(v1, pb[s2], b.st.o1);
        }
    }
}
DI void core1g(ASt& st, const bf16x8 (&qf)[4], LAS unsigned char* buf, bool ok, float m0, int lane) {
    const int r = lane & 31, h = lane >> 5;
    f32x16 s;
    {
        const f32x16 zero = {0.f, 0.f, 0.f, 0.f, 0.f, 0.f, 0.f, 0.f, 0.f, 0.f, 0.f, 0.f, 0.f, 0.f, 0.f, 0.f};
        const bf16x8 kf = lds_frag(buf + r * TROW + h * 16); s = MFMA32(kf, qf[0], zero);
    }
#pragma unroll
    for (int ks = 1; ks < 4; ++ks) { const bf16x8 kf = lds_frag(buf + r * TROW + (2 * ks + h) * 16); s = MFMA32(kf, qf[ks], s); }
    LAS unsigned char* vb = buf + 32 * TROW + (4 * h + ((lane & 15) >> 2)) * TROW + 32 * ((lane >> 4) & 1) + 8 * (lane & 3);
    softmax_p<true>(st, s, 0, 0, 0, ok, false, m0);
    bf16x8 p[2]; pack_p(p, s, ok);
#pragma unroll
    for (int s2 = 0; s2 < 2; ++s2) {
        const bf16x8 v0 = load_vfrag1(vb, 0, s2), v1 = load_vfrag1(vb, 1, s2);
        st.o0 = MFMA32(v0, p[s2], st.o0); st.o1 = MFMA32(v1, p[s2], st.o1);
    }
}
DI bool band_all_ok(int dist0, int kstride, int hi, int h) {
    const int d_first = dist0 + kstride * 4 * h, d_last = d_first - 31 * kstride;
    return (d_last >= 0) && (d_first <= hi);
}
DI void band2(QT& a, QT& b, LAS unsigned char* buf, int dist0a, int dist0b, int kstride, int hi, int who, float m0, int lane) {
    const bool oka = who != 1, okb = who != 0;
    const bool allok = (!oka || band_all_ok(dist0a, kstride, hi, lane >> 5)) && (!okb || band_all_ok(dist0b, kstride, hi, lane >> 5));
    const bool elem = __builtin_amdgcn_ballot_w64(!allok) != 0ull;
    core2(a, b, buf, dist0a, dist0b, kstride, hi, elem, oka, okb, m0, lane);
}

DI void core1b(ASt& st, const bf16x8 (&qf)[4], LAS unsigned char* buf, int dist0, int kstride, int hi, float m0, int lane) {
    const int r = lane & 31, h = lane >> 5;
    const bool elem = __builtin_amdgcn_ballot_w64(!band_all_ok(dist0, kstride, hi, h)) != 0ull;
    f32x16 s;
    {
        const f32x16 zero = {0.f, 0.f, 0.f, 0.f, 0.f, 0.f, 0.f, 0.f, 0.f, 0.f, 0.f, 0.f, 0.f, 0.f, 0.f, 0.f};
        s = MFMA32(lds_frag(buf + r * TROW + h * 16), qf[0], zero);
    }
#pragma unroll
    for (int ks = 1; ks < 4; ++ks) s = MFMA32(lds_frag(buf + r * TROW + (2 * ks + h) * 16), qf[ks], s);
    LAS unsigned char* vb = buf + 32 * TROW + (4 * h + ((lane & 15) >> 2)) * TROW + 32 * ((lane >> 4) & 1) + 8 * (lane & 3);
    softmax_p<true>(st, s, dist0, kstride, hi, true, elem, m0);
    bf16x8 p[2]; pack_p(p, s, true);
#pragma unroll
    for (int s2 = 0; s2 < 2; ++s2) {
        const bf16x8 v0 = load_vfrag1(vb, 0, s2), v1 = load_vfrag1(vb, 1, s2);
        st.o0 = MFMA32(v0, p[s2], st.o0); st.o1 = MFMA32(v1, p[s2], st.o1);
    }
}
DI void attn_finish(ASt& st, float sink_l2, float m0, const bf16_t* zs, bf16_t* y, size_t rowoff  , int h) {
    float l = st.l + __shfl_xor(st.l, 32);
    l += (sink_l2 > -1e29f) ? __builtin_amdgcn_exp2f(sink_l2 - m0) : 0.f;
    const float inv = __builtin_amdgcn_rcpf(l);
#pragma unroll
    for (int dt = 0; dt < 2; ++dt)
#pragma unroll
        for (int g = 0; g < 4; ++g) {
            const size_t off = rowoff + 32 * dt + 8 * g + 4 * h;
            const u32x2 z = *(const u32x2*)(zs + off);
            const float v0 = (dt ? st.o1[4 * g + 0] : st.o0[4 * g + 0]) * inv * bf_lo(z.x);
            const float v1 = (dt ? st.o1[4 * g + 1] : st.o0[4 * g + 1]) * inv * bf_hi(z.x);
            const float v2 = (dt ? st.o1[4 * g + 2] : st.o0[4 * g + 2]) * inv * bf_lo(z.y);
            const float v3 = (dt ? st.o1[4 * g + 3] : st.o0[4 * g + 3]) * inv * bf_hi(z.y);
            u32x2 w; w.x = cvt_pk(v0, v1); w.y = cvt_pk(v2, v3);
            *(u32x2*)(y + off) = w;
        }
}

DI void attn_a_y(unsigned char* ws, LAS unsigned char* buf, int bh, int t0, int lane) {
    const int r = lane & 31, h = lane >> 5;
    const bf16_t* Q = (const bf16_t*)(ws + WS_QA) + (size_t)bh * SEQ * 64;
    const bf16_t* K = (const bf16_t*)(ws + WS_KA) + (size_t)bh * SEQ * 64;
    const bf16_t* V = (const bf16_t*)(ws + WS_VTA) + (size_t)bh * SEQ * 64;
    const int qpa = t0 + r, qpb = qpa + 32;
    const float m0 = ((const float*)(ws + WS_GAINS))[400];
    QT a, b; qt_init(a, Q + (size_t)qpa * 64, h); qt_init(b, Q + (size_t)qpb * 64, h);
    TileRegs tr;
    int T = (t0 >= 128) ? 0 : (128 - t0) / 32;
    tile_gload(tr, K, V, t0 - 128 + 32 * T, 1, lane);
    for (;;) {
        tile_lds_write(buf, tr, lane);
        const bool have = (T + 1) < 6;
        if (have) tile_gload(tr, K, V, t0 - 128 + 32 * (T + 1), 1, lane);
        const int kb = t0 - 128 + 32 * T;
        band2(a, b, buf, qpa - kb - 4 * h, qpb - kb - 4 * h, 1, 128, 2, m0, lane);
        if (!have) break;
        ++T;
    }
    const float la = a.st.l + __shfl_xor(a.st.l, 32), lb = b.st.l + __shfl_xor(b.st.l, 32);
    float* exa = (float*)(ws + WS_EXO) + ((size_t)bh * SEQ + qpa) * 64 + 4 * h;
    float* exb = exa + 32 * 64;
#pragma unroll
    for (int g = 0; g < 4; ++g) {
        *(f32x4*)(exa + 8 * g) = (f32x4){a.st.o0[4 * g], a.st.o0[4 * g + 1], a.st.o0[4 * g + 2], a.st.o0[4 * g + 3]};
        *(f32x4*)(exa + 32 + 8 * g) = (f32x4){a.st.o1[4 * g], a.st.o1[4 * g + 1], a.st.o1[4 * g + 2], a.st.o1[4 * g + 3]};
        *(f32x4*)(exb + 8 * g) = (f32x4){b.st.o0[4 * g], b.st.o0[4 * g + 1], b.st.o0[4 * g + 2], b.st.o0[4 * g + 3]};
        *(f32x4*)(exb + 32 + 8 * g) = (f32x4){b.st.o1[4 * g], b.st.o1[4 * g + 1], b.st.o1[4 * g + 2], b.st.o1[4 * g + 3]};
    }
    if (h == 0) { float* exl = (float*)(ws + WS_EXL) + (size_t)bh * SEQ; exl[qpa] = la; exl[qpb] = lb; }
}
DI bool a_tile_desc(int tau, int ra, int i0, int& kbase, int& kstride, int& hi, int& who) {
    if (tau < 10) { const int t = (tau < 5) ? tau : tau - 5; const int jb = i0 - 128 + 32 * t; who = (tau < 5) ? 0 : 1; kbase = ra + 8 * who + 16 * jb; kstride = 16; hi = 2048; return jb >= 0; }
    who = 2;
    { const int ub = 4 * i0 - 128 + 32 * (tau - 10); kbase = (ra & 3) + 4 * ub; kstride = 4; hi = 512; return ub >= 0; }
}
DI int a_next(int tau, int ra, int i0) { int t = tau + 1, kb, ks, hi, who; while (t < 18 && !a_tile_desc(t, ra, i0, kb, ks, hi, who)) ++t; return t; }
DI void attn_a_x(unsigned char* ws, LAS unsigned char* buf, int bh, int ra, int i0, int lane) {
    const int r = lane & 31, h = lane >> 5;
    const bf16_t* Q = (const bf16_t*)(ws + WS_QA) + (size_t)bh * SEQ * 64;
    const bf16_t* K = (const bf16_t*)(ws + WS_KA) + (size_t)bh * SEQ * 64;
    const bf16_t* V = (const bf16_t*)(ws + WS_VTA) + (size_t)bh * SEQ * 64;
    const int qpa = ra + 16 * (i0 + r), qpb = qpa + 8;
    const float m0 = ((const float*)(ws + WS_GAINS))[400];
    QT a, b; qt_init(a, Q + (size_t)qpa * 64, h); qt_init(b, Q + (size_t)qpb * 64, h);
    {
        const float* exa = (const float*)(ws + WS_EXO) + ((size_t)bh * SEQ + qpa) * 64 + 4 * h;
        const float* exb = exa + 8 * 64;
#pragma unroll
        for (int g = 0; g < 4; ++g) {
            const f32x4 a0 = *(const f32x4*)(exa + 8 * g), a1 = *(const f32x4*)(exa + 32 + 8 * g), b0 = *(const f32x4*)(exb + 8 * g), b1 = *(const f32x4*)(exb + 32 + 8 * g);
#pragma unroll
            for (int j = 0; j < 4; ++j) { a.st.o0[4 * g + j] = a0[j]; a.st.o1[4 * g + j] = a1[j]; b.st.o0[4 * g + j] = b0[j]; b.st.o1[4 * g + j] = b1[j]; }
        }
        const float* exl = (const float*)(ws + WS_EXL) + (size_t)bh * SEQ;
        a.st.l = (h == 0) ? exl[qpa] : 0.f; b.st.l = (h == 0) ? exl[qpb] : 0.f;
    }
    TileRegs tr;
    int tc = a_next(-1, ra, i0);
    { int kb, ks, hi, who; (void)a_tile_desc(tc, ra, i0, kb, ks, hi, who); tile_gload(tr, K, V, kb, ks, lane); }
#define X_STEP(COMPUTE) { tile_lds_write(buf, tr, lane); const int tn = a_next(tc, ra, i0); \
        if (tn < 18) { int kb_, ks_, hi_, who_; (void)a_tile_desc(tn, ra, i0, kb_, ks_, hi_, who_); tile_gload(tr, K, V, kb_, ks_, lane); } \
        { int kb, ks, hi, who; (void)a_tile_desc(tc, ra, i0, kb, ks, hi, who); const int d0a = qpa - kb - ks * 4 * h, d0b = qpb - kb - ks * 4 * h; (void)d0a; (void)d0b; (void)who; COMPUTE; } \
        tc = tn; }
    while (tc < 5) X_STEP(core1b(a.st, a.qf, buf, d0a, ks, hi, m0, lane))
    while (tc < 10) X_STEP(core1b(b.st, b.qf, buf, d0b, ks, hi, m0, lane))
    while (tc < 18) X_STEP(band2(a, b, buf, d0a, d0b, ks, hi, 2, m0, lane))
#undef X_STEP
    const int bb = bh >> 3, head = bh & 7;
    attn_finish(a.st, NEGBIG, m0, (const bf16_t*)(ws + WS_ZS), (bf16_t*)(ws + WS_Y), ((size_t)bb * SEQ + qpa) * DM + head * 64, h);
    attn_finish(b.st, NEGBIG, m0, (const bf16_t*)(ws + WS_ZS), (bf16_t*)(ws + WS_Y), ((size_t)bb * SEQ + qpb) * DM + head * 64, h);
}

DI unsigned moba_select(const bf16x8 (&qf)[4], LAS float* km, int qblk, int h) {
    float v1 = -3e38f, v2 = -3e38f, v3 = -3e38f; int i1 = 31, i2 = 31, i3 = 31;
    for (int n = 0; n < qblk; ++n) {
        float g = 0.f;
#pragma unroll
        for (int ks = 0; ks < 4; ++ks) {
            const LAS f32x4* kp = (const LAS f32x4*)(km + n * 64 + 16 * ks + 8 * h);
            const f32x4 x = kp[0], y = kp[1];
            const u32x4 qu = __builtin_bit_cast(u32x4, qf[ks]);
            g += bf_lo(qu.x) * x[0] + bf_hi(qu.x) * x[1] + bf_lo(qu.y) * x[2] + bf_hi(qu.y) * x[3]
               + bf_lo(qu.z) * y[0] + bf_hi(qu.z) * y[1] + bf_lo(qu.w) * y[2] + bf_hi(qu.w) * y[3];
        }
        g += __shfl_xor(g, 32);
        if (g > v1) { v3 = v2; i3 = i2; v2 = v1; i2 = i1; v1 = g; i1 = n; }
        else if (g > v2) { v3 = v2; i3 = i2; v2 = g; i2 = n; }
        else if (g > v3) { v3 = g; i3 = n; }
    }
    unsigned sel = 0u;
    if (i1 < 16) sel |= 1u << i1;
    if (i2 < 16) sel |= 1u << i2;
    if (i3 < 16) sel |= 1u << i3;
    return sel;
}
DI void attn_b_item(unsigned char* ws, LAS unsigned char* buf, LAS unsigned char* qbuf, LAS unsigned* tbl, LAS float* km  , int bh, int qblk, int w4, int lane) {
    const int r = lane & 31, h = lane >> 5;
    const bf16_t* Q = (const bf16_t*)(ws + WS_QB) + (size_t)bh * SEQ * 64;
    const bf16_t* K = (const bf16_t*)(ws + WS_KB) + (size_t)bh * SEQ * 64;
    const bf16_t* V = (const bf16_t*)(ws + WS_VTB) + (size_t)bh * SEQ * 64;
    const int qpa = qblk * 256 + w4 * 64 + r, qpb = qpa + 32;
    const float m0 = ((const float*)(ws + WS_GAINS))[401];
    QT a, b; qt_init(a, Q + (size_t)qpa * 64, h); qt_init(b, Q + (size_t)qpb * 64, h);
    TileRegs tr;
    tile_gload(tr, Q, Q + 32 * 64, qblk * 256 + w4 * 64, 1, lane); tile_lds_write(qbuf, tr, lane);
    const unsigned sela = moba_select(a.qf, km, qblk, h), selb = moba_select(b.qf, km, qblk, h);
    unsigned uni = 0u, cmask = 0u;
    for (int n = 0; n < qblk; ++n) {
        const unsigned mA = (unsigned)__builtin_amdgcn_ballot_w64(((sela >> n) & 1u) != 0u), mB = (unsigned)__builtin_amdgcn_ballot_w64(((selb >> n) & 1u) != 0u);
        const int tot = __builtin_popcount(mA) + __builtin_popcount(mB);
        if (tot > 0) { uni |= 1u << n; if (tot <= 32) cmask |= 1u << n; }
    }
    uni = (uni & ~cmask) | (1u << qblk);
    const int own_tiles = 2 * w4 + 2;
    {
#define B_ADV(n_, T_, ok_) do { const int cnt_ = ((n_) == qblk) ? own_tiles : 8; if (++(T_) >= cnt_) { const unsigned rest_ = uni & ~((2u << (n_)) - 1u); if (rest_) { (n_) = __builtin_ctz(rest_); (T_) = 0; } else (ok_) = false; } } while (0)
        int nc = __builtin_ctz(uni), Tc = 0;
        tile_gload(tr, K, V, nc * 256, 1, lane);
        for (;;) {
            tile_lds_write(buf, tr, lane);
            int nl = nc, Tl = Tc; bool okl = true; B_ADV(nl, Tl, okl);
            if (okl) tile_gload(tr, K, V, nl * 256 + 32 * Tl, 1, lane);
            {
                const int kb = nc * 256 + 32 * Tc;
                const bool own = (nc == qblk);
                const bool oka = own ? (Tc <= 2 * w4) : (((sela >> nc) & 1u) != 0u), okb = own ? true : (((selb >> nc) & 1u) != 0u);
                core2(a, b, buf, qpa - kb - 4 * h, qpb - kb - 4 * h, 1, 0x7fffffff, own && (Tc >= 2 * w4), oka, okb, m0, lane);
            }
            if (!okl) break;
            nc = nl; Tc = Tl;
        }
#undef B_ADV
    }
    if (cmask) {
        int n = __builtin_ctz(cmask);
        tile_gload(tr, K, V, n * 256, 1, lane);
        for (;;) {
            const unsigned rest = cmask & ~((2u << n) - 1u);
            const int nn = rest ? __builtin_ctz(rest) : -1;
            const bool selA = ((sela >> n) & 1u) != 0u, selB = ((selb >> n) & 1u) != 0u;
            const unsigned mA = (unsigned)__builtin_amdgcn_ballot_w64(selA), mB = (unsigned)__builtin_amdgcn_ballot_w64(selB);
            const int cntA = __builtin_popcount(mA), tot = cntA + __builtin_popcount(mB);
            const unsigned below = (1u << r) - 1u;
            const int posA = __builtin_popcount(mA & below), posB = cntA + __builtin_popcount(mB & below);
            if (h == 0) { if (selA) tbl[posA] = (unsigned)r; if (selB) tbl[posB] = (unsigned)(32 + r); }
            const bool okg = r < tot;
            const unsigned src = okg ? tbl[r] : 0u;
            bf16x8 gq[4]; ASt g;
            {
#pragma unroll
                for (int ks = 0; ks < 4; ++ks) gq[ks] = lds_frag(qbuf + src * TROW + (2 * ks + h) * 16);
#pragma unroll
                for (int i = 0; i < 16; ++i) { g.o0[i] = 0.f; g.o1[i] = 0.f; }
                g.l = 0.f;
            }
#pragma unroll 1
            for (int T = 0; T < 8; ++T) {
                tile_lds_write(buf, tr, lane);
                if (T < 7) tile_gload(tr, K, V, n * 256 + 32 * (T + 1), 1, lane);
                else if (nn >= 0) tile_gload(tr, K, V, nn * 256, 1, lane);
                core1g(g, gq, buf, okg, m0, lane);
            }
            {
#pragma unroll
                for (int g4 = 0; g4 < 4; ++g4) {
                    *(LAS u32x4*)(buf + lane * TROW + 16 * g4) = __builtin_bit_cast(u32x4, (f32x4){g.o0[4 * g4], g.o0[4 * g4 + 1], g.o0[4 * g4 + 2], g.o0[4 * g4 + 3]});
                    *(LAS u32x4*)(buf + lane * TROW + 64 + 16 * g4) = __builtin_bit_cast(u32x4, (f32x4){g.o1[4 * g4], g.o1[4 * g4 + 1], g.o1[4 * g4 + 2], g.o1[4 * g4 + 3]});
                }
                *(LAS u32x4*)(buf + lane * TROW + 128) = __builtin_bit_cast(u32x4, (f32x4){g.l, 0.f, 0.f, 0.f});
                const LAS unsigned char* ra_ = buf + ((selA ? posA : 0) + 32 * h) * TROW;
                const LAS unsigned char* rb_ = buf + ((selB ? posB : 0) + 32 * h) * TROW;
                const float fa = selA ? 1.0f : 0.f, fb = selB ? 1.0f : 0.f;
#pragma unroll
                for (int g4 = 0; g4 < 4; ++g4) {
                    const f32x4 x0 = __builtin_bit_cast(f32x4, *(const LAS u32x4*)(ra_ + 16 * g4)), x1 = __builtin_bit_cast(f32x4, *(const LAS u32x4*)(ra_ + 64 + 16 * g4));
                    const f32x4 y0 = __builtin_bit_cast(f32x4, *(const LAS u32x4*)(rb_ + 16 * g4)), y1 = __builtin_bit_cast(f32x4, *(const LAS u32x4*)(rb_ + 64 + 16 * g4));
#pragma unroll
                    for (int j = 0; j < 4; ++j) {
                        a.st.o0[4 * g4 + j] += fa * x0[j]; a.st.o1[4 * g4 + j] += fa * x1[j];
                        b.st.o0[4 * g4 + j] += fb * y0[j]; b.st.o1[4 * g4 + j] += fb * y1[j];
                    }
                }
                const f32x4 xl = __builtin_bit_cast(f32x4, *(const LAS u32x4*)(ra_ + 128)), yl = __builtin_bit_cast(f32x4, *(const LAS u32x4*)(rb_ + 128));
                a.st.l += fa * xl[0]; b.st.l += fb * yl[0];
            }
            if (nn < 0) break;
            n = nn;
        }
    }
    const int bb = bh >> 3, head = 8 + (bh & 7);
    attn_finish(a.st, NEGBIG, m0, (const bf16_t*)(ws + WS_ZS), (bf16_t*)(ws + WS_Y), ((size_t)bb * SEQ + qpa) * DM + head * 64, h);
    attn_finish(b.st, NEGBIG, m0, (const bf16_t*)(ws + WS_ZS), (bf16_t*)(ws + WS_Y), ((size_t)bb * SEQ + qpb) * DM + head * 64, h);
}

DI void load_z(u32x2 (&z)[8], const bf16_t* zs, size_t rowoff, int h) {
#pragma unroll
    for (int dt = 0; dt < 2; ++dt)
#pragma unroll
        for (int g = 0; g < 4; ++g) z[4 * dt + g] = *(const u32x2*)(zs + rowoff + 32 * dt + 8 * g + 4 * h);
}
DI void attn_finish_pre(ASt& st, float sink_l2, float m0, const u32x2 (&z)[8], bf16_t* y, size_t rowoff, int h) {
    float l = st.l + __shfl_xor(st.l, 32);
    l += (sink_l2 > -1e29f) ? __builtin_amdgcn_exp2f(sink_l2 - m0) : 0.f;
    const float inv = __builtin_amdgcn_rcpf(l);
#pragma unroll
    for (int dt = 0; dt < 2; ++dt)
#pragma unroll
        for (int g = 0; g < 4; ++g) {
            const u32x2 zz = z[4 * dt + g];
            const float v0 = (dt ? st.o1[4 * g + 0] : st.o0[4 * g + 0]) * inv * bf_lo(zz.x);
            const float v1 = (dt ? st.o1[4 * g + 1] : st.o0[4 * g + 1]) * inv * bf_hi(zz.x);
            const float v2 = (dt ? st.o1[4 * g + 2] : st.o0[4 * g + 2]) * inv * bf_lo(zz.y);
            const float v3 = (dt ? st.o1[4 * g + 3] : st.o0[4 * g + 3]) * inv * bf_hi(zz.y);
            u32x2 w; w.x = cvt_pk(v0, v1); w.y = cvt_pk(v2, v3);
            *(u32x2*)(y + rowoff + 32 * dt + 8 * g + 4 * h) = w;
        }
}
DI void c_item_first_loads(unsigned char* ws, int b, int hq, int chunk, int wid, int lane, bf16x8 (&qfa)[4], bf16x8 (&qfb)[4], TileRegs& tr) {
    const int r = lane & 31, h = lane >> 5, kvh = hq >> 3;
    const bf16_t* Qa = (const bf16_t*)(ws + WS_QC) + ((size_t)b * 16 + hq) * SEQ * 64;
    const bf16_t* K = (const bf16_t*)(ws + WS_KC) + ((size_t)b * 2 + kvh) * SEQ * 64;
    const bf16_t* V = (const bf16_t*)(ws + WS_VTC) + ((size_t)b * 2 + kvh) * SEQ * 64;
    const int t0 = chunk * 256 + wid * 32, qpos = t0 + r;
    const bf16x8* qp = (const bf16x8*)(Qa + (size_t)qpos * 64);
#pragma unroll
    for (int ks = 0; ks < 4; ++ks) { qfa[ks] = qp[2 * ks + h]; qfb[ks] = qp[SEQ * 8 + 2 * ks + h]; }
    const int T = (t0 >= 128) ? 0 : (128 - t0) / 32;
    tile_gload(tr, K, V, t0 - 128 + 32 * T, 1, lane);
}
DI void attn_c_item(unsigned char* ws, LAS unsigned char* buf, int b, int hq, int chunk, int wid, int lane, bf16x8 (&qfa)[4], bf16x8 (&qfb)[4], TileRegs& tr,
                    bool hasn, int nb, int nhq, int nchunk) {
    const int r = lane & 31, h = lane >> 5, kvh = hq >> 3;
    const bf16_t* K = (const bf16_t*)(ws + WS_KC) + ((size_t)b * 2 + kvh) * SEQ * 64;
    const bf16_t* V = (const bf16_t*)(ws + WS_VTC) + ((size_t)b * 2 + kvh) * SEQ * 64;
    const int t0 = chunk * 256 + wid * 32, qpos = t0 + r;
    const float m0 = ((const float*)(ws + WS_GAINS))[402];
    QT qa, qb;
#pragma unroll
    for (int ks = 0; ks < 4; ++ks) { qa.qf[ks] = qfa[ks]; qb.qf[ks] = qfb[ks]; }
#pragma unroll
    for (int i = 0; i < 16; ++i) { qa.st.o0[i] = 0.f; qa.st.o1[i] = 0.f; qb.st.o0[i] = 0.f; qb.st.o1[i] = 0.f; }
    qa.st.l = 0.f; qb.st.l = 0.f;
    int T = (t0 >= 128) ? 0 : (128 - t0) / 32;
    for (; T < 4; ++T) {
        tile_lds_write(buf, tr, lane);
        tile_gload(tr, K, V, t0 - 128 + 32 * (T + 1), 1, lane);
        const int d0 = qpos - (t0 - 128 + 32 * T) - 4 * h;
        band2(qa, qb, buf, d0, d0, 1, 127, 2, m0, lane);
    }
    const float* sinks = (const float*)(ws + WS_GAINS) + 384;
    const size_t rowoff = ((size_t)b * SEQ + qpos) * DM + hq * 64;
    tile_lds_write(buf, tr, lane);
    u32x2 za[8], zb[8];
    load_z(za, (const bf16_t*)(ws + WS_ZS1), rowoff, h); load_z(zb, (const bf16_t*)(ws + WS_ZS1), rowoff + 64, h);
    if (hasn) c_item_first_loads(ws, nb, nhq, nchunk, wid, lane, qfa, qfb, tr);
    { const int d0 = qpos - t0 - 4 * h; band2(qa, qb, buf, d0, d0, 1, 127, 2, m0, lane); }
    attn_finish_pre(qa.st, sinks[hq] * 1.44269504088896341f, m0, za, (bf16_t*)(ws + WS_Y), rowoff, h);
    attn_finish_pre(qb.st, sinks[hq + 1] * 1.44269504088896341f, m0, zb, (bf16_t*)(ws + WS_Y), rowoff + 64, h);
}

#define XB_TMO      128
#define XB_XCNT(j)  (256  + 64 * (j))
#define XB_XSUB(j)  (1280 + 64 * (j))
#define XB_XGEN(j)  (2304 + 64 * (j))
#define XB_TOP      3328
#define XB_TOPGEN   3392
#define XCD_BAR_WORDS 3456
#define XB_SPIN_CAP (1u << 18)

__device__ __forceinline__ unsigned xb_ld(unsigned* p)              { return __hip_atomic_load(p, __ATOMIC_RELAXED, __HIP_MEMORY_SCOPE_AGENT); }
__device__ __forceinline__ unsigned xb_add(unsigned* p, unsigned v) { return __hip_atomic_fetch_add(p, v, __ATOMIC_RELAXED, __HIP_MEMORY_SCOPE_AGENT); }
__device__ __forceinline__ unsigned xb_xcc_id() { return (unsigned)__builtin_amdgcn_s_getreg((3 << 11) | 20) & 0xFu; }
#define XB_SPIN(cond, bar) do { unsigned _sp = 0; while (cond) { __builtin_amdgcn_s_sleep(1); \
    if ((++_sp & 255u) == 0u) { if (xb_ld(&(bar)[XB_TMO])) break; if (_sp > XB_SPIN_CAP) { atomicAdd(&(bar)[XB_TMO], 1u); break; } } } } while (0)

struct XcdBarrier {
    unsigned* bar; unsigned x;
    volatile LAS unsigned* st;
};

__device__ __forceinline__ XcdBarrier xcd_barrier_post(unsigned* bar, volatile LAS unsigned* st) {
    XcdBarrier b; b.bar = bar; b.x = xb_xcc_id(); b.st = st;
    if (threadIdx.x == 0) (void)xb_add(&bar[XB_XCNT(b.x)], 1u);
    return b;
}
__device__ __forceinline__ void xcd_barrier_complete(unsigned* bar, unsigned x, unsigned& nloc, unsigned& nx) {
    const unsigned G = gridDim.x * gridDim.y * gridDim.z;
    unsigned sum, cnt, mine, sp = 0u;
    for (;;) {
        sum = 0u; cnt = 0u; mine = 0u;
#pragma unroll
        for (unsigned j = 0; j < 16; ++j) { const unsigned c = xb_ld(&bar[XB_XCNT(j)]); sum += c; cnt += (c > 0u) ? 1u : 0u; mine = (j == x) ? c : mine; }
        if (sum == G) break;
        __builtin_amdgcn_s_sleep(1);
        if ((++sp & 255u) == 0u) { if (xb_ld(&bar[XB_TMO])) break; if (sp > XB_SPIN_CAP) { atomicAdd(&bar[XB_TMO], 1u); break; } }
    }
    nloc = mine > 0u ? mine : 1u; nx = cnt > 0u ? cnt : 1u;
}

__device__ __forceinline__ void xcd_barrier(const XcdBarrier& b) {
    asm volatile("s_waitcnt vmcnt(0)" ::: "memory");
    __syncthreads();
    if (threadIdx.x == 0) {
        unsigned* bar = b.bar;
        __builtin_amdgcn_s_waitcnt(0);
        unsigned nloc = b.st[0], nx = b.st[1];
        if (nloc == 0u) { xcd_barrier_complete(bar, b.x, nloc, nx); b.st[0] = nloc; b.st[1] = nx; }
        const unsigned old = xb_add(&bar[XB_XSUB(b.x)], 1u);
        const unsigned gen = old / nloc;
        if (old + 1u == (gen + 1u) * nloc) {
            __builtin_amdgcn_fence(__ATOMIC_RELEASE, "agent");
            asm volatile("s_waitcnt vmcnt(0)" ::: "memory");
            const unsigned og = xb_add(&bar[XB_TOP], 1u);
            const unsigned tg = og / nx;
            if (og + 1u == (tg + 1u) * nx) xb_add(&bar[XB_TOPGEN], 1u);
            else XB_SPIN(xb_ld(&bar[XB_TOPGEN]) == tg, bar);
            __builtin_amdgcn_fence(__ATOMIC_ACQUIRE, "agent");
            xb_add(&bar[XB_XGEN(b.x)], 1u);
            asm volatile("s_waitcnt vmcnt(0)" ::: "memory");
        } else {
            XB_SPIN(xb_ld(&bar[XB_XGEN(b.x)]) == gen, bar);
            __builtin_amdgcn_fence(__ATOMIC_ACQUIRE, "agent");
            asm volatile("s_waitcnt vmcnt(0)" ::: "memory");
        }
    }
    __syncthreads();
}


__global__ void __launch_bounds__(NTHREADS) fwd_megakernel(Params P) {
    extern __shared__ __attribute__((aligned(16))) unsigned char lds_raw[];
    cg::grid_group grid = cg::this_grid();
    LAS unsigned char* lds = (LAS unsigned char*)lds_raw;
    unsigned char* ws = P.ws;
    const int G = gridDim.x, bid = blockIdx.x;
    volatile LAS unsigned* xb_st = (volatile LAS unsigned*)(lds + LDS_BYTES - 16);
    if (threadIdx.x == 0) { xb_st[0] = 0u; xb_st[1] = 0u; }
    __syncthreads();
    const XcdBarrier xbar = xcd_barrier_post((unsigned*)(ws + WS_BAR), xb_st);
#define PHASE_IDS() int tid_l = threadIdx.x; asm volatile("" : "+v"(tid_l)); const int tid = tid_l, lane = tid & 63, wid = __builtin_amdgcn_readfirstlane(tid >> 6); (void)lane; (void)wid

    if constexpr (PH_MASK & 1) { for (int rep = 0; rep < NREP(0); ++rep) p0_prologue(P, lds); }
    if (G == 0x7fffffff) grid.sync();
    xcd_barrier(xbar);

    if constexpr ((PH_MASK & 2) != 0) {
        pg8::Gemm g{(const bf16_t*)(ws + WS_XB), (const bf16_t*)(ws + WS_BT0), NTOK, N_IN0, DM};
        pg8::StaticOrder S; S.init(NTOK, N_IN0, G, bid);
        EpiIn E{0, ws};
        for (int rep = 0; rep < NREP(1); ++rep) pg8::gemm_phase<EpiIn, pg8::StaticOrder, true, true>(lds, g, S, E);
    }
    xcd_barrier(xbar);

    if constexpr ((PH_MASK & 4) != 0) {
        PHASE_IDS();
        LAS float* km = (LAS float*)(lds + 8 * TBUF);
        LAS unsigned char* buf = lds + wid * TBUF;
        const float* kmp = (const float*)(ws + WS_KMP);
#define P2_DECODE(it_) const int itt = (it_) & 511, j = itt >> 8, c = itt & 255, xcd = c & 7, slot = c >> 3, idx = j * 32 + slot;   \
                       const int bh = xcd * 8 + (idx >> 3), sub = idx & 7; (void)j
#define P2_STAGE_KM(tab_, bh_) do { for (int e = tid; e < 1024; e += NTHREADS) km[(tab_) * 1024 + e] = kmp[(size_t)(bh_) * 1024 + e] + kmp[(size_t)(64 + (bh_)) * 1024 + e]; } while (0)
        for (int rep = 0; rep < 2; ++rep) {
            if (rep == 0 || NREP(2) == 2) {
                __syncthreads();
                { int k = 0; for (int it = bid; it < 512 && k < 2; it += G, ++k) { P2_DECODE(it); (void)sub; P2_STAGE_KM(k, bh); } }
                __syncthreads();
                int k = 0;
                for (int it = bid; it < 512; it += G, ++k) {
                    P2_DECODE(it);
                    if (k >= 2) { __syncthreads(); P2_STAGE_KM(k & 1, bh); __syncthreads(); }
                    const bool lo = (wid < 4) != ((k & 1) != 0);
                    attn_b_item(ws, buf, lds + 82944 + wid * TBUF, (LAS unsigned*)(lds + 81920 + wid * 128), km + (k & 1) * 1024, bh, lo ? sub : 15 - sub, (k & 1) ? 3 - (wid & 3) : (wid & 3)  , lane);
                }
            }
            if (rep == 0 || NREP(7) == 2) {
                for (int it = 512 + bid; it < 1024; it += G) {
                    P2_DECODE(it);
                    attn_a_y(ws, buf, bh, sub * 512 + wid * 64, lane);
                    __syncthreads();
                    attn_a_x(ws, buf, bh, wid, sub * 32, lane);
                }
            }
        }
#undef P2_DECODE
#undef P2_STAGE_KM
    }
    xcd_barrier(xbar);

    if constexpr ((PH_MASK & 8) != 0) {
        pg8::Gemm g{(const bf16_t*)(ws + WS_Y), (const bf16_t*)(ws + WS_BT1), NTOK, DM, DM};
        pg8::StaticOrder S; S.init(NTOK, DM, G, bid);
        EpiOut E{P.x, (float*)(ws + WS_X1), (bf16_t*)(ws + WS_X1B), (float*)(ws + WS_SSQ)};
        for (int rep = 0; rep < NREP(3); ++rep) pg8::gemm_phase<EpiOut, pg8::StaticOrder, true, true>(lds, g, S, E);
    }
    xcd_barrier(xbar);

    if constexpr ((PH_MASK & 16) != 0) {
        pg8::Gemm g{(const bf16_t*)(ws + WS_X1B), (const bf16_t*)(ws + WS_BT2), NTOK, N_IN1, DM};
        pg8::StaticOrder S; S.init(NTOK, N_IN1, G, bid);
        EpiIn E{1, ws};
        for (int rep = 0; rep < NREP(4); ++rep) pg8::gemm_phase<EpiIn, pg8::StaticOrder, true, true>(lds, g, S, E);
    }
    xcd_barrier(xbar);

    if constexpr ((PH_MASK & 32) != 0) {
        PHASE_IDS();
#define P5_DECODE(it_, b_, hq_, ch_) do { const int j_ = (it_) >> 8, c_ = (it_) & 255, idx_ = j_ * 32 + (c_ >> 3)  , bkv_ = (c_ & 7) * 2 + (idx_ >> 6), rem_ = idx_ & 63; \
        (b_) = bkv_ >> 1; (hq_) = (bkv_ & 1) * 8 + 2 * (rem_ >> 4); (ch_) = rem_ & 15; } while (0)
        for (int rep = 0; rep < NREP(5); ++rep) {
            bf16x8 qfa[4], qfb[4]; TileRegs tr;
            if (bid < 1024) { int b0, hq0, ch0; P5_DECODE(bid, b0, hq0, ch0); c_item_first_loads(ws, b0, hq0, ch0, wid, lane, qfa, qfb, tr); }
            for (int it = bid; it < 1024; it += G) {
                int b1, hq1, ch1; P5_DECODE(it, b1, hq1, ch1);
                const bool hasn = (it + G) < 1024;
                int b2 = b1, hq2 = hq1, ch2 = ch1; if (hasn) P5_DECODE(it + G, b2, hq2, ch2);
                attn_c_item(ws, lds + wid * TBUF, b1, hq1, ch1, wid, lane, qfa, qfb, tr, hasn, b2, hq2, ch2);
            }
        }
#undef P5_DECODE
    }
    xcd_barrier(xbar);

    if constexpr ((PH_MASK & 64) != 0) {
        pg8::Gemm g{(const bf16_t*)(ws + WS_Y), (const bf16_t*)(ws + WS_BT3), NTOK, DM, DM};
        pg8::StaticOrder S; S.init(NTOK, DM, G, bid);
        EpiOut E{(const float*)(ws + WS_X1), P.out, nullptr, nullptr};
        for (int rep = 0; rep < NREP(6); ++rep) pg8::gemm_phase<EpiOut, pg8::StaticOrder, true, true>(lds, g, S, E);
    }
}

extern "C" void kernel_launch(void* const* d_in, const int* in_sizes, int n_in, void* d_out, int out_size, void* d_ws, size_t ws_size, hipStream_t stream) {
    static int grid_blocks = 0;
    if (grid_blocks == 0) {
        if (n_in != 14 || in_sizes[0] != NTOK * DM || out_size != NTOK * DM || ws_size < WS_END) {
            fprintf(stderr, "kernel_launch: unexpected shapes (n_in %d in0 %d out %d ws %zu)\n", n_in, n_in > 0 ? in_sizes[0] : -1, out_size, ws_size); grid_blocks = -1; return; }
        int dev = 0, cus = 0, per_cu = 0;
        hipGetDevice(&dev);
        hipDeviceGetAttribute(&cus, hipDeviceAttributeMultiprocessorCount, dev);
        if (hipFuncSetAttribute((const void*)fwd_megakernel, hipFuncAttributeMaxDynamicSharedMemorySize, LDS_BYTES) != hipSuccess) {
            fprintf(stderr, "kernel_launch: hipFuncSetAttribute failed\n"); grid_blocks = -1; return; }
        if (hipOccupancyMaxActiveBlocksPerMultiprocessor(&per_cu, (const void*)fwd_megakernel, NTHREADS, LDS_BYTES) != hipSuccess || per_cu < 1) {
            fprintf(stderr, "kernel_launch: occupancy query gave %d\n", per_cu); per_cu = 1; (void)hipGetLastError(); }
        grid_blocks = cus * 1;
        if (per_cu < 1) grid_blocks = -1;
    }
    if (grid_blocks < 0) return;
    Params p{};
    p.x = (const float*)d_in[0]; p.norm_even = (const float*)d_in[1]; p.w_in_even = (const float*)d_in[2]; p.w_out_even = (const float*)d_in[3];
    p.qn_a = (const float*)d_in[4]; p.kn_a = (const float*)d_in[5]; p.qn_b = (const float*)d_in[6]; p.kn_b = (const float*)d_in[7];
    p.norm_odd = (const float*)d_in[8]; p.w_in_odd = (const float*)d_in[9]; p.w_out_odd = (const float*)d_in[10];
    p.qn_c = (const float*)d_in[11]; p.kn_c = (const float*)d_in[12]; p.sinks = (const float*)d_in[13];
    p.out = (float*)d_out; p.ws = (unsigned char*)d_ws;
    if (hipMemsetAsync((unsigned char*)d_ws + WS_BAR, 0, XCD_BAR_WORDS * 4, stream) != hipSuccess) { fprintf(stderr, "kernel_launch: memset failed\n"); return; }
    void* args[] = {&p};
    hipError_t e = hipLaunchCooperativeKernel((const void*)fwd_megakernel, dim3(grid_blocks), dim3(NTHREADS), args, LDS_BYTES, stream);
    if (e != hipSuccess) fprintf(stderr, "cooperative launch failed: %s (grid %d)\n", hipGetErrorString(e), grid_blocks);
}
```

```cpp
#include <hip/hip_runtime.h>
#include <hip/hip_cooperative_groups.h>
#include <cstdio>
#include <cstdint>
namespace cg = cooperative_groups;
namespace pg8 {
#define PG8_LAS __attribute__((address_space(3)))
typedef unsigned short bf16_t;
typedef short bf16x8 __attribute__((ext_vector_type(8)));
typedef float f32x4 __attribute__((ext_vector_type(4)));
typedef unsigned u32x4 __attribute__((ext_vector_type(4)));
constexpr int BM = 256, BK = 64, HALF = 128, HTB = HALF * BK * 2  , STAGE_BYTES = 8 * HTB, NXCD = 8, WGM = 8;

__host__ __device__ __forceinline__ int lds_byte(int r, int c) { const int st = (r >> 4) * 2 + (c >> 5), rr = r & 15, cc = c & 31, ob = rr * 64 + cc * 2; return st * 1024 + (ob ^ (((ob >> 9) & 1) << 5)); }
__host__ __device__ __forceinline__ void stage_rc(int b, int& R, int& C) { const int st = b / 1024, sb = b % 1024, swz = sb ^ (((sb >> 9) & 1) << 5); R = (st >> 1) * 16 + swz / 64; C = (st & 1) * 32 + (swz % 64) / 2; }
__host__ __device__ __forceinline__ int perm32(int rho) { const int n = rho >> 4, i = rho & 15; return 8 * (i >> 2) + 4 * n + (i & 3); }

struct Unit { int pm, pn; };
struct Gemm { const bf16_t* A; const bf16_t* Bt; int M, N, K; };

struct StaticOrder {
    int nM, nN, nwg, G, c;
    __host__ __device__ void init(int M, int N, int G_, int c_) { nM = M / BM; nN = N / BM; nwg = nM * nN; G = G_; c = c_; }
    __host__ __device__ bool next(int i, Unit& u) const {
        const long L = (long)i * G + c; if (L >= nwg) return false;
        int wgid = (int)L; { const int q = nwg / NXCD, r = nwg % NXCD, xcd = wgid % NXCD, off = wgid / NXCD; wgid = (xcd < r ? xcd * (q + 1) : r * (q + 1) + (xcd - r) * q) + off; }
        const int nig = WGM * nN, gid = wgid / nig, fm = gid * WGM, gsz = (nM - fm) < WGM ? (nM - fm) : WGM;
        u.pm = fm + ((wgid % nig) % gsz); u.pn = (wgid % nig) / gsz; return true;
    }
    __device__ __forceinline__ void a_ready(const Unit&) const {}
    __device__ __forceinline__ void done(const Unit&) const {}
};

template <class Epi, class Sched, bool ALIGN_EPI = false, bool SP2 = false>
__device__ __forceinline__ void gemm_phase(PG8_LAS unsigned char* lds, const Gemm g, const Sched& S, const Epi& E) {
    int tid_l = threadIdx.x; asm volatile("" : "+v"(tid_l));
    const int tid = tid_l, wid = __builtin_amdgcn_readfirstlane(tid >> 6), lane = tid & 63, wr = wid >> 2, wc = wid & 3, fr = lane & 15, fq = lane >> 4;
    const int K = g.K, nt = K / BK;
    unsigned voffA[2], voffB[2];
#pragma unroll
    for (int i = 0; i < 2; ++i) { int R, C; stage_rc(tid * 16 + i * 8192, R, C); const int Rb = Epi::PERM ? ((R & ~31) + perm32(R & 31)) : R;
        voffA[i] = (unsigned)(R * K + C) * 2u; voffB[i] = (unsigned)(Rb * K + C) * 2u; }
    const size_t kstep = (size_t)(BK * 2);
    const size_t hstep = (size_t)HALF * K * 2;
    const size_t tstep = 2 * hstep;
    const unsigned ldsw = (unsigned)wid * 1024u;
    const int aoff = lds_byte(wr * 64 + fr, fq * 8), boff = lds_byte(wc * 32 + fr, fq * 8);
#define PG8_SA(b, h) (((b) * 2 + (h)) * HTB)
#define PG8_SB(b, h) ((4 + (b) * 2 + (h)) * HTB)
#define PG8_STAGE(bufoff, gbase, voff) do { _Pragma("unroll") for (int _i = 0; _i < 2; ++_i) \
        __builtin_amdgcn_global_load_lds((const unsigned*)((const char*)(gbase) + (voff)[_i]), (PG8_LAS unsigned*)(lds + (bufoff) + ldsw + _i * 8192), 16, 0, 0); } while (0)
#define PG8_LDA(dst, b, h) do { _Pragma("unroll") for (int m = 0; m < 4; ++m) _Pragma("unroll") for (int k = 0; k < 2; ++k) dst[m][k] = *(const PG8_LAS bf16x8*)(lds + PG8_SA(b, h) + aoff + m * 2048 + k * 1024); } while (0)
#define PG8_LDB(dst, b, h) do { _Pragma("unroll") for (int n = 0; n < 2; ++n) _Pragma("unroll") for (int k = 0; k < 2; ++k) dst[n][k] = *(const PG8_LAS bf16x8*)(lds + PG8_SB(b, h) + boff + n * 2048 + k * 1024); } while (0)
#define PG8_MMA(ai, bj, At, Bt) do { __builtin_amdgcn_s_setprio(1); _Pragma("unroll") for (int m = 0; m < 4; ++m) _Pragma("unroll") for (int n = 0; n < 2; ++n) _Pragma("unroll") for (int k = 0; k < 2; ++k) \
        acc[ai][bj][m][n] = __builtin_amdgcn_mfma_f32_16x16x32_bf16(Bt[n][k], At[m][k], acc[ai][bj][m][n], 0, 0, 0); __builtin_amdgcn_s_setprio(0); } while (0)
#define PG8_WAIT_V(n) asm volatile("s_waitcnt vmcnt(" #n ")" ::: "memory")
#define PG8_WAIT_L(n) asm volatile("s_waitcnt lgkmcnt(" #n ")" ::: "memory")
#define PG8_BAR __builtin_amdgcn_s_barrier()
#define PG8_SCHED __builtin_amdgcn_sched_barrier(0)
    Unit cur, nxt; int ui = 0;
    if (!S.next(0, cur)) return;
    f32x4 acc[2][2][4][2];
#pragma unroll
    for (int a = 0; a < 2; ++a)
#pragma unroll
        for (int b = 0; b < 2; ++b)
#pragma unroll
            for (int m = 0; m < 4; ++m)
#pragma unroll
                for (int n = 0; n < 2; ++n) acc[a][b][m][n] = (f32x4){0.f, 0.f, 0.f, 0.f};
    bf16x8 At[4][2], B0[2][2], B1[2][2];
    const char* cA = (const char*)g.A + (size_t)cur.pm * tstep; const char* cB = (const char*)g.Bt + (size_t)cur.pn * tstep;
    S.a_ready(cur);
    if constexpr (SP2) {
        PG8_STAGE(PG8_SB(0, 0), cB, voffB); PG8_STAGE(PG8_SB(0, 1), cB + hstep, voffB); PG8_STAGE(PG8_SA(0, 0), cA, voffA); PG8_STAGE(PG8_SA(0, 1), cA + hstep, voffA);
        if (wr == 1) PG8_BAR;
        PG8_WAIT_V(2); PG8_BAR;
        PG8_STAGE(PG8_SB(1, 0), cB + kstep, voffB); PG8_STAGE(PG8_SA(1, 0), cA + kstep, voffA); PG8_STAGE(PG8_SB(1, 1), cB + hstep + kstep, voffB);
        PG8_WAIT_V(6); PG8_BAR;
    } else {
        PG8_STAGE(PG8_SB(0, 0), cB, voffB); PG8_STAGE(PG8_SA(0, 0), cA, voffA); PG8_STAGE(PG8_SB(0, 1), cB + hstep, voffB); PG8_STAGE(PG8_SA(0, 1), cA + hstep, voffA);
        if (wr == 1) PG8_BAR;
        PG8_WAIT_V(4); PG8_BAR;
        PG8_STAGE(PG8_SB(1, 0), cB + kstep, voffB); PG8_STAGE(PG8_SA(1, 0), cA + kstep, voffA); PG8_STAGE(PG8_SB(1, 1), cB + hstep + kstep, voffB);
        PG8_WAIT_V(6); PG8_BAR;
    }
    for (;;) {
        const bool has_next = S.next(ui + 1, nxt);
        const char* nA = has_next ? (const char*)g.A + (size_t)nxt.pm * tstep : cA; const char* nB = has_next ? (const char*)g.Bt + (size_t)nxt.pn * tstep : cB;
        asm volatile(".p2align 8" ::: "memory");
        for (int t = 0; t < nt; t += 2) {
            const bool last = (t == nt - 2);
            const char* a1 = cA + (size_t)(t + 1) * kstep;
            const char* a2 = last ? nA : cA + (size_t)(t + 2) * kstep; const char* b2 = last ? nB : cB + (size_t)(t + 2) * kstep;
            const char* a3 = a2 + kstep; const char* b3 = b2 + kstep;
            if (last && has_next) S.a_ready(nxt);
            if constexpr (SP2) {
            PG8_LDB(B0, 0, 0); PG8_LDB(B1, 0, 1); PG8_SCHED; PG8_LDA(At, 0, 0); PG8_STAGE(PG8_SA(1, 1), a1 + hstep, voffA);
            PG8_WAIT_V(8); PG8_WAIT_L(0); PG8_BAR; PG8_MMA(0, 0, At, B0); PG8_MMA(0, 1, At, B1); PG8_BAR; PG8_SCHED;
            PG8_LDA(At, 0, 1); PG8_STAGE(PG8_SB(0, 0), b2, voffB); PG8_STAGE(PG8_SB(0, 1), b2 + hstep, voffB); PG8_STAGE(PG8_SA(0, 0), a2, voffA);
            PG8_WAIT_V(8); PG8_WAIT_L(0); PG8_BAR; PG8_MMA(1, 0, At, B0); PG8_MMA(1, 1, At, B1); PG8_BAR; PG8_SCHED;
            PG8_LDB(B0, 1, 0); PG8_LDB(B1, 1, 1); PG8_SCHED; PG8_LDA(At, 1, 0); PG8_STAGE(PG8_SA(0, 1), a2 + hstep, voffA);
            PG8_WAIT_V(8); PG8_WAIT_L(0); PG8_BAR; PG8_MMA(0, 0, At, B0); PG8_MMA(0, 1, At, B1); PG8_BAR; PG8_SCHED;
            PG8_LDA(At, 1, 1); PG8_STAGE(PG8_SB(1, 0), b3, voffB); PG8_STAGE(PG8_SB(1, 1), b3 + hstep, voffB); PG8_STAGE(PG8_SA(1, 0), a3, voffA);
            PG8_WAIT_V(8); PG8_WAIT_L(0); PG8_BAR; PG8_MMA(1, 0, At, B0); PG8_MMA(1, 1, At, B1); PG8_BAR; PG8_SCHED;
            } else {
            PG8_LDB(B0, 0, 0); PG8_SCHED; PG8_LDA(At, 0, 0); PG8_STAGE(PG8_SA(1, 1), a1 + hstep, voffA);
            PG8_WAIT_L(8); PG8_BAR; PG8_WAIT_L(0); PG8_MMA(0, 0, At, B0); PG8_BAR; PG8_SCHED;
            PG8_LDB(B1, 0, 1); PG8_STAGE(PG8_SB(0, 0), b2, voffB);
            PG8_BAR; PG8_WAIT_L(0); PG8_MMA(0, 1, At, B1); PG8_BAR;
            PG8_LDA(At, 0, 1); PG8_STAGE(PG8_SA(0, 0), a2, voffA);
            PG8_BAR; PG8_WAIT_L(0); PG8_MMA(1, 0, At, B0); PG8_BAR; PG8_SCHED;
            PG8_STAGE(PG8_SB(0, 1), b2 + hstep, voffB);
            PG8_WAIT_V(6); PG8_BAR; PG8_MMA(1, 1, At, B1); PG8_BAR;
            PG8_LDB(B0, 1, 0); PG8_SCHED; PG8_LDA(At, 1, 0); PG8_STAGE(PG8_SA(0, 1), a2 + hstep, voffA);
            PG8_WAIT_L(8); PG8_BAR; PG8_WAIT_L(0); PG8_MMA(0, 0, At, B0); PG8_BAR; PG8_SCHED;
            PG8_LDB(B1, 1, 1); PG8_STAGE(PG8_SB(1, 0), b3, voffB);
            PG8_BAR; PG8_WAIT_L(0); PG8_MMA(0, 1, At, B1); PG8_BAR;
            PG8_LDA(At, 1, 1); PG8_STAGE(PG8_SA(1, 0), a3, voffA);
            PG8_BAR; PG8_WAIT_L(0); PG8_MMA(1, 0, At, B0); PG8_BAR; PG8_SCHED;
            PG8_STAGE(PG8_SB(1, 1), b3 + hstep, voffB);
            PG8_WAIT_V(6); PG8_BAR; PG8_MMA(1, 1, At, B1); PG8_BAR;
            }
        }
        if constexpr (ALIGN_EPI) { if (wr == 0) PG8_BAR; }
        if constexpr (!Epi::AFTER_DRAIN) { E(acc, cur, wr, wc, fr, fq); S.done(cur); }
        if (!has_next) break;
#pragma unroll
        for (int a = 0; a < 2; ++a)
#pragma unroll
            for (int b = 0; b < 2; ++b)
#pragma unroll
                for (int m = 0; m < 4; ++m)
#pragma unroll
                    for (int n = 0; n < 2; ++n) acc[a][b][m][n] = (f32x4){0.f, 0.f, 0.f, 0.f};
        cur = nxt; cA = nA; cB = nB; ++ui;
        if constexpr (ALIGN_EPI) { if (wr == 1) PG8_BAR; }
    }
    PG8_WAIT_V(0);
    if constexpr (!ALIGN_EPI) { if (wr == 0) PG8_BAR; }
    PG8_BAR;
    if constexpr (Epi::AFTER_DRAIN) { E.fused(acc, cur, wr, wc, fr, fq, lds, wid, lane); S.done(cur); }
#undef PG8_SA
#undef PG8_SB
#undef PG8_STAGE
#undef PG8_LDA
#undef PG8_LDB
#undef PG8_MMA
#undef PG8_WAIT_V
#undef PG8_WAIT_L
#undef PG8_BAR
#undef PG8_SCHED
}
}

using pg8::bf16_t; using pg8::bf16x8; using pg8::f32x4; using pg8::u32x4; using pg8::Unit;
typedef float f32x16 __attribute__((ext_vector_type(16)));
typedef short s16x4 __attribute__((ext_vector_type(4)));
typedef unsigned u32x2 __attribute__((ext_vector_type(2)));
typedef float f32x2 __attribute__((ext_vector_type(2)));
#define DI __device__ __forceinline__
#define LAS __attribute__((address_space(3)))

constexpr int BATCH = 8, SEQ = 4096, DM = 1024, NTOK = BATCH * SEQ;
constexpr int N_IN0 = 4096, N_IN1 = 2304;
constexpr float NORM_EPS = 1e-6f;
constexpr float SC_LOG2 = 0.125f * 1.44269504088896341f;
constexpr float NEGBIG = -1e30f;
constexpr int NTHREADS = 512;
#ifndef PH_MASK
#define PH_MASK 0x7f
#endif
#ifndef PROBE_REP
#define PROBE_REP 0
#endif
#define NREP(k) (((PROBE_REP >> (k)) & 1) ? 2 : 1)
constexpr int LDS_BYTES = 157696;

constexpr size_t MiB = 1u << 20;
constexpr size_t WS_BT0 = 0 * MiB, WS_BT1 = 8 * MiB, WS_BT2 = 10 * MiB, WS_BT3 = 15 * MiB;
constexpr size_t WS_BAR = 17 * MiB + 512 * 1024;
constexpr size_t WS_GAINS = 17 * MiB;
constexpr size_t WS_RSTD0 = 18 * MiB, WS_CS = 19 * MiB, WS_KMP = 20 * MiB, WS_SSQ = 21 * MiB;
constexpr size_t WS_XB = 32 * MiB;
constexpr size_t WS_Y = 32 * MiB;
constexpr size_t WS_QA = 96 * MiB, WS_KA = 128 * MiB, WS_VTA = 160 * MiB, WS_QB = 192 * MiB, WS_KB = 224 * MiB, WS_VTB = 256 * MiB;
constexpr size_t WS_ZS = 288 * MiB;
constexpr size_t WS_X1 = 352 * MiB;
constexpr size_t WS_X1B = 96 * MiB;
constexpr size_t WS_QC = 160 * MiB, WS_KC = 224 * MiB, WS_VTC = 232 * MiB, WS_ZS1 = 240 * MiB;
constexpr size_t WS_EXO = 352 * MiB, WS_EXL = 416 * MiB;
constexpr size_t WS_END = 480 * MiB;

struct Params {
    const float* x; const float* norm_even; const float* w_in_even; const float* w_out_even;
    const float* qn_a; const float* kn_a; const float* qn_b; const float* kn_b;
    const float* norm_odd; const float* w_in_odd; const float* w_out_odd; const float* qn_c; const float* kn_c; const float* sinks;
    float* out; unsigned char* ws;
};

typedef __bf16 bf16v2 __attribute__((ext_vector_type(2)));
DI unsigned cvt_pk(float lo, float hi) { const f32x2 v = {lo, hi}; return __builtin_bit_cast(unsigned, __builtin_convertvector(v, bf16v2)); }
DI float bf_lo(unsigned u) { return __uint_as_float(u << 16); }
DI float bf_hi(unsigned u) { return __uint_as_float(u & 0xffff0000u); }

DI void p0_weight_tile(const float* W, bf16_t* Bt, int N, const float* g, bool permute, int t, int lane) {
    const int ntn = N / 64, k0 = (t / ntn) * 64, n0 = (t % ntn) * 64;
    const int nlog = n0 + lane;
    const int c = permute ? ((nlog & ~255) | (((nlog >> 5) & 1) << 7) | (((nlog >> 6) & 3) << 5) | (nlog & 31)) : nlog;
    const float* src = W + (size_t)k0 * N + nlog;
    bf16_t* dst = Bt + (size_t)c * 1024 + k0;
#pragma unroll
    for (int hh = 0; hh < 2; ++hh) {
        float v[32];
#pragma unroll
        for (int k = 0; k < 32; ++k) v[k] = src[(size_t)(32 * hh + k) * N];
#pragma unroll
        for (int k = 0; k < 32; ++k) v[k] *= (g ? g[k0 + 32 * hh + k] : 1.0f);
#pragma unroll
        for (int j = 0; j < 4; ++j) {
            u32x4 w; w.x = cvt_pk(v[8 * j], v[8 * j + 1]); w.y = cvt_pk(v[8 * j + 2], v[8 * j + 3]); w.z = cvt_pk(v[8 * j + 4], v[8 * j + 5]); w.w = cvt_pk(v[8 * j + 6], v[8 * j + 7]);
            *(u32x4*)(dst + 32 * hh + 8 * j) = w;
        }
    }
}

DI void sincos_d(double x, double& s, double& c) {
    const double kq = __builtin_rint(x * 0.63661977236758134308);
    double r = __builtin_fma(-kq, 1.57079632679489655800e+00, x); r = __builtin_fma(-kq, 6.12323399573676603587e-17, r);
    const int q = ((int)kq) & 3;
    const double r2 = r * r;
    const double sp = r * (1.0 + r2 * (-1.0 / 6 + r2 * (1.0 / 120 + r2 * (-1.0 / 5040 + r2 * (1.0 / 362880 + r2 * (-1.0 / 39916800 + r2 * (1.0 / 6227020800.0)))))));
    const double cp = 1.0 + r2 * (-0.5 + r2 * (1.0 / 24 + r2 * (-1.0 / 720 + r2 * (1.0 / 40320 + r2 * (-1.0 / 3628800 + r2 * (1.0 / 479001600.0 + r2 * (-1.0 / 87178291200.0)))))));
    s = (q == 0) ? sp : (q == 1) ? cp : (q == 2) ? -sp : -cp;
    c = (q == 0) ? cp : (q == 1) ? -sp : (q == 2) ? -cp : sp;
}

DI void p0_prologue(const Params& P, LAS unsigned char* lds) {
    unsigned char* ws = P.ws;
    const int tid = threadIdx.x, lane = tid & 63, wid = tid >> 6;
    const int G = gridDim.x, bid = blockIdx.x;
    {
        bf16_t* xb = (bf16_t*)(ws + WS_XB); float* rstd = (float*)(ws + WS_RSTD0);
        for (int row0 = bid * 8 + wid; row0 < NTOK; row0 += 2 * G * 8) {
            const int row1 = row0 + G * 8; const bool has1 = row1 < NTOK;
            const f32x4* xr0 = (const f32x4*)(P.x + (size_t)row0 * DM);
            const f32x4* xr1 = (const f32x4*)(P.x + (size_t)(has1 ? row1 : row0) * DM);
            f32x4 v0[4], v1[4];
#pragma unroll
            for (int i = 0; i < 4; ++i) { v0[i] = xr0[lane + 64 * i]; v1[i] = xr1[lane + 64 * i]; }
            float s0 = 0.f, s1 = 0.f;
#pragma unroll
            for (int i = 0; i < 4; ++i) {
                s0 += v0[i][0] * v0[i][0] + v0[i][1] * v0[i][1] + v0[i][2] * v0[i][2] + v0[i][3] * v0[i][3];
                s1 += v1[i][0] * v1[i][0] + v1[i][1] * v1[i][1] + v1[i][2] * v1[i][2] + v1[i][3] * v1[i][3];
                u32x2 w; w.x = cvt_pk(v0[i][0], v0[i][1]); w.y = cvt_pk(v0[i][2], v0[i][3]);
                *(u32x2*)(xb + (size_t)row0 * DM + 4 * (lane + 64 * i)) = w;
                if (has1) { u32x2 w1; w1.x = cvt_pk(v1[i][0], v1[i][1]); w1.y = cvt_pk(v1[i][2], v1[i][3]); *(u32x2*)(xb + (size_t)row1 * DM + 4 * (lane + 64 * i)) = w1; }
            }
#pragma unroll
            for (int o = 32; o >= 1; o >>= 1) { s0 += __shfl_xor(s0, o); s1 += __shfl_xor(s1, o); }
            if (lane == 0) { rstd[row0] = rsqrtf(s0 * (1.0f / DM) + NORM_EPS); if (has1) rstd[row1] = rsqrtf(s1 * (1.0f / DM) + NORM_EPS); }
        }
    }
    if (bid == 0 && tid < 64) {
        float* gw = (float*)(ws + WS_GAINS);
        gw[tid] = P.qn_a[tid]; gw[64 + tid] = P.kn_a[tid]; gw[128 + tid] = P.qn_b[tid]; gw[192 + tid] = P.kn_b[tid]; gw[256 + tid] = P.qn_c[tid]; gw[320 + tid] = P.kn_c[tid];
        if (tid < 16) gw[384 + tid] = P.sinks[tid];
        float ma = fabsf(P.qn_a[tid]), mb = fabsf(P.kn_a[tid]), mc = fabsf(P.qn_b[tid]), md = fabsf(P.kn_b[tid]), me = fabsf(P.qn_c[tid]), mf = fabsf(P.kn_c[tid]);
#pragma unroll
        for (int o = 32; o >= 1; o >>= 1) { ma = fmaxf(ma, __shfl_xor(ma, o)); mb = fmaxf(mb, __shfl_xor(mb, o)); mc = fmaxf(mc, __shfl_xor(mc, o)); md = fmaxf(md, __shfl_xor(md, o)); me = fmaxf(me, __shfl_xor(me, o)); mf = fmaxf(mf, __shfl_xor(mf, o)); }
        if (tid == 0) { const float c = 8.0f * 1.44269504088896341f * 1.01f; gw[400] = c * ma * mb; gw[401] = c * mc * md; gw[402] = c * me * mf; }
    }
    {
        f32x2* cs = (f32x2*)(ws + WS_CS);
        for (int e = bid * NTHREADS + tid; e < SEQ * 32; e += G * NTHREADS) {
            const int pos = e >> 5, i = e & 31;
            double f = 1.0;
            for (int k = 0; k < i; ++k) f *= 0.7498942093324558;
            const float invf = (float)f;
            const float ang = (float)pos * invf;
            double s, c; sincos_d((double)ang, s, c);
            cs[e] = (f32x2){(float)c, (float)s};
        }
    }
    {
        const int T0 = 16 * (N_IN0 / 64), T1 = 16 * (DM / 64), T2 = 16 * (N_IN1 / 64), T3 = 16 * (DM / 64);
        for (int t = bid * 8 + wid; t < T0 + T1 + T2 + T3; t += G * 8) {
            if (t < T0) p0_weight_tile(P.w_in_even, (bf16_t*)(ws + WS_BT0), N_IN0, P.norm_even, true, t, lane);
            else if (t < T0 + T1) p0_weight_tile(P.w_out_even, (bf16_t*)(ws + WS_BT1), DM, nullptr, false, t - T0, lane);
            else if (t < T0 + T1 + T2) p0_weight_tile(P.w_in_odd, (bf16_t*)(ws + WS_BT2), N_IN1, P.norm_odd, true, t - T0 - T1, lane);
            else p0_weight_tile(P.w_out_odd, (bf16_t*)(ws + WS_BT3), DM, nullptr, false, t - T0 - T1 - T2, lane);
        }
    }
}

DI float row_rstd1(const float* ssq, int row, int fq) {
    const f32x4 a = *(const f32x4*)(ssq + (size_t)row * 16 + 4 * fq);
    float t = (a[0] + a[1]) + (a[2] + a[3]);
    t += __shfl_xor(t, 16); t += __shfl_xor(t, 32);
    return rsqrtf(t * (1.0f / DM) + NORM_EPS);
}
struct EpiIn {
    static constexpr bool PERM = true, AFTER_DRAIN = false;
    int layer; unsigned char* ws;
    __device__ __forceinline__ void operator()(const f32x4 (&acc)[2][2][4][2], const Unit& u, int wr, int wc, int fr, int fq) const {
        const float* rstd0 = (const float*)(ws + WS_RSTD0); const float* ssq = (const float*)(ws + WS_SSQ); const f32x2* cs = (const f32x2*)(ws + WS_CS);
        const float* gains = (const float*)(ws + WS_GAINS); bf16_t* zs = (bf16_t*)(ws + (layer == 0 ? WS_ZS : WS_ZS1)); float* kmp = (float*)(ws + WS_KMP);
        int mode, head, hpb = 8, zcol = 0; bf16_t* dst = nullptr; const float* gain = gains; bool do_km = false; float qsc = 1.0f;
        if (layer == 0) {
            const int seg = u.pn >> 1; head = (u.pn & 1) * 4 + wc;
            if (seg == 0) { mode = 0; dst = (bf16_t*)(ws + WS_QA); gain = gains; qsc = SC_LOG2; }
            else if (seg == 1) { mode = 0; dst = (bf16_t*)(ws + WS_KA); gain = gains + 64; }
            else if (seg == 2) { mode = 1; dst = (bf16_t*)(ws + WS_VTA); }
            else if (seg == 3) { mode = 2; zcol = head * 64; }
            else if (seg == 4) { mode = 0; dst = (bf16_t*)(ws + WS_QB); gain = gains + 128; qsc = SC_LOG2; }
            else if (seg == 5) { mode = 0; dst = (bf16_t*)(ws + WS_KB); gain = gains + 192; do_km = true; }
            else if (seg == 6) { mode = 1; dst = (bf16_t*)(ws + WS_VTB); }
            else { mode = 2; zcol = 512 + head * 64; }
        } else {
            if (u.pn < 4) { mode = 0; dst = (bf16_t*)(ws + WS_QC); gain = gains + 256; head = u.pn * 4 + wc; hpb = 16; qsc = SC_LOG2; }
            else if (u.pn == 4) { hpb = 2; if (wc < 2) { mode = 0; dst = (bf16_t*)(ws + WS_KC); gain = gains + 320; head = wc; } else { mode = 1; dst = (bf16_t*)(ws + WS_VTC); head = wc - 2; } }
            else { mode = 2; head = (u.pn - 5) * 4 + wc; zcol = head * 64; }
        }
        const int b = u.pm >> 4, sbase = (u.pm & 15) * 256 + wr * 64 + fr, rowbase = u.pm * 256 + wr * 64 + fr;
        const size_t bh = (size_t)b * hpb + head;
        float rsv[2][4];
        if (layer == 0) {
#pragma unroll
            for (int ai = 0; ai < 2; ++ai)
#pragma unroll
                for (int m = 0; m < 4; ++m) rsv[ai][m] = rstd0[rowbase + ai * 128 + m * 16];
        } else {
            f32x4 pr[2][4];
#pragma unroll
            for (int ai = 0; ai < 2; ++ai)
#pragma unroll
                for (int m = 0; m < 4; ++m) pr[ai][m] = *(const f32x4*)(ssq + (size_t)(rowbase + ai * 128 + m * 16) * 16 + 4 * fq);
#pragma unroll
            for (int ai = 0; ai < 2; ++ai)
#pragma unroll
                for (int m = 0; m < 4; ++m) {
                    float t = (pr[ai][m][0] + pr[ai][m][1]) + (pr[ai][m][2] + pr[ai][m][3]);
                    t += __shfl_xor(t, 16); t += __shfl_xor(t, 32);
                    rsv[ai][m] = rsqrtf(t * (1.0f / DM) + NORM_EPS);
                }
        }
#define ROW_RS(ai_, m_) (rsv[ai_][m_])
        if (mode == 0) {
            float g0[8], g1[8], cs0[8], cs1[8];
#pragma unroll
            for (int i = 0; i < 8; ++i) { g0[i] = gain[8 * fq + i] * qsc; g1[i] = gain[32 + 8 * fq + i] * qsc; cs0[i] = 0.f; cs1[i] = 0.f; }
#pragma unroll
            for (int ai = 0; ai < 2; ++ai)
#pragma unroll
                for (int m = 0; m < 4; ++m) {
                    const int s = sbase + ai * 128 + m * 16; const float r = ROW_RS(ai, m);
                    float t0[8], t1[8]; float ss = 0.f;
#pragma unroll
                    for (int n = 0; n < 2; ++n)
#pragma unroll
                        for (int j = 0; j < 4; ++j) { t0[4 * n + j] = acc[ai][0][m][n][j]; t1[4 * n + j] = acc[ai][1][m][n][j]; }
#pragma unroll
                    for (int i = 0; i < 8; ++i) ss += t0[i] * t0[i] + t1[i] * t1[i];
                    ss += __shfl_xor(ss, 16); ss += __shfl_xor(ss, 32);
                    const float hr = r * rsqrtf(ss * (r * r) * (1.0f / 64.0f) + NORM_EPS);
                    const f32x4* cp = (const f32x4*)(cs + (size_t)s * 32 + 8 * fq);
                    float o0[8], o1[8];
#pragma unroll
                    for (int q = 0; q < 4; ++q) { const f32x4 c4 = cp[q];
                        { const int i = 2 * q; const float a = t0[i] * hr * g0[i], bb = t1[i] * hr * g1[i]; o0[i] = a * c4[0] - bb * c4[1]; o1[i] = bb * c4[0] + a * c4[1]; }
                        { const int i = 2 * q + 1; const float a = t0[i] * hr * g0[i], bb = t1[i] * hr * g1[i]; o0[i] = a * c4[2] - bb * c4[3]; o1[i] = bb * c4[2] + a * c4[3]; } }
                    u32x4 w0, w1;
                    w0.x = cvt_pk(o0[0], o0[1]); w0.y = cvt_pk(o0[2], o0[3]); w0.z = cvt_pk(o0[4], o0[5]); w0.w = cvt_pk(o0[6], o0[7]);
                    w1.x = cvt_pk(o1[0], o1[1]); w1.y = cvt_pk(o1[2], o1[3]); w1.z = cvt_pk(o1[4], o1[5]); w1.w = cvt_pk(o1[6], o1[7]);
                    bf16_t* rp = dst + ((bh * SEQ + s) * 64 + 8 * fq);
                    *(u32x4*)rp = w0; *(u32x4*)(rp + 32) = w1;
                    if (do_km) {
#pragma unroll
                        for (int i = 0; i < 8; ++i) { cs0[i] += o0[i]; cs1[i] += o1[i]; }
                    }
                }
            if (do_km) {
#pragma unroll
                for (int i = 0; i < 8; ++i) {
#pragma unroll
                    for (int o = 1; o <= 8; o <<= 1) { cs0[i] += __shfl_xor(cs0[i], o); cs1[i] += __shfl_xor(cs1[i], o); }
                }
                if (fr == 0) {
                    float* kp = kmp + (((size_t)wr * 64 + bh) * 16 + (u.pm & 15)) * 64 + 8 * fq;
                    *(f32x4*)kp = (f32x4){cs0[0], cs0[1], cs0[2], cs0[3]}; *(f32x4*)(kp + 4) = (f32x4){cs0[4], cs0[5], cs0[6], cs0[7]};
                    *(f32x4*)(kp + 32) = (f32x4){cs1[0], cs1[1], cs1[2], cs1[3]}; *(f32x4*)(kp + 36) = (f32x4){cs1[4], cs1[5], cs1[6], cs1[7]};
                }
            }
        } else if (mode == 1) {
#pragma unroll
            for (int ai = 0; ai < 2; ++ai)
#pragma unroll
                for (int m = 0; m < 4; ++m) {
                    const int s = sbase + ai * 128 + m * 16; const float r = ROW_RS(ai, m);
                    bf16_t* rp = dst + ((bh * SEQ + s) * 64 + 8 * fq);
#pragma unroll
                    for (int bj = 0; bj < 2; ++bj) {
                        const f32x4 v0 = acc[ai][bj][m][0] * r, v1 = acc[ai][bj][m][1] * r;
                        u32x4 w; w.x = cvt_pk(v0[0], v0[1]); w.y = cvt_pk(v0[2], v0[3]); w.z = cvt_pk(v1[0], v1[1]); w.w = cvt_pk(v1[2], v1[3]);
                        *(u32x4*)(rp + 32 * bj) = w;
                    }
                }
        } else {
#pragma unroll
            for (int ai = 0; ai < 2; ++ai)
#pragma unroll
                for (int m = 0; m < 4; ++m) {
                    const int row = rowbase + ai * 128 + m * 16; const float r = ROW_RS(ai, m);
#pragma unroll
                    for (int bj = 0; bj < 2; ++bj) {
                        float sv[8];
#pragma unroll
                        for (int n = 0; n < 2; ++n)
#pragma unroll
                            for (int j = 0; j < 4; ++j) { const float z = acc[ai][bj][m][n][j] * r; sv[4 * n + j] = z * __builtin_amdgcn_rcpf(1.0f + __builtin_amdgcn_exp2f(-1.44269504088896341f * z)); }
                        u32x4 w; w.x = cvt_pk(sv[0], sv[1]); w.y = cvt_pk(sv[2], sv[3]); w.z = cvt_pk(sv[4], sv[5]); w.w = cvt_pk(sv[6], sv[7]);
                        *(u32x4*)(zs + (size_t)row * DM + zcol + 32 * bj + 8 * fq) = w;
                    }
                }
        }
    }
};

struct EpiOut {
    static constexpr bool PERM = true, AFTER_DRAIN = false;
    const float* resid; float* out; bf16_t* xb; float* ssq;
    __device__ __forceinline__ void operator()(const f32x4 (&acc)[2][2][4][2], const Unit& u, int wr, int wc, int fr, int fq) const {
        const int col0 = u.pn * 256 + wc * 32 + 8 * fq, rowbase = u.pm * 256 + wr * 64 + fr;
#pragma unroll
        for (int ai = 0; ai < 2; ++ai)
#pragma unroll
            for (int m = 0; m < 4; ++m) {
                const int row = rowbase + ai * 128 + m * 16; const size_t off = (size_t)row * DM + col0;
                float q = 0.f;
#pragma unroll
                for (int bj = 0; bj < 2; ++bj) {
                    const f32x4 r0 = *(const f32x4*)(resid + off + bj * 128), r1 = *(const f32x4*)(resid + off + bj * 128 + 4);
                    const f32x4 o0 = r0 + acc[ai][bj][m][0], o1 = r1 + acc[ai][bj][m][1];
                    *(f32x4*)(out + off + bj * 128) = o0; *(f32x4*)(out + off + bj * 128 + 4) = o1;
                    if (xb) {
                        u32x4 w; w.x = cvt_pk(o0[0], o0[1]); w.y = cvt_pk(o0[2], o0[3]); w.z = cvt_pk(o1[0], o1[1]); w.w = cvt_pk(o1[2], o1[3]);
                        *(u32x4*)(xb + off + bj * 128) = w;
                        q += (o0[0] * o0[0] + o0[1] * o0[1]) + (o0[2] * o0[2] + o0[3] * o0[3]) + (o1[0] * o1[0] + o1[1] * o1[1]) + (o1[2] * o1[2] + o1[3] * o1[3]);
                    }
                }
                if (xb) { q += __shfl_xor(q, 16); q += __shfl_xor(q, 32); if (fq == 0) ssq[(size_t)row * 16 + u.pn * 4 + wc] = q; }
            }
    }
};

#define MFMA32(a, b, c) __builtin_amdgcn_mfma_f32_32x32x16_bf16((a), (b), (c), 0, 0, 0)
constexpr int TROW = 144;
constexpr int TBUF = 2 * 32 * TROW;
struct TileRegs { u32x4 k[4]; u32x4 v[4]; };
struct ASt { f32x16 o0, o1; float l; };
struct QT { bf16x8 qf[4]; ASt st; };

DI void qt_init(QT& t, const bf16_t* qrow, int h) {
    const bf16x8* qp = (const bf16x8*)qrow;
#pragma unroll
    for (int ks = 0; ks < 4; ++ks) t.qf[ks] = qp[2 * ks + h];
#pragma unroll
    for (int i = 0; i < 16; ++i) { t.st.o0[i] = 0.f; t.st.o1[i] = 0.f; }
    t.st.l = 0.f;
}

DI void tile_gload(TileRegs& t, const bf16_t* K, const bf16_t* V, int kbase, int kstride, int lane) {
    const int row0 = lane >> 3, ch = lane & 7;
#pragma unroll
    for (int i = 0; i < 4; ++i) {
        const unsigned off = (unsigned)((kbase + kstride * (row0 + 8 * i)) * 128 + ch * 16);
        t.k[i] = *(const u32x4*)((const unsigned char*)K + off); t.v[i] = *(const u32x4*)((const unsigned char*)V + off);
    }
}
DI bf16x8 lds_frag(const LAS unsigned char* p) { return __builtin_bit_cast(bf16x8, *(const LAS u32x4*)p); }
DI void tile_lds_write(LAS unsigned char* buf, const TileRegs& t, int lane) {
    const int row0 = lane >> 3, ch = lane & 7;
#pragma unroll
    for (int i = 0; i < 4; ++i) {
        const int off = (row0 + 8 * i) * TROW + ch * 16;
        *(LAS u32x4*)(buf + off) = t.k[i]; *(LAS u32x4*)(buf + 32 * TROW + off) = t.v[i];
    }
}
DI void load_kfrag(bf16x8 (&kf)[4], LAS unsigned char* buf, int lane) {
    const int r = lane & 31, h = lane >> 5;
#pragma unroll
    for (int ks = 0; ks < 4; ++ks) kf[ks] = lds_frag(buf + r * TROW + (2 * ks + h) * 16);
}
DI void load_vfrag(bf16x8 (&vf)[2][2], LAS unsigned char* buf, int lane) {
    const int h = lane >> 5, q = (lane & 15) >> 2, p = lane & 3, blk = (lane >> 4) & 1;
    LAS unsigned char* vb = buf + 32 * TROW + (4 * h + q) * TROW + 32 * blk + 8 * p;
#pragma unroll
    for (int dt = 0; dt < 2; ++dt)
#pragma unroll
        for (int s2 = 0; s2 < 2; ++s2) {
            const s16x4 lo = __builtin_amdgcn_ds_read_tr16_b64_v4i16((LAS s16x4*)(vb + (16 * s2) * TROW + 64 * dt));
            const s16x4 hi4 = __builtin_amdgcn_ds_read_tr16_b64_v4i16((LAS s16x4*)(vb + (16 * s2 + 8) * TROW + 64 * dt));
            vf[dt][s2] = __builtin_shufflevector(lo, hi4, 0, 1, 2, 3, 4, 5, 6, 7);
        }
}
DI void qk_mfma(f32x16& s, const bf16x8 (&kf)[4], const bf16x8 (&qf)[4]) {
#pragma unroll
    for (int i = 0; i < 16; ++i) s[i] = 0.f;
#pragma unroll
    for (int ks = 0; ks < 4; ++ks) s = MFMA32(kf[ks], qf[ks], s);
}
template <bool SUB>
DI void softmax_p(ASt& st, f32x16& s, int dist0, int kstride, int hi, bool lane_ok, bool elem, float sub) {
    if (elem) {
        int d0 = dist0; asm volatile("" : "+v"(d0));
#pragma unroll
        for (int i = 0; i < 16; ++i) {
            const unsigned dist = (unsigned)(d0 - kstride * ((i & 3) + 8 * (i >> 2)));
            s[i] = (dist <= (unsigned)hi) ? s[i] : NEGBIG;
        }
    }
    float ps0 = 0.f, ps1 = 0.f;
#pragma unroll
    for (int i = 0; i < 16; i += 2) {
        s[i] = __builtin_amdgcn_exp2f(SUB ? s[i] - sub : s[i]); s[i + 1] = __builtin_amdgcn_exp2f(SUB ? s[i + 1] - sub : s[i + 1]); ps0 += s[i]; ps1 += s[i + 1];
    }
    st.l += lane_ok ? (ps0 + ps1) : 0.f;
}
DI void pv_mfma(ASt& st, const f32x16& s, const bf16x8 (&vf)[2][2]) {
#pragma unroll
    for (int s2 = 0; s2 < 2; ++s2) {
        u32x4 p;
        p.x = cvt_pk(s[8 * s2 + 0], s[8 * s2 + 1]); p.y = cvt_pk(s[8 * s2 + 2], s[8 * s2 + 3]);
        p.z = cvt_pk(s[8 * s2 + 4], s[8 * s2 + 5]); p.w = cvt_pk(s[8 * s2 + 6], s[8 * s2 + 7]);
        const bf16x8 pb = __builtin_bit_cast(bf16x8, p);
        st.o0 = MFMA32(vf[0][s2], pb, st.o0);
        st.o1 = MFMA32(vf[1][s2], pb, st.o1);
    }
}
DI void pack_p(bf16x8 (&pb)[2], const f32x16& s, bool lane_ok) {
    const unsigned lm = lane_ok ? 0xffffffffu : 0u;
#pragma unroll
    for (int s2 = 0; s2 < 2; ++s2) {
        u32x4 p;
        p.x = cvt_pk(s[8 * s2 + 0], s[8 * s2 + 1]) & lm; p.y = cvt_pk(s[8 * s2 + 2], s[8 * s2 + 3]) & lm;
        p.z = cvt_pk(s[8 * s2 + 4], s[8 * s2 + 5]) & lm; p.w = cvt_pk(s[8 * s2 + 6], s[8 * s2 + 7]) & lm;
        pb[s2] = __builtin_bit_cast(bf16x8, p);
    }
}
DI bf16x8 load_vfrag1(LAS unsigned char* vb, int dt, int s2) {
    const s16x4 lo = __builtin_amdgcn_ds_read_tr16_b64_v4i16((LAS s16x4*)(vb + (16 * s2) * TROW + 64 * dt));
    const s16x4 hi4 = __builtin_amdgcn_ds_read_tr16_b64_v4i16((LAS s16x4*)(vb + (16 * s2 + 8) * TROW + 64 * dt));
    return __builtin_shufflevector(lo, hi4, 0, 1, 2, 3, 4, 5, 6, 7);
}
DI void core2(QT& a, QT& b, LAS unsigned char* buf, int dist0a, int dist0b, int kstride, int hi, bool elem, bool oka, bool okb, float m0, int lane) {
    const int r = lane & 31, h = lane >> 5;
    f32x16 sa, sb;
    {
        const float c = -m0;
        const f32x16 cinit = {c, c, c, c, c, c, c, c, c, c, c, c, c, c, c, c};
        const bf16x8 kf = lds_frag(buf + r * TROW + h * 16); sa = MFMA32(kf, a.qf[0], cinit); sb = MFMA32(kf, b.qf[0], cinit);
    }
#pragma unroll
    for (int ks = 1; ks < 4; ++ks) { const bf16x8 kf = lds_frag(buf + r * TROW + (2 * ks + h) * 16); sa = MFMA32(kf, a.qf[ks], sa); sb = MFMA32(kf, b.qf[ks], sb); }
    LAS unsigned char* vb = buf + 32 * TROW + (4 * h + ((lane & 15) >> 2)) * TROW + 32 * ((lane >> 4) & 1) + 8 * (lane & 3);
    softmax_p<false>(a.st, sa, dist0a, kstride, hi, oka, elem, 0.f);
    {
        bf16x8 pa[2]; pack_p(pa, sa, oka);
#pragma unroll
        for (int s2 = 0; s2 < 2; ++s2) {
            const bf16x8 v0 = load_vfrag1(vb, 0, s2), v1 = load_vfrag1(vb, 1, s2);
            a.st.o0 = MFMA32(v0, pa[s2], a.st.o0); a.st.o1 = MFMA32(v1, pa[s2], a.st.o1);
        }
    }
    softmax_p<false>(b.st, sb, dist0b, kstride, hi, okb, elem, 0.f);
    {
        bf16x8 pb[2]; pack_p(pb, sb, okb);
#pragma unroll
        for (int s2 = 0; s2 < 2; ++s2) {
            const bf16x8 v0 = load_vfrag1(vb, 0, s2), v1 = load_vfrag1(vb, 1, s2);
            b.st.o0 = MFMA32(v0, pb[s2], b.st.o0); b.st.o1 = MFMA32(v1, pb[s2], b.st.o1);
        }
    }
}
DI void core1g(ASt& st, const bf16x8 (&qf)[4], LAS unsigned char* buf, bool ok, float m0, int lane) {
    const int r = lane & 31, h = lane >> 5;
    f32x16 s;
    {
        const f32x16 zero = {0.f, 0.f, 0.f, 0.f, 0.f, 0.f, 0.f, 0.f, 0.f, 0.f, 0.f, 0.f, 0.f, 0.f, 0.f, 0.f};
        const bf16x8 kf = lds_frag(buf + r * TROW + h * 16); s = MFMA32(kf, qf[0], zero);
    }
#pragma unroll
    for (int ks = 1; ks < 4; ++ks) { const bf16x8 kf = lds_frag(buf + r * TROW + (2 * ks + h) * 16); s = MFMA32(kf, qf[ks], s); }
    LAS unsigned char* vb = buf + 32 * TROW + (4 * h + ((lane & 15) >> 2)) * TROW + 32 * ((lane >> 4) & 1) + 8 * (lane & 3);
    softmax_p<true>(st, s, 0, 0, 0, ok, false, m0);
    bf16x8 p[2]; pack_p(p, s, ok);
#pragma unroll
    for (int s2 = 0; s2 < 2; ++s2) {
        const bf16x8 v0 = load_vfrag1(vb, 0, s2), v1 = load_vfrag1(vb, 1, s2);
        st.o0 = MFMA32(v0, p[s2], st.o0); st.o1 = MFMA32(v1, p[s2], st.o1);
    }
}
DI bool band_all_ok(int dist0, int kstride, int hi, int h) {
    const int d_first = dist0 + kstride * 4 * h, d_last = d_first - 31 * kstride;
    return (d_last >= 0) && (d_first <= hi);
}
DI void band2(QT& a, QT& b, LAS unsigned char* buf, int dist0a, int dist0b, int kstride, int hi, int who, float m0, int lane) {
    const bool oka = who != 1, okb = who != 0;
    const bool allok = (!oka || band_all_ok(dist0a, kstride, hi, lane >> 5)) && (!okb || band_all_ok(dist0b, kstride, hi, lane >> 5));
    const bool elem = __builtin_amdgcn_ballot_w64(!allok) != 0ull;
    core2(a, b, buf, dist0a, dist0b, kstride, hi, elem, oka, okb, m0, lane);
}

DI void core1b(ASt& st, const bf16x8 (&qf)[4], LAS unsigned char* buf, int dist0, int kstride, int hi, float m0, int lane) {
    const int r = lane & 31, h = lane >> 5;
    const bool elem = __builtin_amdgcn_ballot_w64(!band_all_ok(dist0, kstride, hi, h)) != 0ull;
    f32x16 s;
    {
        const f32x16 zero = {0.f, 0.f, 0.f, 0.f, 0.f, 0.f, 0.f, 0.f, 0.f, 0.f, 0.f, 0.f, 0.f, 0.f, 0.f, 0.f};
        s = MFMA32(lds_frag(buf + r * TROW + h * 16), qf[0], zero);
    }
#pragma unroll
    for (int ks = 1; ks < 4; ++ks) s = MFMA32(lds_frag(buf + r * TROW + (2 * ks + h) * 16), qf[ks], s);
    LAS unsigned char* vb = buf + 32 * TROW + (4 * h + ((lane & 15) >> 2)) * TROW + 32 * ((lane >> 4) & 1) + 8 * (lane & 3);
    softmax_p<true>(st, s, dist0, kstride, hi, true, elem, m0);
    bf16x8 p[2]; pack_p(p, s, true);
#pragma unroll
    for (int s2 = 0; s2 < 2; ++s2) {
        const bf16x8 v0 = load_vfrag1(vb, 0, s2), v1 = load_vfrag1(vb, 1, s2);
        st.o0 = MFMA32(v0, p[s2], st.o0); st.o1 = MFMA32(v1, p[s2], st.o1);
    }
}
DI void attn_finish(ASt& st, float sink_l2, float m0, const bf16_t* zs, bf16_t* y, size_t rowoff  , int h) {
    float l = st.l + __shfl_xor(st.l, 32);
    l += (sink_l2 > -1e29f) ? __builtin_amdgcn_exp2f(sink_l2 - m0) : 0.f;
    const float inv = __builtin_amdgcn_rcpf(l);
#pragma unroll
    for (int dt = 0; dt < 2; ++dt)
#pragma unroll
        for (int g = 0; g < 4; ++g) {
            const size_t off = rowoff + 32 * dt + 8 * g + 4 * h;
            const u32x2 z = *(const u32x2*)(zs + off);
            const float v0 = (dt ? st.o1[4 * g + 0] : st.o0[4 * g + 0]) * inv * bf_lo(z.x);
            const float v1 = (dt ? st.o1[4 * g + 1] : st.o0[4 * g + 1]) * inv * bf_hi(z.x);
            const float v2 = (dt ? st.o1[4 * g + 2] : st.o0[4 * g + 2]) * inv * bf_lo(z.y);
            const float v3 = (dt ? st.o1[4 * g + 3] : st.o0[4 * g + 3]) * inv * bf_hi(z.y);
            u32x2 w; w.x = cvt_pk(v0, v1); w.y = cvt_pk(v2, v3);
            *(u32x2*)(y + off) = w;
        }
}

DI void load_z(u32x2 (&z)[8], const bf16_t* zs, size_t rowoff, int h) {
#pragma unroll
    for (int dt = 0; dt < 2; ++dt)
#pragma unroll
        for (int g = 0; g < 4; ++g) z[4 * dt + g] = *(const u32x2*)(zs + rowoff + 32 * dt + 8 * g + 4 * h);
}
DI void attn_finish_pre(ASt& st, float sink_l2, float m0, const u32x2 (&z)[8], bf16_t* y, size_t rowoff, int h) {
    float l = st.l + __shfl_xor(st.l, 32);
    l += (sink_l2 > -1e29f) ? __builtin_amdgcn_exp2f(sink_l2 - m0) : 0.f;
    const float inv = __builtin_amdgcn_rcpf(l);
#pragma unroll
    for (int dt = 0; dt < 2; ++dt)
#pragma unroll
        for (int g = 0; g < 4; ++g) {
            const u32x2 zz = z[4 * dt + g];
            const float v0 = (dt ? st.o1[4 * g + 0] : st.o0[4 * g + 0]) * inv * bf_lo(zz.x);
            const float v1 = (dt ? st.o1[4 * g + 1] : st.o0[4 * g + 1]) * inv * bf_hi(zz.x);
            const float v2 = (dt ? st.o1[4 * g + 2] : st.o0[4 * g + 2]) * inv * bf_lo(zz.y);
            const float v3 = (dt ? st.o1[4 * g + 3] : st.o0[4 * g + 3]) * inv * bf_hi(zz.y);
            u32x2 w; w.x = cvt_pk(v0, v1); w.y = cvt_pk(v2, v3);
            *(u32x2*)(y + rowoff + 32 * dt + 8 * g + 4 * h) = w;
        }
}
DI void attn_a_y(unsigned char* ws, LAS unsigned char* buf, int bh, int t0, int lane) {
    const int r = lane & 31, h = lane >> 5;
    const bf16_t* Q = (const bf16_t*)(ws + WS_QA) + (size_t)bh * SEQ * 64;
    const bf16_t* K = (const bf16_t*)(ws + WS_KA) + (size_t)bh * SEQ * 64;
    const bf16_t* V = (const bf16_t*)(ws + WS_VTA) + (size_t)bh * SEQ * 64;
    const int qpa = t0 + r, qpb = qpa + 32;
    const float m0 = ((const float*)(ws + WS_GAINS))[400];
    QT a, b; qt_init(a, Q + (size_t)qpa * 64, h); qt_init(b, Q + (size_t)qpb * 64, h);
    TileRegs tr;
    int T = (t0 >= 128) ? 0 : (128 - t0) / 32;
    tile_gload(tr, K, V, t0 - 128 + 32 * T, 1, lane);
    for (;;) {
        tile_lds_write(buf, tr, lane);
        const bool have = (T + 1) < 6;
        if (have) tile_gload(tr, K, V, t0 - 128 + 32 * (T + 1), 1, lane);
        const int kb = t0 - 128 + 32 * T;
        band2(a, b, buf, qpa - kb - 4 * h, qpb - kb - 4 * h, 1, 128, 2, m0, lane);
        if (!have) break;
        ++T;
    }
    const float la = a.st.l + __shfl_xor(a.st.l, 32), lb = b.st.l + __shfl_xor(b.st.l, 32);
    float* exa = (float*)(ws + WS_EXO) + ((size_t)bh * SEQ + qpa) * 64 + 4 * h;
    float* exb = exa + 32 * 64;
#pragma unroll
    for (int g = 0; g < 4; ++g) {
        *(f32x4*)(exa + 8 * g) = (f32x4){a.st.o0[4 * g], a.st.o0[4 * g + 1], a.st.o0[4 * g + 2], a.st.o0[4 * g + 3]};
        *(f32x4*)(exa + 32 + 8 * g) = (f32x4){a.st.o1[4 * g], a.st.o1[4 * g + 1], a.st.o1[4 * g + 2], a.st.o1[4 * g + 3]};
        *(f32x4*)(exb + 8 * g) = (f32x4){b.st.o0[4 * g], b.st.o0[4 * g + 1], b.st.o0[4 * g + 2], b.st.o0[4 * g + 3]};
        *(f32x4*)(exb + 32 + 8 * g) = (f32x4){b.st.o1[4 * g], b.st.o1[4 * g + 1], b.st.o1[4 * g + 2], b.st.o1[4 * g + 3]};
    }
    if (h == 0) { float* exl = (float*)(ws + WS_EXL) + (size_t)bh * SEQ; exl[qpa] = la; exl[qpb] = lb; }
}
DI bool a_tile_desc(int tau, int ra, int i0, int& kbase, int& kstride, int& hi, int& who) {
    if (tau < 10) { const int t = (tau < 5) ? tau : tau - 5; const int jb = i0 - 128 + 32 * t; who = (tau < 5) ? 0 : 1; kbase = ra + 8 * who + 16 * jb; kstride = 16; hi = 2048; return jb >= 0; }
    who = 2;
    { const int ub = 4 * i0 - 128 + 32 * (tau - 10); kbase = (ra & 3) + 4 * ub; kstride = 4; hi = 512; return ub >= 0; }
}
DI int a_next(int tau, int ra, int i0) { int t = tau + 1, kb, ks, hi, who; while (t < 18 && !a_tile_desc(t, ra, i0, kb, ks, hi, who)) ++t; return t; }
DI void attn_a_x(unsigned char* ws, LAS unsigned char* buf, int bh, int ra, int i0, int lane) {
    const int r = lane & 31, h = lane >> 5;
    const bf16_t* Q = (const bf16_t*)(ws + WS_QA) + (size_t)bh * SEQ * 64;
    const bf16_t* K = (const bf16_t*)(ws + WS_KA) + (size_t)bh * SEQ * 64;
    const bf16_t* V = (const bf16_t*)(ws + WS_VTA) + (size_t)bh * SEQ * 64;
    const int qpa = ra + 16 * (i0 + r), qpb = qpa + 8;
    const float m0 = ((const float*)(ws + WS_GAINS))[400];
    QT a, b; qt_init(a, Q + (size_t)qpa * 64, h); qt_init(b, Q + (size_t)qpb * 64, h);
    {
        const float* exa = (const float*)(ws + WS_EXO) + ((size_t)bh * SEQ + qpa) * 64 + 4 * h;
        const float* exb = exa + 8 * 64;
#pragma unroll
        for (int g = 0; g < 4; ++g) {
            const f32x4 a0 = *(const f32x4*)(exa + 8 * g), a1 = *(const f32x4*)(exa + 32 + 8 * g), b0 = *(const f32x4*)(exb + 8 * g), b1 = *(const f32x4*)(exb + 32 + 8 * g);
#pragma unroll
            for (int j = 0; j < 4; ++j) { a.st.o0[4 * g + j] = a0[j]; a.st.o1[4 * g + j] = a1[j]; b.st.o0[4 * g + j] = b0[j]; b.st.o1[4 * g + j] = b1[j]; }
        }
        const float* exl = (const float*)(ws + WS_EXL) + (size_t)bh * SEQ;
        a.st.l = (h == 0) ? exl[qpa] : 0.f; b.st.l = (h == 0) ? exl[qpb] : 0.f;
    }
    TileRegs tr;
    int tc = a_next(-1, ra, i0);
    { int kb, ks, hi, who; (void)a_tile_desc(tc, ra, i0, kb, ks, hi, who); tile_gload(tr, K, V, kb, ks, lane); }
#define X_STEP(COMPUTE) { tile_lds_write(buf, tr, lane); const int tn = a_next(tc, ra, i0); \
        if (tn < 18) { int kb_, ks_, hi_, who_; (void)a_tile_desc(tn, ra, i0, kb_, ks_, hi_, who_); tile_gload(tr, K, V, kb_, ks_, lane); } \
        { int kb, ks, hi, who; (void)a_tile_desc(tc, ra, i0, kb, ks, hi, who); const int d0a = qpa - kb - ks * 4 * h, d0b = qpb - kb - ks * 4 * h; (void)d0a; (void)d0b; (void)who; COMPUTE; } \
        tc = tn; }
    while (tc < 5) X_STEP(core1b(a.st, a.qf, buf, d0a, ks, hi, m0, lane))
    while (tc < 10) X_STEP(core1b(b.st, b.qf, buf, d0b, ks, hi, m0, lane))
    while (tc < 17) X_STEP(band2(a, b, buf, d0a, d0b, ks, hi, 2, m0, lane))
    const int bb = bh >> 3, head = bh & 7;
    const size_t roa = ((size_t)bb * SEQ + qpa) * DM + head * 64, rob = ((size_t)bb * SEQ + qpb) * DM + head * 64;
    u32x2 za[8], zb[8];
    load_z(za, (const bf16_t*)(ws + WS_ZS), roa, h); load_z(zb, (const bf16_t*)(ws + WS_ZS), rob, h);
    X_STEP(band2(a, b, buf, d0a, d0b, ks, hi, 2, m0, lane))
#undef X_STEP
    attn_finish_pre(a.st, NEGBIG, m0, za, (bf16_t*)(ws + WS_Y), roa, h);
    attn_finish_pre(b.st, NEGBIG, m0, zb, (bf16_t*)(ws + WS_Y), rob, h);
}

DI unsigned moba_select(const bf16x8 (&qf)[4], LAS float* km, int qblk, int h) {
    float v1 = -3e38f, v2 = -3e38f, v3 = -3e38f; int i1 = 31, i2 = 31, i3 = 31;
    for (int n = 0; n < qblk; ++n) {
        float g = 0.f;
#pragma unroll
        for (int ks = 0; ks < 4; ++ks) {
            const LAS f32x4* kp = (const LAS f32x4*)(km + n * 64 + 16 * ks + 8 * h);
            const f32x4 x = kp[0], y = kp[1];
            const u32x4 qu = __builtin_bit_cast(u32x4, qf[ks]);
            g += bf_lo(qu.x) * x[0] + bf_hi(qu.x) * x[1] + bf_lo(qu.y) * x[2] + bf_hi(qu.y) * x[3]
               + bf_lo(qu.z) * y[0] + bf_hi(qu.z) * y[1] + bf_lo(qu.w) * y[2] + bf_hi(qu.w) * y[3];
        }
        g += __shfl_xor(g, 32);
        if (g > v1) { v3 = v2; i3 = i2; v2 = v1; i2 = i1; v1 = g; i1 = n; }
        else if (g > v2) { v3 = v2; i3 = i2; v2 = g; i2 = n; }
        else if (g > v3) { v3 = g; i3 = n; }
    }
    unsigned sel = 0u;
    if (i1 < 16) sel |= 1u << i1;
    if (i2 < 16) sel |= 1u << i2;
    if (i3 < 16) sel |= 1u << i3;
    return sel;
}
DI void attn_b_item(unsigned char* ws, LAS unsigned char* buf, LAS unsigned char* qbuf, LAS unsigned* tbl, LAS float* km  , int bh, int qblk, int w4, int lane) {
    const int r = lane & 31, h = lane >> 5;
    const bf16_t* Q = (const bf16_t*)(ws + WS_QB) + (size_t)bh * SEQ * 64;
    const bf16_t* K = (const bf16_t*)(ws + WS_KB) + (size_t)bh * SEQ * 64;
    const bf16_t* V = (const bf16_t*)(ws + WS_VTB) + (size_t)bh * SEQ * 64;
    const int qpa = qblk * 256 + w4 * 64 + r, qpb = qpa + 32;
    const float m0 = ((const float*)(ws + WS_GAINS))[401];
    QT a, b; qt_init(a, Q + (size_t)qpa * 64, h); qt_init(b, Q + (size_t)qpb * 64, h);
    TileRegs tr;
    tile_gload(tr, Q, Q + 32 * 64, qblk * 256 + w4 * 64, 1, lane); tile_lds_write(qbuf, tr, lane);
    const unsigned sela = moba_select(a.qf, km, qblk, h), selb = moba_select(b.qf, km, qblk, h);
    unsigned uni = 0u, cmask = 0u;
    for (int n = 0; n < qblk; ++n) {
        const unsigned mA = (unsigned)__builtin_amdgcn_ballot_w64(((sela >> n) & 1u) != 0u), mB = (unsigned)__builtin_amdgcn_ballot_w64(((selb >> n) & 1u) != 0u);
        const int tot = __builtin_popcount(mA) + __builtin_popcount(mB);
        if (tot > 0) { uni |= 1u << n; if (tot <= 32) cmask |= 1u << n; }
    }
    uni = (uni & ~cmask) | (1u << qblk);
    const int own_tiles = 2 * w4 + 2;
    {
#define B_ADV(n_, T_, ok_) do { const int cnt_ = ((n_) == qblk) ? own_tiles : 8; if (++(T_) >= cnt_) { const unsigned rest_ = uni & ~((2u << (n_)) - 1u); if (rest_) { (n_) = __builtin_ctz(rest_); (T_) = 0; } else (ok_) = false; } } while (0)
        int nc = __builtin_ctz(uni), Tc = 0;
        tile_gload(tr, K, V, nc * 256, 1, lane);
        for (;;) {
            tile_lds_write(buf, tr, lane);
            int nl = nc, Tl = Tc; bool okl = true; B_ADV(nl, Tl, okl);
            if (okl) tile_gload(tr, K, V, nl * 256 + 32 * Tl, 1, lane);
            {
                const int kb = nc * 256 + 32 * Tc;
                const bool own = (nc == qblk);
                const bool oka = own ? (Tc <= 2 * w4) : (((sela >> nc) & 1u) != 0u), okb = own ? true : (((selb >> nc) & 1u) != 0u);
                core2(a, b, buf, qpa - kb - 4 * h, qpb - kb - 4 * h, 1, 0x7fffffff, own && (Tc >= 2 * w4), oka, okb, m0, lane);
            }
            if (!okl) break;
            nc = nl; Tc = Tl;
        }
#undef B_ADV
    }
    if (cmask) {
        int n = __builtin_ctz(cmask);
        tile_gload(tr, K, V, n * 256, 1, lane);
        for (;;) {
            const unsigned rest = cmask & ~((2u << n) - 1u);
            const int nn = rest ? __builtin_ctz(rest) : -1;
            const bool selA = ((sela >> n) & 1u) != 0u, selB = ((selb >> n) & 1u) != 0u;
            const unsigned mA = (unsigned)__builtin_amdgcn_ballot_w64(selA), mB = (unsigned)__builtin_amdgcn_ballot_w64(selB);
            const int cntA = __builtin_popcount(mA), tot = cntA + __builtin_popcount(mB);
            const unsigned below = (1u << r) - 1u;
            const int posA = __builtin_popcount(mA & below), posB = cntA + __builtin_popcount(mB & below);
            if (h == 0) { if (selA) tbl[posA] = (unsigned)r; if (selB) tbl[posB] = (unsigned)(32 + r); }
            const bool okg = r < tot;
            const unsigned src = okg ? tbl[r] : 0u;
            bf16x8 gq[4]; ASt g;
            {
#pragma unroll
                for (int ks = 0; ks < 4; ++ks) gq[ks] = lds_frag(qbuf + src * TROW + (2 * ks + h) * 16);
#pragma unroll
                for (int i = 0; i < 16; ++i) { g.o0[i] = 0.f; g.o1[i] = 0.f; }
                g.l = 0.f;
            }
#pragma unroll 1
            for (int T = 0; T < 8; ++T) {
                tile_lds_write(buf, tr, lane);
                if (T < 7) tile_gload(tr, K, V, n * 256 + 32 * (T + 1), 1, lane);
                else if (nn >= 0) tile_gload(tr, K, V, nn * 256, 1, lane);
                core1g(g, gq, buf, okg, m0, lane);
            }
            {
#pragma unroll
                for (int g4 = 0; g4 < 4; ++g4) {
                    *(LAS u32x4*)(buf + lane * TROW + 16 * g4) = __builtin_bit_cast(u32x4, (f32x4){g.o0[4 * g4], g.o0[4 * g4 + 1], g.o0[4 * g4 + 2], g.o0[4 * g4 + 3]});
                    *(LAS u32x4*)(buf + lane * TROW + 64 + 16 * g4) = __builtin_bit_cast(u32x4, (f32x4){g.o1[4 * g4], g.o1[4 * g4 + 1], g.o1[4 * g4 + 2], g.o1[4 * g4 + 3]});
                }
                *(LAS u32x4*)(buf + lane * TROW + 128) = __builtin_bit_cast(u32x4, (f32x4){g.l, 0.f, 0.f, 0.f});
                const LAS unsigned char* ra_ = buf + ((selA ? posA : 0) + 32 * h) * TROW;
                const LAS unsigned char* rb_ = buf + ((selB ? posB : 0) + 32 * h) * TROW;
                const float fa = selA ? 1.0f : 0.f, fb = selB ? 1.0f : 0.f;
#pragma unroll
                for (int g4 = 0; g4 < 4; ++g4) {
                    const f32x4 x0 = __builtin_bit_cast(f32x4, *(const LAS u32x4*)(ra_ + 16 * g4)), x1 = __builtin_bit_cast(f32x4, *(const LAS u32x4*)(ra_ + 64 + 16 * g4));
                    const f32x4 y0 = __builtin_bit_cast(f32x4, *(const LAS u32x4*)(rb_ + 16 * g4)), y1 = __builtin_bit_cast(f32x4, *(const LAS u32x4*)(rb_ + 64 + 16 * g4));
#pragma unroll
                    for (int j = 0; j < 4; ++j) {
                        a.st.o0[4 * g4 + j] += fa * x0[j]; a.st.o1[4 * g4 + j] += fa * x1[j];
                        b.st.o0[4 * g4 + j] += fb * y0[j]; b.st.o1[4 * g4 + j] += fb * y1[j];
                    }
                }
                const f32x4 xl = __builtin_bit_cast(f32x4, *(const LAS u32x4*)(ra_ + 128)), yl = __builtin_bit_cast(f32x4, *(const LAS u32x4*)(rb_ + 128));
                a.st.l += fa * xl[0]; b.st.l += fb * yl[0];
            }
            if (nn < 0) break;
            n = nn;
        }
    }
    const int bb = bh >> 3, head = 8 + (bh & 7);
    attn_finish(a.st, NEGBIG, m0, (const bf16_t*)(ws + WS_ZS), (bf16_t*)(ws + WS_Y), ((size_t)bb * SEQ + qpa) * DM + head * 64, h);
    attn_finish(b.st, NEGBIG, m0, (const bf16_t*)(ws + WS_ZS), (bf16_t*)(ws + WS_Y), ((size_t)bb * SEQ + qpb) * DM + head * 64, h);
}

DI void c_item_first_loads(unsigned char* ws, int b, int hq, int chunk, int wid, int lane, bf16x8 (&qfa)[4], bf16x8 (&qfb)[4], TileRegs& tr) {
    const int r = lane & 31, h = lane >> 5, kvh = hq >> 3;
    const bf16_t* Qa = (const bf16_t*)(ws + WS_QC) + ((size_t)b * 16 + hq) * SEQ * 64;
    const bf16_t* K = (const bf16_t*)(ws + WS_KC) + ((size_t)b * 2 + kvh) * SEQ * 64;
    const bf16_t* V = (const bf16_t*)(ws + WS_VTC) + ((size_t)b * 2 + kvh) * SEQ * 64;
    const int t0 = chunk * 256 + wid * 32, qpos = t0 + r;
    const bf16x8* qp = (const bf16x8*)(Qa + (size_t)qpos * 64);
#pragma unroll
    for (int ks = 0; ks < 4; ++ks) { qfa[ks] = qp[2 * ks + h]; qfb[ks] = qp[SEQ * 8 + 2 * ks + h]; }
    const int T = (t0 >= 128) ? 0 : (128 - t0) / 32;
    tile_gload(tr, K, V, t0 - 128 + 32 * T, 1, lane);
}
DI void attn_c_item(unsigned char* ws, LAS unsigned char* buf, int b, int hq, int chunk, int wid, int lane, bf16x8 (&qfa)[4], bf16x8 (&qfb)[4], TileRegs& tr,
                    bool hasn, int nb, int nhq, int nchunk) {
    const int r = lane & 31, h = lane >> 5, kvh = hq >> 3;
    const bf16_t* K = (const bf16_t*)(ws + WS_KC) + ((size_t)b * 2 + kvh) * SEQ * 64;
    const bf16_t* V = (const bf16_t*)(ws + WS_VTC) + ((size_t)b * 2 + kvh) * SEQ * 64;
    const int t0 = chunk * 256 + wid * 32, qpos = t0 + r;
    const float m0 = ((const float*)(ws + WS_GAINS))[402];
    QT qa, qb;
#pragma unroll
    for (int ks = 0; ks < 4; ++ks) { qa.qf[ks] = qfa[ks]; qb.qf[ks] = qfb[ks]; }
#pragma unroll
    for (int i = 0; i < 16; ++i) { qa.st.o0[i] = 0.f; qa.st.o1[i] = 0.f; qb.st.o0[i] = 0.f; qb.st.o1[i] = 0.f; }
    qa.st.l = 0.f; qb.st.l = 0.f;
    int T = (t0 >= 128) ? 0 : (128 - t0) / 32;
    for (; T < 4; ++T) {
        tile_lds_write(buf, tr, lane);
        tile_gload(tr, K, V, t0 - 128 + 32 * (T + 1), 1, lane);
        const int d0 = qpos - (t0 - 128 + 32 * T) - 4 * h;
        band2(qa, qb, buf, d0, d0, 1, 127, 2, m0, lane);
    }
    const float* sinks = (const float*)(ws + WS_GAINS) + 384;
    const size_t rowoff = ((size_t)b * SEQ + qpos) * DM + hq * 64;
    tile_lds_write(buf, tr, lane);
    u32x2 za[8], zb[8];
    load_z(za, (const bf16_t*)(ws + WS_ZS1), rowoff, h); load_z(zb, (const bf16_t*)(ws + WS_ZS1), rowoff + 64, h);
    if (hasn) c_item_first_loads(ws, nb, nhq, nchunk, wid, lane, qfa, qfb, tr);
    { const int d0 = qpos - t0 - 4 * h; band2(qa, qb, buf, d0, d0, 1, 127, 2, m0, lane); }
    attn_finish_pre(qa.st, sinks[hq] * 1.44269504088896341f, m0, za, (bf16_t*)(ws + WS_Y), rowoff, h);
    attn_finish_pre(qb.st, sinks[hq + 1] * 1.44269504088896341f, m0, zb, (bf16_t*)(ws + WS_Y), rowoff + 64, h);
}

#define XB_TMO      128
#define XB_XCNT(j)  (256  + 64 * (j))
#define XB_XSUB(j)  (1280 + 64 * (j))
#define XB_XGEN(j)  (2304 + 64 * (j))
#define XB_TOP      3328
#define XB_TOPGEN   3392
#define XCD_BAR_WORDS 3456
#define XB_SPIN_CAP (1u << 18)

__device__ __forceinline__ unsigned xb_ld(unsigned* p)              { return __hip_atomic_load(p, __ATOMIC_RELAXED, __HIP_MEMORY_SCOPE_AGENT); }
__device__ __forceinline__ unsigned xb_add(unsigned* p, unsigned v) { return __hip_atomic_fetch_add(p, v, __ATOMIC_RELAXED, __HIP_MEMORY_SCOPE_AGENT); }
__device__ __forceinline__ unsigned xb_xcc_id() { return (unsigned)__builtin_amdgcn_s_getreg((3 << 11) | 20) & 0xFu; }
#define XB_SPIN(cond, bar) do { unsigned _sp = 0; while (cond) { __builtin_amdgcn_s_sleep(1); \
    if ((++_sp & 255u) == 0u) { if (xb_ld(&(bar)[XB_TMO])) break; if (_sp > XB_SPIN_CAP) { atomicAdd(&(bar)[XB_TMO], 1u); break; } } } } while (0)

struct XcdBarrier {
    unsigned* bar; unsigned x;
    volatile LAS unsigned* st;
};

__device__ __forceinline__ XcdBarrier xcd_barrier_post(unsigned* bar, volatile LAS unsigned* st) {
    XcdBarrier b; b.bar = bar; b.x = xb_xcc_id(); b.st = st;
    if (threadIdx.x == 0) (void)xb_add(&bar[XB_XCNT(b.x)], 1u);
    return b;
}
__device__ __forceinline__ void xcd_barrier_complete(unsigned* bar, unsigned x, unsigned& nloc, unsigned& nx) {
    const unsigned G = gridDim.x * gridDim.y * gridDim.z;
    unsigned sum, cnt, mine, sp = 0u;
    for (;;) {
        sum = 0u; cnt = 0u; mine = 0u;
#pragma unroll
        for (unsigned j = 0; j < 16; ++j) { const unsigned c = xb_ld(&bar[XB_XCNT(j)]); sum += c; cnt += (c > 0u) ? 1u : 0u; mine = (j == x) ? c : mine; }
        if (sum == G) break;
        __builtin_amdgcn_s_sleep(1);
        if ((++sp & 255u) == 0u) { if (xb_ld(&bar[XB_TMO])) break; if (sp > XB_SPIN_CAP) { atomicAdd(&bar[XB_TMO], 1u); break; } }
    }
    nloc = mine > 0u ? mine : 1u; nx = cnt > 0u ? cnt : 1u;
}

__device__ __forceinline__ void xcd_barrier(const XcdBarrier& b) {
    asm volatile("s_waitcnt vmcnt(0)" ::: "memory");
    __syncthreads();
    if (threadIdx.x == 0) {
        unsigned* bar = b.bar;
        __builtin_amdgcn_s_waitcnt(0);
        unsigned nloc = b.st[0], nx = b.st[1];
        if (nloc == 0u) { xcd_barrier_complete(bar, b.x, nloc, nx); b.st[0] = nloc; b.st[1] = nx; }
        const unsigned old = xb_add(&bar[XB_XSUB(b.x)], 1u);
        const unsigned gen = old / nloc;
        if (old + 1u == (gen + 1u) * nloc) {
            __builtin_amdgcn_fence(__ATOMIC_RELEASE, "agent");
            asm volatile("s_waitcnt vmcnt(0)" ::: "memory");
            const unsigned og = xb_add(&bar[XB_TOP], 1u);
            const unsigned tg = og / nx;
            if (og + 1u == (tg + 1u) * nx) xb_add(&bar[XB_TOPGEN], 1u);
            else XB_SPIN(xb_ld(&bar[XB_TOPGEN]) == tg, bar);
            __builtin_amdgcn_fence(__ATOMIC_ACQUIRE, "agent");
            xb_add(&bar[XB_XGEN(b.x)], 1u);
            asm volatile("s_waitcnt vmcnt(0)" ::: "memory");
        } else {
            XB_SPIN(xb_ld(&bar[XB_XGEN(b.x)]) == gen, bar);
            __builtin_amdgcn_fence(__ATOMIC_ACQUIRE, "agent");
            asm volatile("s_waitcnt vmcnt(0)" ::: "memory");
        }
    }
    __syncthreads();
}


__global__ void __launch_bounds__(NTHREADS) fwd_megakernel(Params P) {
    extern __shared__ __attribute__((aligned(16))) unsigned char lds_raw[];
    cg::grid_group grid = cg::this_grid();
    LAS unsigned char* lds = (LAS unsigned char*)lds_raw;
    unsigned char* ws = P.ws;
    const int G = gridDim.x, bid = blockIdx.x;
    volatile LAS unsigned* xb_st = (volatile LAS unsigned*)(lds + LDS_BYTES - 16);
    if (threadIdx.x == 0) { xb_st[0] = 0u; xb_st[1] = 0u; }
    __syncthreads();
    const XcdBarrier xbar = xcd_barrier_post((unsigned*)(ws + WS_BAR), xb_st);
#define PHASE_IDS() int tid_l = threadIdx.x; asm volatile("" : "+v"(tid_l)); const int tid = tid_l, lane = tid & 63, wid = __builtin_amdgcn_readfirstlane(tid >> 6); (void)lane; (void)wid

    if constexpr (PH_MASK & 1) { for (int rep = 0; rep < NREP(0); ++rep) p0_prologue(P, lds); }
    if (G == 0x7fffffff) grid.sync();
    xcd_barrier(xbar);

    if constexpr ((PH_MASK & 2) != 0) {
        pg8::Gemm g{(const bf16_t*)(ws + WS_XB), (const bf16_t*)(ws + WS_BT0), NTOK, N_IN0, DM};
        pg8::StaticOrder S; S.init(NTOK, N_IN0, G, bid);
        EpiIn E{0, ws};
        for (int rep = 0; rep < NREP(1); ++rep) pg8::gemm_phase<EpiIn, pg8::StaticOrder, true, true>(lds, g, S, E);
    }
    xcd_barrier(xbar);

    if constexpr ((PH_MASK & 4) != 0) {
        PHASE_IDS();
        LAS float* km = (LAS float*)(lds + 8 * TBUF);
        LAS unsigned char* buf = lds + wid * TBUF;
        const float* kmp = (const float*)(ws + WS_KMP);
#define P2_DECODE(it_) const int itt = (it_) & 511, j = itt >> 8, c = itt & 255, xcd = c & 7, slot = c >> 3, idx = j * 32 + slot;   \
                       const int bh = xcd * 8 + (idx >> 3), sub = idx & 7; (void)j
#define P2_STAGE_KM(tab_, bh_) do { for (int e = tid; e < 1024; e += NTHREADS) km[(tab_) * 1024 + e] = kmp[(size_t)(bh_) * 1024 + e] + kmp[(size_t)(64 + (bh_)) * 1024 + e]; } while (0)
        for (int rep = 0; rep < 2; ++rep) {
            if (rep == 0 || NREP(2) == 2) {
                __syncthreads();
                { int k = 0; for (int it = bid; it < 512 && k < 2; it += G, ++k) { P2_DECODE(it); (void)sub; P2_STAGE_KM(k, bh); } }
                __syncthreads();
                int k = 0;
                for (int it = bid; it < 512; it += G, ++k) {
                    P2_DECODE(it);
                    if (k >= 2) { __syncthreads(); P2_STAGE_KM(k & 1, bh); __syncthreads(); }
                    const bool lo = (wid < 4) != ((k & 1) != 0);
                    attn_b_item(ws, buf, lds + 82944 + wid * TBUF, (LAS unsigned*)(lds + 81920 + wid * 128), km + (k & 1) * 1024, bh, lo ? sub : 15 - sub, (k & 1) ? 3 - (wid & 3) : (wid & 3)  , lane);
                }
            }
            if (rep == 0 || NREP(7) == 2) {
                for (int it = 512 + bid; it < 1024; it += G) {
                    P2_DECODE(it);
                    attn_a_y(ws, buf, bh, sub * 512 + wid * 64, lane);
                    __syncthreads();
                    attn_a_x(ws, buf, bh, wid, sub * 32, lane);
                }
            }
        }
#undef P2_DECODE
#undef P2_STAGE_KM
    }
    xcd_barrier(xbar);

    if constexpr ((PH_MASK & 8) != 0) {
        pg8::Gemm g{(const bf16_t*)(ws + WS_Y), (const bf16_t*)(ws + WS_BT1), NTOK, DM, DM};
        pg8::StaticOrder S; S.init(NTOK, DM, G, bid);
        EpiOut E{P.x, (float*)(ws + WS_X1), (bf16_t*)(ws + WS_X1B), (float*)(ws + WS_SSQ)};
        for (int rep = 0; rep < NREP(3); ++rep) pg8::gemm_phase<EpiOut, pg8::StaticOrder, true, true>(lds, g, S, E);
    }
    xcd_barrier(xbar);

    if constexpr ((PH_MASK & 16) != 0) {
        pg8::Gemm g{(const bf16_t*)(ws + WS_X1B), (const bf16_t*)(ws + WS_BT2), NTOK, N_IN1, DM};
        pg8::StaticOrder S; S.init(NTOK, N_IN1, G, bid);
        EpiIn E{1, ws};
        for (int rep = 0; rep < NREP(4); ++rep) pg8::gemm_phase<EpiIn, pg8::StaticOrder, true, true>(lds, g, S, E);
    }
    xcd_barrier(xbar);

    if constexpr ((PH_MASK & 32) != 0) {
        PHASE_IDS();
#define P5_DECODE(it_, b_, hq_, ch_) do { const int j_ = (it_) >> 8, c_ = (it_) & 255, idx_ = j_ * 32 + (c_ >> 3)  , bkv_ = (c_ & 7) * 2 + (idx_ >> 6), rem_ = idx_ & 63; \
        (b_) = bkv_ >> 1; (hq_) = (bkv_ & 1) * 8 + 2 * (rem_ >> 4); (ch_) = rem_ & 15; } while (0)
        for (int rep = 0; rep < NREP(5); ++rep) {
            bf16x8 qfa[4], qfb[4]; TileRegs tr;
            if (bid < 1024) { int b0, hq0, ch0; P5_DECODE(bid, b0, hq0, ch0); c_item_first_loads(ws, b0, hq0, ch0, wid, lane, qfa, qfb, tr); }
            for (int it = bid; it < 1024; it += G) {
                int b1, hq1, ch1; P5_DECODE(it, b1, hq1, ch1);
                const bool hasn = (it + G) < 1024;
                int b2 = b1, hq2 = hq1, ch2 = ch1; if (hasn) P5_DECODE(it + G, b2, hq2, ch2);
                attn_c_item(ws, lds + wid * TBUF, b1, hq1, ch1, wid, lane, qfa, qfb, tr, hasn, b2, hq2, ch2);
            }
        }
#undef P5_DECODE
    }
    xcd_barrier(xbar);

    if constexpr ((PH_MASK & 64) != 0) {
        pg8::Gemm g{(const bf16_t*)(ws + WS_Y), (const bf16_t*)(ws + WS_BT3), NTOK, DM, DM};
        pg8::StaticOrder S; S.init(NTOK, DM, G, bid);
        EpiOut E{(const float*)(ws + WS_X1), P.out, nullptr, nullptr};
        for (int rep = 0; rep < NREP(6); ++rep) pg8::gemm_phase<EpiOut, pg8::StaticOrder, true, true>(lds, g, S, E);
    }
}

extern "C" void kernel_launch(void* const* d_in, const int* in_sizes, int n_in, void* d_out, int out_size, void* d_ws, size_t ws_size, hipStream_t stream) {
    static int grid_blocks = 0;
    if (grid_blocks == 0) {
        if (n_in != 14 || in_sizes[0] != NTOK * DM || out_size != NTOK * DM || ws_size < WS_END) {
            fprintf(stderr, "kernel_launch: unexpected shapes (n_in %d in0 %d out %d ws %zu)\n", n_in, n_in > 0 ? in_sizes[0] : -1, out_size, ws_size); grid_blocks = -1; return; }
        int dev = 0, cus = 0, per_cu = 0;
        hipGetDevice(&dev);
        hipDeviceGetAttribute(&cus, hipDeviceAttributeMultiprocessorCount, dev);
        if (hipFuncSetAttribute((const void*)fwd_megakernel, hipFuncAttributeMaxDynamicSharedMemorySize, LDS_BYTES) != hipSuccess) {
            fprintf(stderr, "kernel_launch: hipFuncSetAttribute failed\n"); grid_blocks = -1; return; }
        if (hipOccupancyMaxActiveBlocksPerMultiprocessor(&per_cu, (const void*)fwd_megakernel, NTHREADS, LDS_BYTES) != hipSuccess || per_cu < 1) {
            fprintf(stderr, "kernel_launch: occupancy query gave %d\n", per_cu); per_cu = 1; (void)hipGetLastError(); }
        grid_blocks = cus * 1;
        if (per_cu < 1) grid_blocks = -1;
    }
    if (grid_blocks < 0) return;
    Params p{};
    p.x = (const float*)d_in[0]; p.norm_even = (const float*)d_in[1]; p.w_in_even = (const float*)d_in[2]; p.w_out_even = (const float*)d_in[3];
    p.qn_a = (const float*)d_in[4]; p.kn_a = (const float*)d_in[5]; p.qn_b = (const float*)d_in[6]; p.kn_b = (const float*)d_in[7];
    p.norm_odd = (const float*)d_in[8]; p.w_in_odd = (const float*)d_in[9]; p.w_out_odd = (const float*)d_in[10];
    p.qn_c = (const float*)d_in[11]; p.kn_c = (const float*)d_in[12]; p.sinks = (const float*)d_in[13];
    p.out = (float*)d_out; p.ws = (unsigned char*)d_ws;
    if (hipMemsetAsync((unsigned char*)d_ws + WS_BAR, 0, XCD_BAR_WORDS * 4, stream) != hipSuccess) { fprintf(stderr, "kernel_launch: memset failed\n"); return; }
    void* args[] = {&p};
    hipError_t e = hipLaunchCooperativeKernel((const void*)fwd_megakernel, dim3(grid_blocks), dim3(NTHREADS), args, LDS_BYTES, stream);
    if (e != hipSuccess) fprintf(stderr, "cooperative launch failed: %s (grid %d)\n", hipGetErrorString(e), grid_blocks);
}
```
